# Optimizing an MI355X kernel written in HIP

```python
import jax, jax.numpy as jnp
from jax import lax
import numpy as np

D_MODEL = 1024
BATCH = 2
SEQ = 8192
DEPTH = 1
DEC_BATCH = 32
DEC_SEQ = 16
PAST_LEN = 2048

CHUNK = 64
N_META = 16
NORM_EPS = 1e-6
RW_HEADS = 16
RW_HEAD_DIM = 64
RW_WIDTH = RW_HEADS * RW_HEAD_DIM
RW_DECAY_RANK = 64
RW_A_RANK = 64
RW_SHIFT_WIDTH = 3 * RW_WIDTH + RW_DECAY_RANK + RW_A_RANK
RW_GN_EPS = 64e-5
GD_HEADS = 8
GD_HEAD_DIM = 128
GD_WIDTH = GD_HEADS * GD_HEAD_DIM
GD_CONV = 4
GD_CONV_WIDTH = 3 * GD_WIDTH
N_BRANCH = 2
OFF_RW_SHIFT = 0
OFF_RW_GATE = OFF_RW_SHIFT + RW_SHIFT_WIDTH
OFF_GD_CONV = OFF_RW_GATE + RW_WIDTH
OFF_GD_BETA = OFF_GD_CONV + GD_CONV_WIDTH
OFF_GD_ALPHA = OFF_GD_BETA + GD_HEADS
OFF_GD_GATE = OFF_GD_ALPHA + GD_HEADS
OFF_MERGE = OFF_GD_GATE + GD_WIDTH
PROJ_WIDTH = OFF_MERGE + N_BRANCH * D_MODEL

kernel_name = 'rwkv7_gdn_gated_merge_stream_step'


def rmsnorm(x, gain, eps=NORM_EPS):
    xf = x.astype(jnp.float32)
    y = xf * lax.rsqrt(jnp.mean(xf * xf, axis=-1, keepdims=True) + eps)
    return (y * gain.astype(jnp.float32)).astype(x.dtype)


def l2norm(x, eps=1e-6):
    return x * lax.rsqrt(jnp.sum(x * x, axis=-1, keepdims=True) + eps)


def _heads(t, n_heads):
    return t.reshape(t.shape[:-1] + (n_heads, -1))


def rwkv7_branch(xs, gate, S0, p):
    B, T, _ = xs.shape
    f32 = jnp.float32
    xs = xs.astype(f32)
    r, k, v, wl, al = jnp.split(xs, [RW_WIDTH, 2 * RW_WIDTH, 3 * RW_WIDTH, 3 * RW_WIDTH + RW_DECAY_RANK], axis=-1)
    w_log = -jax.nn.softplus(-(p['rw_w0'] + jnp.tanh(wl) @ p['rw_w2'])) - 0.5
    decay = jnp.exp(-jnp.exp(w_log))
    a = jax.nn.sigmoid(p['rw_a0'] + al @ p['rw_a2'])
    kk = l2norm(_heads(k * p['rw_k_k'], RW_HEADS))
    k = k * (1.0 + (a - 1.0) * p['rw_k_a'])
    r, k, v, decay, a = (_heads(t, RW_HEADS) for t in (r, k, v, decay, a))

    def step(S, inp):
        r_t, w_t, k_t, v_t, a_t, b_t = inp
        sa = jnp.einsum('bhvk,bhk->bhv', S, a_t)
        S = S * w_t[:, :, None, :] + sa[..., None] * b_t[:, :, None, :] + v_t[..., None] * k_t[:, :, None, :]
        return S, jnp.einsum('bhvk,bhk->bhv', S, r_t)

    time_major = lambda t: jnp.moveaxis(t, 1, 0)
    S, y = lax.scan(step, S0.astype(f32), tuple(time_major(t) for t in (r, decay, k, v, -kk, kk * a)))
    y = jnp.moveaxis(y, 0, 1)
    mean = jnp.mean(y, axis=-1, keepdims=True)
    var = jnp.mean(jnp.square(y - mean), axis=-1, keepdims=True)
    y = ((y - mean) * lax.rsqrt(var + RW_GN_EPS)).reshape(B, T, RW_WIDTH) * p['rw_ln_w'] + p['rw_ln_b']
    bonus = jnp.sum(r * k * p['rw_r_k'], axis=-1, keepdims=True) * v
    y = (y + bonus.reshape(B, T, RW_WIDTH)) * jax.nn.silu(gate.astype(f32))
    return y, S


def gdn_chunk(S, inp):
    q, k, v, g, beta = inp
    L = q.shape[1]
    q, k, v = (jnp.swapaxes(t, 1, 2) for t in (q, k, v))
    g, beta = jnp.swapaxes(g, 1, 2), jnp.swapaxes(beta, 1, 2)
    G = jnp.cumsum(g, axis=-1)
    idx = jnp.arange(L)
    incl = idx[:, None] >= idx[None, :]
    strict = idx[:, None] > idx[None, :]
    decay = jnp.exp(jnp.where(incl, G[..., :, None] - G[..., None, :], -jnp.inf))
    kk = jnp.einsum('bhik,bhjk->bhij', k, k)
    A = jnp.eye(L, dtype=jnp.float32) + jnp.where(strict, beta[..., :, None] * decay * kk, 0.0)
    rhs = jnp.concatenate([(beta * jnp.exp(G))[..., None] * k, beta[..., None] * v], axis=-1)
    sol = lax.linalg.triangular_solve(A, rhs, left_side=True, lower=True, unit_diagonal=True)
    W, U = sol[..., :GD_HEAD_DIM], sol[..., GD_HEAD_DIM:]
    delta = U - jnp.einsum('bhik,bhkv->bhiv', W, S)
    qk = jnp.einsum('bhik,bhjk->bhij', q, k) * decay
    o = jnp.exp(G)[..., None] * jnp.einsum('bhik,bhkv->bhiv', q, S) + jnp.einsum('bhij,bhjv->bhiv', qk, delta)
    G_last = G[..., -1:]
    S_new = jnp.exp(G_last)[..., None] * S + jnp.einsum('bhjk,bhjv->bhkv', k * jnp.exp(G_last - G)[..., None], delta)
    return S_new, jnp.swapaxes(o, 1, 2)


def gdn_sequence(S, q, k, v, g, beta, n_lead):
    B = q.shape[0]
    outs = []
    if n_lead:
        S, o = gdn_chunk(S, tuple(t[:, :n_lead] for t in (q, k, v, g, beta)))
        outs.append(o)
    rest = [t[:, n_lead:] for t in (q, k, v, g, beta)]
    T = rest[0].shape[1]
    L = min(CHUNK, T)
    n = T // L
    to_blocks = lambda t: jnp.moveaxis(t.reshape((B, n, L) + t.shape[2:]), 1, 0)
    S, o = lax.scan(gdn_chunk, S, tuple(to_blocks(t) for t in rest))
    outs.append(jnp.moveaxis(o, 0, 1).reshape((B, T) + o.shape[3:]))
    return jnp.concatenate(outs, axis=1), S


def gdn_branch(conv_in, conv_prev, beta_logit, alpha_logit, gate, S0, n_lead, p):
    B, T, _ = conv_in.shape
    f32 = jnp.float32
    xp = jnp.concatenate([conv_prev.astype(conv_in.dtype), conv_in], axis=1)
    w = p['gd_conv_w']
    conv = sum(w[i] * xp[:, i:i + T] for i in range(GD_CONV))
    conv_new = xp[:, T:]
    act = jax.nn.silu(conv.astype(f32))
    q, k, v = (_heads(t, GD_HEADS) for t in jnp.split(act, 3, axis=-1))
    q = l2norm(q) * GD_HEAD_DIM ** -0.5
    k = l2norm(k)
    beta = jax.nn.sigmoid(beta_logit.astype(f32))
    g = -jnp.exp(p['gd_a_log'].astype(f32)) * jax.nn.softplus(alpha_logit.astype(f32) + p['gd_dt_bias'])
    o, S = gdn_sequence(S0.astype(f32), q, k, v, g, beta, n_lead)
    o = rmsnorm(o, p['gd_norm_w']).reshape(B, T, GD_WIDTH) * jax.nn.silu(gate.astype(f32))
    return o, conv_new, S


def trunk_layer(h, n_lead, shift_prev, conv_prev, s_rw, s_gd, p):
    B, T, _ = h.shape
    xn = rmsnorm(h, p['norm_pre'])
    proj = xn @ p['w_in']
    ps = proj[..., OFF_RW_SHIFT:OFF_RW_GATE]
    prev = jnp.concatenate([shift_prev[:, None, :].astype(ps.dtype), ps[:, :-1]], axis=1)
    xs = ps + p['rw_mu'] * (prev - ps)
    y_rw, s_rw_new = rwkv7_branch(xs, proj[..., OFF_RW_GATE:OFF_GD_CONV], s_rw, p)
    y_gd, conv_new, s_gd_new = gdn_branch(proj[..., OFF_GD_CONV:OFF_GD_BETA], conv_prev,
                                          proj[..., OFF_GD_BETA:OFF_GD_ALPHA], proj[..., OFF_GD_ALPHA:OFF_GD_GATE],
                                          proj[..., OFF_GD_GATE:OFF_MERGE], s_gd, n_lead, p)
    gates = jax.nn.sigmoid(proj[..., OFF_MERGE:].astype(jnp.float32)).reshape(B, T, N_BRANCH, D_MODEL)
    merged = gates[..., 0, :] * (y_rw @ p['w_out_a']) + gates[..., 1, :] * (y_gd @ p['w_out_b'])
    out = (merged @ p['w_out']).astype(h.dtype)
    h = h + rmsnorm(out, p['norm_post'])
    dt = h.dtype
    return h, (ps[:, -1].astype(dt), s_rw_new.astype(dt), conv_new.astype(dt), s_gd_new.astype(dt))


def setup_inputs(seed: int = 0) -> dict:
    key = jax.random.key(seed)
    ks = iter(jax.random.split(key, 32))
    nrm = lambda shape, s: jax.random.normal(next(ks), shape, jnp.float32) * s
    unif = lambda shape, lo, hi: jax.random.uniform(next(ks), shape, jnp.float32, lo, hi)
    Ly = (DEPTH,)
    return {
        'x_prompt': nrm((BATCH, SEQ, D_MODEL), 1.0),
        'x_sample': nrm((DEC_BATCH, DEC_SEQ, D_MODEL), 1.0),
        'state_rwkv_shift': nrm(Ly + (DEC_BATCH, RW_SHIFT_WIDTH), 1.0),
        'state_rwkv_wkv': nrm(Ly + (DEC_BATCH, RW_HEADS, RW_HEAD_DIM, RW_HEAD_DIM), 0.3),
        'state_gdn_conv': nrm(Ly + (DEC_BATCH, GD_CONV - 1, GD_CONV_WIDTH), 1.0),
        'state_gdn_ssm': nrm(Ly + (DEC_BATCH, GD_HEADS, GD_HEAD_DIM, GD_HEAD_DIM), 0.1),
        'meta_tokens': nrm((N_META, D_MODEL), 1.0),
        'norm_pre': 1.0 + nrm(Ly + (D_MODEL,), 0.05),
        'w_in': nrm(Ly + (D_MODEL, PROJ_WIDTH), D_MODEL ** -0.5),
        'rw_mu': unif(Ly + (RW_SHIFT_WIDTH,), 0.0, 1.0),
        'rw_w0': nrm(Ly + (RW_WIDTH,), 0.5),
        'rw_w2': nrm(Ly + (RW_DECAY_RANK, RW_WIDTH), RW_DECAY_RANK ** -0.5),
        'rw_a0': nrm(Ly + (RW_WIDTH,), 0.5),
        'rw_a2': nrm(Ly + (RW_A_RANK, RW_WIDTH), RW_A_RANK ** -0.5),
        'rw_k_k': 0.85 + nrm(Ly + (RW_WIDTH,), 0.05),
        'rw_k_a': 1.0 + nrm(Ly + (RW_WIDTH,), 0.05),
        'rw_r_k': nrm(Ly + (RW_HEADS, RW_HEAD_DIM), 0.1),
        'rw_ln_w': 1.0 + nrm(Ly + (RW_WIDTH,), 0.05),
        'rw_ln_b': nrm(Ly + (RW_WIDTH,), 0.02),
        'gd_conv_w': nrm(Ly + (GD_CONV, GD_CONV_WIDTH), GD_CONV ** -0.5),
        'gd_a_log': jnp.log(unif(Ly + (GD_HEADS,), 1.0, 8.0)),
        'gd_dt_bias': nrm(Ly + (GD_HEADS,), 0.5) - 2.0,
        'gd_norm_w': 1.0 + nrm(Ly + (GD_HEAD_DIM,), 0.05),
        'w_out_a': nrm(Ly + (RW_WIDTH, D_MODEL), RW_WIDTH ** -0.5),
        'w_out_b': nrm(Ly + (GD_WIDTH, D_MODEL), GD_WIDTH ** -0.5),
        'w_out': nrm(Ly + (D_MODEL, D_MODEL), D_MODEL ** -0.5),
        'norm_post': 1.0 + nrm(Ly + (D_MODEL,), 0.05),
    }


def reference(x_prompt, x_sample, state_rwkv_shift, state_rwkv_wkv, state_gdn_conv, state_gdn_ssm,
              meta_tokens, norm_pre, w_in, rw_mu, rw_w0, rw_w2, rw_a0, rw_a2, rw_k_k, rw_k_a, rw_r_k,
              rw_ln_w, rw_ln_b, gd_conv_w, gd_a_log, gd_dt_bias, gd_norm_w, w_out_a, w_out_b, w_out, norm_post):
    Bp = x_prompt.shape[0]
    dtp = x_prompt.dtype
    meta = jnp.broadcast_to(meta_tokens.astype(dtp)[None], (Bp, N_META, D_MODEL))
    hp = jnp.concatenate([meta, x_prompt], axis=1)
    hs = x_sample
    p_states = [[], [], [], []]
    s_states = [[], [], [], []]
    for l in range(DEPTH):
        p = {
            'norm_pre': norm_pre[l], 'w_in': w_in[l], 'rw_mu': rw_mu[l], 'rw_w0': rw_w0[l], 'rw_w2': rw_w2[l],
            'rw_a0': rw_a0[l], 'rw_a2': rw_a2[l], 'rw_k_k': rw_k_k[l], 'rw_k_a': rw_k_a[l], 'rw_r_k': rw_r_k[l],
            'rw_ln_w': rw_ln_w[l], 'rw_ln_b': rw_ln_b[l], 'gd_conv_w': gd_conv_w[l], 'gd_a_log': gd_a_log[l],
            'gd_dt_bias': gd_dt_bias[l], 'gd_norm_w': gd_norm_w[l], 'w_out_a': w_out_a[l], 'w_out_b': w_out_b[l],
            'w_out': w_out[l], 'norm_post': norm_post[l],
        }
        hp, new_p = trunk_layer(
            hp, N_META,
            jnp.zeros((Bp, RW_SHIFT_WIDTH), dtp),
            jnp.zeros((Bp, GD_CONV - 1, GD_CONV_WIDTH), dtp),
            jnp.zeros((Bp, RW_HEADS, RW_HEAD_DIM, RW_HEAD_DIM), jnp.float32),
            jnp.zeros((Bp, GD_HEADS, GD_HEAD_DIM, GD_HEAD_DIM), jnp.float32),
            p)
        hs, new_s = trunk_layer(hs, 0, state_rwkv_shift[l], state_gdn_conv[l], state_rwkv_wkv[l], state_gdn_ssm[l], p)
        for i in range(4):
            p_states[i].append(new_p[i])
            s_states[i].append(new_s[i])
    p_shift, p_wkv, p_conv, p_ssm = (jnp.stack(t, axis=0) for t in p_states)
    s_shift, s_wkv, s_conv, s_ssm = (jnp.stack(t, axis=0) for t in s_states)
    y_prompt = hp[:, N_META:]
    y_sample = hs
    return (y_prompt, y_sample, p_shift, p_wkv, p_conv, p_ssm, s_shift, s_wkv, s_conv, s_ssm)
```

```cpp
#include <hip/hip_runtime.h>
#include <hip/hip_cooperative_groups.h>
#include <stdint.h>
#include <stdio.h>
namespace cg = cooperative_groups;

#ifndef MEGA
#define MEGA 0
#endif

typedef unsigned short bf16_t;
using bf16x8 = __attribute__((ext_vector_type(8))) short;
using f32x4 = __attribute__((ext_vector_type(4))) float;
using u32x4 = __attribute__((ext_vector_type(4))) unsigned int;

#define DM 1024
#define PW 10384
#define PWP 10496
#define NSEG 8
#define M0 2592
#define MP0 2688
#define M1 2048
#define C_RWG 3200
#define C_GDC 4224
#define C_BETA 7296
#define C_ALPHA 7304
#define C_GDG 7312
#define C_MA 8336
#define C_MB 9360

struct Params {
  const float *x_prompt, *x_sample, *st_shift, *st_wkv, *st_conv, *st_ssm, *meta, *norm_pre, *w_in, *rw_mu, *rw_w0,
      *rw_w2, *rw_a0, *rw_a2, *rw_k_k, *rw_k_a, *rw_r_k, *rw_ln_w, *rw_ln_b, *gd_conv_w, *gd_a_log, *gd_dt_bias,
      *gd_norm_w, *w_out_a, *w_out_b, *w_out, *norm_post;
  float *y_prompt, *y_sample, *p_shift, *p_wkv, *p_conv, *p_ssm, *s_shift, *s_wkv, *s_conv, *s_ssm;
  bf16_t *WtIn, *WtA, *WtB, *WtO, *XN, *PJ, *YA, *YB, *MG;
  float *RWP, *RWB, *GDP, *YRW, *OGD, *TMP, *OUTB, *CSH, *CCV;
};

__device__ __forceinline__ bf16_t f2bf(float f) {
  uint32_t u = __float_as_uint(f);
  u += 0x7fffu + ((u >> 16) & 1u);
  return (bf16_t)(u >> 16);
}
__device__ __forceinline__ float bf2f(bf16_t h) { return __uint_as_float(((uint32_t)h) << 16); }
__device__ __forceinline__ uint32_t pack2(float a, float b) { return (uint32_t)f2bf(a) | ((uint32_t)f2bf(b) << 16); }
__device__ __forceinline__ float sigmoidf_(float x) { return 1.0f / (1.0f + __expf(-x)); }
__device__ __forceinline__ float siluf_(float x) { return x / (1.0f + __expf(-x)); }
__device__ __forceinline__ float softplusf_(float x) { return fmaxf(x, 0.0f) + log1pf(__expf(-fabsf(x))); }

template <int CTRL>
__device__ __forceinline__ float dppf(float x) {
  return __builtin_bit_cast(float, __builtin_amdgcn_update_dpp(0, __builtin_bit_cast(int, x), CTRL, 0xf, 0xf, true));
}
__device__ __forceinline__ float rowsum16(float x) {
  x += dppf<0xB1>(x);
  x += dppf<0x4E>(x);
  x += dppf<0x141>(x);
  x += dppf<0x140>(x);
  return x;
}
__device__ __forceinline__ float wavesum(float x) {
  x = rowsum16(x);
  x += __shfl_xor(x, 16);
  x += __shfl_xor(x, 32);
  return x;
}

__device__ __forceinline__ int seg_M(int seg) { return seg == 0 ? M0 : M1; }
__device__ __forceinline__ int seg_MP(int seg) { return seg == 0 ? MP0 : M1; }
__device__ __forceinline__ const float* row_src(const Params& p, int seg, int r) {
  if (seg == 0) {
    if (r < 2080) {
      int b = r >= 1040 ? 1 : 0, t = r - b * 1040;
      if (t < 16) return p.meta + t * DM;
      return p.x_prompt + ((size_t)b * 8192 + (t - 16)) * DM;
    }
    return p.x_sample + (size_t)(r - 2080) * DM;
  }
  int b = r >> 10, t = r & 1023;
  return p.x_prompt + ((size_t)b * 8192 + seg * 1024 + t) * DM;
}
__device__ __forceinline__ float* row_dst(const Params& p, int seg, int r) {
  if (seg == 0) {
    if (r < 2080) {
      int b = r >= 1040 ? 1 : 0, t = r - b * 1040;
      if (t < 16) return nullptr;
      return p.y_prompt + ((size_t)b * 8192 + (t - 16)) * DM;
    }
    return p.y_sample + (size_t)(r - 2080) * DM;
  }
  int b = r >> 10, t = r & 1023;
  return p.y_prompt + ((size_t)b * 8192 + seg * 1024 + t) * DM;
}
__device__ __forceinline__ void row_seq(int seg, int r, int& seq, int& t, int& len) {
  if (seg == 0) {
    if (r < 1040) { seq = 0; t = r; len = 1040; }
    else if (r < 2080) { seq = 1; t = r - 1040; len = 1040; }
    else { seq = 2 + ((r - 2080) >> 4); t = (r - 2080) & 15; len = 16; }
  } else { seq = r >> 10; t = r & 1023; len = 1024; }
}
__device__ __forceinline__ void seq_info(int seg, int seq, int& base, int& len) {
  if (seg == 0) {
    if (seq < 2) { base = seq * 1040; len = 1040; }
    else { base = 2080 + (seq - 2) * 16; len = 16; }
  } else { base = seq * 1024; len = 1024; }
}

__device__ void transpose_tile(const float* __restrict__ src, int ld, int nvalid, bf16_t* __restrict__ dst, int k0, int n0,
                               float* tile  ) {
  int tid = threadIdx.x;
  int i = tid >> 4, j = tid & 15;
  __syncthreads();
#pragma unroll
  for (int pass = 0; pass < 4; pass++) {
    int k = pass * 16 + i;
    int n = n0 + 4 * j;
    float4 v = make_float4(0.f, 0.f, 0.f, 0.f);
    if (n < nvalid) v = *(const float4*)(src + (size_t)(k0 + k) * ld + n);
    tile[k * 65 + 4 * j + 0] = v.x; tile[k * 65 + 4 * j + 1] = v.y; tile[k * 65 + 4 * j + 2] = v.z; tile[k * 65 + 4 * j + 3] = v.w;
  }
  __syncthreads();
  int n = tid >> 2, kq = tid & 3;
  uint32_t o[8];
#pragma unroll
  for (int e = 0; e < 8; e++) o[e] = pack2(tile[(kq * 16 + 2 * e) * 65 + n], tile[(kq * 16 + 2 * e + 1) * 65 + n]);
  uint4* d = (uint4*)(dst + (size_t)(n0 + n) * DM + k0 + kq * 16);
  d[0] = make_uint4(o[0], o[1], o[2], o[3]);
  d[1] = make_uint4(o[4], o[5], o[6], o[7]);
}
__device__ void phase_weights(const Params& p, int bid, int nb, char* smem) {
  float* tile = (float*)smem;
  const int nIn = 16 * (PWP / 64);
  const int nSq = 16 * 16;
  for (int it = bid; it < nIn + 3 * nSq; it += nb) {
    if (it < nIn) {
      int kt = it & 15, nt = it >> 4;
      transpose_tile(p.w_in, PW, PW, p.WtIn, kt * 64, nt * 64, tile);
    } else {
      int j = it - nIn, w = j / nSq, r = j % nSq;
      int kt = r & 15, nt = r >> 4;
      const float* src = w == 0 ? p.w_out_a : (w == 1 ? p.w_out_b : p.w_out);
      bf16_t* dst = w == 0 ? p.WtA : (w == 1 ? p.WtB : p.WtO);
      transpose_tile(src, DM, DM, dst, kt * 64, nt * 64, tile);
    }
  }
}

__device__ void phase_xn(const Params& p, int seg, int bid, int nb) {
  int wave = threadIdx.x >> 6, lane = threadIdx.x & 63;
  int M = seg_M(seg), MP = seg_MP(seg);
  for (int r = bid * 4 + wave; r < MP; r += nb * 4) {
    bf16_t* o = p.XN + (size_t)r * DM;
    if (r >= M) {
#pragma unroll
      for (int i = 0; i < 4; i++) *(uint2*)(o + (lane + 64 * i) * 4) = make_uint2(0u, 0u);
      continue;
    }
    const float4* src = (const float4*)row_src(p, seg, r);
    float4 v[4];
    float ss = 0.f;
#pragma unroll
    for (int i = 0; i < 4; i++) {
      v[i] = src[lane + 64 * i];
      ss += v[i].x * v[i].x + v[i].y * v[i].y + v[i].z * v[i].z + v[i].w * v[i].w;
    }
    ss = wavesum(ss);
    float rstd = rsqrtf(ss * (1.0f / DM) + 1e-6f);
#pragma unroll
    for (int i = 0; i < 4; i++) {
      float4 g = ((const float4*)p.norm_pre)[lane + 64 * i];
      *(uint2*)(o + (lane + 64 * i) * 4) =
          make_uint2(pack2(v[i].x * rstd * g.x, v[i].y * rstd * g.y), pack2(v[i].z * rstd * g.z, v[i].w * rstd * g.w));
    }
  }
}

#define LDT 72
template <int MODE>
__device__ void gemm_phase(const Params& p, const bf16_t* __restrict__ A, const bf16_t* __restrict__ Bt, int tilesM, int tilesN,
                           int bid, int nb, char* smem) {
  bf16_t* sA = (bf16_t*)smem;
  bf16_t* sB = sA + 128 * LDT;
  const int tid = threadIdx.x, lane = tid & 63, wid = tid >> 6;
  const int wr = wid >> 1, wc = wid & 1, fr = lane & 15, fq = lane >> 4;
  const int lrow = tid >> 3, lkc = tid & 7;
  for (int tile = bid; tile < tilesM * tilesN; tile += nb) {
    const int m0 = (tile % tilesM) * 128, n0 = (tile / tilesM) * 128;
    f32x4 acc[4][4];
#pragma unroll
    for (int a = 0; a < 4; a++)
#pragma unroll
      for (int b = 0; b < 4; b++) acc[a][b] = (f32x4){0.f, 0.f, 0.f, 0.f};
    u32x4 ra[4], rb[4];
    const bf16_t* gA = A + (size_t)(m0 + lrow) * DM + lkc * 8;
    const bf16_t* gB = Bt + (size_t)(n0 + lrow) * DM + lkc * 8;
#pragma unroll
    for (int i = 0; i < 4; i++) {
      ra[i] = *(const u32x4*)(gA + (size_t)i * 32 * DM);
      rb[i] = *(const u32x4*)(gB + (size_t)i * 32 * DM);
    }
    for (int kt = 0; kt < 16; kt++) {
      __syncthreads();
#pragma unroll
      for (int i = 0; i < 4; i++) {
        *(u32x4*)(sA + (lrow + 32 * i) * LDT + lkc * 8) = ra[i];
        *(u32x4*)(sB + (lrow + 32 * i) * LDT + lkc * 8) = rb[i];
      }
      __syncthreads();
      if (kt + 1 < 16) {
#pragma unroll
        for (int i = 0; i < 4; i++) {
          ra[i] = *(const u32x4*)(gA + (size_t)i * 32 * DM + (kt + 1) * 64);
          rb[i] = *(const u32x4*)(gB + (size_t)i * 32 * DM + (kt + 1) * 64);
        }
      }
#pragma unroll
      for (int kk = 0; kk < 2; kk++) {
        bf16x8 xa[4], wb[4];
#pragma unroll
        for (int i = 0; i < 4; i++) {
          xa[i] = *(const bf16x8*)(sA + (wr * 64 + i * 16 + fr) * LDT + kk * 32 + fq * 8);
          wb[i] = *(const bf16x8*)(sB + (wc * 64 + i * 16 + fr) * LDT + kk * 32 + fq * 8);
        }
#pragma unroll
        for (int ni = 0; ni < 4; ni++)
#pragma unroll
          for (int mi = 0; mi < 4; mi++)
            acc[ni][mi] = __builtin_amdgcn_mfma_f32_16x16x32_bf16(wb[ni], xa[mi], acc[ni][mi], 0, 0, 0);
      }
    }
#pragma unroll
    for (int ni = 0; ni < 4; ni++)
#pragma unroll
      for (int mi = 0; mi < 4; mi++) {
        const int m = m0 + wr * 64 + mi * 16 + fr;
        const int n = n0 + wc * 64 + ni * 16 + fq * 4;
        f32x4 c = acc[ni][mi];
        if (MODE == 0) {
          *(uint2*)(p.PJ + (size_t)m * PWP + n) = make_uint2(pack2(c[0], c[1]), pack2(c[2], c[3]));
        } else if (MODE == 1) {
          uint2 g = *(const uint2*)(p.PJ + (size_t)m * PWP + C_MA + n);
          float4 o;
          o.x = sigmoidf_(bf2f(g.x & 0xffff)) * c[0];
          o.y = sigmoidf_(bf2f(g.x >> 16)) * c[1];
          o.z = sigmoidf_(bf2f(g.y & 0xffff)) * c[2];
          o.w = sigmoidf_(bf2f(g.y >> 16)) * c[3];
          *(float4*)(p.TMP + (size_t)m * DM + n) = o;
        } else if (MODE == 2) {
          uint2 g = *(const uint2*)(p.PJ + (size_t)m * PWP + C_MB + n);
          float4 t = *(const float4*)(p.TMP + (size_t)m * DM + n);
          float o0 = t.x + sigmoidf_(bf2f(g.x & 0xffff)) * c[0];
          float o1 = t.y + sigmoidf_(bf2f(g.x >> 16)) * c[1];
          float o2 = t.z + sigmoidf_(bf2f(g.y & 0xffff)) * c[2];
          float o3 = t.w + sigmoidf_(bf2f(g.y >> 16)) * c[3];
          *(uint2*)(p.MG + (size_t)m * DM + n) = make_uint2(pack2(o0, o1), pack2(o2, o3));
        } else {
          *(float4*)(p.OUTB + (size_t)m * DM + n) = make_float4(c[0], c[1], c[2], c[3]);
        }
      }
  }
}

__device__ void rw_prepass_item(const Params& p, int seg, int grp, int slab, char* smem) {
  float* lwa = (float*)smem;
  const int tid = threadIdx.x;
  const int r0 = grp * 16;
  int seq, t0, len;
  row_seq(seg, r0, seq, t0, len);
  const bool prompt = seq < 2;
  const float* prev0 = nullptr;
  if (t0 == 0) {
    if (seg == 0) prev0 = prompt ? nullptr : p.st_shift + (size_t)(seq - 2) * 3200;
    else prev0 = p.CSH + ((size_t)(seg & 1) * 2 + seq) * 3200;
  }
  __syncthreads();
  {
    const int j = tid & 127;
    const float mu = p.rw_mu[3072 + j];
#pragma unroll
    for (int i = 0; i < 8; i++) {
      int tok = (tid >> 7) + 2 * i;
      int row = r0 + tok;
      float ps = bf2f(p.PJ[(size_t)row * PWP + 3072 + j]);
      float pv;
      if (tok == 0 && t0 == 0) pv = prev0 ? prev0[3072 + j] : 0.f;
      else pv = bf2f(p.PJ[(size_t)(row - 1) * PWP + 3072 + j]);
      float xs = ps + mu * (pv - ps);
      lwa[tok * 128 + j] = j < 64 ? tanhf(xs) : xs;
      if (slab == 0 && t0 + tok == len - 1) {
        if (prompt) {
          p.CSH[((size_t)((seg + 1) & 1) * 2 + seq) * 3200 + 3072 + j] = ps;
          if (seg == NSEG - 1) p.p_shift[(size_t)seq * 3200 + 3072 + j] = ps;
        } else {
          p.s_shift[(size_t)(seq - 2) * 3200 + 3072 + j] = ps;
        }
      }
    }
  }
  __syncthreads();
  const int c = slab * 256 + tid;
  float dw[16], da[16];
  {
    const float w0 = p.rw_w0[c], a0 = p.rw_a0[c];
#pragma unroll
    for (int t = 0; t < 16; t++) { dw[t] = w0; da[t] = a0; }
  }
  for (int j = 0; j < 64; j += 4) {
    float w2v[4], a2v[4];
#pragma unroll
    for (int e = 0; e < 4; e++) {
      w2v[e] = p.rw_w2[(size_t)(j + e) * DM + c];
      a2v[e] = p.rw_a2[(size_t)(j + e) * DM + c];
    }
#pragma unroll
    for (int t = 0; t < 16; t++) {
      float4 lw = *(const float4*)(lwa + t * 128 + j);
      float4 la = *(const float4*)(lwa + t * 128 + 64 + j);
      dw[t] += lw.x * w2v[0] + lw.y * w2v[1] + lw.z * w2v[2] + lw.w * w2v[3];
      da[t] += la.x * a2v[0] + la.y * a2v[1] + la.z * a2v[2] + la.w * a2v[3];
    }
  }
  const float mur = p.rw_mu[c], muk = p.rw_mu[1024 + c], muv = p.rw_mu[2048 + c];
  const float kk_w = p.rw_k_k[c], ka_w = p.rw_k_a[c], rk_w = p.rw_r_k[c];
  float pr, pk, pv;
  if (t0 == 0) {
    pr = prev0 ? prev0[c] : 0.f; pk = prev0 ? prev0[1024 + c] : 0.f; pv = prev0 ? prev0[2048 + c] : 0.f;
  } else {
    const bf16_t* q = p.PJ + (size_t)(r0 - 1) * PWP;
    pr = bf2f(q[c]); pk = bf2f(q[1024 + c]); pv = bf2f(q[2048 + c]);
  }
  const int head = c >> 6;
#pragma unroll
  for (int t = 0; t < 16; t++) {
    const int row = r0 + t;
    const bf16_t* q = p.PJ + (size_t)row * PWP;
    float cr = bf2f(q[c]), ck = bf2f(q[1024 + c]), cv = bf2f(q[2048 + c]);
    float xr = cr + mur * (pr - cr), xk = ck + muk * (pk - ck), xv = cv + muv * (pv - cv);
    pr = cr; pk = ck; pv = cv;
    float w_log = -softplusf_(-dw[t]) - 0.5f;
    float decay = __expf(-__expf(w_log));
    float a = sigmoidf_(da[t]);
    float kkr = xk * kk_w;
    float ss = wavesum(kkr * kkr);
    float kk = kkr * rsqrtf(ss + 1e-6f);
    float k2 = xk * (1.0f + (a - 1.0f) * ka_w);
    float bon = wavesum(xr * k2 * rk_w);
    float* o = p.RWP + (size_t)row * 6144 + c;
    o[0] = xr; o[1024] = decay; o[2048] = k2; o[3072] = xv; o[4096] = -kk; o[5120] = kk * a;
    if ((tid & 63) == 0) p.RWB[(size_t)row * 16 + head] = bon;
    if (t0 + t == len - 1) {
      if (prompt) {
        float* cs = p.CSH + ((size_t)((seg + 1) & 1) * 2 + seq) * 3200;
        cs[c] = cr; cs[1024 + c] = ck; cs[2048 + c] = cv;
        if (seg == NSEG - 1) {
          float* ps = p.p_shift + (size_t)seq * 3200;
          ps[c] = cr; ps[1024 + c] = ck; ps[2048 + c] = cv;
        }
      } else {
        float* ps = p.s_shift + (size_t)(seq - 2) * 3200;
        ps[c] = cr; ps[1024 + c] = ck; ps[2048 + c] = cv;
      }
    }
  }
}

__device__ void gd_prepass_item(const Params& p, int seg, int grp, int slab) {
  const int tid = threadIdx.x;
  const int r0 = grp * 16;
  int seq, t0, len;
  row_seq(seg, r0, seq, t0, len);
  const bool prompt = seq < 2;
  const int c = slab * 512 + 2 * tid;
  const int kind = slab >> 1;
  float2 x0, x1, x2;
  if (t0 == 0) {
    const float* cp = nullptr;
    if (seg == 0) cp = prompt ? nullptr : p.st_conv + (size_t)(seq - 2) * 3 * 3072;
    else cp = p.CCV + ((size_t)(seg & 1) * 2 + seq) * 3 * 3072;
    if (cp) {
      x0 = *(const float2*)(cp + c); x1 = *(const float2*)(cp + 3072 + c); x2 = *(const float2*)(cp + 6144 + c);
    } else {
      x0 = x1 = x2 = make_float2(0.f, 0.f);
    }
  } else {
    uint32_t u0 = *(const uint32_t*)(p.PJ + (size_t)(r0 - 3) * PWP + C_GDC + c);
    uint32_t u1 = *(const uint32_t*)(p.PJ + (size_t)(r0 - 2) * PWP + C_GDC + c);
    uint32_t u2 = *(const uint32_t*)(p.PJ + (size_t)(r0 - 1) * PWP + C_GDC + c);
    x0 = make_float2(bf2f(u0 & 0xffff), bf2f(u0 >> 16));
    x1 = make_float2(bf2f(u1 & 0xffff), bf2f(u1 >> 16));
    x2 = make_float2(bf2f(u2 & 0xffff), bf2f(u2 >> 16));
  }
  const float2 w0 = *(const float2*)(p.gd_conv_w + c), w1 = *(const float2*)(p.gd_conv_w + 3072 + c),
               w2 = *(const float2*)(p.gd_conv_w + 6144 + c), w3 = *(const float2*)(p.gd_conv_w + 9216 + c);
#pragma unroll 4
  for (int t = 0; t < 16; t++) {
    const int row = r0 + t;
    uint32_t u = *(const uint32_t*)(p.PJ + (size_t)row * PWP + C_GDC + c);
    float2 x3 = make_float2(bf2f(u & 0xffff), bf2f(u >> 16));
    float cx = w0.x * x0.x + w1.x * x1.x + w2.x * x2.x + w3.x * x3.x;
    float cy = w0.y * x0.y + w1.y * x1.y + w2.y * x2.y + w3.y * x3.y;
    x0 = x1; x1 = x2; x2 = x3;
    float ax = siluf_(cx), ay = siluf_(cy);
    if (kind < 2) {
      float ss = wavesum(ax * ax + ay * ay);
      float sc = rsqrtf(ss + 1e-6f);
      if (kind == 0) sc *= 0.08838834764831845f;
      ax *= sc; ay *= sc;
    }
    *(float2*)(p.GDP + (size_t)row * 3088 + c) = make_float2(ax, ay);
    if (slab == 0 && tid < 16) {
      float v;
      if (tid < 8) v = sigmoidf_(bf2f(p.PJ[(size_t)row * PWP + C_BETA + tid]));
      else {
        int h = tid - 8;
        float g = -__expf(p.gd_a_log[h]) * softplusf_(bf2f(p.PJ[(size_t)row * PWP + C_ALPHA + h]) + p.gd_dt_bias[h]);
        v = __expf(g);
      }
      p.GDP[(size_t)row * 3088 + 3072 + tid] = v;
    }
    int jj = t0 + t - (len - 3);
    if (jj >= 0) {
      if (prompt) {
        *(float2*)(p.CCV + (((size_t)((seg + 1) & 1) * 2 + seq) * 3 + jj) * 3072 + c) = x3;
        if (seg == NSEG - 1) *(float2*)(p.p_conv + ((size_t)seq * 3 + jj) * 3072 + c) = x3;
      } else {
        *(float2*)(p.s_conv + ((size_t)(seq - 2) * 3 + jj) * 3072 + c) = x3;
      }
    }
  }
}

__device__ void phase_prepass(const Params& p, int seg, int bid, int nb, char* smem) {
  const int ngrp = seg_M(seg) / 16;
  const int nRW = ngrp * 4, nGD = ngrp * 6;
  for (int it = bid; it < nRW + nGD; it += nb) {
    if (it < nRW) rw_prepass_item(p, seg, it >> 2, it & 3, smem);
    else { int j = it - nRW; gd_prepass_item(p, seg, j / 6, j % 6); }
  }
}

#define PD 8
__device__ void rw_scan_task(const Params& p, int seg, int seq, int head, int rg) {
  const int tid = threadIdx.x, q = tid & 15, v = rg * 16 + (tid >> 4);
  int base, len;
  seq_info(seg, seq, base, len);
  const float* sin;
  float* sout;
  if (seq < 2) {
    sout = p.p_wkv + ((size_t)seq * 16 + head) * 4096;
    sin = seg == 0 ? nullptr : sout;
  } else {
    sout = p.s_wkv + ((size_t)(seq - 2) * 16 + head) * 4096;
    sin = p.st_wkv + ((size_t)(seq - 2) * 16 + head) * 4096;
  }
  float4 S = sin ? *(const float4*)(sin + v * 64 + 4 * q) : make_float4(0.f, 0.f, 0.f, 0.f);
  const float* rp = p.RWP + (size_t)base * 6144 + head * 64;
  float* yo = p.YRW + (size_t)base * DM + head * 64 + v;
  float4 R[PD], W[PD], K[PD], A[PD], B[PD];
  float V[PD];
#pragma unroll
  for (int u = 0; u < PD; u++) {
    const float* np = rp + (size_t)u * 6144;
    R[u] = *(const float4*)(np + 4 * q);
    W[u] = *(const float4*)(np + 1024 + 4 * q);
    K[u] = *(const float4*)(np + 2048 + 4 * q);
    A[u] = *(const float4*)(np + 4096 + 4 * q);
    B[u] = *(const float4*)(np + 5120 + 4 * q);
    V[u] = np[3072 + v];
  }
  for (int t0 = 0; t0 < len; t0 += PD) {
#pragma unroll
    for (int u = 0; u < PD; u++) {
      const int t = t0 + u;
      const float4 r = R[u], w = W[u], k = K[u], a = A[u], b = B[u];
      const float vv = V[u];
      int tn = t + PD;
      tn = tn < len ? tn : len - 1;
      const float* np = rp + (size_t)tn * 6144;
      R[u] = *(const float4*)(np + 4 * q);
      W[u] = *(const float4*)(np + 1024 + 4 * q);
      K[u] = *(const float4*)(np + 2048 + 4 * q);
      A[u] = *(const float4*)(np + 4096 + 4 * q);
      B[u] = *(const float4*)(np + 5120 + 4 * q);
      V[u] = np[3072 + v];
      float sa = rowsum16(S.x * a.x + S.y * a.y + S.z * a.z + S.w * a.w);
      S.x = S.x * w.x + sa * b.x + vv * k.x;
      S.y = S.y * w.y + sa * b.y + vv * k.y;
      S.z = S.z * w.z + sa * b.z + vv * k.z;
      S.w = S.w * w.w + sa * b.w + vv * k.w;
      float y = rowsum16(S.x * r.x + S.y * r.y + S.z * r.z + S.w * r.w);
      if (q == 0) yo[(size_t)t * DM] = y;
    }
  }
  *(float4*)(sout + v * 64 + 4 * q) = S;
}

__device__ void gd_scan_task(const Params& p, int seg, int seq, int head, int cgp) {
  const int tid = threadIdx.x, q = tid & 15, c = cgp * 16 + (tid >> 4);
  int base, len;
  seq_info(seg, seq, base, len);
  const float* sin;
  float* sout;
  if (seq < 2) {
    sout = p.p_ssm + ((size_t)seq * 8 + head) * 16384;
    sin = seg == 0 ? nullptr : sout;
  } else {
    sout = p.s_ssm + ((size_t)(seq - 2) * 8 + head) * 16384;
    sin = p.st_ssm + ((size_t)(seq - 2) * 8 + head) * 16384;
  }
  float s[8];
#pragma unroll
  for (int i = 0; i < 8; i++) s[i] = sin ? sin[(size_t)(8 * q + i) * 128 + c] : 0.f;
  const float* gp = p.GDP + (size_t)base * 3088;
  float* oo = p.OGD + (size_t)base * DM + head * 128 + c;
  float4 Q0[PD], Q1[PD], K0[PD], K1[PD];
  float V[PD], BE[PD], EG[PD];
#pragma unroll
  for (int u = 0; u < PD; u++) {
    const float* np = gp + (size_t)u * 3088;
    Q0[u] = *(const float4*)(np + head * 128 + 8 * q);
    Q1[u] = *(const float4*)(np + head * 128 + 8 * q + 4);
    K0[u] = *(const float4*)(np + 1024 + head * 128 + 8 * q);
    K1[u] = *(const float4*)(np + 1024 + head * 128 + 8 * q + 4);
    V[u] = np[2048 + head * 128 + c];
    BE[u] = np[3072 + head];
    EG[u] = np[3080 + head];
  }
  for (int t0 = 0; t0 < len; t0 += PD) {
#pragma unroll
    for (int u = 0; u < PD; u++) {
      const int t = t0 + u;
      const float4 q0 = Q0[u], q1 = Q1[u], k0 = K0[u], k1 = K1[u];
      const float vv = V[u], be = BE[u], eg = EG[u];
      int tn = t + PD;
      tn = tn < len ? tn : len - 1;
      const float* np = gp + (size_t)tn * 3088;
      Q0[u] = *(const float4*)(np + head * 128 + 8 * q);
      Q1[u] = *(const float4*)(np + head * 128 + 8 * q + 4);
      K0[u] = *(const float4*)(np + 1024 + head * 128 + 8 * q);
      K1[u] = *(const float4*)(np + 1024 + head * 128 + 8 * q + 4);
      V[u] = np[2048 + head * 128 + c];
      BE[u] = np[3072 + head];
      EG[u] = np[3080 + head];
#pragma unroll
      for (int i = 0; i < 8; i++) s[i] *= eg;
      float ks = (s[0] * k0.x + s[1] * k0.y) + (s[2] * k0.z + s[3] * k0.w) + (s[4] * k1.x + s[5] * k1.y) + (s[6] * k1.z + s[7] * k1.w);
      ks = rowsum16(ks);
      const float d = be * (vv - ks);
      s[0] += k0.x * d; s[1] += k0.y * d; s[2] += k0.z * d; s[3] += k0.w * d;
      s[4] += k1.x * d; s[5] += k1.y * d; s[6] += k1.z * d; s[7] += k1.w * d;
      float o = (s[0] * q0.x + s[1] * q0.y) + (s[2] * q0.z + s[3] * q0.w) + (s[4] * q1.x + s[5] * q1.y) + (s[6] * q1.z + s[7] * q1.w);
      o = rowsum16(o);
      if (q == 0) oo[(size_t)t * DM] = o;
    }
  }
#pragma unroll
  for (int i = 0; i < 8; i++) sout[(size_t)(8 * q + i) * 128 + c] = s[i];
}

__device__ void phase_scan(const Params& p, int seg, int bid, int nb) {
  const int nseq = seg == 0 ? 34 : 2;
  const int ntask = nseq * 128;
  for (int it = bid; it < ntask; it += nb) {
    int seq, kind, j;
    if (it < 256) { kind = it >> 7; j = it & 127; seq = j >> 6; j &= 63; }
    else { int r = it - 256; seq = 2 + (r >> 7); j = r & 127; kind = j >> 6; j &= 63; }
    if (kind == 0) rw_scan_task(p, seg, seq, j >> 2, j & 3);
    else gd_scan_task(p, seg, seq, j >> 3, j & 7);
  }
}

__device__ void phase_post(const Params& p, int seg, int bid, int nb) {
  const int tid = threadIdx.x, c4 = tid * 4;
  const int M = seg_M(seg);
  for (int row = bid; row < M; row += nb) {
    const bf16_t* pj = p.PJ + (size_t)row * PWP;
    {
      float4 y = *(const float4*)(p.YRW + (size_t)row * DM + c4);
      float mean = rowsum16(y.x + y.y + y.z + y.w) * (1.0f / 64.0f);
      float dx = y.x - mean, dy = y.y - mean, dz = y.z - mean, dw = y.w - mean;
      float var = rowsum16(dx * dx + dy * dy + dz * dz + dw * dw) * (1.0f / 64.0f);
      float rs = rsqrtf(var + 64e-5f);
      float4 lw = *(const float4*)(p.rw_ln_w + c4), lb = *(const float4*)(p.rw_ln_b + c4);
      float bon = p.RWB[(size_t)row * 16 + (tid >> 4)];
      float4 v = *(const float4*)(p.RWP + (size_t)row * 6144 + 3072 + c4);
      uint2 g = *(const uint2*)(pj + C_RWG + c4);
      float o0 = (dx * rs * lw.x + lb.x + bon * v.x) * siluf_(bf2f(g.x & 0xffff));
      float o1 = (dy * rs * lw.y + lb.y + bon * v.y) * siluf_(bf2f(g.x >> 16));
      float o2 = (dz * rs * lw.z + lb.z + bon * v.z) * siluf_(bf2f(g.y & 0xffff));
      float o3 = (dw * rs * lw.w + lb.w + bon * v.w) * siluf_(bf2f(g.y >> 16));
      *(uint2*)(p.YA + (size_t)row * DM + c4) = make_uint2(pack2(o0, o1), pack2(o2, o3));
    }
    {
      float4 o = *(const float4*)(p.OGD + (size_t)row * DM + c4);
      float ss = rowsum16(o.x * o.x + o.y * o.y + o.z * o.z + o.w * o.w);
      ss += __shfl_xor(ss, 16);
      float rs = rsqrtf(ss * (1.0f / 128.0f) + 1e-6f);
      float4 nw = *(const float4*)(p.gd_norm_w + (c4 & 127));
      uint2 g = *(const uint2*)(pj + C_GDG + c4);
      float o0 = o.x * rs * nw.x * siluf_(bf2f(g.x & 0xffff));
      float o1 = o.y * rs * nw.y * siluf_(bf2f(g.x >> 16));
      float o2 = o.z * rs * nw.z * siluf_(bf2f(g.y & 0xffff));
      float o3 = o.w * rs * nw.w * siluf_(bf2f(g.y >> 16));
      *(uint2*)(p.YB + (size_t)row * DM + c4) = make_uint2(pack2(o0, o1), pack2(o2, o3));
    }
  }
}

__device__ void phase_norm(const Params& p, int seg, int bid, int nb) {
  int wave = threadIdx.x >> 6, lane = threadIdx.x & 63;
  int M = seg_M(seg);
  for (int r = bid * 4 + wave; r < M; r += nb * 4) {
    float* dst = row_dst(p, seg, r);
    if (!dst) continue;
    const float4* h = (const float4*)row_src(p, seg, r);
    const float4* o = (const float4*)(p.OUTB + (size_t)r * DM);
    float4 v[4];
    float ss = 0.f;
#pragma unroll
    for (int i = 0; i < 4; i++) {
      v[i] = o[lane + 64 * i];
      ss += v[i].x * v[i].x + v[i].y * v[i].y + v[i].z * v[i].z + v[i].w * v[i].w;
    }
    ss = wavesum(ss);
    float rstd = rsqrtf(ss * (1.0f / DM) + 1e-6f);
#pragma unroll
    for (int i = 0; i < 4; i++) {
      float4 g = ((const float4*)p.norm_post)[lane + 64 * i];
      float4 hh = h[lane + 64 * i];
      ((float4*)dst)[lane + 64 * i] =
          make_float4(hh.x + v[i].x * rstd * g.x, hh.y + v[i].y * rstd * g.y, hh.z + v[i].z * rstd * g.z, hh.w + v[i].w * rstd * g.w);
    }
  }
}

#define SMEM_BYTES (2 * 128 * LDT * 2)

template <int PH>
__device__ __forceinline__ void run_phase(const Params& p, int seg, int bid, int nb, char* smem) {
  if (PH == 0) phase_weights(p, bid, nb, smem);
  else if (PH == 1) phase_xn(p, seg, bid, nb);
  else if (PH == 2) gemm_phase<0>(p, p.XN, p.WtIn, seg_MP(seg) / 128, PWP / 128, bid, nb, smem);
  else if (PH == 3) phase_prepass(p, seg, bid, nb, smem);
  else if (PH == 4) phase_scan(p, seg, bid, nb);
  else if (PH == 5) phase_post(p, seg, bid, nb);
  else if (PH == 6) gemm_phase<1>(p, p.YA, p.WtA, seg_MP(seg) / 128, 8, bid, nb, smem);
  else if (PH == 7) gemm_phase<2>(p, p.YB, p.WtB, seg_MP(seg) / 128, 8, bid, nb, smem);
  else if (PH == 8) gemm_phase<3>(p, p.MG, p.WtO, seg_MP(seg) / 128, 8, bid, nb, smem);
  else if (PH == 9) phase_norm(p, seg, bid, nb);
}

template <int PH>
__global__ void __launch_bounds__(256) k_phase(Params p, int seg) {
  __shared__ __attribute__((aligned(16))) char smem[SMEM_BYTES];
  run_phase<PH>(p, seg, blockIdx.x, gridDim.x, smem);
}

__global__ void __launch_bounds__(256) k_mega(Params p) {
  __shared__ __attribute__((aligned(16))) char smem[SMEM_BYTES];
  cg::grid_group grid = cg::this_grid();
  const int bid = blockIdx.x, nb = gridDim.x;
  run_phase<0>(p, 0, bid, nb, smem);
  for (int seg = 0; seg < NSEG; seg++) {
    run_phase<1>(p, seg, bid, nb, smem);
    grid.sync();
    run_phase<2>(p, seg, bid, nb, smem);
    grid.sync();
    run_phase<3>(p, seg, bid, nb, smem);
    grid.sync();
    run_phase<4>(p, seg, bid, nb, smem);
    grid.sync();
    run_phase<5>(p, seg, bid, nb, smem);
    grid.sync();
    run_phase<6>(p, seg, bid, nb, smem);
    grid.sync();
    run_phase<7>(p, seg, bid, nb, smem);
    grid.sync();
    run_phase<8>(p, seg, bid, nb, smem);
    grid.sync();
    run_phase<9>(p, seg, bid, nb, smem);
    grid.sync();
  }
}

static inline size_t align_up(size_t x) { return (x + 255) & ~(size_t)255; }

extern "C" void kernel_launch(void* const* d_in, const int* in_sizes, int n_in, void* d_out, int out_size, void* d_ws,
                              size_t ws_size, hipStream_t stream) {
  Params p{};
  const float* const* in = (const float* const*)d_in;
  p.x_prompt = in[0]; p.x_sample = in[1]; p.st_shift = in[2]; p.st_wkv = in[3]; p.st_conv = in[4]; p.st_ssm = in[5];
  p.meta = in[6]; p.norm_pre = in[7]; p.w_in = in[8]; p.rw_mu = in[9]; p.rw_w0 = in[10]; p.rw_w2 = in[11];
  p.rw_a0 = in[12]; p.rw_a2 = in[13]; p.rw_k_k = in[14]; p.rw_k_a = in[15]; p.rw_r_k = in[16]; p.rw_ln_w = in[17];
  p.rw_ln_b = in[18]; p.gd_conv_w = in[19]; p.gd_a_log = in[20]; p.gd_dt_bias = in[21]; p.gd_norm_w = in[22];
  p.w_out_a = in[23]; p.w_out_b = in[24]; p.w_out = in[25]; p.norm_post = in[26];
  float* o = (float*)d_out;
  p.y_prompt = o; o += (size_t)2 * 8192 * 1024;
  p.y_sample = o; o += (size_t)32 * 16 * 1024;
  p.p_shift = o; o += 2 * 3200;
  p.p_wkv = o; o += 2 * 16 * 4096;
  p.p_conv = o; o += 2 * 3 * 3072;
  p.p_ssm = o; o += 2 * 8 * 16384;
  p.s_shift = o; o += 32 * 3200;
  p.s_wkv = o; o += 32 * 16 * 4096;
  p.s_conv = o; o += 32 * 3 * 3072;
  p.s_ssm = o; o += 32 * 8 * 16384;
  char* w = (char*)d_ws;
  size_t off = 0;
  auto take = [&](size_t bytes) { char* r = w + off; off += align_up(bytes); return r; };
  p.WtIn = (bf16_t*)take((size_t)PWP * DM * 2);
  p.WtA = (bf16_t*)take((size_t)DM * DM * 2);
  p.WtB = (bf16_t*)take((size_t)DM * DM * 2);
  p.WtO = (bf16_t*)take((size_t)DM * DM * 2);
  p.XN = (bf16_t*)take((size_t)MP0 * DM * 2);
  p.PJ = (bf16_t*)take((size_t)MP0 * PWP * 2);
  char* rwp = take((size_t)M0 * 6144 * 4);
  p.RWP = (float*)rwp;
  p.TMP = (float*)rwp;
  p.OUTB = (float*)(rwp + (size_t)MP0 * DM * 4);
  p.MG = (bf16_t*)(rwp + (size_t)2 * MP0 * DM * 4);
  p.RWB = (float*)take((size_t)M0 * 16 * 4);
  char* gdp = take((size_t)M0 * 3088 * 4);
  p.GDP = (float*)gdp;
  p.YA = (bf16_t*)gdp;
  p.YB = (bf16_t*)(gdp + (size_t)MP0 * DM * 2);
  p.YRW = (float*)take((size_t)M0 * DM * 4);
  p.OGD = (float*)take((size_t)M0 * DM * 4);
  p.CSH = (float*)take((size_t)2 * 2 * 3200 * 4);
  p.CCV = (float*)take((size_t)2 * 2 * 3 * 3072 * 4);
  if (off > ws_size) { fprintf(stderr, "workspace too small: need %zu have %zu\n", off, ws_size); return; }

#if MEGA
  static int grid_blocks = 0;
  if (!grid_blocks) {
    int dev = 0, cus = 0, per_cu = 0;
    hipGetDevice(&dev);
    hipDeviceGetAttribute(&cus, hipDeviceAttributeMultiprocessorCount, dev);
    hipOccupancyMaxActiveBlocksPerMultiprocessor(&per_cu, k_mega, 256, 0);
    if (per_cu > 2) per_cu = 2;
    grid_blocks = cus * per_cu;
  }
  void* args[] = {&p};
  hipError_t e = hipLaunchCooperativeKernel((void*)k_mega, dim3(grid_blocks), dim3(256), args, 0, stream);
  if (e != hipSuccess) fprintf(stderr, "cooperative launch failed: %s (grid %d)\n", hipGetErrorString(e), grid_blocks);
#else
  const int G = 1024;
  k_phase<0><<<G, 256, 0, stream>>>(p, 0);
  for (int seg = 0; seg < NSEG; seg++) {
    k_phase<1><<<G, 256, 0, stream>>>(p, seg);
    k_phase<2><<<G, 256, 0, stream>>>(p, seg);
    k_phase<3><<<G, 256, 0, stream>>>(p, seg);
    k_phase<4><<<seg == 0 ? 34 * 128 : 256, 256, 0, stream>>>(p, seg);
    k_phase<5><<<G, 256, 0, stream>>>(p, seg);
    k_phase<6><<<G, 256, 0, stream>>>(p, seg);
    k_phase<7><<<G, 256, 0, stream>>>(p, seg);
    k_phase<8><<<G, 256, 0, stream>>>(p, seg);
    k_phase<9><<<G, 256, 0, stream>>>(p, seg);
  }
#endif
}
```

```cpp
#include <hip/hip_runtime.h>
#include <hip/hip_cooperative_groups.h>
#include <stdint.h>
#include <stdio.h>
namespace cg = cooperative_groups;

typedef unsigned short bf16_t;
typedef _Float16 f16;
using bf16x8 = __attribute__((ext_vector_type(8))) short;
using f32x4 = __attribute__((ext_vector_type(4))) float;
using u32x4 = __attribute__((ext_vector_type(4))) unsigned int;
using f16x2 = __attribute__((ext_vector_type(2))) _Float16;
using f16x4 = __attribute__((ext_vector_type(4))) _Float16;
using f16x8 = __attribute__((ext_vector_type(8))) _Float16;

#define DM 1024
#define PW 10384
#define VW 10496
#define PJW 6400
#define GTW 4096
#define NSEG 16
#define TS 512
#define M0 1568
#define MP0 1664
#define M1 1024
#define SLOT_ROWS 3712
#define NSCAN 256
#define C_GDC 3200
#define C_BETA 6272
#define C_ALPHA 6280
#define G_RW 0
#define G_GD 1024
#define G_MA 2048
#define G_MB 3072
#define RWS_ROWB 16384
#define GDS_HB 784
#define GDS_ROWB 6272

struct Params {
  const float *x_prompt, *x_sample, *st_shift, *st_wkv, *st_conv, *st_ssm, *meta, *norm_pre, *w_in, *rw_mu, *rw_w0,
      *rw_w2, *rw_a0, *rw_a2, *rw_k_k, *rw_k_a, *rw_r_k, *rw_ln_w, *rw_ln_b, *gd_conv_w, *gd_a_log, *gd_dt_bias,
      *gd_norm_w, *w_out_a, *w_out_b, *w_out, *norm_post;
  float* out;
  char* ws;
};
#define p (*pp)
constexpr size_t al256(size_t x) { return (x + 255) & ~(size_t)255; }
constexpr size_t OO_y_prompt = 0;
constexpr size_t OO_y_sample = OO_y_prompt + (size_t)2 * 8192 * 1024;
constexpr size_t OO_p_shift = OO_y_sample + (size_t)32 * 16 * 1024;
constexpr size_t OO_p_wkv = OO_p_shift + 2 * 3200;
constexpr size_t OO_p_conv = OO_p_wkv + 2 * 16 * 4096;
constexpr size_t OO_p_ssm = OO_p_conv + 2 * 3 * 3072;
constexpr size_t OO_s_shift = OO_p_ssm + 2 * 8 * 16384;
constexpr size_t OO_s_wkv = OO_s_shift + 32 * 3200;
constexpr size_t OO_s_conv = OO_s_wkv + 32 * 16 * 4096;
constexpr size_t OO_s_ssm = OO_s_conv + 32 * 3 * 3072;
constexpr size_t OW_sync = 0;
constexpr size_t OW_WtIn = OW_sync + 16384;
constexpr size_t OW_WtA = OW_WtIn + al256((size_t)VW * DM * 2);
constexpr size_t OW_WtB = OW_WtA + al256((size_t)DM * DM * 2);
constexpr size_t OW_WtO = OW_WtB + al256((size_t)DM * DM * 2);
constexpr size_t OW_XN = OW_WtO + al256((size_t)DM * DM * 2);
constexpr size_t OW_PJA = OW_XN + al256((size_t)MP0 * DM * 2);
constexpr size_t OW_YA = OW_PJA + al256((size_t)MP0 * PJW * 2);
constexpr size_t OW_YB = OW_YA + al256((size_t)MP0 * DM * 2);
constexpr size_t OW_MG = OW_YB + al256((size_t)MP0 * DM * 2);
constexpr size_t OW_OUTB = OW_MG + al256((size_t)MP0 * DM * 2);
constexpr size_t OW_TMP = OW_OUTB + al256((size_t)2 * MP0 * DM * 4);
constexpr size_t OW_GT = OW_TMP + al256((size_t)MP0 * DM * 4);
constexpr size_t OW_RWS = OW_GT + al256((size_t)SLOT_ROWS * GTW * 2);
constexpr size_t OW_GDS = OW_RWS + al256((size_t)SLOT_ROWS * RWS_ROWB);
constexpr size_t OW_RWB = OW_GDS + al256((size_t)SLOT_ROWS * GDS_ROWB + 256);
constexpr size_t OW_YRW = OW_RWB + al256((size_t)SLOT_ROWS * 16 * 4);
constexpr size_t OW_OGD = OW_YRW + al256((size_t)SLOT_ROWS * DM * 4);
constexpr size_t OW_CSH = OW_OGD + al256((size_t)SLOT_ROWS * DM * 4);
constexpr size_t OW_CCV = OW_CSH + al256((size_t)2 * 2 * 3200 * 4);
constexpr size_t OW_END = OW_CCV + al256((size_t)2 * 2 * 3 * 3072 * 4);


__device__ __forceinline__ bf16_t f2bf(float f) {
  uint32_t u = __float_as_uint(f);
  u += 0x7fffu + ((u >> 16) & 1u);
  return (bf16_t)(u >> 16);
}
__device__ __forceinline__ float bf2f(bf16_t h) { return __uint_as_float(((uint32_t)h) << 16); }
__device__ __forceinline__ uint32_t pack2(float a, float b) { return (uint32_t)f2bf(a) | ((uint32_t)f2bf(b) << 16); }
__device__ __forceinline__ float sigmoidf_(float x) { return 1.0f / (1.0f + __expf(-x)); }
__device__ __forceinline__ float siluf_(float x) { return x / (1.0f + __expf(-x)); }
__device__ __forceinline__ float softplusf_(float x) { return fmaxf(x, 0.0f) + log1pf(__expf(-fabsf(x))); }

__device__ __forceinline__ int tid_l() { int t = threadIdx.x; asm volatile("" : "+v"(t)); return t; }
#define LAUNDER_PP asm volatile("" : "+s"(pp))
template <int CTRL>
__device__ __forceinline__ float dppf(float x) {
  return __builtin_bit_cast(float, __builtin_amdgcn_update_dpp(0, __builtin_bit_cast(int, x), CTRL, 0xf, 0xf, true));
}
__device__ __forceinline__ float rowsum16(float x) {
  x += dppf<0xB1>(x);
  x += dppf<0x4E>(x);
  x += dppf<0x141>(x);
  x += dppf<0x140>(x);
  return x;
}
__device__ __forceinline__ float wavesum(float x) {
  x = rowsum16(x);
  x += __shfl_xor(x, 16);
  x += __shfl_xor(x, 32);
  return x;
}

#define SW_XCNT(j) (64 * (1 + (j)))
#define SW_XSUB(j) (64 * (9 + (j)))
#define SW_XGEN(j) (64 * (17 + (j)))
#define SW_TOP (64 * 25)
#define SW_TOPGEN (64 * 26)
#define SW_PRE (64 * 27)
#define SW_SCAN(s) (64 * (28 + (s)))
#define SYNC_BYTES 16384
__device__ __forceinline__ unsigned xb_ld(const unsigned* ptr) {
  return __hip_atomic_load(ptr, __ATOMIC_RELAXED, __HIP_MEMORY_SCOPE_AGENT);
}
__device__ __forceinline__ unsigned xb_add(unsigned* ptr, unsigned v) {
  return __hip_atomic_fetch_add(ptr, v, __ATOMIC_RELAXED, __HIP_MEMORY_SCOPE_AGENT);
}
__device__ __forceinline__ unsigned xcc_id() { return (unsigned)__builtin_amdgcn_s_getreg((3 << 11) | 20) & 0xFu; }
__device__ __forceinline__ void wait_ge(const unsigned* ptr, unsigned target) {
  if (threadIdx.x == 0) {
    while (xb_ld(ptr) < target) __builtin_amdgcn_s_sleep(8);
    __builtin_amdgcn_fence(__ATOMIC_ACQUIRE, "agent");
    asm volatile("s_waitcnt vmcnt(0)" ::: "memory");
  }
  __syncthreads();
}
__device__ __forceinline__ void signal_add(unsigned* ptr) {
  asm volatile("s_waitcnt vmcnt(0)" ::: "memory");
  __syncthreads();
  if (threadIdx.x == 0) {
    __builtin_amdgcn_fence(__ATOMIC_RELEASE, "agent");
    asm volatile("s_waitcnt vmcnt(0)" ::: "memory");
    xb_add(ptr, 1u);
  }
}
__device__ __forceinline__ void worker_barrier(unsigned* bar, const unsigned* lds_cfg) {
  asm volatile("s_waitcnt vmcnt(0)" ::: "memory");
  __syncthreads();
  if (threadIdx.x == 0) {
    const unsigned x = xcc_id() & 7u, nloc = lds_cfg[0], nx = lds_cfg[1];
    const unsigned old = xb_add(&bar[SW_XSUB(x)], 1u);
    const unsigned gen = old / nloc;
    if (old + 1u == (gen + 1u) * nloc) {
      __builtin_amdgcn_fence(__ATOMIC_RELEASE, "agent");
      asm volatile("s_waitcnt vmcnt(0)" ::: "memory");
      const unsigned og = xb_add(&bar[SW_TOP], 1u);
      const unsigned tg = og / nx;
      if (og + 1u == (tg + 1u) * nx) xb_add(&bar[SW_TOPGEN], 1u);
      else while (xb_ld(&bar[SW_TOPGEN]) == tg) __builtin_amdgcn_s_sleep(1);
      __builtin_amdgcn_fence(__ATOMIC_ACQUIRE, "agent");
      xb_add(&bar[SW_XGEN(x)], 1u);
      asm volatile("s_waitcnt vmcnt(0)" ::: "memory");
    } else {
      while (xb_ld(&bar[SW_XGEN(x)]) == gen) __builtin_amdgcn_s_sleep(1);
      __builtin_amdgcn_fence(__ATOMIC_ACQUIRE, "agent");
      asm volatile("s_waitcnt vmcnt(0)" ::: "memory");
    }
  }
  __syncthreads();
}

__device__ __forceinline__ void lds_barrier() {
  asm volatile("s_waitcnt lgkmcnt(0)" ::: "memory");
  __builtin_amdgcn_s_barrier();
  asm volatile("" ::: "memory");
}

__device__ __forceinline__ int seg_M(int seg) { return seg == 0 ? M0 : M1; }
__device__ __forceinline__ int seg_MP(int seg) { return seg == 0 ? MP0 : M1; }
__device__ __forceinline__ int slot_row0(int seg) { int s = seg % 3; return s == 0 ? 0 : MP0 + (s - 1) * M1; }
__device__ __forceinline__ const float* row_src(const Params* __restrict__ pp, int seg, int r) {
  if (seg == 0) {
    if (r < 1056) {
      int b = r >= 528 ? 1 : 0, t = r - b * 528;
      if (t < 16) return p.meta + t * DM;
      return p.x_prompt + ((size_t)b * 8192 + (t - 16)) * DM;
    }
    return p.x_sample + (size_t)(r - 1056) * DM;
  }
  int b = r >> 9, t = r & 511;
  return p.x_prompt + ((size_t)b * 8192 + seg * TS + t) * DM;
}
__device__ __forceinline__ float* row_dst(const Params* __restrict__ pp, int seg, int r) {
  if (seg == 0) {
    if (r < 1056) {
      int b = r >= 528 ? 1 : 0, t = r - b * 528;
      if (t < 16) return nullptr;
      return (p.out + OO_y_prompt) + ((size_t)b * 8192 + (t - 16)) * DM;
    }
    return (p.out + OO_y_sample) + (size_t)(r - 1056) * DM;
  }
  int b = r >> 9, t = r & 511;
  return (p.out + OO_y_prompt) + ((size_t)b * 8192 + seg * TS + t) * DM;
}
__device__ __forceinline__ void row_seq(int seg, int r, int& seq, int& t, int& len) {
  if (seg == 0) {
    if (r < 528) { seq = 0; t = r; len = 528; }
    else if (r < 1056) { seq = 1; t = r - 528; len = 528; }
    else { seq = 2 + ((r - 1056) >> 4); t = (r - 1056) & 15; len = 16; }
  } else { seq = r >> 9; t = r & 511; len = TS; }
}

__device__ __forceinline__ int vcol_src(int n) {
  if (n < 3200) return n;
  if (n < 6288) return n + 1024;
  if (n < 6400) return -1;
  if (n < 7424) return n - 3200;
  return n - 112;
}
__device__ __forceinline__ void transpose_tile(const float* __restrict__ src, int ld, bool remap, bf16_t* __restrict__ dst, int k0, int n0,
                               float* tile  ) {
  int tid = tid_l();
  int i = tid >> 4, j = tid & 15;
  __syncthreads();
  int n = n0 + 4 * j;
  int sc = remap ? vcol_src(n) : n;
#pragma unroll
  for (int pass = 0; pass < 4; pass++) {
    int k = pass * 16 + i;
    float4 v = make_float4(0.f, 0.f, 0.f, 0.f);
    if (sc >= 0) v = *(const float4*)(src + (size_t)(k0 + k) * ld + sc);
    tile[k * 65 + 4 * j + 0] = v.x; tile[k * 65 + 4 * j + 1] = v.y; tile[k * 65 + 4 * j + 2] = v.z; tile[k * 65 + 4 * j + 3] = v.w;
  }
  __syncthreads();
  int nn = tid >> 2, kq = tid & 3;
  uint32_t o[8];
#pragma unroll
  for (int e = 0; e < 8; e++) o[e] = pack2(tile[(kq * 16 + 2 * e) * 65 + nn], tile[(kq * 16 + 2 * e + 1) * 65 + nn]);
  u32x4* d = (u32x4*)(dst + (size_t)(n0 + nn) * DM + k0 + kq * 16);
  d[0] = (u32x4){o[0], o[1], o[2], o[3]};
  d[1] = (u32x4){o[4], o[5], o[6], o[7]};
}
__device__ __forceinline__ void phase_weights(const Params* __restrict__ pp, int bid, int nb, char* smem) {
  LAUNDER_PP;
  float* tile = (float*)smem;
  const int nIn = 16 * (VW / 64);
  const int nSq = 16 * 16;
  for (int it = bid; it < nIn + 3 * nSq; it += nb) {
    if (it < nIn) {
      int kt = it & 15, nt = it >> 4;
      transpose_tile(p.w_in, PW, true, ((bf16_t*)(p.ws + OW_WtIn)), kt * 64, nt * 64, tile);
    } else {
      int j = it - nIn, w = j / nSq, r = j % nSq;
      int kt = r & 15, nt = r >> 4;
      const float* src = w == 0 ? p.w_out_a : (w == 1 ? p.w_out_b : p.w_out);
      bf16_t* dst = w == 0 ? ((bf16_t*)(p.ws + OW_WtA)) : (w == 1 ? ((bf16_t*)(p.ws + OW_WtB)) : ((bf16_t*)(p.ws + OW_WtO)));
      transpose_tile(src, DM, false, dst, kt * 64, nt * 64, tile);
    }
  }
}

__device__ __forceinline__ void xn_item(const Params* __restrict__ pp, int seg, int item) {
  LAUNDER_PP;
  int wave = tid_l() >> 6, lane = tid_l() & 63;
  int M = seg_M(seg);
  int r = item * 4 + wave;
  bf16_t* o = ((bf16_t*)(p.ws + OW_XN)) + (size_t)r * DM;
  if (r >= M) {
#pragma unroll
    for (int i = 0; i < 4; i++) *(uint2*)(o + (lane + 64 * i) * 4) = make_uint2(0u, 0u);
    return;
  }
  const float4* src = (const float4*)row_src(pp, seg, r);
  float4 v[4];
  float ss = 0.f;
#pragma unroll
  for (int i = 0; i < 4; i++) {
    v[i] = src[lane + 64 * i];
    ss += v[i].x * v[i].x + v[i].y * v[i].y + v[i].z * v[i].z + v[i].w * v[i].w;
  }
  ss = wavesum(ss);
  float rstd = rsqrtf(ss * (1.0f / DM) + 1e-6f);
#pragma unroll
  for (int i = 0; i < 4; i++) {
    float4 g = ((const float4*)p.norm_pre)[lane + 64 * i];
    *(uint2*)(o + (lane + 64 * i) * 4) =
        make_uint2(pack2(v[i].x * rstd * g.x, v[i].y * rstd * g.y), pack2(v[i].z * rstd * g.z, v[i].w * rstd * g.w));
  }
}

__device__ __forceinline__ void norm_item(const Params* __restrict__ pp, int seg, int item) {
  LAUNDER_PP;
  int wave = tid_l() >> 6, lane = tid_l() & 63;
  int r = item * 4 + wave;
  float* dst = row_dst(pp, seg, r);
  if (!dst) return;
  const float4* h = (const float4*)row_src(pp, seg, r);
  const float4* o = (const float4*)(((float*)(p.ws + OW_OUTB)) + ((size_t)(seg & 1) * MP0 + r) * DM);
  float4 v[4];
  float ss = 0.f;
#pragma unroll
  for (int i = 0; i < 4; i++) {
    v[i] = o[lane + 64 * i];
    ss += v[i].x * v[i].x + v[i].y * v[i].y + v[i].z * v[i].z + v[i].w * v[i].w;
  }
  ss = wavesum(ss);
  float rstd = rsqrtf(ss * (1.0f / DM) + 1e-6f);
#pragma unroll
  for (int i = 0; i < 4; i++) {
    float4 g = ((const float4*)p.norm_post)[lane + 64 * i];
    float4 hh = h[lane + 64 * i];
    ((float4*)dst)[lane + 64 * i] =
        make_float4(hh.x + v[i].x * rstd * g.x, hh.y + v[i].y * rstd * g.y, hh.z + v[i].z * rstd * g.z, hh.w + v[i].w * rstd * g.w);
  }
}

#define LDT 40
template <int MODE>
__device__ __forceinline__ void gemm_tile(const Params* __restrict__ pp, int seg, int tm, int tn, char* smem) {
  LAUNDER_PP;
  bf16_t* sA = (bf16_t*)smem;
  bf16_t* sB = sA + 128 * LDT;
  const int tid = tid_l(), lane = tid & 63, wid = tid >> 6;
  const int wr = wid >> 1, wc = wid & 1, fr = lane & 15, fq = lane >> 4;
  const int lrow = tid >> 2, lkc = tid & 3;
  const int m0 = tm * 128, n0 = tn * 128;
  bf16_t* GTs = ((bf16_t*)(p.ws + OW_GT)) + (size_t)slot_row0(seg) * GTW;
  f32x4 acc[4][4];
#pragma unroll
  for (int a = 0; a < 4; a++)
#pragma unroll
    for (int b = 0; b < 4; b++) acc[a][b] = (f32x4){0.f, 0.f, 0.f, 0.f};
  {
    const bf16_t* A = (const bf16_t*)(p.ws + (MODE == 0 ? OW_XN : (MODE == 1 ? OW_YA : (MODE == 3 ? OW_YB : OW_MG))));
    const bf16_t* Bt = (const bf16_t*)(p.ws + (MODE == 0 ? OW_WtIn : (MODE == 1 ? OW_WtA : (MODE == 3 ? OW_WtB : OW_WtO))));
    u32x4 ra[2], rb[2];
    const bf16_t* gA = A + (size_t)(m0 + lrow) * DM + lkc * 8;
    const bf16_t* gB = Bt + (size_t)(n0 + lrow) * DM + lkc * 8;
#pragma unroll
    for (int i = 0; i < 2; i++) {
      ra[i] = *(const u32x4*)(gA + (size_t)i * 64 * DM);
      rb[i] = *(const u32x4*)(gB + (size_t)i * 64 * DM);
    }
    bf16_t* wA = sA + lrow * LDT + lkc * 8;
    bf16_t* wB = sB + lrow * LDT + lkc * 8;
    const bf16_t* rA = sA + (wr * 64 + fr) * LDT + fq * 8;
    const bf16_t* rB = sB + (wc * 64 + fr) * LDT + fq * 8;
    for (int kt = 0; kt < 32; kt++) {
      __syncthreads();
#pragma unroll
      for (int i = 0; i < 2; i++) {
        *(u32x4*)(wA + i * 64 * LDT) = ra[i];
        *(u32x4*)(wB + i * 64 * LDT) = rb[i];
      }
      __syncthreads();
      if (kt + 1 < 32) {
#pragma unroll
        for (int i = 0; i < 2; i++) {
          ra[i] = *(const u32x4*)(gA + (size_t)i * 64 * DM + (kt + 1) * 32);
          rb[i] = *(const u32x4*)(gB + (size_t)i * 64 * DM + (kt + 1) * 32);
        }
      }
      bf16x8 xa[4];
#pragma unroll
      for (int i = 0; i < 4; i++) xa[i] = *(const bf16x8*)(rA + i * 16 * LDT);
#pragma unroll
      for (int ni = 0; ni < 4; ni++) {
        const bf16x8 wb = *(const bf16x8*)(rB + ni * 16 * LDT);
#pragma unroll
        for (int mi = 0; mi < 4; mi++)
          acc[ni][mi] = __builtin_amdgcn_mfma_f32_16x16x32_bf16(wb, xa[mi], acc[ni][mi], 0, 0, 0);
      }
    }
  }
  float* OUTBp = (MODE == 2) ? (float*)(p.ws + OW_OUTB) + (size_t)(seg & 1) * MP0 * DM : (float*)(p.ws + OW_TMP);
#pragma unroll
  for (int ni = 0; ni < 4; ni++)
#pragma unroll
    for (int mi = 0; mi < 4; mi++) {
      const int m = m0 + wr * 64 + mi * 16 + fr;
      const int n = n0 + wc * 64 + ni * 16 + fq * 4;
      f32x4 c = acc[ni][mi];
      if (MODE == 0) {
        uint2 o = make_uint2(pack2(c[0], c[1]), pack2(c[2], c[3]));
        if (tn < PJW / 128) *(uint2*)(((bf16_t*)(p.ws + OW_PJA)) + (size_t)m * PJW + n) = o;
        else *(uint2*)(GTs + (size_t)m * GTW + (n - PJW)) = o;
      } else if (MODE == 1) {
        uint2 ga = *(const uint2*)(GTs + (size_t)m * GTW + G_MA + n);
        *(float4*)(OUTBp + (size_t)m * DM + n) =
            make_float4(sigmoidf_(bf2f(ga.x & 0xffff)) * c[0], sigmoidf_(bf2f(ga.x >> 16)) * c[1],
                        sigmoidf_(bf2f(ga.y & 0xffff)) * c[2], sigmoidf_(bf2f(ga.y >> 16)) * c[3]);
      } else if (MODE == 3) {
        uint2 gb = *(const uint2*)(GTs + (size_t)m * GTW + G_MB + n);
        float4 t = *(const float4*)(OUTBp + (size_t)m * DM + n);
        float o0 = t.x + sigmoidf_(bf2f(gb.x & 0xffff)) * c[0];
        float o1 = t.y + sigmoidf_(bf2f(gb.x >> 16)) * c[1];
        float o2 = t.z + sigmoidf_(bf2f(gb.y & 0xffff)) * c[2];
        float o3 = t.w + sigmoidf_(bf2f(gb.y >> 16)) * c[3];
        *(uint2*)(((bf16_t*)(p.ws + OW_MG)) + (size_t)m * DM + n) = make_uint2(pack2(o0, o1), pack2(o2, o3));
      } else {
        *(float4*)(OUTBp + (size_t)m * DM + n) = make_float4(c[0], c[1], c[2], c[3]);
      }
    }
}

__device__ __forceinline__ void rw_prepass_item(const Params* __restrict__ pp, int seg, int grp, int slab, char* smem) {
  LAUNDER_PP;
  float* lwa = (float*)smem;
  const int tid = tid_l();
  const int r0 = grp * 8;
  int seq, t0, len;
  row_seq(seg, r0, seq, t0, len);
  const bool prompt = seq < 2;
  const float* prev0 = nullptr;
  if (t0 == 0) {
    if (seg == 0) prev0 = prompt ? nullptr : p.st_shift + (size_t)(seq - 2) * 3200;
    else prev0 = ((float*)(p.ws + OW_CSH)) + ((size_t)(seg & 1) * 2 + seq) * 3200;
  }
  __syncthreads();
  {
    const int j = tid & 127;
    const float mu = p.rw_mu[3072 + j];
#pragma unroll
    for (int i = 0; i < 4; i++) {
      int tok = (tid >> 7) + 2 * i;
      int row = r0 + tok;
      float ps = bf2f(((bf16_t*)(p.ws + OW_PJA))[(size_t)row * PJW + 3072 + j]);
      float pv;
      if (tok == 0 && t0 == 0) pv = prev0 ? prev0[3072 + j] : 0.f;
      else pv = bf2f(((bf16_t*)(p.ws + OW_PJA))[(size_t)(row - 1) * PJW + 3072 + j]);
      float xs = ps + mu * (pv - ps);
      lwa[tok * 128 + j] = j < 64 ? tanhf(xs) : xs;
      if (slab == 0 && t0 + tok == len - 1) {
        if (prompt) {
          ((float*)(p.ws + OW_CSH))[((size_t)((seg + 1) & 1) * 2 + seq) * 3200 + 3072 + j] = ps;
          if (seg == NSEG - 1) (p.out + OO_p_shift)[(size_t)seq * 3200 + 3072 + j] = ps;
        } else {
          (p.out + OO_s_shift)[(size_t)(seq - 2) * 3200 + 3072 + j] = ps;
        }
      }
    }
  }
  __syncthreads();
  const int c = slab * 256 + tid;
  float dw[8], da[8];
  {
    const float w0 = p.rw_w0[c], a0 = p.rw_a0[c];
#pragma unroll
    for (int t = 0; t < 8; t++) { dw[t] = w0; da[t] = a0; }
  }
  for (int j = 0; j < 64; j += 4) {
    float w2v[4], a2v[4];
#pragma unroll
    for (int e = 0; e < 4; e++) {
      w2v[e] = p.rw_w2[(size_t)(j + e) * DM + c];
      a2v[e] = p.rw_a2[(size_t)(j + e) * DM + c];
    }
#pragma unroll
    for (int t = 0; t < 8; t++) {
      float4 lw = *(const float4*)(lwa + t * 128 + j);
      float4 la = *(const float4*)(lwa + t * 128 + 64 + j);
      dw[t] += lw.x * w2v[0] + lw.y * w2v[1] + lw.z * w2v[2] + lw.w * w2v[3];
      da[t] += la.x * a2v[0] + la.y * a2v[1] + la.z * a2v[2] + la.w * a2v[3];
    }
  }
  const float mur = p.rw_mu[c], muk = p.rw_mu[1024 + c], muv = p.rw_mu[2048 + c];
  const float kk_w = p.rw_k_k[c], ka_w = p.rw_k_a[c], rk_w = p.rw_r_k[c];
  float pr, pk, pv;
  if (t0 == 0) {
    pr = prev0 ? prev0[c] : 0.f; pk = prev0 ? prev0[1024 + c] : 0.f; pv = prev0 ? prev0[2048 + c] : 0.f;
  } else {
    const bf16_t* q = ((bf16_t*)(p.ws + OW_PJA)) + (size_t)(r0 - 1) * PJW;
    pr = bf2f(q[c]); pk = bf2f(q[1024 + c]); pv = bf2f(q[2048 + c]);
  }
  const int head = c >> 6, e = c & 63;
  const int srow0 = slot_row0(seg);
  char* rws = ((char*)(p.ws + OW_RWS)) + ((size_t)(srow0 + r0) * 16 + head) * 1024;
  float* rwb = ((float*)(p.ws + OW_RWB)) + (size_t)(srow0 + r0) * 16 + head;
#pragma unroll
  for (int t = 0; t < 8; t++) {
    const int row = r0 + t;
    const bf16_t* q = ((bf16_t*)(p.ws + OW_PJA)) + (size_t)row * PJW;
    float cr = bf2f(q[c]), ck = bf2f(q[1024 + c]), cv = bf2f(q[2048 + c]);
    float xr = cr + mur * (pr - cr), xk = ck + muk * (pk - ck), xv = cv + muv * (pv - cv);
    pr = cr; pk = ck; pv = cv;
    float w_log = -softplusf_(-dw[t]) - 0.5f;
    float decay = __expf(-__expf(w_log));
    float a = sigmoidf_(da[t]);
    float kkr = xk * kk_w;
    float ss = wavesum(kkr * kkr);
    float kk = kkr * rsqrtf(ss + 1e-6f);
    float k2 = xk * (1.0f + (a - 1.0f) * ka_w);
    float bon = wavesum(xr * k2 * rk_w);
    char* o = rws + (size_t)t * RWS_ROWB;
    ((f16*)o)[e] = (f16)xr;
    ((f16*)(o + 128))[e] = (f16)k2;
    ((f16*)(o + 256))[e] = (f16)(-kk);
    ((f16*)(o + 384))[e] = (f16)(kk * a);
    ((float*)(o + 512))[e] = decay;
    ((float*)(o + 768))[e] = xv;
    if ((tid & 63) == 0) rwb[(size_t)t * 16] = bon;
    if (t0 + t == len - 1) {
      if (prompt) {
        float* cs = ((float*)(p.ws + OW_CSH)) + ((size_t)((seg + 1) & 1) * 2 + seq) * 3200;
        cs[c] = cr; cs[1024 + c] = ck; cs[2048 + c] = cv;
        if (seg == NSEG - 1) {
          float* ps = (p.out + OO_p_shift) + (size_t)seq * 3200;
          ps[c] = cr; ps[1024 + c] = ck; ps[2048 + c] = cv;
        }
      } else {
        float* ps = (p.out + OO_s_shift) + (size_t)(seq - 2) * 3200;
        ps[c] = cr; ps[1024 + c] = ck; ps[2048 + c] = cv;
      }
    }
  }
}

__device__ __forceinline__ void gd_prepass_item(const Params* __restrict__ pp, int seg, int grp, int slab) {
  LAUNDER_PP;
  const int tid = tid_l();
  const int r0 = grp * 16;
  int seq, t0, len;
  row_seq(seg, r0, seq, t0, len);
  const bool prompt = seq < 2;
  const int c = slab * 512 + 2 * tid;
  const int kind = slab >> 1;
  const int head = (c & 1023) >> 7, e = c & 127;
  float2 x0, x1, x2;
  if (t0 == 0) {
    const float* cp = nullptr;
    if (seg == 0) cp = prompt ? nullptr : p.st_conv + (size_t)(seq - 2) * 3 * 3072;
    else cp = ((float*)(p.ws + OW_CCV)) + ((size_t)(seg & 1) * 2 + seq) * 3 * 3072;
    if (cp) {
      x0 = *(const float2*)(cp + c); x1 = *(const float2*)(cp + 3072 + c); x2 = *(const float2*)(cp + 6144 + c);
    } else {
      x0 = x1 = x2 = make_float2(0.f, 0.f);
    }
  } else {
    uint32_t u0 = *(const uint32_t*)(((bf16_t*)(p.ws + OW_PJA)) + (size_t)(r0 - 3) * PJW + C_GDC + c);
    uint32_t u1 = *(const uint32_t*)(((bf16_t*)(p.ws + OW_PJA)) + (size_t)(r0 - 2) * PJW + C_GDC + c);
    uint32_t u2 = *(const uint32_t*)(((bf16_t*)(p.ws + OW_PJA)) + (size_t)(r0 - 1) * PJW + C_GDC + c);
    x0 = make_float2(bf2f(u0 & 0xffff), bf2f(u0 >> 16));
    x1 = make_float2(bf2f(u1 & 0xffff), bf2f(u1 >> 16));
    x2 = make_float2(bf2f(u2 & 0xffff), bf2f(u2 >> 16));
  }
  const float2 w0 = *(const float2*)(p.gd_conv_w + c), w1 = *(const float2*)(p.gd_conv_w + 3072 + c),
               w2 = *(const float2*)(p.gd_conv_w + 6144 + c), w3 = *(const float2*)(p.gd_conv_w + 9216 + c);
  const float a_exp = __expf(p.gd_a_log[head]);
  const float dtb = p.gd_dt_bias[head];
  char* gds = ((char*)(p.ws + OW_GDS)) + ((size_t)(slot_row0(seg) + r0) * 8 + head) * GDS_HB;
#pragma unroll 4
  for (int t = 0; t < 16; t++) {
    const int row = r0 + t;
    uint32_t u = *(const uint32_t*)(((bf16_t*)(p.ws + OW_PJA)) + (size_t)row * PJW + C_GDC + c);
    float2 x3 = make_float2(bf2f(u & 0xffff), bf2f(u >> 16));
    float cx = w0.x * x0.x + w1.x * x1.x + w2.x * x2.x + w3.x * x3.x;
    float cy = w0.y * x0.y + w1.y * x1.y + w2.y * x2.y + w3.y * x3.y;
    x0 = x1; x1 = x2; x2 = x3;
    float ax = siluf_(cx), ay = siluf_(cy);
    float sc = 1.0f;
    if (kind < 2) {
      float ss = wavesum(ax * ax + ay * ay);
      sc = rsqrtf(ss + 1e-6f);
      if (kind == 0) sc *= 0.08838834764831845f;
    }
    if (kind >= 1) {
      float beta = sigmoidf_(bf2f(((bf16_t*)(p.ws + OW_PJA))[(size_t)row * PJW + C_BETA + head]));
      sc *= sqrtf(beta);
    }
    ax *= sc; ay *= sc;
    char* o = gds + (size_t)t * GDS_ROWB;
    f16x2 hv = {(f16)ax, (f16)ay};
    *(f16x2*)(o + kind * 256 + e * 2) = hv;
    if (kind == 0 && (tid & 63) == 0) {
      float g = -a_exp * softplusf_(bf2f(((bf16_t*)(p.ws + OW_PJA))[(size_t)row * PJW + C_ALPHA + head]) + dtb);
      *(float*)(o + 768) = __expf(g);
    }
    int jj = t0 + t - (len - 3);
    if (jj >= 0) {
      if (prompt) {
        *(float2*)(((float*)(p.ws + OW_CCV)) + (((size_t)((seg + 1) & 1) * 2 + seq) * 3 + jj) * 3072 + c) = x3;
        if (seg == NSEG - 1) *(float2*)((p.out + OO_p_conv) + ((size_t)seq * 3 + jj) * 3072 + c) = x3;
      } else {
        *(float2*)((p.out + OO_s_conv) + ((size_t)(seq - 2) * 3 + jj) * 3072 + c) = x3;
      }
    }
  }
}

__device__ __forceinline__ void rw_scan_run(const char* __restrict__ gsrc  , int len, float4& S,
                            float* __restrict__ yo  , int q, int v, char* smem) {
  const int tid = tid_l();
  const int nch = len >> 4;
  const int lstep = tid >> 6, loff = (tid & 63) * 16;
  u32x4 st[4];
#pragma unroll
  for (int i = 0; i < 4; i++) st[i] = *(const u32x4*)(gsrc + (size_t)(lstep + 4 * i) * RWS_ROWB + loff);
  __syncthreads();
#pragma unroll
  for (int i = 0; i < 4; i++) *(u32x4*)(smem + (lstep + 4 * i) * 1024 + loff) = st[i];
  if (nch > 1) {
#pragma unroll
    for (int i = 0; i < 4; i++) st[i] = *(const u32x4*)(gsrc + (size_t)(16 + lstep + 4 * i) * RWS_ROWB + loff);
  }
  __syncthreads();
  for (int c = 0; c < nch; c++) {
    const char* L = smem + (c & 1) * 16384;
#pragma unroll 4
    for (int t = 0; t < 16; t++) {
      const char* Ls = L + t * 1024;
      const f16x4 r = *(const f16x4*)(Ls + q * 8);
      const f16x4 k = *(const f16x4*)(Ls + 128 + q * 8);
      const f16x4 a = *(const f16x4*)(Ls + 256 + q * 8);
      const f16x4 b = *(const f16x4*)(Ls + 384 + q * 8);
      const float4 w = *(const float4*)(Ls + 512 + q * 16);
      const float vv = *(const float*)(Ls + 768 + v * 4);
      float sa0 = (float)a[0] * S.x;
      float sa1 = (float)a[2] * S.z;
      sa0 = fmaf((float)a[1], S.y, sa0);
      sa1 = fmaf((float)a[3], S.w, sa1);
      float t0 = fmaf(vv, (float)k[0], S.x * w.x);
      float t1 = fmaf(vv, (float)k[1], S.y * w.y);
      float t2 = fmaf(vv, (float)k[2], S.z * w.z);
      float t3 = fmaf(vv, (float)k[3], S.w * w.w);
      const float sa = rowsum16(sa0 + sa1);
      S.x = fmaf(sa, (float)b[0], t0);
      S.y = fmaf(sa, (float)b[1], t1);
      S.z = fmaf(sa, (float)b[2], t2);
      S.w = fmaf(sa, (float)b[3], t3);
      float y0 = (float)r[0] * S.x;
      float y1 = (float)r[2] * S.z;
      y0 = fmaf((float)r[1], S.y, y0);
      y1 = fmaf((float)r[3], S.w, y1);
      const float y = rowsum16(y0 + y1);
      if (q == 0) yo[(size_t)(c * 16 + t) * DM] = y;
    }
    if (c + 1 < nch) {
      char* Ln = smem + ((c + 1) & 1) * 16384;
#pragma unroll
      for (int i = 0; i < 4; i++) *(u32x4*)(Ln + (lstep + 4 * i) * 1024 + loff) = st[i];
      if (c + 2 < nch) {
#pragma unroll
        for (int i = 0; i < 4; i++)
          st[i] = *(const u32x4*)(gsrc + (size_t)((c + 2) * 16 + lstep + 4 * i) * RWS_ROWB + loff);
      }
    }
    lds_barrier();
  }
}

__device__ __forceinline__ void gd_scan_run(const char* __restrict__ gsrc  , int len, float (&s)[8],
                            float* __restrict__ oo  , int q, int cl, char* smem) {
  const int tid = tid_l();
  const int nch = len >> 4;
  u32x4 st[4];
  int lt[4], lo[4];
#pragma unroll
  for (int i = 0; i < 4; i++) {
    int id = tid + 256 * i;
    if (id > 783) id = 783;
    lt[i] = id / 49;
    lo[i] = (id % 49) * 16;
  }
#pragma unroll
  for (int i = 0; i < 4; i++) st[i] = *(const u32x4*)(gsrc + (size_t)lt[i] * GDS_ROWB + lo[i]);
  __syncthreads();
#pragma unroll
  for (int i = 0; i < 4; i++) *(u32x4*)(smem + lt[i] * GDS_HB + lo[i]) = st[i];
  if (nch > 1) {
#pragma unroll
    for (int i = 0; i < 4; i++) st[i] = *(const u32x4*)(gsrc + (size_t)(16 + lt[i]) * GDS_ROWB + lo[i]);
  }
  __syncthreads();
  for (int c = 0; c < nch; c++) {
    const char* L = smem + (c & 1) * 16384;
#pragma unroll 4
    for (int t = 0; t < 16; t++) {
      const char* Ls = L + t * GDS_HB;
      const f16x8 qv = *(const f16x8*)(Ls + q * 16);
      const f16x8 kv = *(const f16x8*)(Ls + 256 + q * 16);
      const float vv = (float)*(const f16*)(Ls + 512 + cl * 2);
      const float eg = *(const float*)(Ls + 768);
      float k0 = (float)kv[0] * s[0], k1 = (float)kv[4] * s[4];
      k0 = fmaf((float)kv[1], s[1], k0); k1 = fmaf((float)kv[5], s[5], k1);
      k0 = fmaf((float)kv[2], s[2], k0); k1 = fmaf((float)kv[6], s[6], k1);
      k0 = fmaf((float)kv[3], s[3], k0); k1 = fmaf((float)kv[7], s[7], k1);
      float es[8];
#pragma unroll
      for (int i = 0; i < 8; i++) es[i] = eg * s[i];
      const float ks = rowsum16(k0 + k1);
      const float d = fmaf(-eg, ks, vv);
#pragma unroll
      for (int i = 0; i < 8; i++) s[i] = fmaf((float)kv[i], d, es[i]);
      float o0 = (float)qv[0] * s[0], o1 = (float)qv[4] * s[4];
      o0 = fmaf((float)qv[1], s[1], o0); o1 = fmaf((float)qv[5], s[5], o1);
      o0 = fmaf((float)qv[2], s[2], o0); o1 = fmaf((float)qv[6], s[6], o1);
      o0 = fmaf((float)qv[3], s[3], o0); o1 = fmaf((float)qv[7], s[7], o1);
      const float o = rowsum16(o0 + o1);
      if (q == 0) oo[(size_t)(c * 16 + t) * DM] = o;
    }
    if (c + 1 < nch) {
      char* Ln = smem + ((c + 1) & 1) * 16384;
#pragma unroll
      for (int i = 0; i < 4; i++) *(u32x4*)(Ln + lt[i] * GDS_HB + lo[i]) = st[i];
      if (c + 2 < nch) {
#pragma unroll
        for (int i = 0; i < 4; i++) st[i] = *(const u32x4*)(gsrc + (size_t)((c + 2) * 16 + lt[i]) * GDS_ROWB + lo[i]);
      }
    }
    lds_barrier();
  }
}

__device__ __forceinline__ void sample_scan_task(const Params* __restrict__ pp, int task, char* smem) {
  LAUNDER_PP;
  const int sj = task >> 7, j = task & 127, kind = j >> 6, jj = j & 63;
  const int tid = tid_l(), q = tid & 15;
  const int row0 = 1056 + sj * 16;
  if (kind == 0) {
    const int head = jj >> 2, v = (jj & 3) * 16 + (tid >> 4);
    const float* sin = p.st_wkv + ((size_t)sj * 16 + head) * 4096;
    float* sout = (p.out + OO_s_wkv) + ((size_t)sj * 16 + head) * 4096;
    float4 S = *(const float4*)(sin + v * 64 + 4 * q);
    rw_scan_run(((char*)(p.ws + OW_RWS)) + ((size_t)row0 * 16 + head) * 1024, 16, S, ((float*)(p.ws + OW_YRW)) + (size_t)row0 * DM + head * 64 + v, q, v, smem);
    *(float4*)(sout + v * 64 + 4 * q) = S;
  } else {
    const int head = jj >> 3, cl = (jj & 7) * 16 + (tid >> 4);
    const float* sin = p.st_ssm + ((size_t)sj * 8 + head) * 16384;
    float* sout = (p.out + OO_s_ssm) + ((size_t)sj * 8 + head) * 16384;
    float s[8];
#pragma unroll
    for (int i = 0; i < 8; i++) s[i] = sin[(size_t)(8 * q + i) * 128 + cl];
    gd_scan_run(((char*)(p.ws + OW_GDS)) + ((size_t)row0 * 8 + head) * GDS_HB, 16, s, ((float*)(p.ws + OW_OGD)) + (size_t)row0 * DM + head * 128 + cl, q, cl, smem);
#pragma unroll
    for (int i = 0; i < 8; i++) sout[(size_t)(8 * q + i) * 128 + cl] = s[i];
  }
}

__device__ __forceinline__ void scan_block_rw(const Params* __restrict__ pp, int j, char* smem) {
  LAUNDER_PP;
  const int seq = j >> 6, jj = j & 63;
  const int tid = tid_l(), q = tid & 15;
  const int head = jj >> 2, v = (jj & 3) * 16 + (tid >> 4);
  float4 S = make_float4(0.f, 0.f, 0.f, 0.f);
  for (int seg = 0; seg < NSEG; seg++) {
    wait_ge(((unsigned int*)(p.ws + OW_sync)) + SW_PRE, seg + 1);
    const int len = seg == 0 ? 528 : TS;
    const int row0 = slot_row0(seg) + (seg == 0 ? seq * 528 : seq * TS);
    rw_scan_run(((char*)(p.ws + OW_RWS)) + ((size_t)row0 * 16 + head) * 1024, len, S,
                ((float*)(p.ws + OW_YRW)) + (size_t)row0 * DM + head * 64 + v, q, v, smem);
    signal_add(((unsigned int*)(p.ws + OW_sync)) + SW_SCAN(seg));
  }
  *(float4*)((p.out + OO_p_wkv) + ((size_t)seq * 16 + head) * 4096 + v * 64 + 4 * q) = S;
}
__device__ __forceinline__ void scan_block_gd(const Params* __restrict__ pp, int j, char* smem) {
  LAUNDER_PP;
  const int seq = j >> 6, jj = j & 63;
  const int tid = tid_l(), q = tid & 15;
  const int head = jj >> 3, cl = (jj & 7) * 16 + (tid >> 4);
  float s[8];
#pragma unroll
  for (int i = 0; i < 8; i++) s[i] = 0.f;
  for (int seg = 0; seg < NSEG; seg++) {
    wait_ge(((unsigned int*)(p.ws + OW_sync)) + SW_PRE, seg + 1);
    const int len = seg == 0 ? 528 : TS;
    const int row0 = slot_row0(seg) + (seg == 0 ? seq * 528 : seq * TS);
    gd_scan_run(((char*)(p.ws + OW_GDS)) + ((size_t)row0 * 8 + head) * GDS_HB, len, s,
                ((float*)(p.ws + OW_OGD)) + (size_t)row0 * DM + head * 128 + cl, q, cl, smem);
    signal_add(((unsigned int*)(p.ws + OW_sync)) + SW_SCAN(seg));
  }
  float* sout = (p.out + OO_p_ssm) + ((size_t)seq * 8 + head) * 16384;
#pragma unroll
  for (int i = 0; i < 8; i++) sout[(size_t)(8 * q + i) * 128 + cl] = s[i];
}

__device__ __forceinline__ void post_item(const Params* __restrict__ pp, int seg, int row) {
  LAUNDER_PP;
  const int tid = tid_l(), c4 = tid * 4;
  const int srow = slot_row0(seg) + row;
  const bf16_t* gt = ((bf16_t*)(p.ws + OW_GT)) + (size_t)srow * GTW;
  {
    float4 y = *(const float4*)(((float*)(p.ws + OW_YRW)) + (size_t)srow * DM + c4);
    float mean = rowsum16(y.x + y.y + y.z + y.w) * (1.0f / 64.0f);
    float dx = y.x - mean, dy = y.y - mean, dz = y.z - mean, dw = y.w - mean;
    float var = rowsum16(dx * dx + dy * dy + dz * dz + dw * dw) * (1.0f / 64.0f);
    float rs = rsqrtf(var + 64e-5f);
    float4 lw = *(const float4*)(p.rw_ln_w + c4), lb = *(const float4*)(p.rw_ln_b + c4);
    float bon = ((float*)(p.ws + OW_RWB))[(size_t)srow * 16 + (tid >> 4)];
    float4 v = *(const float4*)(((char*)(p.ws + OW_RWS)) + ((size_t)srow * 16 + (tid >> 4)) * 1024 + 768 + (tid & 15) * 16);
    uint2 g = *(const uint2*)(gt + G_RW + c4);
    float o0 = (dx * rs * lw.x + lb.x + bon * v.x) * siluf_(bf2f(g.x & 0xffff));
    float o1 = (dy * rs * lw.y + lb.y + bon * v.y) * siluf_(bf2f(g.x >> 16));
    float o2 = (dz * rs * lw.z + lb.z + bon * v.z) * siluf_(bf2f(g.y & 0xffff));
    float o3 = (dw * rs * lw.w + lb.w + bon * v.w) * siluf_(bf2f(g.y >> 16));
    *(uint2*)(((bf16_t*)(p.ws + OW_YA)) + (size_t)row * DM + c4) = make_uint2(pack2(o0, o1), pack2(o2, o3));
  }
  {
    float4 o = *(const float4*)(((float*)(p.ws + OW_OGD)) + (size_t)srow * DM + c4);
    float ss = rowsum16(o.x * o.x + o.y * o.y + o.z * o.z + o.w * o.w);
    ss += __shfl_xor(ss, 16);
    float rs = rsqrtf(ss * (1.0f / 128.0f) + 1e-6f);
    float4 nw = *(const float4*)(p.gd_norm_w + (c4 & 127));
    uint2 g = *(const uint2*)(gt + G_GD + c4);
    float o0 = o.x * rs * nw.x * siluf_(bf2f(g.x & 0xffff));
    float o1 = o.y * rs * nw.y * siluf_(bf2f(g.x >> 16));
    float o2 = o.z * rs * nw.z * siluf_(bf2f(g.y & 0xffff));
    float o3 = o.w * rs * nw.w * siluf_(bf2f(g.y >> 16));
    *(uint2*)(((bf16_t*)(p.ws + OW_YB)) + (size_t)row * DM + c4) = make_uint2(pack2(o0, o1), pack2(o2, o3));
  }
}

#define SMEM_BYTES (32768 + 16)

__global__ void __launch_bounds__(256, 4) k_mega(Params p_arg) {
  const Params* pp = (const Params*)__builtin_amdgcn_kernarg_segment_ptr();
  __shared__ __attribute__((aligned(16))) char smem[SMEM_BYTES];
  cg::grid_group grid = cg::this_grid();
  const int bid = blockIdx.x, nb = gridDim.x;
  unsigned* sync = (unsigned*)(p.ws + OW_sync);
  const unsigned xcc = xcc_id() & 7u;
  if (bid >= NSCAN && threadIdx.x == 0) xb_add(&sync[SW_XCNT(xcc)], 1u);
  phase_weights(pp, bid, nb, smem);
  for (int it = bid; it < seg_MP(0) / 4; it += nb) xn_item(pp, 0, it);
  grid.sync();
  if (bid < NSCAN) {
    __builtin_amdgcn_s_setprio(3);
    if (bid < 128) scan_block_rw(pp, bid, smem);
    else scan_block_gd(pp, bid - 128, smem);
    return;
  }
  const int w = bid - NSCAN, NW = nb - NSCAN;
  unsigned* cfg = (unsigned*)(smem + 32768);
  if (threadIdx.x == 0) {
    unsigned mine = 0, nx = 0;
#pragma unroll
    for (unsigned j = 0; j < 8; j++) { unsigned c = xb_ld(&sync[SW_XCNT(j)]); nx += c > 0u ? 1u : 0u; mine = (j == xcc) ? c : mine; }
    cfg[0] = mine > 0u ? mine : 1u;
    cfg[1] = nx > 0u ? nx : 1u;
  }
  __syncthreads();
  for (int i = 0; i < NSEG + 3; i++) {
    const int sj = i - 2;
    const int sn = i - 3;
    const int sp = i - 1;
    const bool front = i < NSEG, back = sj >= 0 && sj < NSEG, nrm = sn >= 0 && sn < NSEG, pst = sp >= 0 && sp < NSEG;
    {
      const int nB = back ? (seg_MP(sj) / 128) * 8 : 0;
      const int tmF = front ? seg_MP(i) / 128 : 1;
      const int nF = front ? tmF * (VW / 128) : 0;
      for (int it = w; it < nB + nF; it += NW) {
        if (it < nB) { gemm_tile<1>(pp, sj, it >> 3, it & 7, smem); gemm_tile<3>(pp, sj, it >> 3, it & 7, smem); }
        else { int t = it - nB; gemm_tile<0>(pp, i, t % tmF, t / tmF, smem); }
      }
      if (i == 1) {
        for (int it = w; it < 32 * 128; it += NW) sample_scan_task(pp, it, smem);
      }
    }
    worker_barrier((unsigned*)(p.ws + OW_sync), (const unsigned*)(smem + 32768));
    {
      const int nB = back ? (seg_MP(sj) / 128) * 8 : 0;
      const int ngrp = front ? seg_M(i) / 16 : 0;
      const int nRW = ngrp * 8, nGD = ngrp * 6;
      const int nX = (i + 1 < NSEG) ? seg_MP(i + 1) / 4 : 0;
      const int nN = nrm ? seg_M(sn) / 4 : 0;
      const int tot = nB + nRW + nGD + nX + nN;
      for (int it = w; it < tot; it += NW) {
        int t = it;
        if (t < nB) { gemm_tile<2>(pp, sj, t >> 3, t & 7, smem); continue; }
        t -= nB;
        if (t < nRW) { rw_prepass_item(pp, i, t >> 2, t & 3, smem); continue; }
        t -= nRW;
        if (t < nGD) { gd_prepass_item(pp, i, t / 6, t % 6); continue; }
        t -= nGD;
        if (t < nX) { xn_item(pp, i + 1, t); continue; }
        t -= nX;
        norm_item(pp, sn, t);
      }
      if (pst) {
        wait_ge((unsigned*)(p.ws + OW_sync) + SW_SCAN(sp), NSCAN);
        const int n = seg_M(sp);
        for (int it = w; it < n; it += NW) post_item(pp, sp, it);
      }
    }
    worker_barrier((unsigned*)(p.ws + OW_sync), (const unsigned*)(smem + 32768));
    if (front && w == 0 && threadIdx.x == 0)
      __hip_atomic_store((unsigned*)(p.ws + OW_sync) + SW_PRE, (unsigned)(i + 1), __ATOMIC_RELAXED, __HIP_MEMORY_SCOPE_AGENT);
  }
}

static inline size_t align_up(size_t x) { return (x + 255) & ~(size_t)255; }

#undef p
extern "C" void kernel_launch(void* const* d_in, const int* in_sizes, int n_in, void* d_out, int out_size, void* d_ws,
                              size_t ws_size, hipStream_t stream) {
  Params p{};
  const float* const* in = (const float* const*)d_in;
  p.x_prompt = in[0]; p.x_sample = in[1]; p.st_shift = in[2]; p.st_wkv = in[3]; p.st_conv = in[4]; p.st_ssm = in[5];
  p.meta = in[6]; p.norm_pre = in[7]; p.w_in = in[8]; p.rw_mu = in[9]; p.rw_w0 = in[10]; p.rw_w2 = in[11];
  p.rw_a0 = in[12]; p.rw_a2 = in[13]; p.rw_k_k = in[14]; p.rw_k_a = in[15]; p.rw_r_k = in[16]; p.rw_ln_w = in[17];
  p.rw_ln_b = in[18]; p.gd_conv_w = in[19]; p.gd_a_log = in[20]; p.gd_dt_bias = in[21]; p.gd_norm_w = in[22];
  p.w_out_a = in[23]; p.w_out_b = in[24]; p.w_out = in[25]; p.norm_post = in[26];
  p.out = (float*)d_out;
  p.ws = (char*)d_ws;
  if (OW_END > ws_size) { fprintf(stderr, "workspace too small: need %zu have %zu\n", (size_t)OW_END, ws_size); return; }

  static int grid_blocks = 0;
  if (!grid_blocks) {
    int dev = 0, cus = 0, per_cu = 0;
    (void)hipGetDevice(&dev);
    (void)hipDeviceGetAttribute(&cus, hipDeviceAttributeMultiprocessorCount, dev);
    (void)hipOccupancyMaxActiveBlocksPerMultiprocessor(&per_cu, k_mega, 256, 0);
    if (per_cu > 4) per_cu = 4;
    grid_blocks = cus * per_cu;
  }
  (void)hipMemsetAsync(p.ws + OW_sync, 0, 16384, stream);
  void* args[] = {&p};
  hipError_t e = hipLaunchCooperativeKernel((void*)k_mega, dim3(grid_blocks), dim3(256), args, 0, stream);
  if (e != hipSuccess) fprintf(stderr, "cooperative launch failed: %s (grid %d)\n", hipGetErrorString(e), grid_blocks);
}
```

```cpp
#include <hip/hip_runtime.h>
#include <hip/hip_cooperative_groups.h>
#include <stdint.h>
#include <stdio.h>
namespace cg = cooperative_groups;

typedef unsigned short bf16_t;
typedef _Float16 f16;
using bf16x8 = __attribute__((ext_vector_type(8))) short;
using f32x4 = __attribute__((ext_vector_type(4))) float;
using u32x4 = __attribute__((ext_vector_type(4))) unsigned int;
using f16x2 = __attribute__((ext_vector_type(2))) _Float16;
using f16x4 = __attribute__((ext_vector_type(4))) _Float16;
using f16x8 = __attribute__((ext_vector_type(8))) _Float16;

#define DM 1024
#define PW 10384
#define VW 10496
#define PJW 6400
#define GTW 4096
#define NSEG 16
#define TS 512
#define M0 1568
#define MP0 1664
#define M1 1024
#define SLOT_ROWS 3712
#define NSCAN 256
#define C_GDC 3200
#define C_BETA 6272
#define C_ALPHA 6280
#define G_RW 0
#define G_GD 1024
#define G_MA 2048
#define G_MB 3072
#define RWS_ROWB 16384
#define GDS_HB 784
#define GDS_ROWB 6272

struct Params {
  const float *x_prompt, *x_sample, *st_shift, *st_wkv, *st_conv, *st_ssm, *meta, *norm_pre, *w_in, *rw_mu, *rw_w0,
      *rw_w2, *rw_a0, *rw_a2, *rw_k_k, *rw_k_a, *rw_r_k, *rw_ln_w, *rw_ln_b, *gd_conv_w, *gd_a_log, *gd_dt_bias,
      *gd_norm_w, *w_out_a, *w_out_b, *w_out, *norm_post;
  float* out;
  char* ws;
};
#define p (PV(pp))
#define GLOBAL_AS __attribute__((address_space(1)))
#define CONST_AS __attribute__((address_space(4)))
struct ParamsG {
  const GLOBAL_AS float *x_prompt, *x_sample, *st_shift, *st_wkv, *st_conv, *st_ssm, *meta, *norm_pre, *w_in, *rw_mu, *rw_w0,
      *rw_w2, *rw_a0, *rw_a2, *rw_k_k, *rw_k_a, *rw_r_k, *rw_ln_w, *rw_ln_b, *gd_conv_w, *gd_a_log, *gd_dt_bias,
      *gd_norm_w, *w_out_a, *w_out_b, *w_out, *norm_post;
  GLOBAL_AS float* out;
  GLOBAL_AS char* ws;
};
typedef const CONST_AS ParamsG* PP;
__device__ __forceinline__ Params PV(PP pp) {
  Params v;
  v.x_prompt = (const float*)pp->x_prompt;
  v.x_sample = (const float*)pp->x_sample;
  v.st_shift = (const float*)pp->st_shift;
  v.st_wkv = (const float*)pp->st_wkv;
  v.st_conv = (const float*)pp->st_conv;
  v.st_ssm = (const float*)pp->st_ssm;
  v.meta = (const float*)pp->meta;
  v.norm_pre = (const float*)pp->norm_pre;
  v.w_in = (const float*)pp->w_in;
  v.rw_mu = (const float*)pp->rw_mu;
  v.rw_w0 = (const float*)pp->rw_w0;
  v.rw_w2 = (const float*)pp->rw_w2;
  v.rw_a0 = (const float*)pp->rw_a0;
  v.rw_a2 = (const float*)pp->rw_a2;
  v.rw_k_k = (const float*)pp->rw_k_k;
  v.rw_k_a = (const float*)pp->rw_k_a;
  v.rw_r_k = (const float*)pp->rw_r_k;
  v.rw_ln_w = (const float*)pp->rw_ln_w;
  v.rw_ln_b = (const float*)pp->rw_ln_b;
  v.gd_conv_w = (const float*)pp->gd_conv_w;
  v.gd_a_log = (const float*)pp->gd_a_log;
  v.gd_dt_bias = (const float*)pp->gd_dt_bias;
  v.gd_norm_w = (const float*)pp->gd_norm_w;
  v.w_out_a = (const float*)pp->w_out_a;
  v.w_out_b = (const float*)pp->w_out_b;
  v.w_out = (const float*)pp->w_out;
  v.norm_post = (const float*)pp->norm_post;
  v.out = (float*)pp->out;
  v.ws = (char*)pp->ws;
  return v;
}
constexpr size_t al256(size_t x) { return (x + 255) & ~(size_t)255; }
constexpr size_t OO_y_prompt = 0;
constexpr size_t OO_y_sample = OO_y_prompt + (size_t)2 * 8192 * 1024;
constexpr size_t OO_p_shift = OO_y_sample + (size_t)32 * 16 * 1024;
constexpr size_t OO_p_wkv = OO_p_shift + 2 * 3200;
constexpr size_t OO_p_conv = OO_p_wkv + 2 * 16 * 4096;
constexpr size_t OO_p_ssm = OO_p_conv + 2 * 3 * 3072;
constexpr size_t OO_s_shift = OO_p_ssm + 2 * 8 * 16384;
constexpr size_t OO_s_wkv = OO_s_shift + 32 * 3200;
constexpr size_t OO_s_conv = OO_s_wkv + 32 * 16 * 4096;
constexpr size_t OO_s_ssm = OO_s_conv + 32 * 3 * 3072;
constexpr size_t OW_sync = 0;
constexpr size_t OW_WtIn = OW_sync + 16384;
constexpr size_t OW_WtA = OW_WtIn + al256((size_t)VW * DM * 2);
constexpr size_t OW_WtB = OW_WtA + al256((size_t)DM * DM * 2);
constexpr size_t OW_WtO = OW_WtB + al256((size_t)DM * DM * 2);
constexpr size_t OW_XN = OW_WtO + al256((size_t)DM * DM * 2);
constexpr size_t OW_PJA = OW_XN + al256((size_t)MP0 * DM * 2);
constexpr size_t OW_YA = OW_PJA + al256((size_t)MP0 * PJW * 2);
constexpr size_t OW_YB = OW_YA + al256((size_t)MP0 * DM * 2);
constexpr size_t OW_MG = OW_YB + al256((size_t)MP0 * DM * 2);
constexpr size_t OW_OUTB = OW_MG + al256((size_t)MP0 * DM * 2);
constexpr size_t OW_TMP = OW_OUTB + al256((size_t)2 * MP0 * DM * 4);
constexpr size_t OW_GT = OW_TMP + al256((size_t)MP0 * DM * 4);
constexpr size_t OW_RWS = OW_GT + al256((size_t)SLOT_ROWS * GTW * 2);
constexpr size_t OW_GDS = OW_RWS + al256((size_t)SLOT_ROWS * RWS_ROWB);
constexpr size_t OW_RWB = OW_GDS + al256((size_t)SLOT_ROWS * GDS_ROWB + 256);
constexpr size_t OW_YRW = OW_RWB + al256((size_t)SLOT_ROWS * 16 * 4);
constexpr size_t OW_OGD = OW_YRW + al256((size_t)SLOT_ROWS * DM * 4);
constexpr size_t OW_CSH = OW_OGD + al256((size_t)SLOT_ROWS * DM * 4);
constexpr size_t OW_CCV = OW_CSH + al256((size_t)2 * 2 * 3200 * 4);
constexpr size_t OW_END = OW_CCV + al256((size_t)2 * 2 * 3 * 3072 * 4);


__device__ __forceinline__ bf16_t f2bf(float f) {
  uint32_t u = __float_as_uint(f);
  u += 0x7fffu + ((u >> 16) & 1u);
  return (bf16_t)(u >> 16);
}
__device__ __forceinline__ float bf2f(bf16_t h) { return __uint_as_float(((uint32_t)h) << 16); }
__device__ __forceinline__ uint32_t pack2(float a, float b) { return (uint32_t)f2bf(a) | ((uint32_t)f2bf(b) << 16); }
__device__ __forceinline__ float sigmoidf_(float x) { return 1.0f / (1.0f + __expf(-x)); }
__device__ __forceinline__ float siluf_(float x) { return x / (1.0f + __expf(-x)); }
__device__ __forceinline__ float softplusf_(float x) { return fmaxf(x, 0.0f) + log1pf(__expf(-fabsf(x))); }

__device__ __forceinline__ int tid_l() { int t = threadIdx.x; asm volatile("" : "+v"(t)); return t; }
#define LAUNDER_PP asm volatile("" : "+s"(pp))
template <int CTRL>
__device__ __forceinline__ float dppf(float x) {
  return __builtin_bit_cast(float, __builtin_amdgcn_update_dpp(0, __builtin_bit_cast(int, x), CTRL, 0xf, 0xf, true));
}
__device__ __forceinline__ float rowsum16(float x) {
  x += dppf<0xB1>(x);
  x += dppf<0x4E>(x);
  x += dppf<0x141>(x);
  x += dppf<0x140>(x);
  return x;
}
__device__ __forceinline__ float wavesum(float x) {
  x = rowsum16(x);
  x += __shfl_xor(x, 16);
  x += __shfl_xor(x, 32);
  return x;
}

#define SW_XCNT(j) (64 * (1 + (j)))
#define SW_XSUB(j) (64 * (9 + (j)))
#define SW_XGEN(j) (64 * (17 + (j)))
#define SW_TOP (64 * 25)
#define SW_TOPGEN (64 * 26)
#define SW_PRE (64 * 27)
#define SW_SCAN(s) (64 * (28 + (s)))
#define SYNC_BYTES 16384
__device__ __forceinline__ unsigned xb_ld(const unsigned* ptr) {
  return __hip_atomic_load(ptr, __ATOMIC_RELAXED, __HIP_MEMORY_SCOPE_AGENT);
}
__device__ __forceinline__ unsigned xb_add(unsigned* ptr, unsigned v) {
  return __hip_atomic_fetch_add(ptr, v, __ATOMIC_RELAXED, __HIP_MEMORY_SCOPE_AGENT);
}
__device__ __forceinline__ unsigned xcc_id() { return (unsigned)__builtin_amdgcn_s_getreg((3 << 11) | 20) & 0xFu; }
__device__ __forceinline__ void wait_ge(const unsigned* ptr, unsigned target) {
  if (threadIdx.x == 0) {
    while (xb_ld(ptr) < target) __builtin_amdgcn_s_sleep(8);
    __builtin_amdgcn_fence(__ATOMIC_ACQUIRE, "agent");
    asm volatile("s_waitcnt vmcnt(0)" ::: "memory");
  }
  __syncthreads();
}
__device__ __forceinline__ void signal_add(unsigned* ptr) {
  asm volatile("s_waitcnt vmcnt(0)" ::: "memory");
  __syncthreads();
  if (threadIdx.x == 0) {
    __builtin_amdgcn_fence(__ATOMIC_RELEASE, "agent");
    asm volatile("s_waitcnt vmcnt(0)" ::: "memory");
    xb_add(ptr, 1u);
  }
}
__device__ __forceinline__ void worker_barrier(unsigned* bar, const unsigned* lds_cfg) {
  asm volatile("s_waitcnt vmcnt(0)" ::: "memory");
  __syncthreads();
  if (threadIdx.x == 0) {
    const unsigned x = xcc_id() & 7u, nloc = lds_cfg[0], nx = lds_cfg[1];
    const unsigned old = xb_add(&bar[SW_XSUB(x)], 1u);
    const unsigned gen = old / nloc;
    if (old + 1u == (gen + 1u) * nloc) {
      __builtin_amdgcn_fence(__ATOMIC_RELEASE, "agent");
      asm volatile("s_waitcnt vmcnt(0)" ::: "memory");
      const unsigned og = xb_add(&bar[SW_TOP], 1u);
      const unsigned tg = og / nx;
      if (og + 1u == (tg + 1u) * nx) xb_add(&bar[SW_TOPGEN], 1u);
      else while (xb_ld(&bar[SW_TOPGEN]) == tg) __builtin_amdgcn_s_sleep(1);
      __builtin_amdgcn_fence(__ATOMIC_ACQUIRE, "agent");
      xb_add(&bar[SW_XGEN(x)], 1u);
      asm volatile("s_waitcnt vmcnt(0)" ::: "memory");
    } else {
      while (xb_ld(&bar[SW_XGEN(x)]) == gen) __builtin_amdgcn_s_sleep(1);
      __builtin_amdgcn_fence(__ATOMIC_ACQUIRE, "agent");
      asm volatile("s_waitcnt vmcnt(0)" ::: "memory");
    }
  }
  __syncthreads();
}

__device__ __forceinline__ void lds_barrier() {
  asm volatile("s_waitcnt lgkmcnt(0)" ::: "memory");
  __builtin_amdgcn_s_barrier();
  asm volatile("" ::: "memory");
}

__device__ __forceinline__ int seg_M(int seg) { return seg == 0 ? M0 : M1; }
__device__ __forceinline__ int seg_MP(int seg) { return seg == 0 ? MP0 : M1; }
__device__ __forceinline__ int slot_row0(int seg) { int s = seg % 3; return s == 0 ? 0 : MP0 + (s - 1) * M1; }
__device__ __forceinline__ const float* row_src(PP pp, int seg, int r) {
  if (seg == 0) {
    if (r < 1056) {
      int b = r >= 528 ? 1 : 0, t = r - b * 528;
      if (t < 16) return p.meta + t * DM;
      return p.x_prompt + ((size_t)b * 8192 + (t - 16)) * DM;
    }
    return p.x_sample + (size_t)(r - 1056) * DM;
  }
  int b = r >> 9, t = r & 511;
  return p.x_prompt + ((size_t)b * 8192 + seg * TS + t) * DM;
}
__device__ __forceinline__ float* row_dst(PP pp, int seg, int r) {
  if (seg == 0) {
    if (r < 1056) {
      int b = r >= 528 ? 1 : 0, t = r - b * 528;
      if (t < 16) return nullptr;
      return (p.out + OO_y_prompt) + ((size_t)b * 8192 + (t - 16)) * DM;
    }
    return (p.out + OO_y_sample) + (size_t)(r - 1056) * DM;
  }
  int b = r >> 9, t = r & 511;
  return (p.out + OO_y_prompt) + ((size_t)b * 8192 + seg * TS + t) * DM;
}
__device__ __forceinline__ void row_seq(int seg, int r, int& seq, int& t, int& len) {
  if (seg == 0) {
    if (r < 528) { seq = 0; t = r; len = 528; }
    else if (r < 1056) { seq = 1; t = r - 528; len = 528; }
    else { seq = 2 + ((r - 1056) >> 4); t = (r - 1056) & 15; len = 16; }
  } else { seq = r >> 9; t = r & 511; len = TS; }
}

__device__ __forceinline__ int vcol_src(int n) {
  if (n < 3200) return n;
  if (n < 6288) return n + 1024;
  if (n < 6400) return -1;
  if (n < 7424) return n - 3200;
  return n - 112;
}
__device__ __forceinline__ void transpose_tile(const float* __restrict__ src, int ld, bool remap, bf16_t* __restrict__ dst, int k0, int n0,
                               float* tile  ) {
  int tid = tid_l();
  int i = tid >> 4, j = tid & 15;
  __syncthreads();
  int n = n0 + 4 * j;
  int sc = remap ? vcol_src(n) : n;
#pragma unroll
  for (int pass = 0; pass < 4; pass++) {
    int k = pass * 16 + i;
    float4 v = make_float4(0.f, 0.f, 0.f, 0.f);
    if (sc >= 0) v = *(const float4*)(src + (size_t)(k0 + k) * ld + sc);
    tile[k * 65 + 4 * j + 0] = v.x; tile[k * 65 + 4 * j + 1] = v.y; tile[k * 65 + 4 * j + 2] = v.z; tile[k * 65 + 4 * j + 3] = v.w;
  }
  __syncthreads();
  int nn = tid >> 2, kq = tid & 3;
  uint32_t o[8];
#pragma unroll
  for (int e = 0; e < 8; e++) o[e] = pack2(tile[(kq * 16 + 2 * e) * 65 + nn], tile[(kq * 16 + 2 * e + 1) * 65 + nn]);
  u32x4* d = (u32x4*)(dst + (size_t)(n0 + nn) * DM + k0 + kq * 16);
  d[0] = (u32x4){o[0], o[1], o[2], o[3]};
  d[1] = (u32x4){o[4], o[5], o[6], o[7]};
}
__device__ __forceinline__ void phase_weights(PP pp, int bid, int nb, char* smem) {
  LAUNDER_PP;
  float* tile = (float*)smem;
  const int nIn = 16 * (VW / 64);
  const int nSq = 16 * 16;
  for (int it = bid; it < nIn + 3 * nSq; it += nb) {
    if (it < nIn) {
      int kt = it & 15, nt = it >> 4;
      transpose_tile(p.w_in, PW, true, ((bf16_t*)(p.ws + OW_WtIn)), kt * 64, nt * 64, tile);
    } else {
      int j = it - nIn, w = j / nSq, r = j % nSq;
      int kt = r & 15, nt = r >> 4;
      const float* src = w == 0 ? p.w_out_a : (w == 1 ? p.w_out_b : p.w_out);
      bf16_t* dst = w == 0 ? ((bf16_t*)(p.ws + OW_WtA)) : (w == 1 ? ((bf16_t*)(p.ws + OW_WtB)) : ((bf16_t*)(p.ws + OW_WtO)));
      transpose_tile(src, DM, false, dst, kt * 64, nt * 64, tile);
    }
  }
}

__device__ __forceinline__ void xn_item(PP pp, int seg, int item) {
  LAUNDER_PP;
  int wave = tid_l() >> 6, lane = tid_l() & 63;
  int M = seg_M(seg);
  int r = item * 4 + wave;
  bf16_t* o = ((bf16_t*)(p.ws + OW_XN)) + (size_t)r * DM;
  if (r >= M) {
#pragma unroll
    for (int i = 0; i < 4; i++) *(uint2*)(o + (lane + 64 * i) * 4) = make_uint2(0u, 0u);
    return;
  }
  const float4* src = (const float4*)row_src(pp, seg, r);
  float4 v[4];
  float ss = 0.f;
#pragma unroll
  for (int i = 0; i < 4; i++) {
    v[i] = src[lane + 64 * i];
    ss += v[i].x * v[i].x + v[i].y * v[i].y + v[i].z * v[i].z + v[i].w * v[i].w;
  }
  ss = wavesum(ss);
  float rstd = rsqrtf(ss * (1.0f / DM) + 1e-6f);
#pragma unroll
  for (int i = 0; i < 4; i++) {
    float4 g = ((const float4*)p.norm_pre)[lane + 64 * i];
    *(uint2*)(o + (lane + 64 * i) * 4) =
        make_uint2(pack2(v[i].x * rstd * g.x, v[i].y * rstd * g.y), pack2(v[i].z * rstd * g.z, v[i].w * rstd * g.w));
  }
}

__device__ __forceinline__ void norm_item(PP pp, int seg, int item) {
  LAUNDER_PP;
  int wave = tid_l() >> 6, lane = tid_l() & 63;
  int r = item * 4 + wave;
  float* dst = row_dst(pp, seg, r);
  if (!dst) return;
  const float4* h = (const float4*)row_src(pp, seg, r);
  const float4* o = (const float4*)(((float*)(p.ws + OW_OUTB)) + ((size_t)(seg & 1) * MP0 + r) * DM);
  float4 v[4];
  float ss = 0.f;
#pragma unroll
  for (int i = 0; i < 4; i++) {
    v[i] = o[lane + 64 * i];
    ss += v[i].x * v[i].x + v[i].y * v[i].y + v[i].z * v[i].z + v[i].w * v[i].w;
  }
  ss = wavesum(ss);
  float rstd = rsqrtf(ss * (1.0f / DM) + 1e-6f);
#pragma unroll
  for (int i = 0; i < 4; i++) {
    float4 g = ((const float4*)p.norm_post)[lane + 64 * i];
    float4 hh = h[lane + 64 * i];
    ((float4*)dst)[lane + 64 * i] =
        make_float4(hh.x + v[i].x * rstd * g.x, hh.y + v[i].y * rstd * g.y, hh.z + v[i].z * rstd * g.z, hh.w + v[i].w * rstd * g.w);
  }
}

#define LDT 40
template <int MODE>
__device__ __forceinline__ void gemm_tile(PP pp, int seg, int tm, int tn, char* smem) {
  LAUNDER_PP;
  bf16_t* sA = (bf16_t*)smem;
  bf16_t* sB = sA + 128 * LDT;
  const int tid = tid_l(), lane = tid & 63, wid = tid >> 6;
  const int wr = wid >> 1, wc = wid & 1, fr = lane & 15, fq = lane >> 4;
  const int lrow = tid >> 2, lkc = tid & 3;
  const int m0 = tm * 128, n0 = tn * 128;
  bf16_t* GTs = ((bf16_t*)(p.ws + OW_GT)) + (size_t)slot_row0(seg) * GTW;
  f32x4 acc[4][4];
#pragma unroll
  for (int a = 0; a < 4; a++)
#pragma unroll
    for (int b = 0; b < 4; b++) acc[a][b] = (f32x4){0.f, 0.f, 0.f, 0.f};
  {
    const bf16_t* A = (const bf16_t*)(p.ws + (MODE == 0 ? OW_XN : (MODE == 1 ? OW_YA : (MODE == 3 ? OW_YB : OW_MG))));
    const bf16_t* Bt = (const bf16_t*)(p.ws + (MODE == 0 ? OW_WtIn : (MODE == 1 ? OW_WtA : (MODE == 3 ? OW_WtB : OW_WtO))));
    u32x4 ra[2], rb[2];
    const bf16_t* gA = A + (size_t)(m0 + lrow) * DM + lkc * 8;
    const bf16_t* gB = Bt + (size_t)(n0 + lrow) * DM + lkc * 8;
#pragma unroll
    for (int i = 0; i < 2; i++) {
      ra[i] = *(const u32x4*)(gA + (size_t)i * 64 * DM);
      rb[i] = *(const u32x4*)(gB + (size_t)i * 64 * DM);
    }
    bf16_t* wA = sA + lrow * LDT + lkc * 8;
    bf16_t* wB = sB + lrow * LDT + lkc * 8;
    const bf16_t* rA = sA + (wr * 64 + fr) * LDT + fq * 8;
    const bf16_t* rB = sB + (wc * 64 + fr) * LDT + fq * 8;
    for (int kt = 0; kt < 32; kt++) {
      __syncthreads();
#pragma unroll
      for (int i = 0; i < 2; i++) {
        *(u32x4*)(wA + i * 64 * LDT) = ra[i];
        *(u32x4*)(wB + i * 64 * LDT) = rb[i];
      }
      __syncthreads();
      if (kt + 1 < 32) {
#pragma unroll
        for (int i = 0; i < 2; i++) {
          ra[i] = *(const u32x4*)(gA + (size_t)i * 64 * DM + (kt + 1) * 32);
          rb[i] = *(const u32x4*)(gB + (size_t)i * 64 * DM + (kt + 1) * 32);
        }
      }
      bf16x8 xa[4];
#pragma unroll
      for (int i = 0; i < 4; i++) xa[i] = *(const bf16x8*)(rA + i * 16 * LDT);
#pragma unroll
      for (int ni = 0; ni < 4; ni++) {
        const bf16x8 wb = *(const bf16x8*)(rB + ni * 16 * LDT);
#pragma unroll
        for (int mi = 0; mi < 4; mi++)
          acc[ni][mi] = __builtin_amdgcn_mfma_f32_16x16x32_bf16(wb, xa[mi], acc[ni][mi], 0, 0, 0);
      }
    }
  }
  float* OUTBp = (MODE == 2) ? (float*)(p.ws + OW_OUTB) + (size_t)(seg & 1) * MP0 * DM : (float*)(p.ws + OW_TMP);
#pragma unroll
  for (int ni = 0; ni < 4; ni++)
#pragma unroll
    for (int mi = 0; mi < 4; mi++) {
      const int m = m0 + wr * 64 + mi * 16 + fr;
      const int n = n0 + wc * 64 + ni * 16 + fq * 4;
      f32x4 c = acc[ni][mi];
      if (MODE == 0) {
        uint2 o = make_uint2(pack2(c[0], c[1]), pack2(c[2], c[3]));
        if (tn < PJW / 128) *(uint2*)(((bf16_t*)(p.ws + OW_PJA)) + (size_t)m * PJW + n) = o;
        else *(uint2*)(GTs + (size_t)m * GTW + (n - PJW)) = o;
      } else if (MODE == 1) {
        uint2 ga = *(const uint2*)(GTs + (size_t)m * GTW + G_MA + n);
        *(float4*)(OUTBp + (size_t)m * DM + n) =
            make_float4(sigmoidf_(bf2f(ga.x & 0xffff)) * c[0], sigmoidf_(bf2f(ga.x >> 16)) * c[1],
                        sigmoidf_(bf2f(ga.y & 0xffff)) * c[2], sigmoidf_(bf2f(ga.y >> 16)) * c[3]);
      } else if (MODE == 3) {
        uint2 gb = *(const uint2*)(GTs + (size_t)m * GTW + G_MB + n);
        float4 t = *(const float4*)(OUTBp + (size_t)m * DM + n);
        float o0 = t.x + sigmoidf_(bf2f(gb.x & 0xffff)) * c[0];
        float o1 = t.y + sigmoidf_(bf2f(gb.x >> 16)) * c[1];
        float o2 = t.z + sigmoidf_(bf2f(gb.y & 0xffff)) * c[2];
        float o3 = t.w + sigmoidf_(bf2f(gb.y >> 16)) * c[3];
        *(uint2*)(((bf16_t*)(p.ws + OW_MG)) + (size_t)m * DM + n) = make_uint2(pack2(o0, o1), pack2(o2, o3));
      } else {
        *(float4*)(OUTBp + (size_t)m * DM + n) = make_float4(c[0], c[1], c[2], c[3]);
      }
    }
}

__device__ __forceinline__ void rw_prepass_item(PP pp, int seg, int grp, int slab, char* smem) {
  LAUNDER_PP;
  float* lwa = (float*)smem;
  const int tid = tid_l();
  const int r0 = grp * 8;
  int seq, t0, len;
  row_seq(seg, r0, seq, t0, len);
  const bool prompt = seq < 2;
  const float* prev0 = nullptr;
  if (t0 == 0) {
    if (seg == 0) prev0 = prompt ? nullptr : p.st_shift + (size_t)(seq - 2) * 3200;
    else prev0 = ((float*)(p.ws + OW_CSH)) + ((size_t)(seg & 1) * 2 + seq) * 3200;
  }
  __syncthreads();
  {
    const int j = tid & 127;
    const float mu = p.rw_mu[3072 + j];
#pragma unroll
    for (int i = 0; i < 4; i++) {
      int tok = (tid >> 7) + 2 * i;
      int row = r0 + tok;
      float ps = bf2f(((bf16_t*)(p.ws + OW_PJA))[(size_t)row * PJW + 3072 + j]);
      float pv;
      if (tok == 0 && t0 == 0) pv = prev0 ? prev0[3072 + j] : 0.f;
      else pv = bf2f(((bf16_t*)(p.ws + OW_PJA))[(size_t)(row - 1) * PJW + 3072 + j]);
      float xs = ps + mu * (pv - ps);
      lwa[tok * 128 + j] = j < 64 ? tanhf(xs) : xs;
      if (slab == 0 && t0 + tok == len - 1) {
        if (prompt) {
          ((float*)(p.ws + OW_CSH))[((size_t)((seg + 1) & 1) * 2 + seq) * 3200 + 3072 + j] = ps;
          if (seg == NSEG - 1) (p.out + OO_p_shift)[(size_t)seq * 3200 + 3072 + j] = ps;
        } else {
          (p.out + OO_s_shift)[(size_t)(seq - 2) * 3200 + 3072 + j] = ps;
        }
      }
    }
  }
  __syncthreads();
  const int c = slab * 256 + tid;
  float dw[8], da[8];
  {
    const float w0 = p.rw_w0[c], a0 = p.rw_a0[c];
#pragma unroll
    for (int t = 0; t < 8; t++) { dw[t] = w0; da[t] = a0; }
  }
  for (int j = 0; j < 64; j += 4) {
    float w2v[4], a2v[4];
#pragma unroll
    for (int e = 0; e < 4; e++) {
      w2v[e] = p.rw_w2[(size_t)(j + e) * DM + c];
      a2v[e] = p.rw_a2[(size_t)(j + e) * DM + c];
    }
#pragma unroll
    for (int t = 0; t < 8; t++) {
      float4 lw = *(const float4*)(lwa + t * 128 + j);
      float4 la = *(const float4*)(lwa + t * 128 + 64 + j);
      dw[t] += lw.x * w2v[0] + lw.y * w2v[1] + lw.z * w2v[2] + lw.w * w2v[3];
      da[t] += la.x * a2v[0] + la.y * a2v[1] + la.z * a2v[2] + la.w * a2v[3];
    }
  }
  const float mur = p.rw_mu[c], muk = p.rw_mu[1024 + c], muv = p.rw_mu[2048 + c];
  const float kk_w = p.rw_k_k[c], ka_w = p.rw_k_a[c], rk_w = p.rw_r_k[c];
  float pr, pk, pv;
  if (t0 == 0) {
    pr = prev0 ? prev0[c] : 0.f; pk = prev0 ? prev0[1024 + c] : 0.f; pv = prev0 ? prev0[2048 + c] : 0.f;
  } else {
    const bf16_t* q = ((bf16_t*)(p.ws + OW_PJA)) + (size_t)(r0 - 1) * PJW;
    pr = bf2f(q[c]); pk = bf2f(q[1024 + c]); pv = bf2f(q[2048 + c]);
  }
  const int head = c >> 6, e = c & 63;
  const int srow0 = slot_row0(seg);
  char* rws = ((char*)(p.ws + OW_RWS)) + ((size_t)(srow0 + r0) * 16 + head) * 1024;
  float* rwb = ((float*)(p.ws + OW_RWB)) + (size_t)(srow0 + r0) * 16 + head;
#pragma unroll
  for (int t = 0; t < 8; t++) {
    const int row = r0 + t;
    const bf16_t* q = ((bf16_t*)(p.ws + OW_PJA)) + (size_t)row * PJW;
    float cr = bf2f(q[c]), ck = bf2f(q[1024 + c]), cv = bf2f(q[2048 + c]);
    float xr = cr + mur * (pr - cr), xk = ck + muk * (pk - ck), xv = cv + muv * (pv - cv);
    pr = cr; pk = ck; pv = cv;
    float w_log = -softplusf_(-dw[t]) - 0.5f;
    float decay = __expf(-__expf(w_log));
    float a = sigmoidf_(da[t]);
    float kkr = xk * kk_w;
    float ss = wavesum(kkr * kkr);
    float kk = kkr * rsqrtf(ss + 1e-6f);
    float k2 = xk * (1.0f + (a - 1.0f) * ka_w);
    float bon = wavesum(xr * k2 * rk_w);
    char* o = rws + (size_t)t * RWS_ROWB;
    ((f16*)o)[e] = (f16)xr;
    ((f16*)(o + 128))[e] = (f16)k2;
    ((f16*)(o + 256))[e] = (f16)(-kk);
    ((f16*)(o + 384))[e] = (f16)(kk * a);
    ((float*)(o + 512))[e] = decay;
    ((float*)(o + 768))[e] = xv;
    if ((tid & 63) == 0) rwb[(size_t)t * 16] = bon;
    if (t0 + t == len - 1) {
      if (prompt) {
        float* cs = ((float*)(p.ws + OW_CSH)) + ((size_t)((seg + 1) & 1) * 2 + seq) * 3200;
        cs[c] = cr; cs[1024 + c] = ck; cs[2048 + c] = cv;
        if (seg == NSEG - 1) {
          float* ps = (p.out + OO_p_shift) + (size_t)seq * 3200;
          ps[c] = cr; ps[1024 + c] = ck; ps[2048 + c] = cv;
        }
      } else {
        float* ps = (p.out + OO_s_shift) + (size_t)(seq - 2) * 3200;
        ps[c] = cr; ps[1024 + c] = ck; ps[2048 + c] = cv;
      }
    }
  }
}

__device__ __forceinline__ void gd_prepass_item(PP pp, int seg, int grp, int slab) {
  LAUNDER_PP;
  const int tid = tid_l();
  const int r0 = grp * 16;
  int seq, t0, len;
  row_seq(seg, r0, seq, t0, len);
  const bool prompt = seq < 2;
  const int c = slab * 512 + 2 * tid;
  const int kind = slab >> 1;
  const int head = (c & 1023) >> 7, e = c & 127;
  float2 x0, x1, x2;
  if (t0 == 0) {
    const float* cp = nullptr;
    if (seg == 0) cp = prompt ? nullptr : p.st_conv + (size_t)(seq - 2) * 3 * 3072;
    else cp = ((float*)(p.ws + OW_CCV)) + ((size_t)(seg & 1) * 2 + seq) * 3 * 3072;
    if (cp) {
      x0 = *(const float2*)(cp + c); x1 = *(const float2*)(cp + 3072 + c); x2 = *(const float2*)(cp + 6144 + c);
    } else {
      x0 = x1 = x2 = make_float2(0.f, 0.f);
    }
  } else {
    uint32_t u0 = *(const uint32_t*)(((bf16_t*)(p.ws + OW_PJA)) + (size_t)(r0 - 3) * PJW + C_GDC + c);
    uint32_t u1 = *(const uint32_t*)(((bf16_t*)(p.ws + OW_PJA)) + (size_t)(r0 - 2) * PJW + C_GDC + c);
    uint32_t u2 = *(const uint32_t*)(((bf16_t*)(p.ws + OW_PJA)) + (size_t)(r0 - 1) * PJW + C_GDC + c);
    x0 = make_float2(bf2f(u0 & 0xffff), bf2f(u0 >> 16));
    x1 = make_float2(bf2f(u1 & 0xffff), bf2f(u1 >> 16));
    x2 = make_float2(bf2f(u2 & 0xffff), bf2f(u2 >> 16));
  }
  const float2 w0 = *(const float2*)(p.gd_conv_w + c), w1 = *(const float2*)(p.gd_conv_w + 3072 + c),
               w2 = *(const float2*)(p.gd_conv_w + 6144 + c), w3 = *(const float2*)(p.gd_conv_w + 9216 + c);
  const float a_exp = __expf(p.gd_a_log[head]);
  const float dtb = p.gd_dt_bias[head];
  char* gds = ((char*)(p.ws + OW_GDS)) + ((size_t)(slot_row0(seg) + r0) * 8 + head) * GDS_HB;
#pragma unroll 4
  for (int t = 0; t < 16; t++) {
    const int row = r0 + t;
    uint32_t u = *(const uint32_t*)(((bf16_t*)(p.ws + OW_PJA)) + (size_t)row * PJW + C_GDC + c);
    float2 x3 = make_float2(bf2f(u & 0xffff), bf2f(u >> 16));
    float cx = w0.x * x0.x + w1.x * x1.x + w2.x * x2.x + w3.x * x3.x;
    float cy = w0.y * x0.y + w1.y * x1.y + w2.y * x2.y + w3.y * x3.y;
    x0 = x1; x1 = x2; x2 = x3;
    float ax = siluf_(cx), ay = siluf_(cy);
    float sc = 1.0f;
    if (kind < 2) {
      float ss = wavesum(ax * ax + ay * ay);
      sc = rsqrtf(ss + 1e-6f);
      if (kind == 0) sc *= 0.08838834764831845f;
    }
    if (kind >= 1) {
      float beta = sigmoidf_(bf2f(((bf16_t*)(p.ws + OW_PJA))[(size_t)row * PJW + C_BETA + head]));
      sc *= sqrtf(beta);
    }
    ax *= sc; ay *= sc;
    char* o = gds + (size_t)t * GDS_ROWB;
    f16x2 hv = {(f16)ax, (f16)ay};
    *(f16x2*)(o + kind * 256 + e * 2) = hv;
    if (kind == 0 && (tid & 63) == 0) {
      float g = -a_exp * softplusf_(bf2f(((bf16_t*)(p.ws + OW_PJA))[(size_t)row * PJW + C_ALPHA + head]) + dtb);
      *(float*)(o + 768) = __expf(g);
    }
    int jj = t0 + t - (len - 3);
    if (jj >= 0) {
      if (prompt) {
        *(float2*)(((float*)(p.ws + OW_CCV)) + (((size_t)((seg + 1) & 1) * 2 + seq) * 3 + jj) * 3072 + c) = x3;
        if (seg == NSEG - 1) *(float2*)((p.out + OO_p_conv) + ((size_t)seq * 3 + jj) * 3072 + c) = x3;
      } else {
        *(float2*)((p.out + OO_s_conv) + ((size_t)(seq - 2) * 3 + jj) * 3072 + c) = x3;
      }
    }
  }
}

struct RwOps { f16x4 r, k, a, b; float4 w; float vv; };
__device__ __forceinline__ RwOps rw_ld(const char* Ls, int q, int v) {
  RwOps o;
  o.r = *(const f16x4*)(Ls + q * 8);
  o.k = *(const f16x4*)(Ls + 128 + q * 8);
  o.a = *(const f16x4*)(Ls + 256 + q * 8);
  o.b = *(const f16x4*)(Ls + 384 + q * 8);
  o.w = *(const float4*)(Ls + 512 + q * 16);
  o.vv = *(const float*)(Ls + 768 + v * 4);
  return o;
}
__device__ __forceinline__ float rw_step(const RwOps& o, float4& S) {
  float sa0 = (float)o.a[0] * S.x;
  float sa1 = (float)o.a[2] * S.z;
  sa0 = fmaf((float)o.a[1], S.y, sa0);
  sa1 = fmaf((float)o.a[3], S.w, sa1);
  float t0 = fmaf(o.vv, (float)o.k[0], S.x * o.w.x);
  float t1 = fmaf(o.vv, (float)o.k[1], S.y * o.w.y);
  float t2 = fmaf(o.vv, (float)o.k[2], S.z * o.w.z);
  float t3 = fmaf(o.vv, (float)o.k[3], S.w * o.w.w);
  const float sa = rowsum16(sa0 + sa1);
  S.x = fmaf(sa, (float)o.b[0], t0);
  S.y = fmaf(sa, (float)o.b[1], t1);
  S.z = fmaf(sa, (float)o.b[2], t2);
  S.w = fmaf(sa, (float)o.b[3], t3);
  float y0 = (float)o.r[0] * S.x;
  float y1 = (float)o.r[2] * S.z;
  y0 = fmaf((float)o.r[1], S.y, y0);
  y1 = fmaf((float)o.r[3], S.w, y1);
  return rowsum16(y0 + y1);
}
__device__ __forceinline__ void rw_scan_run(const char* __restrict__ gsrc  , int len, float4& S,
                            float* __restrict__ yo  , int q, int v, char* smem) {
  const int tid = tid_l();
  const int nch = len >> 4;
  const int lstep = tid >> 6, loff = (tid & 63) * 16;
  u32x4 st[4];
#pragma unroll
  for (int i = 0; i < 4; i++) st[i] = *(const u32x4*)(gsrc + (size_t)(lstep + 4 * i) * RWS_ROWB + loff);
  __syncthreads();
#pragma unroll
  for (int i = 0; i < 4; i++) *(u32x4*)(smem + (lstep + 4 * i) * 1024 + loff) = st[i];
  if (nch > 1) {
#pragma unroll
    for (int i = 0; i < 4; i++) st[i] = *(const u32x4*)(gsrc + (size_t)(16 + lstep + 4 * i) * RWS_ROWB + loff);
  }
  __syncthreads();
  for (int c = 0; c < nch; c++) {
    const char* L = smem + (c & 1) * 16384;
    float ykeep = 0.f;
    RwOps oa = rw_ld(L, q, v);
#pragma unroll 1
    for (int t = 0; t < 16; t += 2) {
      const RwOps ob = rw_ld(L + (t + 1) * 1024, q, v);
      asm volatile("" ::: "memory");
      const float ya = rw_step(oa, S);
      ykeep = (q == t) ? ya : ykeep;
      oa = rw_ld(L + ((t + 2) & 15) * 1024, q, v);
      asm volatile("" ::: "memory");
      const float yb = rw_step(ob, S);
      ykeep = (q == t + 1) ? yb : ykeep;
    }
    yo[(size_t)(c * 16 + q) * DM] = ykeep;
    if (c + 1 < nch) {
      char* Ln = smem + ((c + 1) & 1) * 16384;
#pragma unroll
      for (int i = 0; i < 4; i++) *(u32x4*)(Ln + (lstep + 4 * i) * 1024 + loff) = st[i];
      if (c + 2 < nch) {
#pragma unroll
        for (int i = 0; i < 4; i++)
          st[i] = *(const u32x4*)(gsrc + (size_t)((c + 2) * 16 + lstep + 4 * i) * RWS_ROWB + loff);
      }
    }
    lds_barrier();
  }
}

struct GdOps { f16x8 qv, kv; float vv, eg; };
__device__ __forceinline__ GdOps gd_ld(const char* Ls, int q, int cl) {
  GdOps o;
  o.kv = *(const f16x8*)(Ls + 256 + q * 16);
  o.vv = (float)*(const f16*)(Ls + 512 + cl * 2);
  o.eg = *(const float*)(Ls + 768);
  o.qv = *(const f16x8*)(Ls + q * 16);
  return o;
}
__device__ __forceinline__ float gd_step(const GdOps& o, float (&s)[8]) {
  float k0 = (float)o.kv[0] * s[0], k1 = (float)o.kv[4] * s[4];
  k0 = fmaf((float)o.kv[1], s[1], k0); k1 = fmaf((float)o.kv[5], s[5], k1);
  k0 = fmaf((float)o.kv[2], s[2], k0); k1 = fmaf((float)o.kv[6], s[6], k1);
  k0 = fmaf((float)o.kv[3], s[3], k0); k1 = fmaf((float)o.kv[7], s[7], k1);
  float es[8];
#pragma unroll
  for (int i = 0; i < 8; i++) es[i] = o.eg * s[i];
  const float ks = rowsum16(k0 + k1);
  const float d = fmaf(-o.eg, ks, o.vv);
#pragma unroll
  for (int i = 0; i < 8; i++) s[i] = fmaf((float)o.kv[i], d, es[i]);
  float o0 = (float)o.qv[0] * s[0], o1 = (float)o.qv[4] * s[4];
  o0 = fmaf((float)o.qv[1], s[1], o0); o1 = fmaf((float)o.qv[5], s[5], o1);
  o0 = fmaf((float)o.qv[2], s[2], o0); o1 = fmaf((float)o.qv[6], s[6], o1);
  o0 = fmaf((float)o.qv[3], s[3], o0); o1 = fmaf((float)o.qv[7], s[7], o1);
  return rowsum16(o0 + o1);
}
__device__ __forceinline__ void gd_scan_run(const char* __restrict__ gsrc  , int len, float (&s)[8],
                            float* __restrict__ oo  , int q, int cl, char* smem) {
  const int tid = tid_l();
  const int nch = len >> 4;
  u32x4 st[4];
  int lt[4], lo[4];
#pragma unroll
  for (int i = 0; i < 4; i++) {
    int id = tid + 256 * i;
    if (id > 783) id = 783;
    lt[i] = id / 49;
    lo[i] = (id % 49) * 16;
  }
#pragma unroll
  for (int i = 0; i < 4; i++) st[i] = *(const u32x4*)(gsrc + (size_t)lt[i] * GDS_ROWB + lo[i]);
  __syncthreads();
#pragma unroll
  for (int i = 0; i < 4; i++) *(u32x4*)(smem + lt[i] * GDS_HB + lo[i]) = st[i];
  if (nch > 1) {
#pragma unroll
    for (int i = 0; i < 4; i++) st[i] = *(const u32x4*)(gsrc + (size_t)(16 + lt[i]) * GDS_ROWB + lo[i]);
  }
  __syncthreads();
  for (int c = 0; c < nch; c++) {
    const char* L = smem + (c & 1) * 16384;
    float okeep = 0.f;
    GdOps oa = gd_ld(L, q, cl);
#pragma unroll 1
    for (int t = 0; t < 16; t += 2) {
      const GdOps ob = gd_ld(L + (t + 1) * GDS_HB, q, cl);
      asm volatile("" ::: "memory");
      const float ya = gd_step(oa, s);
      okeep = (q == t) ? ya : okeep;
      oa = gd_ld(L + ((t + 2) & 15) * GDS_HB, q, cl);
      asm volatile("" ::: "memory");
      const float yb = gd_step(ob, s);
      okeep = (q == t + 1) ? yb : okeep;
    }
    oo[(size_t)(c * 16 + q) * DM] = okeep;
    if (c + 1 < nch) {
      char* Ln = smem + ((c + 1) & 1) * 16384;
#pragma unroll
      for (int i = 0; i < 4; i++) *(u32x4*)(Ln + lt[i] * GDS_HB + lo[i]) = st[i];
      if (c + 2 < nch) {
#pragma unroll
        for (int i = 0; i < 4; i++) st[i] = *(const u32x4*)(gsrc + (size_t)((c + 2) * 16 + lt[i]) * GDS_ROWB + lo[i]);
      }
    }
    lds_barrier();
  }
}

__device__ __forceinline__ void sample_scan_task(PP pp, int task, char* smem) {
  LAUNDER_PP;
  const int sj = task >> 7, j = task & 127, kind = j >> 6, jj = j & 63;
  const int tid = tid_l(), q = tid & 15;
  const int row0 = 1056 + sj * 16;
  if (kind == 0) {
    const int head = jj >> 2, v = (jj & 3) * 16 + (tid >> 4);
    const float* sin = p.st_wkv + ((size_t)sj * 16 + head) * 4096;
    float* sout = (p.out + OO_s_wkv) + ((size_t)sj * 16 + head) * 4096;
    float4 S = *(const float4*)(sin + v * 64 + 4 * q);
    rw_scan_run(((char*)(p.ws + OW_RWS)) + ((size_t)row0 * 16 + head) * 1024, 16, S, ((float*)(p.ws + OW_YRW)) + (size_t)row0 * DM + head * 64 + v, q, v, smem);
    *(float4*)(sout + v * 64 + 4 * q) = S;
  } else {
    const int head = jj >> 3, cl = (jj & 7) * 16 + (tid >> 4);
    const float* sin = p.st_ssm + ((size_t)sj * 8 + head) * 16384;
    float* sout = (p.out + OO_s_ssm) + ((size_t)sj * 8 + head) * 16384;
    float s[8];
#pragma unroll
    for (int i = 0; i < 8; i++) s[i] = sin[(size_t)(8 * q + i) * 128 + cl];
    gd_scan_run(((char*)(p.ws + OW_GDS)) + ((size_t)row0 * 8 + head) * GDS_HB, 16, s, ((float*)(p.ws + OW_OGD)) + (size_t)row0 * DM + head * 128 + cl, q, cl, smem);
#pragma unroll
    for (int i = 0; i < 8; i++) sout[(size_t)(8 * q + i) * 128 + cl] = s[i];
  }
}

__device__ __forceinline__ void scan_block_rw(PP pp, int j, char* smem) {
  LAUNDER_PP;
  const int seq = j >> 6, jj = j & 63;
  const int tid = tid_l(), q = tid & 15;
  const int head = jj >> 2, v = (jj & 3) * 16 + (tid >> 4);
  float4 S = make_float4(0.f, 0.f, 0.f, 0.f);
  for (int seg = 0; seg < NSEG; seg++) {
    wait_ge(((unsigned int*)(p.ws + OW_sync)) + SW_PRE, seg + 1);
    const int len = seg == 0 ? 528 : TS;
    const int row0 = slot_row0(seg) + (seg == 0 ? seq * 528 : seq * TS);
    rw_scan_run(((char*)(p.ws + OW_RWS)) + ((size_t)row0 * 16 + head) * 1024, len, S,
                ((float*)(p.ws + OW_YRW)) + (size_t)row0 * DM + head * 64 + v, q, v, smem);
    signal_add(((unsigned int*)(p.ws + OW_sync)) + SW_SCAN(seg));
  }
  *(float4*)((p.out + OO_p_wkv) + ((size_t)seq * 16 + head) * 4096 + v * 64 + 4 * q) = S;
}
__device__ __forceinline__ void scan_block_gd(PP pp, int j, char* smem) {
  LAUNDER_PP;
  const int seq = j >> 6, jj = j & 63;
  const int tid = tid_l(), q = tid & 15;
  const int head = jj >> 3, cl = (jj & 7) * 16 + (tid >> 4);
  float s[8];
#pragma unroll
  for (int i = 0; i < 8; i++) s[i] = 0.f;
  for (int seg = 0; seg < NSEG; seg++) {
    wait_ge(((unsigned int*)(p.ws + OW_sync)) + SW_PRE, seg + 1);
    const int len = seg == 0 ? 528 : TS;
    const int row0 = slot_row0(seg) + (seg == 0 ? seq * 528 : seq * TS);
    gd_scan_run(((char*)(p.ws + OW_GDS)) + ((size_t)row0 * 8 + head) * GDS_HB, len, s,
                ((float*)(p.ws + OW_OGD)) + (size_t)row0 * DM + head * 128 + cl, q, cl, smem);
    signal_add(((unsigned int*)(p.ws + OW_sync)) + SW_SCAN(seg));
  }
  float* sout = (p.out + OO_p_ssm) + ((size_t)seq * 8 + head) * 16384;
#pragma unroll
  for (int i = 0; i < 8; i++) sout[(size_t)(8 * q + i) * 128 + cl] = s[i];
}

__device__ __forceinline__ void post_item(PP pp, int seg, int row) {
  LAUNDER_PP;
  const int tid = tid_l(), c4 = tid * 4;
  const int srow = slot_row0(seg) + row;
  const bf16_t* gt = ((bf16_t*)(p.ws + OW_GT)) + (size_t)srow * GTW;
  {
    float4 y = *(const float4*)(((float*)(p.ws + OW_YRW)) + (size_t)srow * DM + c4);
    float mean = rowsum16(y.x + y.y + y.z + y.w) * (1.0f / 64.0f);
    float dx = y.x - mean, dy = y.y - mean, dz = y.z - mean, dw = y.w - mean;
    float var = rowsum16(dx * dx + dy * dy + dz * dz + dw * dw) * (1.0f / 64.0f);
    float rs = rsqrtf(var + 64e-5f);
    float4 lw = *(const float4*)(p.rw_ln_w + c4), lb = *(const float4*)(p.rw_ln_b + c4);
    float bon = ((float*)(p.ws + OW_RWB))[(size_t)srow * 16 + (tid >> 4)];
    float4 v = *(const float4*)(((char*)(p.ws + OW_RWS)) + ((size_t)srow * 16 + (tid >> 4)) * 1024 + 768 + (tid & 15) * 16);
    uint2 g = *(const uint2*)(gt + G_RW + c4);
    float o0 = (dx * rs * lw.x + lb.x + bon * v.x) * siluf_(bf2f(g.x & 0xffff));
    float o1 = (dy * rs * lw.y + lb.y + bon * v.y) * siluf_(bf2f(g.x >> 16));
    float o2 = (dz * rs * lw.z + lb.z + bon * v.z) * siluf_(bf2f(g.y & 0xffff));
    float o3 = (dw * rs * lw.w + lb.w + bon * v.w) * siluf_(bf2f(g.y >> 16));
    *(uint2*)(((bf16_t*)(p.ws + OW_YA)) + (size_t)row * DM + c4) = make_uint2(pack2(o0, o1), pack2(o2, o3));
  }
  {
    float4 o = *(const float4*)(((float*)(p.ws + OW_OGD)) + (size_t)srow * DM + c4);
    float ss = rowsum16(o.x * o.x + o.y * o.y + o.z * o.z + o.w * o.w);
    ss += __shfl_xor(ss, 16);
    float rs = rsqrtf(ss * (1.0f / 128.0f) + 1e-6f);
    float4 nw = *(const float4*)(p.gd_norm_w + (c4 & 127));
    uint2 g = *(const uint2*)(gt + G_GD + c4);
    float o0 = o.x * rs * nw.x * siluf_(bf2f(g.x & 0xffff));
    float o1 = o.y * rs * nw.y * siluf_(bf2f(g.x >> 16));
    float o2 = o.z * rs * nw.z * siluf_(bf2f(g.y & 0xffff));
    float o3 = o.w * rs * nw.w * siluf_(bf2f(g.y >> 16));
    *(uint2*)(((bf16_t*)(p.ws + OW_YB)) + (size_t)row * DM + c4) = make_uint2(pack2(o0, o1), pack2(o2, o3));
  }
}

#define SMEM_BYTES (32768 + 16)

__global__ void __launch_bounds__(256, 4) k_mega(Params p_arg) {
  PP pp = (PP)__builtin_amdgcn_kernarg_segment_ptr();
  __shared__ __attribute__((aligned(16))) char smem[SMEM_BYTES];
  cg::grid_group grid = cg::this_grid();
  const int bid = blockIdx.x, nb = gridDim.x;
  unsigned* sync = (unsigned*)(p.ws + OW_sync);
  const unsigned xcc = xcc_id() & 7u;
  if (bid >= NSCAN && threadIdx.x == 0) xb_add(&sync[SW_XCNT(xcc)], 1u);
  phase_weights(pp, bid, nb, smem);
  for (int it = bid; it < seg_MP(0) / 4; it += nb) xn_item(pp, 0, it);
  grid.sync();
  if (bid < NSCAN) {
    __builtin_amdgcn_s_setprio(3);
    if (bid < 128) scan_block_rw(pp, bid, smem);
    else scan_block_gd(pp, bid - 128, smem);
    return;
  }
  const int w = bid - NSCAN, NW = nb - NSCAN;
  unsigned* cfg = (unsigned*)(smem + 32768);
  if (threadIdx.x == 0) {
    unsigned mine = 0, nx = 0;
#pragma unroll
    for (unsigned j = 0; j < 8; j++) { unsigned c = xb_ld(&sync[SW_XCNT(j)]); nx += c > 0u ? 1u : 0u; mine = (j == xcc) ? c : mine; }
    cfg[0] = mine > 0u ? mine : 1u;
    cfg[1] = nx > 0u ? nx : 1u;
  }
  __syncthreads();
  for (int i = 0; i < NSEG + 3; i++) {
    const int sj = i - 2;
    const int sn = i - 3;
    const int sp = i - 1;
    const bool front = i < NSEG, back = sj >= 0 && sj < NSEG, nrm = sn >= 0 && sn < NSEG, pst = sp >= 0 && sp < NSEG;
    {
      const int nB = back ? (seg_MP(sj) / 128) * 8 : 0;
      const int tmF = front ? seg_MP(i) / 128 : 1;
      const int nF = front ? tmF * (VW / 128) : 0;
      for (int it = w; it < nB + nF; it += NW) {
        if (it < nB) { gemm_tile<1>(pp, sj, it >> 3, it & 7, smem); gemm_tile<3>(pp, sj, it >> 3, it & 7, smem); }
        else { int t = it - nB; gemm_tile<0>(pp, i, t % tmF, t / tmF, smem); }
      }
      if (i == 1) {
        for (int it = w; it < 32 * 128; it += NW) sample_scan_task(pp, it, smem);
      }
    }
    worker_barrier((unsigned*)(p.ws + OW_sync), (const unsigned*)(smem + 32768));
    {
      const int nB = back ? (seg_MP(sj) / 128) * 8 : 0;
      const int ngrp = front ? seg_M(i) / 16 : 0;
      const int nRW = ngrp * 8, nGD = ngrp * 6;
      const int nX = (i + 1 < NSEG) ? seg_MP(i + 1) / 4 : 0;
      const int nN = nrm ? seg_M(sn) / 4 : 0;
      const int tot = nB + nRW + nGD + nX + nN;
      for (int it = w; it < tot; it += NW) {
        int t = it;
        if (t < nB) { gemm_tile<2>(pp, sj, t >> 3, t & 7, smem); continue; }
        t -= nB;
        if (t < nRW) { rw_prepass_item(pp, i, t >> 2, t & 3, smem); continue; }
        t -= nRW;
        if (t < nGD) { gd_prepass_item(pp, i, t / 6, t % 6); continue; }
        t -= nGD;
        if (t < nX) { xn_item(pp, i + 1, t); continue; }
        t -= nX;
        norm_item(pp, sn, t);
      }
      if (pst) {
        wait_ge((unsigned*)(p.ws + OW_sync) + SW_SCAN(sp), NSCAN);
        const int n = seg_M(sp);
        for (int it = w; it < n; it += NW) post_item(pp, sp, it);
      }
    }
    worker_barrier((unsigned*)(p.ws + OW_sync), (const unsigned*)(smem + 32768));
    if (front && w == 0 && threadIdx.x == 0)
      __hip_atomic_store((unsigned*)(p.ws + OW_sync) + SW_PRE, (unsigned)(i + 1), __ATOMIC_RELAXED, __HIP_MEMORY_SCOPE_AGENT);
  }
}

static inline size_t align_up(size_t x) { return (x + 255) & ~(size_t)255; }

#undef p
extern "C" void kernel_launch(void* const* d_in, const int* in_sizes, int n_in, void* d_out, int out_size, void* d_ws,
                              size_t ws_size, hipStream_t stream) {
  Params p{};
  const float* const* in = (const float* const*)d_in;
  p.x_prompt = in[0]; p.x_sample = in[1]; p.st_shift = in[2]; p.st_wkv = in[3]; p.st_conv = in[4]; p.st_ssm = in[5];
  p.meta = in[6]; p.norm_pre = in[7]; p.w_in = in[8]; p.rw_mu = in[9]; p.rw_w0 = in[10]; p.rw_w2 = in[11];
  p.rw_a0 = in[12]; p.rw_a2 = in[13]; p.rw_k_k = in[14]; p.rw_k_a = in[15]; p.rw_r_k = in[16]; p.rw_ln_w = in[17];
  p.rw_ln_b = in[18]; p.gd_conv_w = in[19]; p.gd_a_log = in[20]; p.gd_dt_bias = in[21]; p.gd_norm_w = in[22];
  p.w_out_a = in[23]; p.w_out_b = in[24]; p.w_out = in[25]; p.norm_post = in[26];
  p.out = (float*)d_out;
  p.ws = (char*)d_ws;
  if (OW_END > ws_size) { fprintf(stderr, "workspace too small: need %zu have %zu\n", (size_t)OW_END, ws_size); return; }

  static int grid_blocks = 0;
  if (!grid_blocks) {
    int dev = 0, cus = 0, per_cu = 0;
    (void)hipGetDevice(&dev);
    (void)hipDeviceGetAttribute(&cus, hipDeviceAttributeMultiprocessorCount, dev);
    (void)hipOccupancyMaxActiveBlocksPerMultiprocessor(&per_cu, k_mega, 256, 0);
    if (per_cu > 4) per_cu = 4;
    grid_blocks = cus * per_cu;
  }
  (void)hipMemsetAsync(p.ws + OW_sync, 0, 16384, stream);
  void* args[] = {&p};
  hipError_t e = hipLaunchCooperativeKernel((void*)k_mega, dim3(grid_blocks), dim3(256), args, 0, stream);
  if (e != hipSuccess) fprintf(stderr, "cooperative launch failed: %s (grid %d)\n", hipGetErrorString(e), grid_blocks);
}
```

```cpp
#include <hip/hip_runtime.h>
#include <hip/hip_cooperative_groups.h>
#include <stdint.h>
#include <stdio.h>
namespace cg = cooperative_groups;

typedef unsigned short bf16_t;
typedef _Float16 f16;
using bf16x8 = __attribute__((ext_vector_type(8))) short;
using f32x4 = __attribute__((ext_vector_type(4))) float;
using u32x4 = __attribute__((ext_vector_type(4))) unsigned int;
using f16x2 = __attribute__((ext_vector_type(2))) _Float16;
using f16x4 = __attribute__((ext_vector_type(4))) _Float16;
using f16x8 = __attribute__((ext_vector_type(8))) _Float16;

#define DM 1024
#define PW 10384
#define VW 10496
#define PJW 6400
#define GTW 4096
#define NSEG 16
#define TS 512
#define M0 1568
#define MP0 1664
#define M1 1024
#define SLOT_ROWS 3712
#define GT_ROWS 4736
#define NSCAN 256
#define C_GDC 3200
#define C_BETA 6272
#define C_ALPHA 6280
#define G_RW 0
#define G_GD 1024
#define G_MA 2048
#define G_MB 3072
#define RWS_ROWB 16384
#define GDS_HB 784
#define GDS_ROWB 6272

struct Params {
  const float *x_prompt, *x_sample, *st_shift, *st_wkv, *st_conv, *st_ssm, *meta, *norm_pre, *w_in, *rw_mu, *rw_w0,
      *rw_w2, *rw_a0, *rw_a2, *rw_k_k, *rw_k_a, *rw_r_k, *rw_ln_w, *rw_ln_b, *gd_conv_w, *gd_a_log, *gd_dt_bias,
      *gd_norm_w, *w_out_a, *w_out_b, *w_out, *norm_post;
  float* out;
  char* ws;
};
#define p (PV(pp))
#define GLOBAL_AS __attribute__((address_space(1)))
#define CONST_AS __attribute__((address_space(4)))
struct ParamsG {
  const GLOBAL_AS float *x_prompt, *x_sample, *st_shift, *st_wkv, *st_conv, *st_ssm, *meta, *norm_pre, *w_in, *rw_mu, *rw_w0,
      *rw_w2, *rw_a0, *rw_a2, *rw_k_k, *rw_k_a, *rw_r_k, *rw_ln_w, *rw_ln_b, *gd_conv_w, *gd_a_log, *gd_dt_bias,
      *gd_norm_w, *w_out_a, *w_out_b, *w_out, *norm_post;
  GLOBAL_AS float* out;
  GLOBAL_AS char* ws;
};
typedef const CONST_AS ParamsG* PP;
__device__ __forceinline__ Params PV(PP pp) {
  Params v;
  v.x_prompt = (const float*)pp->x_prompt;
  v.x_sample = (const float*)pp->x_sample;
  v.st_shift = (const float*)pp->st_shift;
  v.st_wkv = (const float*)pp->st_wkv;
  v.st_conv = (const float*)pp->st_conv;
  v.st_ssm = (const float*)pp->st_ssm;
  v.meta = (const float*)pp->meta;
  v.norm_pre = (const float*)pp->norm_pre;
  v.w_in = (const float*)pp->w_in;
  v.rw_mu = (const float*)pp->rw_mu;
  v.rw_w0 = (const float*)pp->rw_w0;
  v.rw_w2 = (const float*)pp->rw_w2;
  v.rw_a0 = (const float*)pp->rw_a0;
  v.rw_a2 = (const float*)pp->rw_a2;
  v.rw_k_k = (const float*)pp->rw_k_k;
  v.rw_k_a = (const float*)pp->rw_k_a;
  v.rw_r_k = (const float*)pp->rw_r_k;
  v.rw_ln_w = (const float*)pp->rw_ln_w;
  v.rw_ln_b = (const float*)pp->rw_ln_b;
  v.gd_conv_w = (const float*)pp->gd_conv_w;
  v.gd_a_log = (const float*)pp->gd_a_log;
  v.gd_dt_bias = (const float*)pp->gd_dt_bias;
  v.gd_norm_w = (const float*)pp->gd_norm_w;
  v.w_out_a = (const float*)pp->w_out_a;
  v.w_out_b = (const float*)pp->w_out_b;
  v.w_out = (const float*)pp->w_out;
  v.norm_post = (const float*)pp->norm_post;
  v.out = (float*)pp->out;
  v.ws = (char*)pp->ws;
  return v;
}
constexpr size_t al256(size_t x) { return (x + 255) & ~(size_t)255; }
constexpr size_t OO_y_prompt = 0;
constexpr size_t OO_y_sample = OO_y_prompt + (size_t)2 * 8192 * 1024;
constexpr size_t OO_p_shift = OO_y_sample + (size_t)32 * 16 * 1024;
constexpr size_t OO_p_wkv = OO_p_shift + 2 * 3200;
constexpr size_t OO_p_conv = OO_p_wkv + 2 * 16 * 4096;
constexpr size_t OO_p_ssm = OO_p_conv + 2 * 3 * 3072;
constexpr size_t OO_s_shift = OO_p_ssm + 2 * 8 * 16384;
constexpr size_t OO_s_wkv = OO_s_shift + 32 * 3200;
constexpr size_t OO_s_conv = OO_s_wkv + 32 * 16 * 4096;
constexpr size_t OO_s_ssm = OO_s_conv + 32 * 3 * 3072;
constexpr size_t OW_sync = 0;
constexpr size_t OW_WtIn = OW_sync + 16384;
constexpr size_t OW_WtA = OW_WtIn + al256((size_t)VW * DM * 2);
constexpr size_t OW_WtB = OW_WtA + al256((size_t)DM * DM * 2);
constexpr size_t OW_WtO = OW_WtB + al256((size_t)DM * DM * 2);
constexpr size_t OW_XN = OW_WtO + al256((size_t)DM * DM * 2);
constexpr size_t OW_PJA = OW_XN + al256((size_t)MP0 * DM * 2);
constexpr size_t OW_YA = OW_PJA + al256((size_t)MP0 * PJW * 2);
constexpr size_t OW_YB = OW_YA + al256((size_t)2 * MP0 * DM * 2);
constexpr size_t OW_MG = OW_YB + al256((size_t)2 * MP0 * DM * 2);
constexpr size_t OW_OUTB = OW_MG + al256((size_t)MP0 * DM * 2);
constexpr size_t OW_TMP = OW_OUTB + al256((size_t)2 * MP0 * DM * 4);
constexpr size_t OW_GT = OW_TMP + al256((size_t)2 * MP0 * DM * 4);
constexpr size_t OW_RWS = OW_GT + al256((size_t)GT_ROWS * GTW * 2);
constexpr size_t OW_GDS = OW_RWS + al256((size_t)SLOT_ROWS * RWS_ROWB);
constexpr size_t OW_RWB = OW_GDS + al256((size_t)SLOT_ROWS * GDS_ROWB + 256);
constexpr size_t OW_YRW = OW_RWB + al256((size_t)SLOT_ROWS * 16 * 4);
constexpr size_t OW_OGD = OW_YRW + al256((size_t)SLOT_ROWS * DM * 4);
constexpr size_t OW_CSH = OW_OGD + al256((size_t)SLOT_ROWS * DM * 4);
constexpr size_t OW_CCV = OW_CSH + al256((size_t)2 * 2 * 3200 * 4);
constexpr size_t OW_END = OW_CCV + al256((size_t)2 * 2 * 3 * 3072 * 4);


__device__ __forceinline__ bf16_t f2bf(float f) {
  uint32_t u = __float_as_uint(f);
  u += 0x7fffu + ((u >> 16) & 1u);
  return (bf16_t)(u >> 16);
}
__device__ __forceinline__ float bf2f(bf16_t h) { return __uint_as_float(((uint32_t)h) << 16); }
__device__ __forceinline__ uint32_t pack2(float a, float b) { return (uint32_t)f2bf(a) | ((uint32_t)f2bf(b) << 16); }
__device__ __forceinline__ float sigmoidf_(float x) { return 1.0f / (1.0f + __expf(-x)); }
__device__ __forceinline__ float siluf_(float x) { return x / (1.0f + __expf(-x)); }
__device__ __forceinline__ float softplusf_(float x) { return fmaxf(x, 0.0f) + log1pf(__expf(-fabsf(x))); }

__device__ __forceinline__ int tid_l() { int t = threadIdx.x; asm volatile("" : "+v"(t)); return t; }
#define LAUNDER_PP asm volatile("" : "+s"(pp))
template <int CTRL>
__device__ __forceinline__ float dppf(float x) {
  return __builtin_bit_cast(float, __builtin_amdgcn_update_dpp(0, __builtin_bit_cast(int, x), CTRL, 0xf, 0xf, true));
}
__device__ __forceinline__ float rowsum16(float x) {
  x += dppf<0xB1>(x);
  x += dppf<0x4E>(x);
  x += dppf<0x141>(x);
  x += dppf<0x140>(x);
  return x;
}
__device__ __forceinline__ float wavesum(float x) {
  x = rowsum16(x);
  x += __shfl_xor(x, 16);
  x += __shfl_xor(x, 32);
  return x;
}

#define SW_XCNT(j) (64 * (1 + (j)))
#define SW_XSUB(j) (64 * (9 + (j)))
#define SW_XGEN(j) (64 * (17 + (j)))
#define SW_TOP (64 * 25)
#define SW_TOPGEN (64 * 26)
#define SW_PRE (64 * 27)
#define SW_SCAN(s) (64 * (28 + (s)))
#define SYNC_BYTES 16384
__device__ __forceinline__ unsigned xb_ld(const unsigned* ptr) {
  return __hip_atomic_load(ptr, __ATOMIC_RELAXED, __HIP_MEMORY_SCOPE_AGENT);
}
__device__ __forceinline__ unsigned xb_add(unsigned* ptr, unsigned v) {
  return __hip_atomic_fetch_add(ptr, v, __ATOMIC_RELAXED, __HIP_MEMORY_SCOPE_AGENT);
}
__device__ __forceinline__ unsigned xcc_id() { return (unsigned)__builtin_amdgcn_s_getreg((3 << 11) | 20) & 0xFu; }
__device__ __forceinline__ void wait_ge(const unsigned* ptr, unsigned target) {
  if (threadIdx.x == 0) {
    while (xb_ld(ptr) < target) __builtin_amdgcn_s_sleep(8);
    __builtin_amdgcn_fence(__ATOMIC_ACQUIRE, "agent");
    asm volatile("s_waitcnt vmcnt(0)" ::: "memory");
  }
  __syncthreads();
}
__device__ __forceinline__ void signal_add(unsigned* ptr) {
  asm volatile("s_waitcnt vmcnt(0)" ::: "memory");
  __syncthreads();
  if (threadIdx.x == 0) {
    __builtin_amdgcn_fence(__ATOMIC_RELEASE, "agent");
    asm volatile("s_waitcnt vmcnt(0)" ::: "memory");
    xb_add(ptr, 1u);
  }
}
__device__ __forceinline__ void worker_barrier(unsigned* bar, const unsigned* lds_cfg) {
  asm volatile("s_waitcnt vmcnt(0)" ::: "memory");
  __syncthreads();
  if (threadIdx.x == 0) {
    const unsigned x = xcc_id() & 7u, nloc = lds_cfg[0], nx = lds_cfg[1];
    const unsigned old = xb_add(&bar[SW_XSUB(x)], 1u);
    const unsigned gen = old / nloc;
    if (old + 1u == (gen + 1u) * nloc) {
      __builtin_amdgcn_fence(__ATOMIC_RELEASE, "agent");
      asm volatile("s_waitcnt vmcnt(0)" ::: "memory");
      const unsigned og = xb_add(&bar[SW_TOP], 1u);
      const unsigned tg = og / nx;
      if (og + 1u == (tg + 1u) * nx) xb_add(&bar[SW_TOPGEN], 1u);
      else while (xb_ld(&bar[SW_TOPGEN]) == tg) __builtin_amdgcn_s_sleep(1);
      __builtin_amdgcn_fence(__ATOMIC_ACQUIRE, "agent");
      xb_add(&bar[SW_XGEN(x)], 1u);
      asm volatile("s_waitcnt vmcnt(0)" ::: "memory");
    } else {
      while (xb_ld(&bar[SW_XGEN(x)]) == gen) __builtin_amdgcn_s_sleep(1);
      __builtin_amdgcn_fence(__ATOMIC_ACQUIRE, "agent");
      asm volatile("s_waitcnt vmcnt(0)" ::: "memory");
    }
  }
  __syncthreads();
}

__device__ __forceinline__ void lds_barrier() {
  asm volatile("s_waitcnt lgkmcnt(0)" ::: "memory");
  __builtin_amdgcn_s_barrier();
  asm volatile("" ::: "memory");
}

__device__ __forceinline__ int seg_M(int seg) { return seg == 0 ? M0 : M1; }
__device__ __forceinline__ int seg_MP(int seg) { return seg == 0 ? MP0 : M1; }
__device__ __forceinline__ int slot_row0(int seg) { int s = seg % 3; return s == 0 ? 0 : MP0 + (s - 1) * M1; }
__device__ __forceinline__ int gt_row0(int seg) { int s = seg & 3; return s == 0 ? 0 : MP0 + (s - 1) * M1; }
__device__ __forceinline__ const float* row_src(PP pp, int seg, int r) {
  if (seg == 0) {
    if (r < 1056) {
      int b = r >= 528 ? 1 : 0, t = r - b * 528;
      if (t < 16) return p.meta + t * DM;
      return p.x_prompt + ((size_t)b * 8192 + (t - 16)) * DM;
    }
    return p.x_sample + (size_t)(r - 1056) * DM;
  }
  int b = r >> 9, t = r & 511;
  return p.x_prompt + ((size_t)b * 8192 + seg * TS + t) * DM;
}
__device__ __forceinline__ float* row_dst(PP pp, int seg, int r) {
  if (seg == 0) {
    if (r < 1056) {
      int b = r >= 528 ? 1 : 0, t = r - b * 528;
      if (t < 16) return nullptr;
      return (p.out + OO_y_prompt) + ((size_t)b * 8192 + (t - 16)) * DM;
    }
    return (p.out + OO_y_sample) + (size_t)(r - 1056) * DM;
  }
  int b = r >> 9, t = r & 511;
  return (p.out + OO_y_prompt) + ((size_t)b * 8192 + seg * TS + t) * DM;
}
__device__ __forceinline__ void row_seq(int seg, int r, int& seq, int& t, int& len) {
  if (seg == 0) {
    if (r < 528) { seq = 0; t = r; len = 528; }
    else if (r < 1056) { seq = 1; t = r - 528; len = 528; }
    else { seq = 2 + ((r - 1056) >> 4); t = (r - 1056) & 15; len = 16; }
  } else { seq = r >> 9; t = r & 511; len = TS; }
}

__device__ __forceinline__ int vcol_src(int n) {
  if (n < 3200) return n;
  if (n < 6288) return n + 1024;
  if (n < 6400) return -1;
  if (n < 7424) return n - 3200;
  return n - 112;
}
__device__ __forceinline__ void transpose_tile(const float* __restrict__ src, int ld, bool remap, bf16_t* __restrict__ dst, int k0, int n0,
                               float* tile  ) {
  int tid = tid_l();
  int i = tid >> 4, j = tid & 15;
  __syncthreads();
  int n = n0 + 4 * j;
  int sc = remap ? vcol_src(n) : n;
#pragma unroll
  for (int pass = 0; pass < 4; pass++) {
    int k = pass * 16 + i;
    float4 v = make_float4(0.f, 0.f, 0.f, 0.f);
    if (sc >= 0) v = *(const float4*)(src + (size_t)(k0 + k) * ld + sc);
    tile[k * 65 + 4 * j + 0] = v.x; tile[k * 65 + 4 * j + 1] = v.y; tile[k * 65 + 4 * j + 2] = v.z; tile[k * 65 + 4 * j + 3] = v.w;
  }
  __syncthreads();
  int nn = tid >> 2, kq = tid & 3;
  uint32_t o[8];
#pragma unroll
  for (int e = 0; e < 8; e++) o[e] = pack2(tile[(kq * 16 + 2 * e) * 65 + nn], tile[(kq * 16 + 2 * e + 1) * 65 + nn]);
  u32x4* d = (u32x4*)(dst + (size_t)(n0 + nn) * DM + k0 + kq * 16);
  d[0] = (u32x4){o[0], o[1], o[2], o[3]};
  d[1] = (u32x4){o[4], o[5], o[6], o[7]};
}
__device__ __forceinline__ void phase_weights(PP pp, int bid, int nb, char* smem) {
  LAUNDER_PP;
  float* tile = (float*)smem;
  const int nIn = 16 * (VW / 64);
  const int nSq = 16 * 16;
  for (int it = bid; it < nIn + 3 * nSq; it += nb) {
    if (it < nIn) {
      int kt = it & 15, nt = it >> 4;
      transpose_tile(p.w_in, PW, true, ((bf16_t*)(p.ws + OW_WtIn)), kt * 64, nt * 64, tile);
    } else {
      int j = it - nIn, w = j / nSq, r = j % nSq;
      int kt = r & 15, nt = r >> 4;
      const float* src = w == 0 ? p.w_out_a : (w == 1 ? p.w_out_b : p.w_out);
      bf16_t* dst = w == 0 ? ((bf16_t*)(p.ws + OW_WtA)) : (w == 1 ? ((bf16_t*)(p.ws + OW_WtB)) : ((bf16_t*)(p.ws + OW_WtO)));
      transpose_tile(src, DM, false, dst, kt * 64, nt * 64, tile);
    }
  }
}

__device__ __forceinline__ void xn_item(PP pp, int seg, int item) {
  LAUNDER_PP;
  int wave = tid_l() >> 6, lane = tid_l() & 63;
  int M = seg_M(seg);
  int r = item * 4 + wave;
  bf16_t* o = ((bf16_t*)(p.ws + OW_XN)) + (size_t)r * DM;
  if (r >= M) {
#pragma unroll
    for (int i = 0; i < 4; i++) *(uint2*)(o + (lane + 64 * i) * 4) = make_uint2(0u, 0u);
    return;
  }
  const float4* src = (const float4*)row_src(pp, seg, r);
  float4 v[4];
  float ss = 0.f;
#pragma unroll
  for (int i = 0; i < 4; i++) {
    v[i] = src[lane + 64 * i];
    ss += v[i].x * v[i].x + v[i].y * v[i].y + v[i].z * v[i].z + v[i].w * v[i].w;
  }
  ss = wavesum(ss);
  float rstd = rsqrtf(ss * (1.0f / DM) + 1e-6f);
#pragma unroll
  for (int i = 0; i < 4; i++) {
    float4 g = ((const float4*)p.norm_pre)[lane + 64 * i];
    *(uint2*)(o + (lane + 64 * i) * 4) =
        make_uint2(pack2(v[i].x * rstd * g.x, v[i].y * rstd * g.y), pack2(v[i].z * rstd * g.z, v[i].w * rstd * g.w));
  }
}

__device__ __forceinline__ void norm_item(PP pp, int seg, int item) {
  LAUNDER_PP;
  int wave = tid_l() >> 6, lane = tid_l() & 63;
  int r = item * 4 + wave;
  float* dst = row_dst(pp, seg, r);
  if (!dst) return;
  const float4* h = (const float4*)row_src(pp, seg, r);
  const float4* o = (const float4*)(((float*)(p.ws + OW_OUTB)) + ((size_t)(seg & 1) * MP0 + r) * DM);
  float4 v[4];
  float ss = 0.f;
#pragma unroll
  for (int i = 0; i < 4; i++) {
    v[i] = o[lane + 64 * i];
    ss += v[i].x * v[i].x + v[i].y * v[i].y + v[i].z * v[i].z + v[i].w * v[i].w;
  }
  ss = wavesum(ss);
  float rstd = rsqrtf(ss * (1.0f / DM) + 1e-6f);
#pragma unroll
  for (int i = 0; i < 4; i++) {
    float4 g = ((const float4*)p.norm_post)[lane + 64 * i];
    float4 hh = h[lane + 64 * i];
    ((float4*)dst)[lane + 64 * i] =
        make_float4(hh.x + v[i].x * rstd * g.x, hh.y + v[i].y * rstd * g.y, hh.z + v[i].z * rstd * g.z, hh.w + v[i].w * rstd * g.w);
  }
}

__device__ __forceinline__ void merge_item(PP pp, int item) {
  LAUNDER_PP;
  const int tid = tid_l();
  const int wave = tid >> 6, lane = tid & 63;
  const int r = item * 4 + wave;
  const float4* t1 = (const float4*)((const float*)(p.ws + OW_TMP) + (size_t)r * DM);
  const float4* t2 = (const float4*)((const float*)(p.ws + OW_TMP) + ((size_t)MP0 + r) * DM);
  bf16_t* o = (bf16_t*)(p.ws + OW_MG) + (size_t)r * DM;
#pragma unroll
  for (int i = 0; i < 4; i++) {
    float4 a = t1[lane + 64 * i], b = t2[lane + 64 * i];
    *(uint2*)(o + (lane + 64 * i) * 4) = make_uint2(pack2(a.x + b.x, a.y + b.y), pack2(a.z + b.z, a.w + b.w));
  }
}

#define LDT 32
template <int MODE>
__device__ __forceinline__ void gemm_tile(PP pp, int seg, int tm, int tn, char* smem) {
  LAUNDER_PP;
  const int tid = tid_l(), lane = tid & 63, wid = tid >> 6;
  const int wr = wid >> 1, wc = wid & 1, fr = lane & 15, fq = lane >> 4;
  const int lrow = tid >> 2, lkc = tid & 3;
  const int m0 = tm * 128, n0 = tn * 128;
  bf16_t* GTs = ((bf16_t*)(p.ws + OW_GT)) + (size_t)gt_row0(seg) * GTW;
  f32x4 acc[4][4];
#pragma unroll
  for (int a = 0; a < 4; a++)
#pragma unroll
    for (int b = 0; b < 4; b++) acc[a][b] = (f32x4){0.f, 0.f, 0.f, 0.f};
  {
    const bf16_t* A = (MODE == 0) ? (const bf16_t*)(p.ws + OW_XN)
                    : (MODE == 1) ? (const bf16_t*)(p.ws + OW_YA) + (size_t)(seg & 1) * MP0 * DM
                    : (MODE == 3) ? (const bf16_t*)(p.ws + OW_YB) + (size_t)(seg & 1) * MP0 * DM
                                  : (const bf16_t*)(p.ws + OW_MG);
    const bf16_t* Bt = (const bf16_t*)(p.ws + (MODE == 0 ? OW_WtIn : (MODE == 1 ? OW_WtA : (MODE == 3 ? OW_WtB : OW_WtO))));
    u32x4 ra[2], rb[2];
    const bf16_t* gA = A + (size_t)(m0 + lrow) * DM + lkc * 8;
    const bf16_t* gB = Bt + (size_t)(n0 + lrow) * DM + lkc * 8;
    const int wofs = lrow * 64 + ((lkc ^ ((lrow >> 2) & 3)) << 4);
    const int rofs = fr * 64 + ((fq ^ ((fr >> 2) & 3)) << 4);
    __syncthreads();
#pragma unroll
    for (int i = 0; i < 2; i++) {
      ra[i] = *(const u32x4*)(gA + (size_t)i * 64 * DM);
      rb[i] = *(const u32x4*)(gB + (size_t)i * 64 * DM);
    }
#pragma unroll
    for (int i = 0; i < 2; i++) {
      *(u32x4*)(smem + wofs + i * 4096) = ra[i];
      *(u32x4*)(smem + 8192 + wofs + i * 4096) = rb[i];
    }
#pragma unroll
    for (int i = 0; i < 2; i++) {
      ra[i] = *(const u32x4*)(gA + (size_t)i * 64 * DM + 32);
      rb[i] = *(const u32x4*)(gB + (size_t)i * 64 * DM + 32);
    }
    lds_barrier();
#pragma unroll 1
    for (int kt = 0; kt < 32; kt++) {
      const char* cA = smem + (kt & 1) * 16384 + wr * 4096 + rofs;
      const char* cB = smem + (kt & 1) * 16384 + 8192 + wc * 4096 + rofs;
      bf16x8 xa[4];
#pragma unroll
      for (int i = 0; i < 4; i++) xa[i] = *(const bf16x8*)(cA + i * 1024);
#pragma unroll
      for (int ni = 0; ni < 4; ni++) {
        const bf16x8 wb = *(const bf16x8*)(cB + ni * 1024);
#pragma unroll
        for (int mi = 0; mi < 4; mi++)
          acc[ni][mi] = __builtin_amdgcn_mfma_f32_16x16x32_bf16(wb, xa[mi], acc[ni][mi], 0, 0, 0);
      }
      if (kt + 1 < 32) {
        char* nx = smem + ((kt + 1) & 1) * 16384;
#pragma unroll
        for (int i = 0; i < 2; i++) {
          *(u32x4*)(nx + wofs + i * 4096) = ra[i];
          *(u32x4*)(nx + 8192 + wofs + i * 4096) = rb[i];
        }
        if (kt + 2 < 32) {
#pragma unroll
          for (int i = 0; i < 2; i++) {
            ra[i] = *(const u32x4*)(gA + (size_t)i * 64 * DM + (kt + 2) * 32);
            rb[i] = *(const u32x4*)(gB + (size_t)i * 64 * DM + (kt + 2) * 32);
          }
        }
      }
      lds_barrier();
    }
  }
  float* OUTBp = (MODE == 2) ? (float*)(p.ws + OW_OUTB) + (size_t)(seg & 1) * MP0 * DM
                             : (float*)(p.ws + OW_TMP) + (size_t)(MODE == 3 ? 1 : 0) * MP0 * DM;
#pragma unroll
  for (int ni = 0; ni < 4; ni++)
#pragma unroll
    for (int mi = 0; mi < 4; mi++) {
      const int m = m0 + wr * 64 + mi * 16 + fr;
      const int n = n0 + wc * 64 + ni * 16 + fq * 4;
      f32x4 c = acc[ni][mi];
      if (MODE == 0) {
        uint2 o = make_uint2(pack2(c[0], c[1]), pack2(c[2], c[3]));
        if (tn < PJW / 128) *(uint2*)(((bf16_t*)(p.ws + OW_PJA)) + (size_t)m * PJW + n) = o;
        else *(uint2*)(GTs + (size_t)m * GTW + (n - PJW)) = o;
      } else if (MODE == 1) {
        uint2 ga = *(const uint2*)(GTs + (size_t)m * GTW + G_MA + n);
        *(float4*)(OUTBp + (size_t)m * DM + n) =
            make_float4(sigmoidf_(bf2f(ga.x & 0xffff)) * c[0], sigmoidf_(bf2f(ga.x >> 16)) * c[1],
                        sigmoidf_(bf2f(ga.y & 0xffff)) * c[2], sigmoidf_(bf2f(ga.y >> 16)) * c[3]);
      } else if (MODE == 3) {
        uint2 gb = *(const uint2*)(GTs + (size_t)m * GTW + G_MB + n);
        *(float4*)(OUTBp + (size_t)m * DM + n) =
            make_float4(sigmoidf_(bf2f(gb.x & 0xffff)) * c[0], sigmoidf_(bf2f(gb.x >> 16)) * c[1],
                        sigmoidf_(bf2f(gb.y & 0xffff)) * c[2], sigmoidf_(bf2f(gb.y >> 16)) * c[3]);
      } else {
        *(float4*)(OUTBp + (size_t)m * DM + n) = make_float4(c[0], c[1], c[2], c[3]);
      }
    }
}

__device__ __forceinline__ void rw_prepass_item(PP pp, int seg, int grp, int slab, char* smem) {
  LAUNDER_PP;
  float* lwa = (float*)smem;
  const int tid = tid_l();
  const int r0 = grp * 8;
  int seq, t0, len;
  row_seq(seg, r0, seq, t0, len);
  const bool prompt = seq < 2;
  const float* prev0 = nullptr;
  if (t0 == 0) {
    if (seg == 0) prev0 = prompt ? nullptr : p.st_shift + (size_t)(seq - 2) * 3200;
    else prev0 = ((float*)(p.ws + OW_CSH)) + ((size_t)(seg & 1) * 2 + seq) * 3200;
  }
  __syncthreads();
  {
    const int j = tid & 127;
    const float mu = p.rw_mu[3072 + j];
#pragma unroll
    for (int i = 0; i < 4; i++) {
      int tok = (tid >> 7) + 2 * i;
      int row = r0 + tok;
      float ps = bf2f(((bf16_t*)(p.ws + OW_PJA))[(size_t)row * PJW + 3072 + j]);
      float pv;
      if (tok == 0 && t0 == 0) pv = prev0 ? prev0[3072 + j] : 0.f;
      else pv = bf2f(((bf16_t*)(p.ws + OW_PJA))[(size_t)(row - 1) * PJW + 3072 + j]);
      float xs = ps + mu * (pv - ps);
      lwa[tok * 128 + j] = j < 64 ? tanhf(xs) : xs;
      if (slab == 0 && t0 + tok == len - 1) {
        if (prompt) {
          ((float*)(p.ws + OW_CSH))[((size_t)((seg + 1) & 1) * 2 + seq) * 3200 + 3072 + j] = ps;
          if (seg == NSEG - 1) (p.out + OO_p_shift)[(size_t)seq * 3200 + 3072 + j] = ps;
        } else {
          (p.out + OO_s_shift)[(size_t)(seq - 2) * 3200 + 3072 + j] = ps;
        }
      }
    }
  }
  __syncthreads();
  const int c = slab * 256 + tid;
  float dw[8], da[8];
  {
    const float w0 = p.rw_w0[c], a0 = p.rw_a0[c];
#pragma unroll
    for (int t = 0; t < 8; t++) { dw[t] = w0; da[t] = a0; }
  }
  for (int j = 0; j < 64; j += 4) {
    float w2v[4], a2v[4];
#pragma unroll
    for (int e = 0; e < 4; e++) {
      w2v[e] = p.rw_w2[(size_t)(j + e) * DM + c];
      a2v[e] = p.rw_a2[(size_t)(j + e) * DM + c];
    }
#pragma unroll
    for (int t = 0; t < 8; t++) {
      float4 lw = *(const float4*)(lwa + t * 128 + j);
      float4 la = *(const float4*)(lwa + t * 128 + 64 + j);
      dw[t] += lw.x * w2v[0] + lw.y * w2v[1] + lw.z * w2v[2] + lw.w * w2v[3];
      da[t] += la.x * a2v[0] + la.y * a2v[1] + la.z * a2v[2] + la.w * a2v[3];
    }
  }
  const float mur = p.rw_mu[c], muk = p.rw_mu[1024 + c], muv = p.rw_mu[2048 + c];
  const float kk_w = p.rw_k_k[c], ka_w = p.rw_k_a[c], rk_w = p.rw_r_k[c];
  float pr, pk, pv;
  if (t0 == 0) {
    pr = prev0 ? prev0[c] : 0.f; pk = prev0 ? prev0[1024 + c] : 0.f; pv = prev0 ? prev0[2048 + c] : 0.f;
  } else {
    const bf16_t* q = ((bf16_t*)(p.ws + OW_PJA)) + (size_t)(r0 - 1) * PJW;
    pr = bf2f(q[c]); pk = bf2f(q[1024 + c]); pv = bf2f(q[2048 + c]);
  }
  const int head = c >> 6, e = c & 63;
  const int srow0 = slot_row0(seg);
  char* rws = ((char*)(p.ws + OW_RWS)) + ((size_t)(srow0 + r0) * 16 + head) * 1024;
  float* rwb = ((float*)(p.ws + OW_RWB)) + (size_t)(srow0 + r0) * 16 + head;
#pragma unroll
  for (int t = 0; t < 8; t++) {
    const int row = r0 + t;
    const bf16_t* q = ((bf16_t*)(p.ws + OW_PJA)) + (size_t)row * PJW;
    float cr = bf2f(q[c]), ck = bf2f(q[1024 + c]), cv = bf2f(q[2048 + c]);
    float xr = cr + mur * (pr - cr), xk = ck + muk * (pk - ck), xv = cv + muv * (pv - cv);
    pr = cr; pk = ck; pv = cv;
    float w_log = -softplusf_(-dw[t]) - 0.5f;
    float decay = __expf(-__expf(w_log));
    float a = sigmoidf_(da[t]);
    float kkr = xk * kk_w;
    float ss = wavesum(kkr * kkr);
    float kk = kkr * rsqrtf(ss + 1e-6f);
    float k2 = xk * (1.0f + (a - 1.0f) * ka_w);
    float bon = wavesum(xr * k2 * rk_w);
    char* o = rws + (size_t)t * RWS_ROWB;
    ((f16*)o)[e] = (f16)xr;
    ((f16*)(o + 128))[e] = (f16)k2;
    ((f16*)(o + 256))[e] = (f16)(-kk);
    ((f16*)(o + 384))[e] = (f16)(kk * a);
    ((float*)(o + 512))[e] = decay;
    ((float*)(o + 768))[e] = xv;
    if ((tid & 63) == 0) rwb[(size_t)t * 16] = bon;
    if (t0 + t == len - 1) {
      if (prompt) {
        float* cs = ((float*)(p.ws + OW_CSH)) + ((size_t)((seg + 1) & 1) * 2 + seq) * 3200;
        cs[c] = cr; cs[1024 + c] = ck; cs[2048 + c] = cv;
        if (seg == NSEG - 1) {
          float* ps = (p.out + OO_p_shift) + (size_t)seq * 3200;
          ps[c] = cr; ps[1024 + c] = ck; ps[2048 + c] = cv;
        }
      } else {
        float* ps = (p.out + OO_s_shift) + (size_t)(seq - 2) * 3200;
        ps[c] = cr; ps[1024 + c] = ck; ps[2048 + c] = cv;
      }
    }
  }
}

__device__ __forceinline__ void gd_prepass_item(PP pp, int seg, int grp, int slab) {
  LAUNDER_PP;
  const int tid = tid_l();
  const int r0 = grp * 16;
  int seq, t0, len;
  row_seq(seg, r0, seq, t0, len);
  const bool prompt = seq < 2;
  const int c = slab * 512 + 2 * tid;
  const int kind = slab >> 1;
  const int head = (c & 1023) >> 7, e = c & 127;
  float2 x0, x1, x2;
  if (t0 == 0) {
    const float* cp = nullptr;
    if (seg == 0) cp = prompt ? nullptr : p.st_conv + (size_t)(seq - 2) * 3 * 3072;
    else cp = ((float*)(p.ws + OW_CCV)) + ((size_t)(seg & 1) * 2 + seq) * 3 * 3072;
    if (cp) {
      x0 = *(const float2*)(cp + c); x1 = *(const float2*)(cp + 3072 + c); x2 = *(const float2*)(cp + 6144 + c);
    } else {
      x0 = x1 = x2 = make_float2(0.f, 0.f);
    }
  } else {
    uint32_t u0 = *(const uint32_t*)(((bf16_t*)(p.ws + OW_PJA)) + (size_t)(r0 - 3) * PJW + C_GDC + c);
    uint32_t u1 = *(const uint32_t*)(((bf16_t*)(p.ws + OW_PJA)) + (size_t)(r0 - 2) * PJW + C_GDC + c);
    uint32_t u2 = *(const uint32_t*)(((bf16_t*)(p.ws + OW_PJA)) + (size_t)(r0 - 1) * PJW + C_GDC + c);
    x0 = make_float2(bf2f(u0 & 0xffff), bf2f(u0 >> 16));
    x1 = make_float2(bf2f(u1 & 0xffff), bf2f(u1 >> 16));
    x2 = make_float2(bf2f(u2 & 0xffff), bf2f(u2 >> 16));
  }
  const float2 w0 = *(const float2*)(p.gd_conv_w + c), w1 = *(const float2*)(p.gd_conv_w + 3072 + c),
               w2 = *(const float2*)(p.gd_conv_w + 6144 + c), w3 = *(const float2*)(p.gd_conv_w + 9216 + c);
  const float a_exp = __expf(p.gd_a_log[head]);
  const float dtb = p.gd_dt_bias[head];
  char* gds = ((char*)(p.ws + OW_GDS)) + ((size_t)(slot_row0(seg) + r0) * 8 + head) * GDS_HB;
#pragma unroll 4
  for (int t = 0; t < 16; t++) {
    const int row = r0 + t;
    uint32_t u = *(const uint32_t*)(((bf16_t*)(p.ws + OW_PJA)) + (size_t)row * PJW + C_GDC + c);
    float2 x3 = make_float2(bf2f(u & 0xffff), bf2f(u >> 16));
    float cx = w0.x * x0.x + w1.x * x1.x + w2.x * x2.x + w3.x * x3.x;
    float cy = w0.y * x0.y + w1.y * x1.y + w2.y * x2.y + w3.y * x3.y;
    x0 = x1; x1 = x2; x2 = x3;
    float ax = siluf_(cx), ay = siluf_(cy);
    float sc = 1.0f;
    if (kind < 2) {
      float ss = wavesum(ax * ax + ay * ay);
      sc = rsqrtf(ss + 1e-6f);
      if (kind == 0) sc *= 0.08838834764831845f;
    }
    if (kind >= 1) {
      float beta = sigmoidf_(bf2f(((bf16_t*)(p.ws + OW_PJA))[(size_t)row * PJW + C_BETA + head]));
      sc *= sqrtf(beta);
    }
    ax *= sc; ay *= sc;
    char* o = gds + (size_t)t * GDS_ROWB;
    f16x2 hv = {(f16)ax, (f16)ay};
    *(f16x2*)(o + kind * 256 + e * 2) = hv;
    if (kind == 0 && (tid & 63) == 0) {
      float g = -a_exp * softplusf_(bf2f(((bf16_t*)(p.ws + OW_PJA))[(size_t)row * PJW + C_ALPHA + head]) + dtb);
      *(float*)(o + 768) = __expf(g);
    }
    int jj = t0 + t - (len - 3);
    if (jj >= 0) {
      if (prompt) {
        *(float2*)(((float*)(p.ws + OW_CCV)) + (((size_t)((seg + 1) & 1) * 2 + seq) * 3 + jj) * 3072 + c) = x3;
        if (seg == NSEG - 1) *(float2*)((p.out + OO_p_conv) + ((size_t)seq * 3 + jj) * 3072 + c) = x3;
      } else {
        *(float2*)((p.out + OO_s_conv) + ((size_t)(seq - 2) * 3 + jj) * 3072 + c) = x3;
      }
    }
  }
}

struct RwOps { f16x4 r, k, a, b; float4 w; float vv; };
__device__ __forceinline__ RwOps rw_ld(const char* Ls, int q, int v) {
  RwOps o;
  o.r = *(const f16x4*)(Ls + q * 8);
  o.k = *(const f16x4*)(Ls + 128 + q * 8);
  o.a = *(const f16x4*)(Ls + 256 + q * 8);
  o.b = *(const f16x4*)(Ls + 384 + q * 8);
  o.w = *(const float4*)(Ls + 512 + q * 16);
  o.vv = *(const float*)(Ls + 768 + v * 4);
  return o;
}
__device__ __forceinline__ float rw_step(const RwOps& o, float4& S) {
  float sa0 = (float)o.a[0] * S.x;
  float sa1 = (float)o.a[2] * S.z;
  sa0 = fmaf((float)o.a[1], S.y, sa0);
  sa1 = fmaf((float)o.a[3], S.w, sa1);
  float t0 = fmaf(o.vv, (float)o.k[0], S.x * o.w.x);
  float t1 = fmaf(o.vv, (float)o.k[1], S.y * o.w.y);
  float t2 = fmaf(o.vv, (float)o.k[2], S.z * o.w.z);
  float t3 = fmaf(o.vv, (float)o.k[3], S.w * o.w.w);
  const float sa = rowsum16(sa0 + sa1);
  S.x = fmaf(sa, (float)o.b[0], t0);
  S.y = fmaf(sa, (float)o.b[1], t1);
  S.z = fmaf(sa, (float)o.b[2], t2);
  S.w = fmaf(sa, (float)o.b[3], t3);
  float y0 = (float)o.r[0] * S.x;
  float y1 = (float)o.r[2] * S.z;
  y0 = fmaf((float)o.r[1], S.y, y0);
  y1 = fmaf((float)o.r[3], S.w, y1);
  return rowsum16(y0 + y1);
}
__device__ __forceinline__ void rw_scan_run(const char* __restrict__ gsrc  , int len, float4& S,
                            float* __restrict__ yo  , int q, int v, char* smem) {
  const int tid = tid_l();
  const int nch = len >> 4;
  const int lstep = tid >> 6, loff = (tid & 63) * 16;
  u32x4 st[4];
#pragma unroll
  for (int i = 0; i < 4; i++) st[i] = *(const u32x4*)(gsrc + (size_t)(lstep + 4 * i) * RWS_ROWB + loff);
  __syncthreads();
#pragma unroll
  for (int i = 0; i < 4; i++) *(u32x4*)(smem + (lstep + 4 * i) * 1024 + loff) = st[i];
  if (nch > 1) {
#pragma unroll
    for (int i = 0; i < 4; i++) st[i] = *(const u32x4*)(gsrc + (size_t)(16 + lstep + 4 * i) * RWS_ROWB + loff);
  }
  __syncthreads();
  for (int c = 0; c < nch; c++) {
    const char* L = smem + (c & 1) * 16384;
    float ykeep = 0.f;
    RwOps oa = rw_ld(L, q, v);
#pragma unroll 1
    for (int t = 0; t < 16; t += 2) {
      const RwOps ob = rw_ld(L + (t + 1) * 1024, q, v);
      asm volatile("" ::: "memory");
      const float ya = rw_step(oa, S);
      ykeep = (q == t) ? ya : ykeep;
      oa = rw_ld(L + ((t + 2) & 15) * 1024, q, v);
      asm volatile("" ::: "memory");
      const float yb = rw_step(ob, S);
      ykeep = (q == t + 1) ? yb : ykeep;
    }
    yo[(size_t)(c * 16 + q) * DM] = ykeep;
    if (c + 1 < nch) {
      char* Ln = smem + ((c + 1) & 1) * 16384;
#pragma unroll
      for (int i = 0; i < 4; i++) *(u32x4*)(Ln + (lstep + 4 * i) * 1024 + loff) = st[i];
      if (c + 2 < nch) {
#pragma unroll
        for (int i = 0; i < 4; i++)
          st[i] = *(const u32x4*)(gsrc + (size_t)((c + 2) * 16 + lstep + 4 * i) * RWS_ROWB + loff);
      }
    }
    lds_barrier();
  }
}

struct GdOps { f16x8 qv, kv; float vv, eg; };
__device__ __forceinline__ GdOps gd_ld(const char* Ls, int q, int cl) {
  GdOps o;
  o.kv = *(const f16x8*)(Ls + 256 + q * 16);
  o.vv = (float)*(const f16*)(Ls + 512 + cl * 2);
  o.eg = *(const float*)(Ls + 768);
  o.qv = *(const f16x8*)(Ls + q * 16);
  return o;
}
typedef float f32x2 __attribute__((ext_vector_type(2)));
__device__ __forceinline__ float gd_step(const GdOps& o, float (&s)[8]) {
  f32x2 s2[4], k2[4], q2[4];
#pragma unroll
  for (int j = 0; j < 4; j++) {
    s2[j] = (f32x2){s[2 * j], s[2 * j + 1]};
    k2[j] = (f32x2){(float)o.kv[2 * j], (float)o.kv[2 * j + 1]};
  }
  f32x2 acc = k2[0] * s2[0];
  acc = k2[1] * s2[1] + acc;
  acc = k2[2] * s2[2] + acc;
  acc = k2[3] * s2[3] + acc;
  const f32x2 eg2 = (f32x2){o.eg, o.eg};
  f32x2 es[4];
#pragma unroll
  for (int j = 0; j < 4; j++) es[j] = s2[j] * eg2;
  const float ks = rowsum16(acc[0] + acc[1]);
  const float d = fmaf(-o.eg, ks, o.vv);
  const f32x2 d2 = (f32x2){d, d};
#pragma unroll
  for (int j = 0; j < 4; j++) s2[j] = k2[j] * d2 + es[j];
#pragma unroll
  for (int j = 0; j < 4; j++) q2[j] = (f32x2){(float)o.qv[2 * j], (float)o.qv[2 * j + 1]};
  f32x2 oacc = q2[0] * s2[0];
  oacc = q2[1] * s2[1] + oacc;
  oacc = q2[2] * s2[2] + oacc;
  oacc = q2[3] * s2[3] + oacc;
#pragma unroll
  for (int j = 0; j < 4; j++) { s[2 * j] = s2[j][0]; s[2 * j + 1] = s2[j][1]; }
  return rowsum16(oacc[0] + oacc[1]);
}
__device__ __forceinline__ void gd_scan_run(const char* __restrict__ gsrc  , int len, float (&s)[8],
                            float* __restrict__ oo  , int q, int cl, char* smem) {
  const int tid = tid_l();
  const int nch = len >> 4;
  u32x4 st[4];
  int lt[4], lo[4];
#pragma unroll
  for (int i = 0; i < 4; i++) {
    int id = tid + 256 * i;
    if (id > 783) id = 783;
    lt[i] = id / 49;
    lo[i] = (id % 49) * 16;
  }
#pragma unroll
  for (int i = 0; i < 4; i++) st[i] = *(const u32x4*)(gsrc + (size_t)lt[i] * GDS_ROWB + lo[i]);
  __syncthreads();
#pragma unroll
  for (int i = 0; i < 4; i++) *(u32x4*)(smem + lt[i] * GDS_HB + lo[i]) = st[i];
  if (nch > 1) {
#pragma unroll
    for (int i = 0; i < 4; i++) st[i] = *(const u32x4*)(gsrc + (size_t)(16 + lt[i]) * GDS_ROWB + lo[i]);
  }
  __syncthreads();
  for (int c = 0; c < nch; c++) {
    const char* L = smem + (c & 1) * 16384;
    float okeep = 0.f;
    GdOps oa = gd_ld(L, q, cl);
#pragma unroll 1
    for (int t = 0; t < 16; t += 2) {
      const GdOps ob = gd_ld(L + (t + 1) * GDS_HB, q, cl);
      asm volatile("" ::: "memory");
      const float ya = gd_step(oa, s);
      okeep = (q == t) ? ya : okeep;
      oa = gd_ld(L + ((t + 2) & 15) * GDS_HB, q, cl);
      asm volatile("" ::: "memory");
      const float yb = gd_step(ob, s);
      okeep = (q == t + 1) ? yb : okeep;
    }
    oo[(size_t)(c * 16 + q) * DM] = okeep;
    if (c + 1 < nch) {
      char* Ln = smem + ((c + 1) & 1) * 16384;
#pragma unroll
      for (int i = 0; i < 4; i++) *(u32x4*)(Ln + lt[i] * GDS_HB + lo[i]) = st[i];
      if (c + 2 < nch) {
#pragma unroll
        for (int i = 0; i < 4; i++) st[i] = *(const u32x4*)(gsrc + (size_t)((c + 2) * 16 + lt[i]) * GDS_ROWB + lo[i]);
      }
    }
    lds_barrier();
  }
}

__device__ __forceinline__ void sample_scan_task(PP pp, int task, char* smem) {
  LAUNDER_PP;
  const int sj = task >> 7, j = task & 127, kind = j >> 6, jj = j & 63;
  const int tid = tid_l(), q = tid & 15;
  const int row0 = 1056 + sj * 16;
  if (kind == 0) {
    const int head = jj >> 2, v = (jj & 3) * 16 + (tid >> 4);
    const float* sin = p.st_wkv + ((size_t)sj * 16 + head) * 4096;
    float* sout = (p.out + OO_s_wkv) + ((size_t)sj * 16 + head) * 4096;
    float4 S = *(const float4*)(sin + v * 64 + 4 * q);
    rw_scan_run(((char*)(p.ws + OW_RWS)) + ((size_t)row0 * 16 + head) * 1024, 16, S, ((float*)(p.ws + OW_YRW)) + (size_t)row0 * DM + head * 64 + v, q, v, smem);
    *(float4*)(sout + v * 64 + 4 * q) = S;
  } else {
    const int head = jj >> 3, cl = (jj & 7) * 16 + (tid >> 4);
    const float* sin = p.st_ssm + ((size_t)sj * 8 + head) * 16384;
    float* sout = (p.out + OO_s_ssm) + ((size_t)sj * 8 + head) * 16384;
    float s[8];
#pragma unroll
    for (int i = 0; i < 8; i++) s[i] = sin[(size_t)(8 * q + i) * 128 + cl];
    gd_scan_run(((char*)(p.ws + OW_GDS)) + ((size_t)row0 * 8 + head) * GDS_HB, 16, s, ((float*)(p.ws + OW_OGD)) + (size_t)row0 * DM + head * 128 + cl, q, cl, smem);
#pragma unroll
    for (int i = 0; i < 8; i++) sout[(size_t)(8 * q + i) * 128 + cl] = s[i];
  }
}

__device__ __forceinline__ void scan_block_rw(PP pp, int j, char* smem) {
  LAUNDER_PP;
  const int seq = j >> 6, jj = j & 63;
  const int tid = tid_l(), q = tid & 15;
  const int head = jj >> 2, v = (jj & 3) * 16 + (tid >> 4);
  float4 S = make_float4(0.f, 0.f, 0.f, 0.f);
  for (int seg = 0; seg < NSEG; seg++) {
    wait_ge(((unsigned int*)(p.ws + OW_sync)) + SW_PRE, seg + 1);
    const int len = seg == 0 ? 528 : TS;
    const int row0 = slot_row0(seg) + (seg == 0 ? seq * 528 : seq * TS);
    rw_scan_run(((char*)(p.ws + OW_RWS)) + ((size_t)row0 * 16 + head) * 1024, len, S,
                ((float*)(p.ws + OW_YRW)) + (size_t)row0 * DM + head * 64 + v, q, v, smem);
    signal_add(((unsigned int*)(p.ws + OW_sync)) + SW_SCAN(seg));
  }
  {
    const int tid2 = tid_l(), q2 = tid2 & 15, v2 = (jj & 3) * 16 + (tid2 >> 4);
    *(float4*)((p.out + OO_p_wkv) + ((size_t)seq * 16 + head) * 4096 + v2 * 64 + 4 * q2) = S;
  }
}
__device__ __forceinline__ void scan_block_gd(PP pp, int j, char* smem) {
  LAUNDER_PP;
  const int seq = j >> 6, jj = j & 63;
  const int tid = tid_l(), q = tid & 15;
  const int head = jj >> 3, cl = (jj & 7) * 16 + (tid >> 4);
  float s[8];
#pragma unroll
  for (int i = 0; i < 8; i++) s[i] = 0.f;
  for (int seg = 0; seg < NSEG; seg++) {
    wait_ge(((unsigned int*)(p.ws + OW_sync)) + SW_PRE, seg + 1);
    const int len = seg == 0 ? 528 : TS;
    const int row0 = slot_row0(seg) + (seg == 0 ? seq * 528 : seq * TS);
    gd_scan_run(((char*)(p.ws + OW_GDS)) + ((size_t)row0 * 8 + head) * GDS_HB, len, s,
                ((float*)(p.ws + OW_OGD)) + (size_t)row0 * DM + head * 128 + cl, q, cl, smem);
    signal_add(((unsigned int*)(p.ws + OW_sync)) + SW_SCAN(seg));
  }
  {
    const int tid2 = tid_l(), q2 = tid2 & 15, cl2 = (jj & 7) * 16 + (tid2 >> 4);
    float* sout = (p.out + OO_p_ssm) + ((size_t)seq * 8 + head) * 16384;
#pragma unroll
    for (int i = 0; i < 8; i++) sout[(size_t)(8 * q2 + i) * 128 + cl2] = s[i];
  }
}

__device__ __forceinline__ void post_item(PP pp, int seg, int row) {
  LAUNDER_PP;
  const int tid = tid_l(), c4 = tid * 4;
  const int srow = slot_row0(seg) + row;
  const bf16_t* gt = ((bf16_t*)(p.ws + OW_GT)) + (size_t)(gt_row0(seg) + row) * GTW;
  {
    float4 y = *(const float4*)(((float*)(p.ws + OW_YRW)) + (size_t)srow * DM + c4);
    float mean = rowsum16(y.x + y.y + y.z + y.w) * (1.0f / 64.0f);
    float dx = y.x - mean, dy = y.y - mean, dz = y.z - mean, dw = y.w - mean;
    float var = rowsum16(dx * dx + dy * dy + dz * dz + dw * dw) * (1.0f / 64.0f);
    float rs = rsqrtf(var + 64e-5f);
    float4 lw = *(const float4*)(p.rw_ln_w + c4), lb = *(const float4*)(p.rw_ln_b + c4);
    float bon = ((float*)(p.ws + OW_RWB))[(size_t)srow * 16 + (tid >> 4)];
    float4 v = *(const float4*)(((char*)(p.ws + OW_RWS)) + ((size_t)srow * 16 + (tid >> 4)) * 1024 + 768 + (tid & 15) * 16);
    uint2 g = *(const uint2*)(gt + G_RW + c4);
    float o0 = (dx * rs * lw.x + lb.x + bon * v.x) * siluf_(bf2f(g.x & 0xffff));
    float o1 = (dy * rs * lw.y + lb.y + bon * v.y) * siluf_(bf2f(g.x >> 16));
    float o2 = (dz * rs * lw.z + lb.z + bon * v.z) * siluf_(bf2f(g.y & 0xffff));
    float o3 = (dw * rs * lw.w + lb.w + bon * v.w) * siluf_(bf2f(g.y >> 16));
    *(uint2*)(((bf16_t*)(p.ws + OW_YA)) + ((size_t)(seg & 1) * MP0 + row) * DM + c4) = make_uint2(pack2(o0, o1), pack2(o2, o3));
  }
  {
    float4 o = *(const float4*)(((float*)(p.ws + OW_OGD)) + (size_t)srow * DM + c4);
    float ss = rowsum16(o.x * o.x + o.y * o.y + o.z * o.z + o.w * o.w);
    ss += __shfl_xor(ss, 16);
    float rs = rsqrtf(ss * (1.0f / 128.0f) + 1e-6f);
    float4 nw = *(const float4*)(p.gd_norm_w + (c4 & 127));
    uint2 g = *(const uint2*)(gt + G_GD + c4);
    float o0 = o.x * rs * nw.x * siluf_(bf2f(g.x & 0xffff));
    float o1 = o.y * rs * nw.y * siluf_(bf2f(g.x >> 16));
    float o2 = o.z * rs * nw.z * siluf_(bf2f(g.y & 0xffff));
    float o3 = o.w * rs * nw.w * siluf_(bf2f(g.y >> 16));
    *(uint2*)(((bf16_t*)(p.ws + OW_YB)) + ((size_t)(seg & 1) * MP0 + row) * DM + c4) = make_uint2(pack2(o0, o1), pack2(o2, o3));
  }
}

#define SMEM_BYTES (32768 + 16)

__global__ void __launch_bounds__(256, 4) k_mega(Params p_arg) {
  PP pp = (PP)__builtin_amdgcn_kernarg_segment_ptr();
  __shared__ __attribute__((aligned(16))) char smem[SMEM_BYTES];
  cg::grid_group grid = cg::this_grid();
  const int bid = blockIdx.x, nb = gridDim.x;
  unsigned* sync = (unsigned*)(p.ws + OW_sync);
  const unsigned xcc = xcc_id() & 7u;
  if (bid >= NSCAN && threadIdx.x == 0) xb_add(&sync[SW_XCNT(xcc)], 1u);
  phase_weights(pp, bid, nb, smem);
  for (int it = bid; it < seg_MP(0) / 4; it += nb) xn_item(pp, 0, it);
  grid.sync();
  if (bid < NSCAN) {
    __builtin_amdgcn_s_setprio(3);
    if (bid < 128) scan_block_rw(pp, bid, smem);
    else scan_block_gd(pp, bid - 128, smem);
    return;
  }
  const int w = bid - NSCAN, NW = nb - NSCAN;
  unsigned* cfg = (unsigned*)(smem + 32768);
  if (threadIdx.x == 0) {
    unsigned mine = 0, nx = 0;
#pragma unroll
    for (unsigned j = 0; j < 8; j++) { unsigned c = xb_ld(&sync[SW_XCNT(j)]); nx += c > 0u ? 1u : 0u; mine = (j == xcc) ? c : mine; }
    cfg[0] = mine > 0u ? mine : 1u;
    cfg[1] = nx > 0u ? nx : 1u;
  }
  __syncthreads();
  for (int i = 0; i < NSEG + 5; i++) {
    const int sm = i - 4, snn = i - 5, sj = i - 3, so = i - 4, sp = i - 2;
    const bool front = i < NSEG;
    const bool mrg = sm >= 0 && sm < NSEG, nrm = snn >= 0 && snn < NSEG, back = sj >= 0 && sj < NSEG, outv = so >= 0 && so < NSEG,
               pst = sp >= 0 && sp < NSEG;
    {
      const int tmF = front ? seg_MP(i) / 128 : 1;
      const int nF = front ? tmF * (VW / 128) : 0;
      const int nM = mrg ? seg_MP(sm) / 4 : 0;
      const int nN = nrm ? seg_M(snn) / 4 : 0;
      for (int it = w; it < nF + nM + nN; it += NW) {
        int t = it;
        if (t < nF) { gemm_tile<0>(pp, i, t % tmF, t / tmF, smem); continue; }
        t -= nF;
        if (t < nM) { merge_item(pp, t); continue; }
        t -= nM;
        norm_item(pp, snn, t);
      }
      if (i == 1) {
        for (int it = w; it < 32 * 128; it += NW) sample_scan_task(pp, it, smem);
      }
    }
    worker_barrier((unsigned*)(p.ws + OW_sync), (const unsigned*)(smem + 32768));
    {
      const int nB = back ? (seg_MP(sj) / 128) * 8 : 0;
      const int nO = outv ? (seg_MP(so) / 128) * 8 : 0;
      const int nHeavy = 2 * nB + nO;
      const int nHeavyW = nHeavy < NW / 2 ? nHeavy : NW / 2;
      const int NL = NW - nHeavyW;
      const int ngrp = front ? seg_M(i) / 16 : 0;
      const int nRW = ngrp * 8, nGD = ngrp * 6;
      const int nX = (i + 1 < NSEG) ? seg_MP(i + 1) / 4 : 0;
      const int tot = nRW + nGD + nX;
      if (w >= NL) {
        for (int it = w - NL; it < nHeavy; it += nHeavyW) {
          int t = it;
          if (t < nB) { gemm_tile<1>(pp, sj, t >> 3, t & 7, smem); continue; }
          t -= nB;
          if (t < nB) { gemm_tile<3>(pp, sj, t >> 3, t & 7, smem); continue; }
          t -= nB;
          gemm_tile<2>(pp, so, t >> 3, t & 7, smem);
        }
      } else {
        for (int it = w; it < tot; it += NL) {
          int t = it;
          if (t < nRW) { rw_prepass_item(pp, i, t >> 2, t & 3, smem); continue; }
          t -= nRW;
          if (t < nGD) { gd_prepass_item(pp, i, t / 6, t % 6); continue; }
          t -= nGD;
          xn_item(pp, i + 1, t);
        }
      }
      if (pst) {
        wait_ge((unsigned*)(p.ws + OW_sync) + SW_SCAN(sp), NSCAN);
        const int n = seg_M(sp);
        for (int it = w; it < n; it += NW) post_item(pp, sp, it);
      }
    }
    worker_barrier((unsigned*)(p.ws + OW_sync), (const unsigned*)(smem + 32768));
    if (front && w == 0 && threadIdx.x == 0)
      __hip_atomic_store((unsigned*)(p.ws + OW_sync) + SW_PRE, (unsigned)(i + 1), __ATOMIC_RELAXED, __HIP_MEMORY_SCOPE_AGENT);
  }
}

static inline size_t align_up(size_t x) { return (x + 255) & ~(size_t)255; }

#undef p
extern "C" void kernel_launch(void* const* d_in, const int* in_sizes, int n_in, void* d_out, int out_size, void* d_ws,
                              size_t ws_size, hipStream_t stream) {
  Params p{};
  const float* const* in = (const float* const*)d_in;
  p.x_prompt = in[0]; p.x_sample = in[1]; p.st_shift = in[2]; p.st_wkv = in[3]; p.st_conv = in[4]; p.st_ssm = in[5];
  p.meta = in[6]; p.norm_pre = in[7]; p.w_in = in[8]; p.rw_mu = in[9]; p.rw_w0 = in[10]; p.rw_w2 = in[11];
  p.rw_a0 = in[12]; p.rw_a2 = in[13]; p.rw_k_k = in[14]; p.rw_k_a = in[15]; p.rw_r_k = in[16]; p.rw_ln_w = in[17];
  p.rw_ln_b = in[18]; p.gd_conv_w = in[19]; p.gd_a_log = in[20]; p.gd_dt_bias = in[21]; p.gd_norm_w = in[22];
  p.w_out_a = in[23]; p.w_out_b = in[24]; p.w_out = in[25]; p.norm_post = in[26];
  p.out = (float*)d_out;
  p.ws = (char*)d_ws;
  if (OW_END > ws_size) { fprintf(stderr, "workspace too small: need %zu have %zu\n", (size_t)OW_END, ws_size); return; }

  static int grid_blocks = 0;
  if (!grid_blocks) {
    int dev = 0, cus = 0, per_cu = 0;
    (void)hipGetDevice(&dev);
    (void)hipDeviceGetAttribute(&cus, hipDeviceAttributeMultiprocessorCount, dev);
    (void)hipOccupancyMaxActiveBlocksPerMultiprocessor(&per_cu, k_mega, 256, 0);
    if (per_cu > 4) per_cu = 4;
    grid_blocks = cus * per_cu;
  }
  (void)hipMemsetAsync(p.ws + OW_sync, 0, 16384, stream);
  void* args[] = {&p};
  hipError_t e = hipLaunchCooperativeKernel((void*)k_mega, dim3(grid_blocks), dim3(256), args, 0, stream);
  if (e != hipSuccess) fprintf(stderr, "cooperative launch failed: %s (grid %d)\n", hipGetErrorString(e), grid_blocks);
}
```

```cpp
#include <hip/hip_runtime.h>
#include <hip/hip_cooperative_groups.h>
#include <stdint.h>
#include <stdio.h>
namespace cg = cooperative_groups;

typedef unsigned short bf16_t;
typedef _Float16 f16;
using bf16x8 = __attribute__((ext_vector_type(8))) short;
using f32x4 = __attribute__((ext_vector_type(4))) float;
using u32x4 = __attribute__((ext_vector_type(4))) unsigned int;
using f16x2 = __attribute__((ext_vector_type(2))) _Float16;
using f16x4 = __attribute__((ext_vector_type(4))) _Float16;
using f16x8 = __attribute__((ext_vector_type(8))) _Float16;

#define DM 1024
#define PW 10384
#define VW 10496
#define PJW 6400
#define GTW 4096
#define NSEG 16
#define TS 512
#define M0 1568
#define MP0 1664
#define M1 1024
#define SLOT_ROWS 3712
#define GT_ROWS 4736
#define NSCAN 256
#define C_GDC 3200
#define C_BETA 6272
#define C_ALPHA 6280
#define G_RW 0
#define G_GD 1024
#define G_MA 2048
#define G_MB 3072
#define RWS_ROWB 16384
#define GDS_HB 784
#define GDS_ROWB 6272

struct Params {
  const float *x_prompt, *x_sample, *st_shift, *st_wkv, *st_conv, *st_ssm, *meta, *norm_pre, *w_in, *rw_mu, *rw_w0,
      *rw_w2, *rw_a0, *rw_a2, *rw_k_k, *rw_k_a, *rw_r_k, *rw_ln_w, *rw_ln_b, *gd_conv_w, *gd_a_log, *gd_dt_bias,
      *gd_norm_w, *w_out_a, *w_out_b, *w_out, *norm_post;
  float* out;
  char* ws;
};
#define p (PV(pp))
#define GLOBAL_AS __attribute__((address_space(1)))
#define CONST_AS __attribute__((address_space(4)))
struct ParamsG {
  const GLOBAL_AS float *x_prompt, *x_sample, *st_shift, *st_wkv, *st_conv, *st_ssm, *meta, *norm_pre, *w_in, *rw_mu, *rw_w0,
      *rw_w2, *rw_a0, *rw_a2, *rw_k_k, *rw_k_a, *rw_r_k, *rw_ln_w, *rw_ln_b, *gd_conv_w, *gd_a_log, *gd_dt_bias,
      *gd_norm_w, *w_out_a, *w_out_b, *w_out, *norm_post;
  GLOBAL_AS float* out;
  GLOBAL_AS char* ws;
};
typedef const CONST_AS ParamsG* PP;
__device__ __forceinline__ Params PV(PP pp) {
  Params v;
  v.x_prompt = (const float*)pp->x_prompt;
  v.x_sample = (const float*)pp->x_sample;
  v.st_shift = (const float*)pp->st_shift;
  v.st_wkv = (const float*)pp->st_wkv;
  v.st_conv = (const float*)pp->st_conv;
  v.st_ssm = (const float*)pp->st_ssm;
  v.meta = (const float*)pp->meta;
  v.norm_pre = (const float*)pp->norm_pre;
  v.w_in = (const float*)pp->w_in;
  v.rw_mu = (const float*)pp->rw_mu;
  v.rw_w0 = (const float*)pp->rw_w0;
  v.rw_w2 = (const float*)pp->rw_w2;
  v.rw_a0 = (const float*)pp->rw_a0;
  v.rw_a2 = (const float*)pp->rw_a2;
  v.rw_k_k = (const float*)pp->rw_k_k;
  v.rw_k_a = (const float*)pp->rw_k_a;
  v.rw_r_k = (const float*)pp->rw_r_k;
  v.rw_ln_w = (const float*)pp->rw_ln_w;
  v.rw_ln_b = (const float*)pp->rw_ln_b;
  v.gd_conv_w = (const float*)pp->gd_conv_w;
  v.gd_a_log = (const float*)pp->gd_a_log;
  v.gd_dt_bias = (const float*)pp->gd_dt_bias;
  v.gd_norm_w = (const float*)pp->gd_norm_w;
  v.w_out_a = (const float*)pp->w_out_a;
  v.w_out_b = (const float*)pp->w_out_b;
  v.w_out = (const float*)pp->w_out;
  v.norm_post = (const float*)pp->norm_post;
  v.out = (float*)pp->out;
  v.ws = (char*)pp->ws;
  return v;
}
constexpr size_t al256(size_t x) { return (x + 255) & ~(size_t)255; }
constexpr size_t OO_y_prompt = 0;
constexpr size_t OO_y_sample = OO_y_prompt + (size_t)2 * 8192 * 1024;
constexpr size_t OO_p_shift = OO_y_sample + (size_t)32 * 16 * 1024;
constexpr size_t OO_p_wkv = OO_p_shift + 2 * 3200;
constexpr size_t OO_p_conv = OO_p_wkv + 2 * 16 * 4096;
constexpr size_t OO_p_ssm = OO_p_conv + 2 * 3 * 3072;
constexpr size_t OO_s_shift = OO_p_ssm + 2 * 8 * 16384;
constexpr size_t OO_s_wkv = OO_s_shift + 32 * 3200;
constexpr size_t OO_s_conv = OO_s_wkv + 32 * 16 * 4096;
constexpr size_t OO_s_ssm = OO_s_conv + 32 * 3 * 3072;
constexpr size_t OW_sync = 0;
constexpr size_t OW_WtIn = OW_sync + 16384;
constexpr size_t OW_WtA = OW_WtIn + al256((size_t)VW * DM * 2);
constexpr size_t OW_WtB = OW_WtA + al256((size_t)DM * DM * 2);
constexpr size_t OW_WtO = OW_WtB + al256((size_t)DM * DM * 2);
constexpr size_t OW_XN = OW_WtO + al256((size_t)DM * DM * 2);
constexpr size_t OW_PJA = OW_XN + al256((size_t)MP0 * DM * 2);
constexpr size_t OW_YA = OW_PJA + al256((size_t)MP0 * PJW * 2);
constexpr size_t OW_YB = OW_YA + al256((size_t)2 * MP0 * DM * 2);
constexpr size_t OW_MG = OW_YB + al256((size_t)2 * MP0 * DM * 2);
constexpr size_t OW_OUTB = OW_MG + al256((size_t)MP0 * DM * 2);
constexpr size_t OW_TMP = OW_OUTB + al256((size_t)2 * MP0 * DM * 4);
constexpr size_t OW_GT = OW_TMP + al256((size_t)2 * MP0 * DM * 4);
constexpr size_t OW_RWS = OW_GT + al256((size_t)GT_ROWS * GTW * 2);
constexpr size_t OW_GDS = OW_RWS + al256((size_t)SLOT_ROWS * RWS_ROWB);
constexpr size_t OW_RWB = OW_GDS + al256((size_t)SLOT_ROWS * GDS_ROWB + 256);
constexpr size_t OW_YRW = OW_RWB + al256((size_t)SLOT_ROWS * 16 * 4);
constexpr size_t OW_OGD = OW_YRW + al256((size_t)SLOT_ROWS * DM * 4);
constexpr size_t OW_CSH = OW_OGD + al256((size_t)SLOT_ROWS * DM * 4);
constexpr size_t OW_CCV = OW_CSH + al256((size_t)2 * 2 * 3200 * 4);
constexpr size_t OW_END = OW_CCV + al256((size_t)2 * 2 * 3 * 3072 * 4);


__device__ __forceinline__ bf16_t f2bf(float f) {
  uint32_t u = __float_as_uint(f);
  u += 0x7fffu + ((u >> 16) & 1u);
  return (bf16_t)(u >> 16);
}
__device__ __forceinline__ float bf2f(bf16_t h) { return __uint_as_float(((uint32_t)h) << 16); }
__device__ __forceinline__ uint32_t pack2(float a, float b) { return (uint32_t)f2bf(a) | ((uint32_t)f2bf(b) << 16); }
__device__ __forceinline__ float sigmoidf_(float x) { return 1.0f / (1.0f + __expf(-x)); }
__device__ __forceinline__ float siluf_(float x) { return x / (1.0f + __expf(-x)); }
__device__ __forceinline__ float softplusf_(float x) { return fmaxf(x, 0.0f) + log1pf(__expf(-fabsf(x))); }

__device__ __forceinline__ int tid_l() { int t = threadIdx.x; asm volatile("" : "+v"(t)); return t; }
#define LAUNDER_PP asm volatile("" : "+s"(pp))
template <int CTRL>
__device__ __forceinline__ float dppf(float x) {
  return __builtin_bit_cast(float, __builtin_amdgcn_update_dpp(0, __builtin_bit_cast(int, x), CTRL, 0xf, 0xf, true));
}
__device__ __forceinline__ float rowsum16(float x) {
  x += dppf<0xB1>(x);
  x += dppf<0x4E>(x);
  x += dppf<0x141>(x);
  x += dppf<0x140>(x);
  return x;
}
__device__ __forceinline__ float wavesum(float x) {
  x = rowsum16(x);
  x += __shfl_xor(x, 16);
  x += __shfl_xor(x, 32);
  return x;
}

#define SW_XCNT(j) (64 * (1 + (j)))
#define SW_XSUB(j) (64 * (9 + (j)))
#define SW_XGEN(j) (64 * (17 + (j)))
#define SW_TOP (64 * 25)
#define SW_TOPGEN (64 * 26)
#define SW_PRE (64 * 27)
#define SW_SCAN(s) (64 * (28 + (s)))
#define SYNC_BYTES 16384
__device__ __forceinline__ unsigned xb_ld(const unsigned* ptr) {
  return __hip_atomic_load(ptr, __ATOMIC_RELAXED, __HIP_MEMORY_SCOPE_AGENT);
}
__device__ __forceinline__ unsigned xb_add(unsigned* ptr, unsigned v) {
  return __hip_atomic_fetch_add(ptr, v, __ATOMIC_RELAXED, __HIP_MEMORY_SCOPE_AGENT);
}
__device__ __forceinline__ unsigned xcc_id() { return (unsigned)__builtin_amdgcn_s_getreg((3 << 11) | 20) & 0xFu; }
__device__ __forceinline__ void wait_ge(const unsigned* ptr, unsigned target) {
  if (threadIdx.x == 0) {
    while (xb_ld(ptr) < target) __builtin_amdgcn_s_sleep(8);
    __builtin_amdgcn_fence(__ATOMIC_ACQUIRE, "agent");
    asm volatile("s_waitcnt vmcnt(0)" ::: "memory");
  }
  __syncthreads();
}
__device__ __forceinline__ void signal_add(unsigned* ptr) {
  asm volatile("s_waitcnt vmcnt(0)" ::: "memory");
  __syncthreads();
  if (threadIdx.x == 0) {
    __builtin_amdgcn_fence(__ATOMIC_RELEASE, "agent");
    asm volatile("s_waitcnt vmcnt(0)" ::: "memory");
    xb_add(ptr, 1u);
  }
}
__device__ __forceinline__ void worker_barrier(unsigned* bar, const unsigned* lds_cfg) {
  asm volatile("s_waitcnt vmcnt(0)" ::: "memory");
  __syncthreads();
  if (threadIdx.x == 0) {
    const unsigned x = xcc_id() & 7u, nloc = lds_cfg[0], nx = lds_cfg[1];
    const unsigned old = xb_add(&bar[SW_XSUB(x)], 1u);
    const unsigned gen = old / nloc;
    if (old + 1u == (gen + 1u) * nloc) {
      __builtin_amdgcn_fence(__ATOMIC_RELEASE, "agent");
      asm volatile("s_waitcnt vmcnt(0)" ::: "memory");
      const unsigned og = xb_add(&bar[SW_TOP], 1u);
      const unsigned tg = og / nx;
      if (og + 1u == (tg + 1u) * nx) xb_add(&bar[SW_TOPGEN], 1u);
      else while (xb_ld(&bar[SW_TOPGEN]) == tg) __builtin_amdgcn_s_sleep(1);
      __builtin_amdgcn_fence(__ATOMIC_ACQUIRE, "agent");
      xb_add(&bar[SW_XGEN(x)], 1u);
      asm volatile("s_waitcnt vmcnt(0)" ::: "memory");
    } else {
      while (xb_ld(&bar[SW_XGEN(x)]) == gen) __builtin_amdgcn_s_sleep(1);
      __builtin_amdgcn_fence(__ATOMIC_ACQUIRE, "agent");
      asm volatile("s_waitcnt vmcnt(0)" ::: "memory");
    }
  }
  __syncthreads();
}

__device__ __forceinline__ void lds_barrier() {
  asm volatile("s_waitcnt lgkmcnt(0)" ::: "memory");
  __builtin_amdgcn_s_barrier();
  asm volatile("" ::: "memory");
}

__device__ __forceinline__ int seg_M(int seg) { return seg == 0 ? M0 : M1; }
__device__ __forceinline__ int seg_MP(int seg) { return seg == 0 ? MP0 : M1; }
__device__ __forceinline__ int slot_row0(int seg) { int s = seg % 3; return s == 0 ? 0 : MP0 + (s - 1) * M1; }
__device__ __forceinline__ int gt_row0(int seg) { int s = seg & 3; return s == 0 ? 0 : MP0 + (s - 1) * M1; }
__device__ __forceinline__ const float* row_src(PP pp, int seg, int r) {
  if (seg == 0) {
    if (r < 1056) {
      int b = r >= 528 ? 1 : 0, t = r - b * 528;
      if (t < 16) return p.meta + t * DM;
      return p.x_prompt + ((size_t)b * 8192 + (t - 16)) * DM;
    }
    return p.x_sample + (size_t)(r - 1056) * DM;
  }
  int b = r >> 9, t = r & 511;
  return p.x_prompt + ((size_t)b * 8192 + seg * TS + t) * DM;
}
__device__ __forceinline__ float* row_dst(PP pp, int seg, int r) {
  if (seg == 0) {
    if (r < 1056) {
      int b = r >= 528 ? 1 : 0, t = r - b * 528;
      if (t < 16) return nullptr;
      return (p.out + OO_y_prompt) + ((size_t)b * 8192 + (t - 16)) * DM;
    }
    return (p.out + OO_y_sample) + (size_t)(r - 1056) * DM;
  }
  int b = r >> 9, t = r & 511;
  return (p.out + OO_y_prompt) + ((size_t)b * 8192 + seg * TS + t) * DM;
}
__device__ __forceinline__ void row_seq(int seg, int r, int& seq, int& t, int& len) {
  if (seg == 0) {
    if (r < 528) { seq = 0; t = r; len = 528; }
    else if (r < 1056) { seq = 1; t = r - 528; len = 528; }
    else { seq = 2 + ((r - 1056) >> 4); t = (r - 1056) & 15; len = 16; }
  } else { seq = r >> 9; t = r & 511; len = TS; }
}

__device__ __forceinline__ int vcol_src(int n) {
  if (n < 3200) return n;
  if (n < 6288) return n + 1024;
  if (n < 6400) return -1;
  if (n < 7424) return n - 3200;
  return n - 112;
}
__device__ __forceinline__ void transpose_tile(const float* __restrict__ src, int ld, bool remap, bf16_t* __restrict__ dst, int k0, int n0,
                               float* tile  ) {
  int tid = tid_l();
  int i = tid >> 4, j = tid & 15;
  __syncthreads();
  int n = n0 + 4 * j;
  int sc = remap ? vcol_src(n) : n;
#pragma unroll
  for (int pass = 0; pass < 4; pass++) {
    int k = pass * 16 + i;
    float4 v = make_float4(0.f, 0.f, 0.f, 0.f);
    if (sc >= 0) v = *(const float4*)(src + (size_t)(k0 + k) * ld + sc);
    tile[k * 65 + 4 * j + 0] = v.x; tile[k * 65 + 4 * j + 1] = v.y; tile[k * 65 + 4 * j + 2] = v.z; tile[k * 65 + 4 * j + 3] = v.w;
  }
  __syncthreads();
  int nn = tid >> 2, kq = tid & 3;
  uint32_t o[8];
#pragma unroll
  for (int e = 0; e < 8; e++) o[e] = pack2(tile[(kq * 16 + 2 * e) * 65 + nn], tile[(kq * 16 + 2 * e + 1) * 65 + nn]);
  u32x4* d = (u32x4*)(dst + (size_t)(n0 + nn) * DM + k0 + kq * 16);
  d[0] = (u32x4){o[0], o[1], o[2], o[3]};
  d[1] = (u32x4){o[4], o[5], o[6], o[7]};
}
__device__ __forceinline__ void phase_weights(PP pp, int bid, int nb, char* smem) {
  LAUNDER_PP;
  float* tile = (float*)smem;
  const int nIn = 16 * (VW / 64);
  const int nSq = 16 * 16;
  for (int it = bid; it < nIn + 3 * nSq; it += nb) {
    if (it < nIn) {
      int kt = it & 15, nt = it >> 4;
      transpose_tile(p.w_in, PW, true, ((bf16_t*)(p.ws + OW_WtIn)), kt * 64, nt * 64, tile);
    } else {
      int j = it - nIn, w = j / nSq, r = j % nSq;
      int kt = r & 15, nt = r >> 4;
      const float* src = w == 0 ? p.w_out_a : (w == 1 ? p.w_out_b : p.w_out);
      bf16_t* dst = w == 0 ? ((bf16_t*)(p.ws + OW_WtA)) : (w == 1 ? ((bf16_t*)(p.ws + OW_WtB)) : ((bf16_t*)(p.ws + OW_WtO)));
      transpose_tile(src, DM, false, dst, kt * 64, nt * 64, tile);
    }
  }
}

__device__ __forceinline__ void xn_item(PP pp, int seg, int item) {
  LAUNDER_PP;
  int wave = tid_l() >> 6, lane = tid_l() & 63;
  int M = seg_M(seg);
  int r = item * 4 + wave;
  bf16_t* o = ((bf16_t*)(p.ws + OW_XN)) + (size_t)r * DM;
  if (r >= M) {
#pragma unroll
    for (int i = 0; i < 4; i++) *(uint2*)(o + (lane + 64 * i) * 4) = make_uint2(0u, 0u);
    return;
  }
  const float4* src = (const float4*)row_src(pp, seg, r);
  float4 v[4];
  float ss = 0.f;
#pragma unroll
  for (int i = 0; i < 4; i++) {
    v[i] = src[lane + 64 * i];
    ss += v[i].x * v[i].x + v[i].y * v[i].y + v[i].z * v[i].z + v[i].w * v[i].w;
  }
  ss = wavesum(ss);
  float rstd = rsqrtf(ss * (1.0f / DM) + 1e-6f);
#pragma unroll
  for (int i = 0; i < 4; i++) {
    float4 g = ((const float4*)p.norm_pre)[lane + 64 * i];
    *(uint2*)(o + (lane + 64 * i) * 4) =
        make_uint2(pack2(v[i].x * rstd * g.x, v[i].y * rstd * g.y), pack2(v[i].z * rstd * g.z, v[i].w * rstd * g.w));
  }
}

__device__ __forceinline__ void norm_item(PP pp, int seg, int item) {
  LAUNDER_PP;
  int wave = tid_l() >> 6, lane = tid_l() & 63;
  int r = item * 4 + wave;
  float* dst = row_dst(pp, seg, r);
  if (!dst) return;
  const float4* h = (const float4*)row_src(pp, seg, r);
  const float4* o = (const float4*)(((float*)(p.ws + OW_OUTB)) + ((size_t)(seg & 1) * MP0 + r) * DM);
  float4 v[4];
  float ss = 0.f;
#pragma unroll
  for (int i = 0; i < 4; i++) {
    v[i] = o[lane + 64 * i];
    ss += v[i].x * v[i].x + v[i].y * v[i].y + v[i].z * v[i].z + v[i].w * v[i].w;
  }
  ss = wavesum(ss);
  float rstd = rsqrtf(ss * (1.0f / DM) + 1e-6f);
#pragma unroll
  for (int i = 0; i < 4; i++) {
    float4 g = ((const float4*)p.norm_post)[lane + 64 * i];
    float4 hh = h[lane + 64 * i];
    ((float4*)dst)[lane + 64 * i] =
        make_float4(hh.x + v[i].x * rstd * g.x, hh.y + v[i].y * rstd * g.y, hh.z + v[i].z * rstd * g.z, hh.w + v[i].w * rstd * g.w);
  }
}

__device__ __forceinline__ void merge_item(PP pp, int item) {
  LAUNDER_PP;
  const int tid = tid_l();
  const int wave = tid >> 6, lane = tid & 63;
  const int r = item * 4 + wave;
  const float4* t1 = (const float4*)((const float*)(p.ws + OW_TMP) + (size_t)r * DM);
  const float4* t2 = (const float4*)((const float*)(p.ws + OW_TMP) + ((size_t)MP0 + r) * DM);
  bf16_t* o = (bf16_t*)(p.ws + OW_MG) + (size_t)r * DM;
#pragma unroll
  for (int i = 0; i < 4; i++) {
    float4 a = t1[lane + 64 * i], b = t2[lane + 64 * i];
    *(uint2*)(o + (lane + 64 * i) * 4) = make_uint2(pack2(a.x + b.x, a.y + b.y), pack2(a.z + b.z, a.w + b.w));
  }
}

#define LDT 32
template <int MODE>
__device__ __forceinline__ void gemm_tile(PP pp, int seg, int tm, int tn, char* smem) {
  LAUNDER_PP;
  const int tid = tid_l(), lane = tid & 63, wid = tid >> 6;
  const int wr = wid >> 1, wc = wid & 1, fr = lane & 15, fq = lane >> 4;
  const int lrow = tid >> 2, lkc = tid & 3;
  const int m0 = tm * 128, n0 = tn * 128;
  bf16_t* GTs = ((bf16_t*)(p.ws + OW_GT)) + (size_t)gt_row0(seg) * GTW;
  f32x4 acc[4][4];
#pragma unroll
  for (int a = 0; a < 4; a++)
#pragma unroll
    for (int b = 0; b < 4; b++) acc[a][b] = (f32x4){0.f, 0.f, 0.f, 0.f};
  {
    const bf16_t* A = (MODE == 0) ? (const bf16_t*)(p.ws + OW_XN)
                    : (MODE == 1) ? (const bf16_t*)(p.ws + OW_YA) + (size_t)(seg & 1) * MP0 * DM
                    : (MODE == 3) ? (const bf16_t*)(p.ws + OW_YB) + (size_t)(seg & 1) * MP0 * DM
                                  : (const bf16_t*)(p.ws + OW_MG);
    const bf16_t* Bt = (const bf16_t*)(p.ws + (MODE == 0 ? OW_WtIn : (MODE == 1 ? OW_WtA : (MODE == 3 ? OW_WtB : OW_WtO))));
    u32x4 ra[2], rb[2];
    const bf16_t* gA = A + (size_t)(m0 + lrow) * DM + lkc * 8;
    const bf16_t* gB = Bt + (size_t)(n0 + lrow) * DM + lkc * 8;
    const int wofs = lrow * 64 + ((lkc ^ ((lrow >> 2) & 3)) << 4);
    const int rofs = fr * 64 + ((fq ^ ((fr >> 2) & 3)) << 4);
    __syncthreads();
#pragma unroll
    for (int i = 0; i < 2; i++) {
      ra[i] = *(const u32x4*)(gA + (size_t)i * 64 * DM);
      rb[i] = *(const u32x4*)(gB + (size_t)i * 64 * DM);
    }
#pragma unroll
    for (int i = 0; i < 2; i++) {
      *(u32x4*)(smem + wofs + i * 4096) = ra[i];
      *(u32x4*)(smem + 8192 + wofs + i * 4096) = rb[i];
    }
#pragma unroll
    for (int i = 0; i < 2; i++) {
      ra[i] = *(const u32x4*)(gA + (size_t)i * 64 * DM + 32);
      rb[i] = *(const u32x4*)(gB + (size_t)i * 64 * DM + 32);
    }
    lds_barrier();
#pragma unroll 1
    for (int kt = 0; kt < 32; kt++) {
      const char* cA = smem + (kt & 1) * 16384 + wr * 4096 + rofs;
      const char* cB = smem + (kt & 1) * 16384 + 8192 + wc * 4096 + rofs;
      bf16x8 xa[4];
#pragma unroll
      for (int i = 0; i < 4; i++) xa[i] = *(const bf16x8*)(cA + i * 1024);
#pragma unroll
      for (int ni = 0; ni < 4; ni++) {
        const bf16x8 wb = *(const bf16x8*)(cB + ni * 1024);
#pragma unroll
        for (int mi = 0; mi < 4; mi++)
          acc[ni][mi] = __builtin_amdgcn_mfma_f32_16x16x32_bf16(wb, xa[mi], acc[ni][mi], 0, 0, 0);
      }
      if (kt + 1 < 32) {
        char* nx = smem + ((kt + 1) & 1) * 16384;
#pragma unroll
        for (int i = 0; i < 2; i++) {
          *(u32x4*)(nx + wofs + i * 4096) = ra[i];
          *(u32x4*)(nx + 8192 + wofs + i * 4096) = rb[i];
        }
        if (kt + 2 < 32) {
#pragma unroll
          for (int i = 0; i < 2; i++) {
            ra[i] = *(const u32x4*)(gA + (size_t)i * 64 * DM + (kt + 2) * 32);
            rb[i] = *(const u32x4*)(gB + (size_t)i * 64 * DM + (kt + 2) * 32);
          }
        }
      }
      lds_barrier();
    }
  }
  float* OUTBp = (MODE == 2) ? (float*)(p.ws + OW_OUTB) + (size_t)(seg & 1) * MP0 * DM
                             : (float*)(p.ws + OW_TMP) + (size_t)(MODE == 3 ? 1 : 0) * MP0 * DM;
#pragma unroll
  for (int ni = 0; ni < 4; ni++)
#pragma unroll
    for (int mi = 0; mi < 4; mi++) {
      const int m = m0 + wr * 64 + mi * 16 + fr;
      const int n = n0 + wc * 64 + ni * 16 + fq * 4;
      f32x4 c = acc[ni][mi];
      if (MODE == 0) {
        uint2 o = make_uint2(pack2(c[0], c[1]), pack2(c[2], c[3]));
        if (tn < PJW / 128) *(uint2*)(((bf16_t*)(p.ws + OW_PJA)) + (size_t)m * PJW + n) = o;
        else *(uint2*)(GTs + (size_t)m * GTW + (n - PJW)) = o;
      } else if (MODE == 1) {
        uint2 ga = *(const uint2*)(GTs + (size_t)m * GTW + G_MA + n);
        *(float4*)(OUTBp + (size_t)m * DM + n) =
            make_float4(sigmoidf_(bf2f(ga.x & 0xffff)) * c[0], sigmoidf_(bf2f(ga.x >> 16)) * c[1],
                        sigmoidf_(bf2f(ga.y & 0xffff)) * c[2], sigmoidf_(bf2f(ga.y >> 16)) * c[3]);
      } else if (MODE == 3) {
        uint2 gb = *(const uint2*)(GTs + (size_t)m * GTW + G_MB + n);
        *(float4*)(OUTBp + (size_t)m * DM + n) =
            make_float4(sigmoidf_(bf2f(gb.x & 0xffff)) * c[0], sigmoidf_(bf2f(gb.x >> 16)) * c[1],
                        sigmoidf_(bf2f(gb.y & 0xffff)) * c[2], sigmoidf_(bf2f(gb.y >> 16)) * c[3]);
      } else {
        *(float4*)(OUTBp + (size_t)m * DM + n) = make_float4(c[0], c[1], c[2], c[3]);
      }
    }
}

__device__ __forceinline__ void rw_prepass_item(PP pp, int seg, int grp, int slab, char* smem) {
  LAUNDER_PP;
  float* lwa = (float*)smem;
  const int tid = tid_l();
  const int r0 = grp * 8;
  int seq, t0, len;
  row_seq(seg, r0, seq, t0, len);
  const bool prompt = seq < 2;
  const float* prev0 = nullptr;
  if (t0 == 0) {
    if (seg == 0) prev0 = prompt ? nullptr : p.st_shift + (size_t)(seq - 2) * 3200;
    else prev0 = ((float*)(p.ws + OW_CSH)) + ((size_t)(seg & 1) * 2 + seq) * 3200;
  }
  __syncthreads();
  {
    const int j = tid & 127;
    const float mu = p.rw_mu[3072 + j];
#pragma unroll
    for (int i = 0; i < 4; i++) {
      int tok = (tid >> 7) + 2 * i;
      int row = r0 + tok;
      float ps = bf2f(((bf16_t*)(p.ws + OW_PJA))[(size_t)row * PJW + 3072 + j]);
      float pv;
      if (tok == 0 && t0 == 0) pv = prev0 ? prev0[3072 + j] : 0.f;
      else pv = bf2f(((bf16_t*)(p.ws + OW_PJA))[(size_t)(row - 1) * PJW + 3072 + j]);
      float xs = ps + mu * (pv - ps);
      lwa[tok * 128 + j] = j < 64 ? tanhf(xs) : xs;
      if (slab == 0 && t0 + tok == len - 1) {
        if (prompt) {
          ((float*)(p.ws + OW_CSH))[((size_t)((seg + 1) & 1) * 2 + seq) * 3200 + 3072 + j] = ps;
          if (seg == NSEG - 1) (p.out + OO_p_shift)[(size_t)seq * 3200 + 3072 + j] = ps;
        } else {
          (p.out + OO_s_shift)[(size_t)(seq - 2) * 3200 + 3072 + j] = ps;
        }
      }
    }
  }
  __syncthreads();
  const int c = slab * 256 + tid;
  float dw[8], da[8];
  {
    const float w0 = p.rw_w0[c], a0 = p.rw_a0[c];
#pragma unroll
    for (int t = 0; t < 8; t++) { dw[t] = w0; da[t] = a0; }
  }
  for (int j = 0; j < 64; j += 4) {
    float w2v[4], a2v[4];
#pragma unroll
    for (int e = 0; e < 4; e++) {
      w2v[e] = p.rw_w2[(size_t)(j + e) * DM + c];
      a2v[e] = p.rw_a2[(size_t)(j + e) * DM + c];
    }
#pragma unroll
    for (int t = 0; t < 8; t++) {
      float4 lw = *(const float4*)(lwa + t * 128 + j);
      float4 la = *(const float4*)(lwa + t * 128 + 64 + j);
      dw[t] += lw.x * w2v[0] + lw.y * w2v[1] + lw.z * w2v[2] + lw.w * w2v[3];
      da[t] += la.x * a2v[0] + la.y * a2v[1] + la.z * a2v[2] + la.w * a2v[3];
    }
  }
  const float mur = p.rw_mu[c], muk = p.rw_mu[1024 + c], muv = p.rw_mu[2048 + c];
  const float kk_w = p.rw_k_k[c], ka_w = p.rw_k_a[c], rk_w = p.rw_r_k[c];
  float pr, pk, pv;
  if (t0 == 0) {
    pr = prev0 ? prev0[c] : 0.f; pk = prev0 ? prev0[1024 + c] : 0.f; pv = prev0 ? prev0[2048 + c] : 0.f;
  } else {
    const bf16_t* q = ((bf16_t*)(p.ws + OW_PJA)) + (size_t)(r0 - 1) * PJW;
    pr = bf2f(q[c]); pk = bf2f(q[1024 + c]); pv = bf2f(q[2048 + c]);
  }
  const int head = c >> 6, e = c & 63;
  const int srow0 = slot_row0(seg);
  char* rws = ((char*)(p.ws + OW_RWS)) + ((size_t)(srow0 + r0) * 16 + head) * 1024;
  float* rwb = ((float*)(p.ws + OW_RWB)) + (size_t)(srow0 + r0) * 16 + head;
#pragma unroll
  for (int t = 0; t < 8; t++) {
    const int row = r0 + t;
    const bf16_t* q = ((bf16_t*)(p.ws + OW_PJA)) + (size_t)row * PJW;
    float cr = bf2f(q[c]), ck = bf2f(q[1024 + c]), cv = bf2f(q[2048 + c]);
    float xr = cr + mur * (pr - cr), xk = ck + muk * (pk - ck), xv = cv + muv * (pv - cv);
    pr = cr; pk = ck; pv = cv;
    float w_log = -softplusf_(-dw[t]) - 0.5f;
    float decay = __expf(-__expf(w_log));
    float a = sigmoidf_(da[t]);
    float kkr = xk * kk_w;
    float ss = wavesum(kkr * kkr);
    float kk = kkr * rsqrtf(ss + 1e-6f);
    float k2 = xk * (1.0f + (a - 1.0f) * ka_w);
    float bon = wavesum(xr * k2 * rk_w);
    char* o = rws + (size_t)t * RWS_ROWB;
    ((f16*)o)[e] = (f16)xr;
    ((f16*)(o + 128))[e] = (f16)k2;
    ((f16*)(o + 256))[e] = (f16)(-kk);
    ((f16*)(o + 384))[e] = (f16)(kk * a);
    ((float*)(o + 512))[e] = decay;
    ((float*)(o + 768))[e] = xv;
    if ((tid & 63) == 0) rwb[(size_t)t * 16] = bon;
    if (t0 + t == len - 1) {
      if (prompt) {
        float* cs = ((float*)(p.ws + OW_CSH)) + ((size_t)((seg + 1) & 1) * 2 + seq) * 3200;
        cs[c] = cr; cs[1024 + c] = ck; cs[2048 + c] = cv;
        if (seg == NSEG - 1) {
          float* ps = (p.out + OO_p_shift) + (size_t)seq * 3200;
          ps[c] = cr; ps[1024 + c] = ck; ps[2048 + c] = cv;
        }
      } else {
        float* ps = (p.out + OO_s_shift) + (size_t)(seq - 2) * 3200;
        ps[c] = cr; ps[1024 + c] = ck; ps[2048 + c] = cv;
      }
    }
  }
}

__device__ __forceinline__ void gd_prepass_item(PP pp, int seg, int grp, int slab) {
  LAUNDER_PP;
  const int tid = tid_l();
  const int r0 = grp * 16;
  int seq, t0, len;
  row_seq(seg, r0, seq, t0, len);
  const bool prompt = seq < 2;
  const int c = slab * 512 + 2 * tid;
  const int kind = slab >> 1;
  const int head = (c & 1023) >> 7, e = c & 127;
  float2 x0, x1, x2;
  if (t0 == 0) {
    const float* cp = nullptr;
    if (seg == 0) cp = prompt ? nullptr : p.st_conv + (size_t)(seq - 2) * 3 * 3072;
    else cp = ((float*)(p.ws + OW_CCV)) + ((size_t)(seg & 1) * 2 + seq) * 3 * 3072;
    if (cp) {
      x0 = *(const float2*)(cp + c); x1 = *(const float2*)(cp + 3072 + c); x2 = *(const float2*)(cp + 6144 + c);
    } else {
      x0 = x1 = x2 = make_float2(0.f, 0.f);
    }
  } else {
    uint32_t u0 = *(const uint32_t*)(((bf16_t*)(p.ws + OW_PJA)) + (size_t)(r0 - 3) * PJW + C_GDC + c);
    uint32_t u1 = *(const uint32_t*)(((bf16_t*)(p.ws + OW_PJA)) + (size_t)(r0 - 2) * PJW + C_GDC + c);
    uint32_t u2 = *(const uint32_t*)(((bf16_t*)(p.ws + OW_PJA)) + (size_t)(r0 - 1) * PJW + C_GDC + c);
    x0 = make_float2(bf2f(u0 & 0xffff), bf2f(u0 >> 16));
    x1 = make_float2(bf2f(u1 & 0xffff), bf2f(u1 >> 16));
    x2 = make_float2(bf2f(u2 & 0xffff), bf2f(u2 >> 16));
  }
  const float2 w0 = *(const float2*)(p.gd_conv_w + c), w1 = *(const float2*)(p.gd_conv_w + 3072 + c),
               w2 = *(const float2*)(p.gd_conv_w + 6144 + c), w3 = *(const float2*)(p.gd_conv_w + 9216 + c);
  const float a_exp = __expf(p.gd_a_log[head]);
  const float dtb = p.gd_dt_bias[head];
  char* gds = ((char*)(p.ws + OW_GDS)) + ((size_t)(slot_row0(seg) + r0) * 8 + head) * GDS_HB;
#pragma unroll 4
  for (int t = 0; t < 16; t++) {
    const int row = r0 + t;
    uint32_t u = *(const uint32_t*)(((bf16_t*)(p.ws + OW_PJA)) + (size_t)row * PJW + C_GDC + c);
    float2 x3 = make_float2(bf2f(u & 0xffff), bf2f(u >> 16));
    float cx = w0.x * x0.x + w1.x * x1.x + w2.x * x2.x + w3.x * x3.x;
    float cy = w0.y * x0.y + w1.y * x1.y + w2.y * x2.y + w3.y * x3.y;
    x0 = x1; x1 = x2; x2 = x3;
    float ax = siluf_(cx), ay = siluf_(cy);
    float sc = 1.0f;
    if (kind < 2) {
      float ss = wavesum(ax * ax + ay * ay);
      sc = rsqrtf(ss + 1e-6f);
      if (kind == 0) sc *= 0.08838834764831845f;
    }
    if (kind >= 1) {
      float beta = sigmoidf_(bf2f(((bf16_t*)(p.ws + OW_PJA))[(size_t)row * PJW + C_BETA + head]));
      sc *= sqrtf(beta);
    }
    ax *= sc; ay *= sc;
    char* o = gds + (size_t)t * GDS_ROWB;
    f16x2 hv = {(f16)ax, (f16)ay};
    *(f16x2*)(o + kind * 256 + e * 2) = hv;
    if (kind == 0 && (tid & 63) == 0) {
      float g = -a_exp * softplusf_(bf2f(((bf16_t*)(p.ws + OW_PJA))[(size_t)row * PJW + C_ALPHA + head]) + dtb);
      *(float*)(o + 768) = __expf(g);
    }
    int jj = t0 + t - (len - 3);
    if (jj >= 0) {
      if (prompt) {
        *(float2*)(((float*)(p.ws + OW_CCV)) + (((size_t)((seg + 1) & 1) * 2 + seq) * 3 + jj) * 3072 + c) = x3;
        if (seg == NSEG - 1) *(float2*)((p.out + OO_p_conv) + ((size_t)seq * 3 + jj) * 3072 + c) = x3;
      } else {
        *(float2*)((p.out + OO_s_conv) + ((size_t)(seq - 2) * 3 + jj) * 3072 + c) = x3;
      }
    }
  }
}

struct RwOps { f16x4 r, k, a, b; float4 w; float vv; };
__device__ __forceinline__ RwOps rw_ld(const char* Ls, int q, int v) {
  RwOps o;
  o.r = *(const f16x4*)(Ls + q * 8);
  o.k = *(const f16x4*)(Ls + 128 + q * 8);
  o.a = *(const f16x4*)(Ls + 256 + q * 8);
  o.b = *(const f16x4*)(Ls + 384 + q * 8);
  o.w = *(const float4*)(Ls + 512 + q * 16);
  o.vv = *(const float*)(Ls + 768 + v * 4);
  return o;
}
__device__ __forceinline__ float rw_step(const RwOps& o, float4& S) {
  float sa0 = (float)o.a[0] * S.x;
  float sa1 = (float)o.a[2] * S.z;
  sa0 = fmaf((float)o.a[1], S.y, sa0);
  sa1 = fmaf((float)o.a[3], S.w, sa1);
  float t0 = fmaf(o.vv, (float)o.k[0], S.x * o.w.x);
  float t1 = fmaf(o.vv, (float)o.k[1], S.y * o.w.y);
  float t2 = fmaf(o.vv, (float)o.k[2], S.z * o.w.z);
  float t3 = fmaf(o.vv, (float)o.k[3], S.w * o.w.w);
  const float sa = rowsum16(sa0 + sa1);
  S.x = fmaf(sa, (float)o.b[0], t0);
  S.y = fmaf(sa, (float)o.b[1], t1);
  S.z = fmaf(sa, (float)o.b[2], t2);
  S.w = fmaf(sa, (float)o.b[3], t3);
  float y0 = (float)o.r[0] * S.x;
  float y1 = (float)o.r[2] * S.z;
  y0 = fmaf((float)o.r[1], S.y, y0);
  y1 = fmaf((float)o.r[3], S.w, y1);
  return rowsum16(y0 + y1);
}
__device__ __forceinline__ void rw_scan_run(const char* __restrict__ gsrc  , int len, float4& S,
                            float* __restrict__ yo  , int q, int v, char* smem) {
  const int tid = tid_l();
  const int nch = len >> 4;
  const int lstep = tid >> 6, loff = (tid & 63) * 16;
  u32x4 st[4];
#pragma unroll
  for (int i = 0; i < 4; i++) st[i] = *(const u32x4*)(gsrc + (size_t)(lstep + 4 * i) * RWS_ROWB + loff);
  __syncthreads();
#pragma unroll
  for (int i = 0; i < 4; i++) *(u32x4*)(smem + (lstep + 4 * i) * 1024 + loff) = st[i];
  u32x4 st2[4];
#pragma unroll
  for (int i = 0; i < 4; i++) st2[i] = st[i];
  if (nch > 1) {
#pragma unroll
    for (int i = 0; i < 4; i++) st[i] = *(const u32x4*)(gsrc + (size_t)(16 + lstep + 4 * i) * RWS_ROWB + loff);
  }
  if (nch > 2) {
#pragma unroll
    for (int i = 0; i < 4; i++) st2[i] = *(const u32x4*)(gsrc + (size_t)(32 + lstep + 4 * i) * RWS_ROWB + loff);
  }
  __syncthreads();
  for (int c = 0; c < nch; c++) {
    const char* L = smem + (c & 1) * 16384;
    float ykeep = 0.f;
    RwOps oa = rw_ld(L, q, v);
#pragma unroll 1
    for (int t = 0; t < 16; t += 2) {
      const RwOps ob = rw_ld(L + (t + 1) * 1024, q, v);
      asm volatile("" ::: "memory");
      const float ya = rw_step(oa, S);
      ykeep = (q == t) ? ya : ykeep;
      oa = rw_ld(L + ((t + 2) & 15) * 1024, q, v);
      asm volatile("" ::: "memory");
      const float yb = rw_step(ob, S);
      ykeep = (q == t + 1) ? yb : ykeep;
    }
    yo[(size_t)(c * 16 + q) * DM] = ykeep;
    if (c + 1 < nch) {
      char* Ln = smem + ((c + 1) & 1) * 16384;
#pragma unroll
      for (int i = 0; i < 4; i++) *(u32x4*)(Ln + (lstep + 4 * i) * 1024 + loff) = st[i];
#pragma unroll
      for (int i = 0; i < 4; i++) st[i] = st2[i];
      if (c + 3 < nch) {
#pragma unroll
        for (int i = 0; i < 4; i++)
          st2[i] = *(const u32x4*)(gsrc + (size_t)((c + 3) * 16 + lstep + 4 * i) * RWS_ROWB + loff);
      }
    }
    lds_barrier();
  }
}

struct GdOps { f16x8 qv, kv; float vv, eg; };
__device__ __forceinline__ GdOps gd_ld(const char* Ls, int q, int cl) {
  GdOps o;
  o.kv = *(const f16x8*)(Ls + 256 + q * 16);
  o.vv = (float)*(const f16*)(Ls + 512 + cl * 2);
  o.eg = *(const float*)(Ls + 768);
  o.qv = *(const f16x8*)(Ls + q * 16);
  return o;
}
typedef float f32x2 __attribute__((ext_vector_type(2)));
__device__ __forceinline__ float gd_step(const GdOps& o, float (&s)[8]) {
  f32x2 s2[4], k2[4], q2[4];
#pragma unroll
  for (int j = 0; j < 4; j++) {
    s2[j] = (f32x2){s[2 * j], s[2 * j + 1]};
    k2[j] = (f32x2){(float)o.kv[2 * j], (float)o.kv[2 * j + 1]};
  }
  f32x2 acc = k2[0] * s2[0];
  acc = k2[1] * s2[1] + acc;
  acc = k2[2] * s2[2] + acc;
  acc = k2[3] * s2[3] + acc;
  const f32x2 eg2 = (f32x2){o.eg, o.eg};
  f32x2 es[4];
#pragma unroll
  for (int j = 0; j < 4; j++) es[j] = s2[j] * eg2;
  const float ks = rowsum16(acc[0] + acc[1]);
  const float d = fmaf(-o.eg, ks, o.vv);
  const f32x2 d2 = (f32x2){d, d};
#pragma unroll
  for (int j = 0; j < 4; j++) s2[j] = k2[j] * d2 + es[j];
#pragma unroll
  for (int j = 0; j < 4; j++) q2[j] = (f32x2){(float)o.qv[2 * j], (float)o.qv[2 * j + 1]};
  f32x2 oacc = q2[0] * s2[0];
  oacc = q2[1] * s2[1] + oacc;
  oacc = q2[2] * s2[2] + oacc;
  oacc = q2[3] * s2[3] + oacc;
#pragma unroll
  for (int j = 0; j < 4; j++) { s[2 * j] = s2[j][0]; s[2 * j + 1] = s2[j][1]; }
  return rowsum16(oacc[0] + oacc[1]);
}
__device__ __forceinline__ void gd_scan_run(const char* __restrict__ gsrc  , int len, float (&s)[8],
                            float* __restrict__ oo  , int q, int cl, char* smem) {
  const int tid = tid_l();
  const int nch = len >> 4;
  u32x4 st[4];
  int lt[4], lo[4];
#pragma unroll
  for (int i = 0; i < 4; i++) {
    int id = tid + 256 * i;
    if (id > 783) id = 783;
    lt[i] = id / 49;
    lo[i] = (id % 49) * 16;
  }
#pragma unroll
  for (int i = 0; i < 4; i++) st[i] = *(const u32x4*)(gsrc + (size_t)lt[i] * GDS_ROWB + lo[i]);
  __syncthreads();
#pragma unroll
  for (int i = 0; i < 4; i++) *(u32x4*)(smem + lt[i] * GDS_HB + lo[i]) = st[i];
  u32x4 st2[4];
#pragma unroll
  for (int i = 0; i < 4; i++) st2[i] = st[i];
  if (nch > 1) {
#pragma unroll
    for (int i = 0; i < 4; i++) st[i] = *(const u32x4*)(gsrc + (size_t)(16 + lt[i]) * GDS_ROWB + lo[i]);
  }
  if (nch > 2) {
#pragma unroll
    for (int i = 0; i < 4; i++) st2[i] = *(const u32x4*)(gsrc + (size_t)(32 + lt[i]) * GDS_ROWB + lo[i]);
  }
  __syncthreads();
  for (int c = 0; c < nch; c++) {
    const char* L = smem + (c & 1) * 16384;
    float okeep = 0.f;
    GdOps oa = gd_ld(L, q, cl);
#pragma unroll 1
    for (int t = 0; t < 16; t += 2) {
      const GdOps ob = gd_ld(L + (t + 1) * GDS_HB, q, cl);
      asm volatile("" ::: "memory");
      const float ya = gd_step(oa, s);
      okeep = (q == t) ? ya : okeep;
      oa = gd_ld(L + ((t + 2) & 15) * GDS_HB, q, cl);
      asm volatile("" ::: "memory");
      const float yb = gd_step(ob, s);
      okeep = (q == t + 1) ? yb : okeep;
    }
    oo[(size_t)(c * 16 + q) * DM] = okeep;
    if (c + 1 < nch) {
      char* Ln = smem + ((c + 1) & 1) * 16384;
#pragma unroll
      for (int i = 0; i < 4; i++) *(u32x4*)(Ln + lt[i] * GDS_HB + lo[i]) = st[i];
#pragma unroll
      for (int i = 0; i < 4; i++) st[i] = st2[i];
      if (c + 3 < nch) {
#pragma unroll
        for (int i = 0; i < 4; i++) st2[i] = *(const u32x4*)(gsrc + (size_t)((c + 3) * 16 + lt[i]) * GDS_ROWB + lo[i]);
      }
    }
    lds_barrier();
  }
}

__device__ __forceinline__ void sample_scan_task(PP pp, int task, char* smem) {
  LAUNDER_PP;
  const int sj = task >> 7, j = task & 127, kind = j >> 6, jj = j & 63;
  const int tid = tid_l(), q = tid & 15;
  const int row0 = 1056 + sj * 16;
  if (kind == 0) {
    const int head = jj >> 2, v = (jj & 3) * 16 + (tid >> 4);
    const float* sin = p.st_wkv + ((size_t)sj * 16 + head) * 4096;
    float* sout = (p.out + OO_s_wkv) + ((size_t)sj * 16 + head) * 4096;
    float4 S = *(const float4*)(sin + v * 64 + 4 * q);
    rw_scan_run(((char*)(p.ws + OW_RWS)) + ((size_t)row0 * 16 + head) * 1024, 16, S, ((float*)(p.ws + OW_YRW)) + (size_t)row0 * DM + head * 64 + v, q, v, smem);
    *(float4*)(sout + v * 64 + 4 * q) = S;
  } else {
    const int head = jj >> 3, cl = (jj & 7) * 16 + (tid >> 4);
    const float* sin = p.st_ssm + ((size_t)sj * 8 + head) * 16384;
    float* sout = (p.out + OO_s_ssm) + ((size_t)sj * 8 + head) * 16384;
    float s[8];
#pragma unroll
    for (int i = 0; i < 8; i++) s[i] = sin[(size_t)(8 * q + i) * 128 + cl];
    gd_scan_run(((char*)(p.ws + OW_GDS)) + ((size_t)row0 * 8 + head) * GDS_HB, 16, s, ((float*)(p.ws + OW_OGD)) + (size_t)row0 * DM + head * 128 + cl, q, cl, smem);
#pragma unroll
    for (int i = 0; i < 8; i++) sout[(size_t)(8 * q + i) * 128 + cl] = s[i];
  }
}

__device__ __forceinline__ void scan_block_rw(PP pp, int j, char* smem) {
  LAUNDER_PP;
  const int seq = j >> 6, jj = j & 63;
  const int tid = tid_l(), q = tid & 15;
  const int head = jj >> 2, v = (jj & 3) * 16 + (tid >> 4);
  float4 S = make_float4(0.f, 0.f, 0.f, 0.f);
  for (int seg = 0; seg < NSEG; seg++) {
    wait_ge(((unsigned int*)(p.ws + OW_sync)) + SW_PRE, seg + 1);
    const int len = seg == 0 ? 528 : TS;
    const int row0 = slot_row0(seg) + (seg == 0 ? seq * 528 : seq * TS);
    rw_scan_run(((char*)(p.ws + OW_RWS)) + ((size_t)row0 * 16 + head) * 1024, len, S,
                ((float*)(p.ws + OW_YRW)) + (size_t)row0 * DM + head * 64 + v, q, v, smem);
    signal_add(((unsigned int*)(p.ws + OW_sync)) + SW_SCAN(seg));
  }
  {
    const int tid2 = tid_l(), q2 = tid2 & 15, v2 = (jj & 3) * 16 + (tid2 >> 4);
    *(float4*)((p.out + OO_p_wkv) + ((size_t)seq * 16 + head) * 4096 + v2 * 64 + 4 * q2) = S;
  }
}
__device__ __forceinline__ void scan_block_gd(PP pp, int j, char* smem) {
  LAUNDER_PP;
  const int seq = j >> 6, jj = j & 63;
  const int tid = tid_l(), q = tid & 15;
  const int head = jj >> 3, cl = (jj & 7) * 16 + (tid >> 4);
  float s[8];
#pragma unroll
  for (int i = 0; i < 8; i++) s[i] = 0.f;
  for (int seg = 0; seg < NSEG; seg++) {
    wait_ge(((unsigned int*)(p.ws + OW_sync)) + SW_PRE, seg + 1);
    const int len = seg == 0 ? 528 : TS;
    const int row0 = slot_row0(seg) + (seg == 0 ? seq * 528 : seq * TS);
    gd_scan_run(((char*)(p.ws + OW_GDS)) + ((size_t)row0 * 8 + head) * GDS_HB, len, s,
                ((float*)(p.ws + OW_OGD)) + (size_t)row0 * DM + head * 128 + cl, q, cl, smem);
    signal_add(((unsigned int*)(p.ws + OW_sync)) + SW_SCAN(seg));
  }
  {
    const int tid2 = tid_l(), q2 = tid2 & 15, cl2 = (jj & 7) * 16 + (tid2 >> 4);
    float* sout = (p.out + OO_p_ssm) + ((size_t)seq * 8 + head) * 16384;
#pragma unroll
    for (int i = 0; i < 8; i++) sout[(size_t)(8 * q2 + i) * 128 + cl2] = s[i];
  }
}

__device__ __forceinline__ void post_item(PP pp, int seg, int row) {
  LAUNDER_PP;
  const int tid = tid_l(), c4 = tid * 4;
  const int srow = slot_row0(seg) + row;
  const bf16_t* gt = ((bf16_t*)(p.ws + OW_GT)) + (size_t)(gt_row0(seg) + row) * GTW;
  {
    float4 y = *(const float4*)(((float*)(p.ws + OW_YRW)) + (size_t)srow * DM + c4);
    float mean = rowsum16(y.x + y.y + y.z + y.w) * (1.0f / 64.0f);
    float dx = y.x - mean, dy = y.y - mean, dz = y.z - mean, dw = y.w - mean;
    float var = rowsum16(dx * dx + dy * dy + dz * dz + dw * dw) * (1.0f / 64.0f);
    float rs = rsqrtf(var + 64e-5f);
    float4 lw = *(const float4*)(p.rw_ln_w + c4), lb = *(const float4*)(p.rw_ln_b + c4);
    float bon = ((float*)(p.ws + OW_RWB))[(size_t)srow * 16 + (tid >> 4)];
    float4 v = *(const float4*)(((char*)(p.ws + OW_RWS)) + ((size_t)srow * 16 + (tid >> 4)) * 1024 + 768 + (tid & 15) * 16);
    uint2 g = *(const uint2*)(gt + G_RW + c4);
    float o0 = (dx * rs * lw.x + lb.x + bon * v.x) * siluf_(bf2f(g.x & 0xffff));
    float o1 = (dy * rs * lw.y + lb.y + bon * v.y) * siluf_(bf2f(g.x >> 16));
    float o2 = (dz * rs * lw.z + lb.z + bon * v.z) * siluf_(bf2f(g.y & 0xffff));
    float o3 = (dw * rs * lw.w + lb.w + bon * v.w) * siluf_(bf2f(g.y >> 16));
    *(uint2*)(((bf16_t*)(p.ws + OW_YA)) + ((size_t)(seg & 1) * MP0 + row) * DM + c4) = make_uint2(pack2(o0, o1), pack2(o2, o3));
  }
  {
    float4 o = *(const float4*)(((float*)(p.ws + OW_OGD)) + (size_t)srow * DM + c4);
    float ss = rowsum16(o.x * o.x + o.y * o.y + o.z * o.z + o.w * o.w);
    ss += __shfl_xor(ss, 16);
    float rs = rsqrtf(ss * (1.0f / 128.0f) + 1e-6f);
    float4 nw = *(const float4*)(p.gd_norm_w + (c4 & 127));
    uint2 g = *(const uint2*)(gt + G_GD + c4);
    float o0 = o.x * rs * nw.x * siluf_(bf2f(g.x & 0xffff));
    float o1 = o.y * rs * nw.y * siluf_(bf2f(g.x >> 16));
    float o2 = o.z * rs * nw.z * siluf_(bf2f(g.y & 0xffff));
    float o3 = o.w * rs * nw.w * siluf_(bf2f(g.y >> 16));
    *(uint2*)(((bf16_t*)(p.ws + OW_YB)) + ((size_t)(seg & 1) * MP0 + row) * DM + c4) = make_uint2(pack2(o0, o1), pack2(o2, o3));
  }
}

#define SMEM_BYTES (32768 + 16)

__global__ void __launch_bounds__(256, 4) k_mega(Params p_arg) {
  PP pp = (PP)__builtin_amdgcn_kernarg_segment_ptr();
  __shared__ __attribute__((aligned(16))) char smem[SMEM_BYTES];
  cg::grid_group grid = cg::this_grid();
  const int bid = blockIdx.x, nb = gridDim.x;
  unsigned* sync = (unsigned*)(p.ws + OW_sync);
  const unsigned xcc = xcc_id() & 7u;
  if (bid >= NSCAN && threadIdx.x == 0) xb_add(&sync[SW_XCNT(xcc)], 1u);
  phase_weights(pp, bid, nb, smem);
  for (int it = bid; it < seg_MP(0) / 4; it += nb) xn_item(pp, 0, it);
  grid.sync();
  if (bid < NSCAN) {
    __builtin_amdgcn_s_setprio(3);
    if (bid < 128) scan_block_rw(pp, bid, smem);
    else scan_block_gd(pp, bid - 128, smem);
    return;
  }
  const int w = bid - NSCAN, NW = nb - NSCAN;
  unsigned* cfg = (unsigned*)(smem + 32768);
  if (threadIdx.x == 0) {
    unsigned mine = 0, nx = 0;
#pragma unroll
    for (unsigned j = 0; j < 8; j++) { unsigned c = xb_ld(&sync[SW_XCNT(j)]); nx += c > 0u ? 1u : 0u; mine = (j == xcc) ? c : mine; }
    cfg[0] = mine > 0u ? mine : 1u;
    cfg[1] = nx > 0u ? nx : 1u;
  }
  __syncthreads();
  for (int i = 0; i < NSEG + 5; i++) {
    const int sm = i - 4, snn = i - 5, sj = i - 3, so = i - 4, sp = i - 2;
    const bool front = i < NSEG;
    const bool mrg = sm >= 0 && sm < NSEG, nrm = snn >= 0 && snn < NSEG, back = sj >= 0 && sj < NSEG, outv = so >= 0 && so < NSEG,
               pst = sp >= 0 && sp < NSEG;
    {
      const int tmF = front ? seg_MP(i) / 128 : 1;
      const int nF = front ? tmF * (VW / 128) : 0;
      const int nM = mrg ? seg_MP(sm) / 4 : 0;
      const int nN = nrm ? seg_M(snn) / 4 : 0;
      for (int it = w; it < nF + nM + nN; it += NW) {
        int t = it;
        if (t < nF) { gemm_tile<0>(pp, i, t % tmF, t / tmF, smem); continue; }
        t -= nF;
        if (t < nM) { merge_item(pp, t); continue; }
        t -= nM;
        norm_item(pp, snn, t);
      }
      if (i == 1) {
        for (int it = w; it < 32 * 128; it += NW) sample_scan_task(pp, it, smem);
      }
    }
    worker_barrier((unsigned*)(p.ws + OW_sync), (const unsigned*)(smem + 32768));
    {
      const int nB = back ? (seg_MP(sj) / 128) * 8 : 0;
      const int nO = outv ? (seg_MP(so) / 128) * 8 : 0;
      const int nHeavy = 2 * nB + nO;
      const int nHeavyW = nHeavy < NW / 2 ? nHeavy : NW / 2;
      const int NL = NW - nHeavyW;
      const int ngrp = front ? seg_M(i) / 16 : 0;
      const int nRW = ngrp * 8, nGD = ngrp * 6;
      const int nX = (i + 1 < NSEG) ? seg_MP(i + 1) / 4 : 0;
      const int tot = nRW + nGD + nX;
      if (w >= NL) {
        for (int it = w - NL; it < nHeavy; it += nHeavyW) {
          int t = it;
          if (t < nB) { gemm_tile<1>(pp, sj, t >> 3, t & 7, smem); continue; }
          t -= nB;
          if (t < nB) { gemm_tile<3>(pp, sj, t >> 3, t & 7, smem); continue; }
          t -= nB;
          gemm_tile<2>(pp, so, t >> 3, t & 7, smem);
        }
      } else {
        for (int it = w; it < tot; it += NL) {
          int t = it;
          if (t < nRW) { rw_prepass_item(pp, i, t >> 2, t & 3, smem); continue; }
          t -= nRW;
          if (t < nGD) { gd_prepass_item(pp, i, t / 6, t % 6); continue; }
          t -= nGD;
          xn_item(pp, i + 1, t);
        }
      }
      if (pst) {
        wait_ge((unsigned*)(p.ws + OW_sync) + SW_SCAN(sp), NSCAN);
        const int n = seg_M(sp);
        for (int it = w; it < n; it += NW) post_item(pp, sp, it);
      }
    }
    worker_barrier((unsigned*)(p.ws + OW_sync), (const unsigned*)(smem + 32768));
    if (front && w == 0 && threadIdx.x == 0)
      __hip_atomic_store((unsigned*)(p.ws + OW_sync) + SW_PRE, (unsigned)(i + 1), __ATOMIC_RELAXED, __HIP_MEMORY_SCOPE_AGENT);
  }
}

static inline size_t align_up(size_t x) { return (x + 255) & ~(size_t)255; }

#undef p
extern "C" void kernel_launch(void* const* d_in, const int* in_sizes, int n_in, void* d_out, int out_size, void* d_ws,
                              size_t ws_size, hipStream_t stream) {
  Params p{};
  const float* const* in = (const float* const*)d_in;
  p.x_prompt = in[0]; p.x_sample = in[1]; p.st_shift = in[2]; p.st_wkv = in[3]; p.st_conv = in[4]; p.st_ssm = in[5];
  p.meta = in[6]; p.norm_pre = in[7]; p.w_in = in[8]; p.rw_mu = in[9]; p.rw_w0 = in[10]; p.rw_w2 = in[11];
  p.rw_a0 = in[12]; p.rw_a2 = in[13]; p.rw_k_k = in[14]; p.rw_k_a = in[15]; p.rw_r_k = in[16]; p.rw_ln_w = in[17];
  p.rw_ln_b = in[18]; p.gd_conv_w = in[19]; p.gd_a_log = in[20]; p.gd_dt_bias = in[21]; p.gd_norm_w = in[22];
  p.w_out_a = in[23]; p.w_out_b = in[24]; p.w_out = in[25]; p.norm_post = in[26];
  p.out = (float*)d_out;
  p.ws = (char*)d_ws;
  if (OW_END > ws_size) { fprintf(stderr, "workspace too small: need %zu have %zu\n", (size_t)OW_END, ws_size); return; }

  static int grid_blocks = 0;
  if (!grid_blocks) {
    int dev = 0, cus = 0, per_cu = 0;
    (void)hipGetDevice(&dev);
    (void)hipDeviceGetAttribute(&cus, hipDeviceAttributeMultiprocessorCount, dev);
    (void)hipOccupancyMaxActiveBlocksPerMultiprocessor(&per_cu, k_mega, 256, 0);
    if (per_cu > 4) per_cu = 4;
    grid_blocks = cus * per_cu;
  }
  (void)hipMemsetAsync(p.ws + OW_sync, 0, 16384, stream);
  void* args[] = {&p};
  hipError_t e = hipLaunchCooperativeKernel((void*)k_mega, dim3(grid_blocks), dim3(256), args, 0, stream);
  if (e != hipSuccess) fprintf(stderr, "cooperative launch failed: %s (grid %d)\n", hipGetErrorString(e), grid_blocks);
}
```

```cpp
#include <hip/hip_runtime.h>
#include <hip/hip_cooperative_groups.h>
#include <stdint.h>
#include <stdio.h>
namespace cg = cooperative_groups;

typedef unsigned short bf16_t;
typedef _Float16 f16;
using bf16x8 = __attribute__((ext_vector_type(8))) short;
using f32x4 = __attribute__((ext_vector_type(4))) float;
using u32x4 = __attribute__((ext_vector_type(4))) unsigned int;
using f32x16 = __attribute__((ext_vector_type(16))) float;
using f16x2 = __attribute__((ext_vector_type(2))) _Float16;
using f16x4 = __attribute__((ext_vector_type(4))) _Float16;
using f16x8 = __attribute__((ext_vector_type(8))) _Float16;

#define DM 1024
#define PW 10384
#define VW 10496
#define PJW 6400
#define GTW 4096
#define NSEG 16
#define TS 512
#define M0 1568
#define MP0 1664
#define M1 1024
#define SLOT_ROWS 3712
#define GT_ROWS 4736
#define NSCAN 256
#define C_GDC 3200
#define C_BETA 6272
#define C_ALPHA 6280
#define G_RW 0
#define G_GD 1024
#define G_MA 2048
#define G_MB 3072
#define RWS_ROWB 16384
#define GDS_HB 784
#define GDS_ROWB 6272

struct Params {
  const float *x_prompt, *x_sample, *st_shift, *st_wkv, *st_conv, *st_ssm, *meta, *norm_pre, *w_in, *rw_mu, *rw_w0,
      *rw_w2, *rw_a0, *rw_a2, *rw_k_k, *rw_k_a, *rw_r_k, *rw_ln_w, *rw_ln_b, *gd_conv_w, *gd_a_log, *gd_dt_bias,
      *gd_norm_w, *w_out_a, *w_out_b, *w_out, *norm_post;
  float* out;
  char* ws;
};
#define p (PV(pp))
#define GLOBAL_AS __attribute__((address_space(1)))
#define CONST_AS __attribute__((address_space(4)))
struct ParamsG {
  const GLOBAL_AS float *x_prompt, *x_sample, *st_shift, *st_wkv, *st_conv, *st_ssm, *meta, *norm_pre, *w_in, *rw_mu, *rw_w0,
      *rw_w2, *rw_a0, *rw_a2, *rw_k_k, *rw_k_a, *rw_r_k, *rw_ln_w, *rw_ln_b, *gd_conv_w, *gd_a_log, *gd_dt_bias,
      *gd_norm_w, *w_out_a, *w_out_b, *w_out, *norm_post;
  GLOBAL_AS float* out;
  GLOBAL_AS char* ws;
};
typedef const CONST_AS ParamsG* PP;
__device__ __forceinline__ Params PV(PP pp) {
  Params v;
  v.x_prompt = (const float*)pp->x_prompt;
  v.x_sample = (const float*)pp->x_sample;
  v.st_shift = (const float*)pp->st_shift;
  v.st_wkv = (const float*)pp->st_wkv;
  v.st_conv = (const float*)pp->st_conv;
  v.st_ssm = (const float*)pp->st_ssm;
  v.meta = (const float*)pp->meta;
  v.norm_pre = (const float*)pp->norm_pre;
  v.w_in = (const float*)pp->w_in;
  v.rw_mu = (const float*)pp->rw_mu;
  v.rw_w0 = (const float*)pp->rw_w0;
  v.rw_w2 = (const float*)pp->rw_w2;
  v.rw_a0 = (const float*)pp->rw_a0;
  v.rw_a2 = (const float*)pp->rw_a2;
  v.rw_k_k = (const float*)pp->rw_k_k;
  v.rw_k_a = (const float*)pp->rw_k_a;
  v.rw_r_k = (const float*)pp->rw_r_k;
  v.rw_ln_w = (const float*)pp->rw_ln_w;
  v.rw_ln_b = (const float*)pp->rw_ln_b;
  v.gd_conv_w = (const float*)pp->gd_conv_w;
  v.gd_a_log = (const float*)pp->gd_a_log;
  v.gd_dt_bias = (const float*)pp->gd_dt_bias;
  v.gd_norm_w = (const float*)pp->gd_norm_w;
  v.w_out_a = (const float*)pp->w_out_a;
  v.w_out_b = (const float*)pp->w_out_b;
  v.w_out = (const float*)pp->w_out;
  v.norm_post = (const float*)pp->norm_post;
  v.out = (float*)pp->out;
  v.ws = (char*)pp->ws;
  return v;
}
constexpr size_t al256(size_t x) { return (x + 255) & ~(size_t)255; }
constexpr size_t OO_y_prompt = 0;
constexpr size_t OO_y_sample = OO_y_prompt + (size_t)2 * 8192 * 1024;
constexpr size_t OO_p_shift = OO_y_sample + (size_t)32 * 16 * 1024;
constexpr size_t OO_p_wkv = OO_p_shift + 2 * 3200;
constexpr size_t OO_p_conv = OO_p_wkv + 2 * 16 * 4096;
constexpr size_t OO_p_ssm = OO_p_conv + 2 * 3 * 3072;
constexpr size_t OO_s_shift = OO_p_ssm + 2 * 8 * 16384;
constexpr size_t OO_s_wkv = OO_s_shift + 32 * 3200;
constexpr size_t OO_s_conv = OO_s_wkv + 32 * 16 * 4096;
constexpr size_t OO_s_ssm = OO_s_conv + 32 * 3 * 3072;
constexpr size_t OW_sync = 0;
constexpr size_t OW_WtIn = OW_sync + 16384;
constexpr size_t OW_WtA = OW_WtIn + al256((size_t)VW * DM * 2);
constexpr size_t OW_WtB = OW_WtA + al256((size_t)DM * DM * 2);
constexpr size_t OW_WtO = OW_WtB + al256((size_t)DM * DM * 2);
constexpr size_t OW_XN = OW_WtO + al256((size_t)DM * DM * 2);
constexpr size_t OW_PJA = OW_XN + al256((size_t)MP0 * DM * 2);
constexpr size_t OW_YA = OW_PJA + al256((size_t)MP0 * PJW * 2);
constexpr size_t OW_YB = OW_YA + al256((size_t)2 * MP0 * DM * 2);
constexpr size_t OW_MG = OW_YB + al256((size_t)2 * MP0 * DM * 2);
constexpr size_t OW_OUTB = OW_MG + al256((size_t)MP0 * DM * 2);
constexpr size_t OW_TMP = OW_OUTB + al256((size_t)2 * MP0 * DM * 4);
constexpr size_t OW_GT = OW_TMP + al256((size_t)2 * MP0 * DM * 4);
constexpr size_t OW_RWS = OW_GT + al256((size_t)GT_ROWS * GTW * 2);
constexpr size_t OW_GDS = OW_RWS + al256((size_t)SLOT_ROWS * RWS_ROWB);
constexpr size_t OW_RWB = OW_GDS + al256((size_t)SLOT_ROWS * GDS_ROWB + 256);
constexpr size_t OW_YRW = OW_RWB + al256((size_t)SLOT_ROWS * 16 * 4);
constexpr size_t OW_OGD = OW_YRW + al256((size_t)SLOT_ROWS * DM * 4);
constexpr size_t OW_CSH = OW_OGD + al256((size_t)SLOT_ROWS * DM * 4);
constexpr size_t OW_CCV = OW_CSH + al256((size_t)2 * 2 * 3200 * 4);
constexpr size_t OW_END = OW_CCV + al256((size_t)2 * 2 * 3 * 3072 * 4);


__device__ __forceinline__ bf16_t f2bf(float f) {
  uint32_t u = __float_as_uint(f);
  u += 0x7fffu + ((u >> 16) & 1u);
  return (bf16_t)(u >> 16);
}
__device__ __forceinline__ float bf2f(bf16_t h) { return __uint_as_float(((uint32_t)h) << 16); }
__device__ __forceinline__ uint32_t pack2(float a, float b) { return (uint32_t)f2bf(a) | ((uint32_t)f2bf(b) << 16); }
__device__ __forceinline__ float sigmoidf_(float x) { return 1.0f / (1.0f + __expf(-x)); }
__device__ __forceinline__ float siluf_(float x) { return x / (1.0f + __expf(-x)); }
__device__ __forceinline__ float softplusf_(float x) { return fmaxf(x, 0.0f) + log1pf(__expf(-fabsf(x))); }

__device__ __forceinline__ int tid_l() { int t = threadIdx.x; asm volatile("" : "+v"(t)); return t; }
#define LAUNDER_PP asm volatile("" : "+s"(pp))
template <int CTRL>
__device__ __forceinline__ float dppf(float x) {
  return __builtin_bit_cast(float, __builtin_amdgcn_update_dpp(0, __builtin_bit_cast(int, x), CTRL, 0xf, 0xf, true));
}
__device__ __forceinline__ float rowsum16(float x) {
  x += dppf<0xB1>(x);
  x += dppf<0x4E>(x);
  x += dppf<0x141>(x);
  x += dppf<0x140>(x);
  return x;
}
__device__ __forceinline__ float wavesum(float x) {
  x = rowsum16(x);
  x += __shfl_xor(x, 16);
  x += __shfl_xor(x, 32);
  return x;
}

#define SW_XCNT(j) (64 * (1 + (j)))
#define SW_XSUB(j) (64 * (9 + (j)))
#define SW_XGEN(j) (64 * (17 + (j)))
#define SW_TOP (64 * 25)
#define SW_TOPGEN (64 * 26)
#define SW_PRE (64 * 27)
#define SW_SCAN(s) (64 * (28 + (s)))
#define SYNC_BYTES 16384
__device__ __forceinline__ unsigned xb_ld(const unsigned* ptr) {
  return __hip_atomic_load(ptr, __ATOMIC_RELAXED, __HIP_MEMORY_SCOPE_AGENT);
}
__device__ __forceinline__ unsigned xb_add(unsigned* ptr, unsigned v) {
  return __hip_atomic_fetch_add(ptr, v, __ATOMIC_RELAXED, __HIP_MEMORY_SCOPE_AGENT);
}
__device__ __forceinline__ unsigned xcc_id() { return (unsigned)__builtin_amdgcn_s_getreg((3 << 11) | 20) & 0xFu; }
__device__ __forceinline__ void wait_ge(const unsigned* ptr, unsigned target) {
  if (threadIdx.x == 0) {
    while (xb_ld(ptr) < target) __builtin_amdgcn_s_sleep(8);
    __builtin_amdgcn_fence(__ATOMIC_ACQUIRE, "agent");
    asm volatile("s_waitcnt vmcnt(0)" ::: "memory");
  }
  __syncthreads();
}
__device__ __forceinline__ void signal_add(unsigned* ptr) {
  asm volatile("s_waitcnt vmcnt(0)" ::: "memory");
  __syncthreads();
  if (threadIdx.x == 0) {
    __builtin_amdgcn_fence(__ATOMIC_RELEASE, "agent");
    asm volatile("s_waitcnt vmcnt(0)" ::: "memory");
    xb_add(ptr, 1u);
  }
}
__device__ __forceinline__ void worker_barrier(unsigned* bar, const unsigned* lds_cfg) {
  asm volatile("s_waitcnt vmcnt(0)" ::: "memory");
  __syncthreads();
  if (threadIdx.x == 0) {
    const unsigned x = xcc_id() & 7u, nloc = lds_cfg[0], nx = lds_cfg[1];
    const unsigned old = xb_add(&bar[SW_XSUB(x)], 1u);
    const unsigned gen = old / nloc;
    if (old + 1u == (gen + 1u) * nloc) {
      __builtin_amdgcn_fence(__ATOMIC_RELEASE, "agent");
      asm volatile("s_waitcnt vmcnt(0)" ::: "memory");
      const unsigned og = xb_add(&bar[SW_TOP], 1u);
      const unsigned tg = og / nx;
      if (og + 1u == (tg + 1u) * nx) xb_add(&bar[SW_TOPGEN], 1u);
      else while (xb_ld(&bar[SW_TOPGEN]) == tg) __builtin_amdgcn_s_sleep(1);
      __builtin_amdgcn_fence(__ATOMIC_ACQUIRE, "agent");
      xb_add(&bar[SW_XGEN(x)], 1u);
      asm volatile("s_waitcnt vmcnt(0)" ::: "memory");
    } else {
      while (xb_ld(&bar[SW_XGEN(x)]) == gen) __builtin_amdgcn_s_sleep(1);
      __builtin_amdgcn_fence(__ATOMIC_ACQUIRE, "agent");
      asm volatile("s_waitcnt vmcnt(0)" ::: "memory");
    }
  }
  __syncthreads();
}

__device__ __forceinline__ void lds_barrier() {
  asm volatile("s_waitcnt lgkmcnt(0)" ::: "memory");
  __builtin_amdgcn_s_barrier();
  asm volatile("" ::: "memory");
}

__device__ __forceinline__ int seg_M(int seg) { return seg == 0 ? M0 : M1; }
__device__ __forceinline__ int seg_MP(int seg) { return seg == 0 ? MP0 : M1; }
__device__ __forceinline__ int slot_row0(int seg) { int s = seg % 3; return s == 0 ? 0 : MP0 + (s - 1) * M1; }
__device__ __forceinline__ int gt_row0(int seg) { int s = seg & 3; return s == 0 ? 0 : MP0 + (s - 1) * M1; }
__device__ __forceinline__ const float* row_src(PP pp, int seg, int r) {
  if (seg == 0) {
    if (r < 1056) {
      int b = r >= 528 ? 1 : 0, t = r - b * 528;
      if (t < 16) return p.meta + t * DM;
      return p.x_prompt + ((size_t)b * 8192 + (t - 16)) * DM;
    }
    return p.x_sample + (size_t)(r - 1056) * DM;
  }
  int b = r >> 9, t = r & 511;
  return p.x_prompt + ((size_t)b * 8192 + seg * TS + t) * DM;
}
__device__ __forceinline__ float* row_dst(PP pp, int seg, int r) {
  if (seg == 0) {
    if (r < 1056) {
      int b = r >= 528 ? 1 : 0, t = r - b * 528;
      if (t < 16) return nullptr;
      return (p.out + OO_y_prompt) + ((size_t)b * 8192 + (t - 16)) * DM;
    }
    return (p.out + OO_y_sample) + (size_t)(r - 1056) * DM;
  }
  int b = r >> 9, t = r & 511;
  return (p.out + OO_y_prompt) + ((size_t)b * 8192 + seg * TS + t) * DM;
}
__device__ __forceinline__ void row_seq(int seg, int r, int& seq, int& t, int& len) {
  if (seg == 0) {
    if (r < 528) { seq = 0; t = r; len = 528; }
    else if (r < 1056) { seq = 1; t = r - 528; len = 528; }
    else { seq = 2 + ((r - 1056) >> 4); t = (r - 1056) & 15; len = 16; }
  } else { seq = r >> 9; t = r & 511; len = TS; }
}

__device__ __forceinline__ int vcol_src(int n) {
  if (n < 3200) return n;
  if (n < 6288) return n + 1024;
  if (n < 6400) return -1;
  if (n < 7424) return n - 3200;
  return n - 112;
}
__device__ __forceinline__ void transpose_tile(const float* __restrict__ src, int ld, bool remap, bf16_t* __restrict__ dst, int k0, int n0,
                               float* tile  ) {
  int tid = tid_l();
  int i = tid >> 4, j = tid & 15;
  __syncthreads();
  int n = n0 + 4 * j;
  int sc = remap ? vcol_src(n) : n;
#pragma unroll
  for (int pass = 0; pass < 4; pass++) {
    int k = pass * 16 + i;
    float4 v = make_float4(0.f, 0.f, 0.f, 0.f);
    if (sc >= 0) v = *(const float4*)(src + (size_t)(k0 + k) * ld + sc);
    tile[k * 65 + 4 * j + 0] = v.x; tile[k * 65 + 4 * j + 1] = v.y; tile[k * 65 + 4 * j + 2] = v.z; tile[k * 65 + 4 * j + 3] = v.w;
  }
  __syncthreads();
  int nn = tid >> 2, kq = tid & 3;
  uint32_t o[8];
#pragma unroll
  for (int e = 0; e < 8; e++) o[e] = pack2(tile[(kq * 16 + 2 * e) * 65 + nn], tile[(kq * 16 + 2 * e + 1) * 65 + nn]);
  u32x4* d = (u32x4*)(dst + (size_t)(n0 + nn) * DM + k0 + kq * 16);
  d[0] = (u32x4){o[0], o[1], o[2], o[3]};
  d[1] = (u32x4){o[4], o[5], o[6], o[7]};
}
__device__ __forceinline__ void phase_weights(PP pp, int bid, int nb, char* smem) {
  LAUNDER_PP;
  float* tile = (float*)smem;
  const int nIn = 16 * (VW / 64);
  const int nSq = 16 * 16;
  for (int it = bid; it < nIn + 3 * nSq; it += nb) {
    if (it < nIn) {
      int kt = it & 15, nt = it >> 4;
      transpose_tile(p.w_in, PW, true, ((bf16_t*)(p.ws + OW_WtIn)), kt * 64, nt * 64, tile);
    } else {
      int j = it - nIn, w = j / nSq, r = j % nSq;
      int kt = r & 15, nt = r >> 4;
      const float* src = w == 0 ? p.w_out_a : (w == 1 ? p.w_out_b : p.w_out);
      bf16_t* dst = w == 0 ? ((bf16_t*)(p.ws + OW_WtA)) : (w == 1 ? ((bf16_t*)(p.ws + OW_WtB)) : ((bf16_t*)(p.ws + OW_WtO)));
      transpose_tile(src, DM, false, dst, kt * 64, nt * 64, tile);
    }
  }
}

__device__ __forceinline__ void xn_item(PP pp, int seg, int item) {
  LAUNDER_PP;
  int wave = tid_l() >> 6, lane = tid_l() & 63;
  int M = seg_M(seg);
  int r = item * 4 + wave;
  bf16_t* o = ((bf16_t*)(p.ws + OW_XN)) + (size_t)r * DM;
  if (r >= M) {
#pragma unroll
    for (int i = 0; i < 4; i++) *(uint2*)(o + (lane + 64 * i) * 4) = make_uint2(0u, 0u);
    return;
  }
  const float4* src = (const float4*)row_src(pp, seg, r);
  float4 v[4];
  float ss = 0.f;
#pragma unroll
  for (int i = 0; i < 4; i++) {
    v[i] = src[lane + 64 * i];
    ss += v[i].x * v[i].x + v[i].y * v[i].y + v[i].z * v[i].z + v[i].w * v[i].w;
  }
  ss = wavesum(ss);
  float rstd = rsqrtf(ss * (1.0f / DM) + 1e-6f);
#pragma unroll
  for (int i = 0; i < 4; i++) {
    float4 g = ((const float4*)p.norm_pre)[lane + 64 * i];
    *(uint2*)(o + (lane + 64 * i) * 4) =
        make_uint2(pack2(v[i].x * rstd * g.x, v[i].y * rstd * g.y), pack2(v[i].z * rstd * g.z, v[i].w * rstd * g.w));
  }
}

__device__ __forceinline__ void norm_item(PP pp, int seg, int item) {
  LAUNDER_PP;
  int wave = tid_l() >> 6, lane = tid_l() & 63;
  int r = item * 4 + wave;
  float* dst = row_dst(pp, seg, r);
  if (!dst) return;
  const float4* h = (const float4*)row_src(pp, seg, r);
  const float4* o = (const float4*)(((float*)(p.ws + OW_OUTB)) + ((size_t)(seg & 1) * MP0 + r) * DM);
  float4 v[4];
  float ss = 0.f;
#pragma unroll
  for (int i = 0; i < 4; i++) {
    v[i] = o[lane + 64 * i];
    ss += v[i].x * v[i].x + v[i].y * v[i].y + v[i].z * v[i].z + v[i].w * v[i].w;
  }
  ss = wavesum(ss);
  float rstd = rsqrtf(ss * (1.0f / DM) + 1e-6f);
#pragma unroll
  for (int i = 0; i < 4; i++) {
    float4 g = ((const float4*)p.norm_post)[lane + 64 * i];
    float4 hh = h[lane + 64 * i];
    ((float4*)dst)[lane + 64 * i] =
        make_float4(hh.x + v[i].x * rstd * g.x, hh.y + v[i].y * rstd * g.y, hh.z + v[i].z * rstd * g.z, hh.w + v[i].w * rstd * g.w);
  }
}

__device__ __forceinline__ void merge_item(PP pp, int item) {
  LAUNDER_PP;
  const int tid = tid_l();
  const int wave = tid >> 6, lane = tid & 63;
  const int r = item * 4 + wave;
  const float4* t1 = (const float4*)((const float*)(p.ws + OW_TMP) + (size_t)r * DM);
  const float4* t2 = (const float4*)((const float*)(p.ws + OW_TMP) + ((size_t)MP0 + r) * DM);
  bf16_t* o = (bf16_t*)(p.ws + OW_MG) + (size_t)r * DM;
#pragma unroll
  for (int i = 0; i < 4; i++) {
    float4 a = t1[lane + 64 * i], b = t2[lane + 64 * i];
    *(uint2*)(o + (lane + 64 * i) * 4) = make_uint2(pack2(a.x + b.x, a.y + b.y), pack2(a.z + b.z, a.w + b.w));
  }
}

#define LDT 32
template <int MODE>
__device__ __forceinline__ void gemm_tile(PP pp, int seg, int tm, int tn, char* smem) {
  LAUNDER_PP;
  const int tid = tid_l(), lane = tid & 63, wid = tid >> 6;
  const int wr = wid >> 1, wc = wid & 1, l31 = lane & 31, lh = lane >> 5;
  const int lrow = tid >> 2, lkc = tid & 3;
  const int m0 = tm * 128, n0 = tn * 128;
  bf16_t* GTs = ((bf16_t*)(p.ws + OW_GT)) + (size_t)gt_row0(seg) * GTW;
  f32x16 acc[2][2];
#pragma unroll
  for (int a = 0; a < 2; a++)
#pragma unroll
    for (int b = 0; b < 2; b++)
#pragma unroll
      for (int e = 0; e < 16; e++) acc[a][b][e] = 0.f;
  {
    const bf16_t* A = (MODE == 0) ? (const bf16_t*)(p.ws + OW_XN)
                    : (MODE == 1) ? (const bf16_t*)(p.ws + OW_YA) + (size_t)(seg & 1) * MP0 * DM
                    : (MODE == 3) ? (const bf16_t*)(p.ws + OW_YB) + (size_t)(seg & 1) * MP0 * DM
                                  : (const bf16_t*)(p.ws + OW_MG);
    const bf16_t* Bt = (const bf16_t*)(p.ws + (MODE == 0 ? OW_WtIn : (MODE == 1 ? OW_WtA : (MODE == 3 ? OW_WtB : OW_WtO))));
    u32x4 ra[2], rb[2];
    const bf16_t* gA = A + (size_t)(m0 + lrow) * DM + lkc * 8;
    const bf16_t* gB = Bt + (size_t)(n0 + lrow) * DM + lkc * 8;
    const int wofs = lrow * 64 + ((lkc ^ ((lrow >> 2) & 3)) << 4);
    const int sw = (l31 >> 2) & 3;
    const int rofs0 = l31 * 64 + (((0 + lh) ^ sw) << 4);
    const int rofs1 = l31 * 64 + (((2 + lh) ^ sw) << 4);
    __syncthreads();
#pragma unroll
    for (int i = 0; i < 2; i++) {
      ra[i] = *(const u32x4*)(gA + (size_t)i * 64 * DM);
      rb[i] = *(const u32x4*)(gB + (size_t)i * 64 * DM);
    }
#pragma unroll
    for (int i = 0; i < 2; i++) {
      *(u32x4*)(smem + wofs + i * 4096) = ra[i];
      *(u32x4*)(smem + 8192 + wofs + i * 4096) = rb[i];
    }
#pragma unroll
    for (int i = 0; i < 2; i++) {
      ra[i] = *(const u32x4*)(gA + (size_t)i * 64 * DM + 32);
      rb[i] = *(const u32x4*)(gB + (size_t)i * 64 * DM + 32);
    }
    lds_barrier();
#pragma unroll 1
    for (int kt = 0; kt < 32; kt++) {
      const char* cA = smem + (kt & 1) * 16384 + wr * 4096;
      const char* cB = smem + (kt & 1) * 16384 + 8192 + wc * 4096;
#pragma unroll
      for (int ks = 0; ks < 2; ks++) {
        const int ro = ks ? rofs1 : rofs0;
        const bf16x8 x0 = *(const bf16x8*)(cA + ro), x1 = *(const bf16x8*)(cA + 2048 + ro);
        const bf16x8 w0 = *(const bf16x8*)(cB + ro), w1 = *(const bf16x8*)(cB + 2048 + ro);
        acc[0][0] = __builtin_amdgcn_mfma_f32_32x32x16_bf16(w0, x0, acc[0][0], 0, 0, 0);
        acc[0][1] = __builtin_amdgcn_mfma_f32_32x32x16_bf16(w0, x1, acc[0][1], 0, 0, 0);
        acc[1][0] = __builtin_amdgcn_mfma_f32_32x32x16_bf16(w1, x0, acc[1][0], 0, 0, 0);
        acc[1][1] = __builtin_amdgcn_mfma_f32_32x32x16_bf16(w1, x1, acc[1][1], 0, 0, 0);
      }
      if (kt + 1 < 32) {
        char* nx = smem + ((kt + 1) & 1) * 16384;
#pragma unroll
        for (int i = 0; i < 2; i++) {
          *(u32x4*)(nx + wofs + i * 4096) = ra[i];
          *(u32x4*)(nx + 8192 + wofs + i * 4096) = rb[i];
        }
        if (kt + 2 < 32) {
#pragma unroll
          for (int i = 0; i < 2; i++) {
            ra[i] = *(const u32x4*)(gA + (size_t)i * 64 * DM + (kt + 2) * 32);
            rb[i] = *(const u32x4*)(gB + (size_t)i * 64 * DM + (kt + 2) * 32);
          }
        }
      }
      lds_barrier();
    }
  }
  float* OUTBp = (MODE == 2) ? (float*)(p.ws + OW_OUTB) + (size_t)(seg & 1) * MP0 * DM
                             : (float*)(p.ws + OW_TMP) + (size_t)(MODE == 3 ? 1 : 0) * MP0 * DM;
#pragma unroll
  for (int ni = 0; ni < 2; ni++)
#pragma unroll
    for (int mi = 0; mi < 2; mi++)
#pragma unroll
      for (int g = 0; g < 4; g++) {
        const int m = m0 + wr * 64 + mi * 32 + l31;
        const int n = n0 + wc * 64 + ni * 32 + 8 * g + 4 * lh;
        const float c0 = acc[ni][mi][4 * g], c1 = acc[ni][mi][4 * g + 1], c2 = acc[ni][mi][4 * g + 2], c3 = acc[ni][mi][4 * g + 3];
        if (MODE == 0) {
          uint2 o = make_uint2(pack2(c0, c1), pack2(c2, c3));
          if (tn < PJW / 128) *(uint2*)(((bf16_t*)(p.ws + OW_PJA)) + (size_t)m * PJW + n) = o;
          else *(uint2*)(GTs + (size_t)m * GTW + (n - PJW)) = o;
        } else if (MODE == 1 || MODE == 3) {
          uint2 ga = *(const uint2*)(GTs + (size_t)m * GTW + (MODE == 1 ? G_MA : G_MB) + n);
          *(float4*)(OUTBp + (size_t)m * DM + n) =
              make_float4(sigmoidf_(bf2f(ga.x & 0xffff)) * c0, sigmoidf_(bf2f(ga.x >> 16)) * c1,
                          sigmoidf_(bf2f(ga.y & 0xffff)) * c2, sigmoidf_(bf2f(ga.y >> 16)) * c3);
        } else {
          *(float4*)(OUTBp + (size_t)m * DM + n) = make_float4(c0, c1, c2, c3);
        }
      }
}

__device__ __forceinline__ void rw_prepass_item(PP pp, int seg, int grp, int slab, char* smem) {
  LAUNDER_PP;
  float* lwa = (float*)smem;
  const int tid = tid_l();
  const int r0 = grp * 8;
  int seq, t0, len;
  row_seq(seg, r0, seq, t0, len);
  const bool prompt = seq < 2;
  const float* prev0 = nullptr;
  if (t0 == 0) {
    if (seg == 0) prev0 = prompt ? nullptr : p.st_shift + (size_t)(seq - 2) * 3200;
    else prev0 = ((float*)(p.ws + OW_CSH)) + ((size_t)(seg & 1) * 2 + seq) * 3200;
  }
  __syncthreads();
  {
    const int j = tid & 127;
    const float mu = p.rw_mu[3072 + j];
#pragma unroll
    for (int i = 0; i < 4; i++) {
      int tok = (tid >> 7) + 2 * i;
      int row = r0 + tok;
      float ps = bf2f(((bf16_t*)(p.ws + OW_PJA))[(size_t)row * PJW + 3072 + j]);
      float pv;
      if (tok == 0 && t0 == 0) pv = prev0 ? prev0[3072 + j] : 0.f;
      else pv = bf2f(((bf16_t*)(p.ws + OW_PJA))[(size_t)(row - 1) * PJW + 3072 + j]);
      float xs = ps + mu * (pv - ps);
      lwa[tok * 128 + j] = j < 64 ? tanhf(xs) : xs;
      if (slab == 0 && t0 + tok == len - 1) {
        if (prompt) {
          ((float*)(p.ws + OW_CSH))[((size_t)((seg + 1) & 1) * 2 + seq) * 3200 + 3072 + j] = ps;
          if (seg == NSEG - 1) (p.out + OO_p_shift)[(size_t)seq * 3200 + 3072 + j] = ps;
        } else {
          (p.out + OO_s_shift)[(size_t)(seq - 2) * 3200 + 3072 + j] = ps;
        }
      }
    }
  }
  __syncthreads();
  const int c = slab * 256 + tid;
  float dw[8], da[8];
  {
    const float w0 = p.rw_w0[c], a0 = p.rw_a0[c];
#pragma unroll
    for (int t = 0; t < 8; t++) { dw[t] = w0; da[t] = a0; }
  }
  for (int j = 0; j < 64; j += 4) {
    float w2v[4], a2v[4];
#pragma unroll
    for (int e = 0; e < 4; e++) {
      w2v[e] = p.rw_w2[(size_t)(j + e) * DM + c];
      a2v[e] = p.rw_a2[(size_t)(j + e) * DM + c];
    }
#pragma unroll
    for (int t = 0; t < 8; t++) {
      float4 lw = *(const float4*)(lwa + t * 128 + j);
      float4 la = *(const float4*)(lwa + t * 128 + 64 + j);
      dw[t] += lw.x * w2v[0] + lw.y * w2v[1] + lw.z * w2v[2] + lw.w * w2v[3];
      da[t] += la.x * a2v[0] + la.y * a2v[1] + la.z * a2v[2] + la.w * a2v[3];
    }
  }
  const float mur = p.rw_mu[c], muk = p.rw_mu[1024 + c], muv = p.rw_mu[2048 + c];
  const float kk_w = p.rw_k_k[c], ka_w = p.rw_k_a[c], rk_w = p.rw_r_k[c];
  float pr, pk, pv;
  if (t0 == 0) {
    pr = prev0 ? prev0[c] : 0.f; pk = prev0 ? prev0[1024 + c] : 0.f; pv = prev0 ? prev0[2048 + c] : 0.f;
  } else {
    const bf16_t* q = ((bf16_t*)(p.ws + OW_PJA)) + (size_t)(r0 - 1) * PJW;
    pr = bf2f(q[c]); pk = bf2f(q[1024 + c]); pv = bf2f(q[2048 + c]);
  }
  const int head = c >> 6, e = c & 63;
  const int srow0 = slot_row0(seg);
  char* rws = ((char*)(p.ws + OW_RWS)) + ((size_t)(srow0 + r0) * 16 + head) * 1024;
  float* rwb = ((float*)(p.ws + OW_RWB)) + (size_t)(srow0 + r0) * 16 + head;
#pragma unroll
  for (int t = 0; t < 8; t++) {
    const int row = r0 + t;
    const bf16_t* q = ((bf16_t*)(p.ws + OW_PJA)) + (size_t)row * PJW;
    float cr = bf2f(q[c]), ck = bf2f(q[1024 + c]), cv = bf2f(q[2048 + c]);
    float xr = cr + mur * (pr - cr), xk = ck + muk * (pk - ck), xv = cv + muv * (pv - cv);
    pr = cr; pk = ck; pv = cv;
    float w_log = -softplusf_(-dw[t]) - 0.5f;
    float decay = __expf(-__expf(w_log));
    float a = sigmoidf_(da[t]);
    float kkr = xk * kk_w;
    float ss = wavesum(kkr * kkr);
    float kk = kkr * rsqrtf(ss + 1e-6f);
    float k2 = xk * (1.0f + (a - 1.0f) * ka_w);
    float bon = wavesum(xr * k2 * rk_w);
    char* o = rws + (size_t)t * RWS_ROWB;
    ((f16*)o)[e] = (f16)xr;
    ((f16*)(o + 128))[e] = (f16)k2;
    ((f16*)(o + 256))[e] = (f16)(-kk);
    ((f16*)(o + 384))[e] = (f16)(kk * a);
    ((float*)(o + 512))[e] = decay;
    ((float*)(o + 768))[e] = xv;
    if ((tid & 63) == 0) rwb[(size_t)t * 16] = bon;
    if (t0 + t == len - 1) {
      if (prompt) {
        float* cs = ((float*)(p.ws + OW_CSH)) + ((size_t)((seg + 1) & 1) * 2 + seq) * 3200;
        cs[c] = cr; cs[1024 + c] = ck; cs[2048 + c] = cv;
        if (seg == NSEG - 1) {
          float* ps = (p.out + OO_p_shift) + (size_t)seq * 3200;
          ps[c] = cr; ps[1024 + c] = ck; ps[2048 + c] = cv;
        }
      } else {
        float* ps = (p.out + OO_s_shift) + (size_t)(seq - 2) * 3200;
        ps[c] = cr; ps[1024 + c] = ck; ps[2048 + c] = cv;
      }
    }
  }
}

__device__ __forceinline__ void gd_prepass_item(PP pp, int seg, int grp, int slab) {
  LAUNDER_PP;
  const int tid = tid_l();
  const int r0 = grp * 16;
  int seq, t0, len;
  row_seq(seg, r0, seq, t0, len);
  const bool prompt = seq < 2;
  const int c = slab * 512 + 2 * tid;
  const int kind = slab >> 1;
  const int head = (c & 1023) >> 7, e = c & 127;
  float2 x0, x1, x2;
  if (t0 == 0) {
    const float* cp = nullptr;
    if (seg == 0) cp = prompt ? nullptr : p.st_conv + (size_t)(seq - 2) * 3 * 3072;
    else cp = ((float*)(p.ws + OW_CCV)) + ((size_t)(seg & 1) * 2 + seq) * 3 * 3072;
    if (cp) {
      x0 = *(const float2*)(cp + c); x1 = *(const float2*)(cp + 3072 + c); x2 = *(const float2*)(cp + 6144 + c);
    } else {
      x0 = x1 = x2 = make_float2(0.f, 0.f);
    }
  } else {
    uint32_t u0 = *(const uint32_t*)(((bf16_t*)(p.ws + OW_PJA)) + (size_t)(r0 - 3) * PJW + C_GDC + c);
    uint32_t u1 = *(const uint32_t*)(((bf16_t*)(p.ws + OW_PJA)) + (size_t)(r0 - 2) * PJW + C_GDC + c);
    uint32_t u2 = *(const uint32_t*)(((bf16_t*)(p.ws + OW_PJA)) + (size_t)(r0 - 1) * PJW + C_GDC + c);
    x0 = make_float2(bf2f(u0 & 0xffff), bf2f(u0 >> 16));
    x1 = make_float2(bf2f(u1 & 0xffff), bf2f(u1 >> 16));
    x2 = make_float2(bf2f(u2 & 0xffff), bf2f(u2 >> 16));
  }
  const float2 w0 = *(const float2*)(p.gd_conv_w + c), w1 = *(const float2*)(p.gd_conv_w + 3072 + c),
               w2 = *(const float2*)(p.gd_conv_w + 6144 + c), w3 = *(const float2*)(p.gd_conv_w + 9216 + c);
  const float a_exp = __expf(p.gd_a_log[head]);
  const float dtb = p.gd_dt_bias[head];
  char* gds = ((char*)(p.ws + OW_GDS)) + ((size_t)(slot_row0(seg) + r0) * 8 + head) * GDS_HB;
#pragma unroll 4
  for (int t = 0; t < 16; t++) {
    const int row = r0 + t;
    uint32_t u = *(const uint32_t*)(((bf16_t*)(p.ws + OW_PJA)) + (size_t)row * PJW + C_GDC + c);
    float2 x3 = make_float2(bf2f(u & 0xffff), bf2f(u >> 16));
    float cx = w0.x * x0.x + w1.x * x1.x + w2.x * x2.x + w3.x * x3.x;
    float cy = w0.y * x0.y + w1.y * x1.y + w2.y * x2.y + w3.y * x3.y;
    x0 = x1; x1 = x2; x2 = x3;
    float ax = siluf_(cx), ay = siluf_(cy);
    float sc = 1.0f;
    if (kind < 2) {
      float ss = wavesum(ax * ax + ay * ay);
      sc = rsqrtf(ss + 1e-6f);
      if (kind == 0) sc *= 0.08838834764831845f;
    }
    if (kind >= 1) {
      float beta = sigmoidf_(bf2f(((bf16_t*)(p.ws + OW_PJA))[(size_t)row * PJW + C_BETA + head]));
      sc *= sqrtf(beta);
    }
    ax *= sc; ay *= sc;
    char* o = gds + (size_t)t * GDS_ROWB;
    f16x2 hv = {(f16)ax, (f16)ay};
    *(f16x2*)(o + kind * 256 + e * 2) = hv;
    if (kind == 0 && (tid & 63) == 0) {
      float g = -a_exp * softplusf_(bf2f(((bf16_t*)(p.ws + OW_PJA))[(size_t)row * PJW + C_ALPHA + head]) + dtb);
      *(float*)(o + 768) = __expf(g);
    }
    int jj = t0 + t - (len - 3);
    if (jj >= 0) {
      if (prompt) {
        *(float2*)(((float*)(p.ws + OW_CCV)) + (((size_t)((seg + 1) & 1) * 2 + seq) * 3 + jj) * 3072 + c) = x3;
        if (seg == NSEG - 1) *(float2*)((p.out + OO_p_conv) + ((size_t)seq * 3 + jj) * 3072 + c) = x3;
      } else {
        *(float2*)((p.out + OO_s_conv) + ((size_t)(seq - 2) * 3 + jj) * 3072 + c) = x3;
      }
    }
  }
}


using u32x2 = __attribute__((ext_vector_type(2))) unsigned int;
__device__ __forceinline__ float fmix_lo(unsigned h, float b, float c) {
  float d;
  asm("v_fma_mix_f32 %0, %1, %2, %3 op_sel_hi:[1,0,0]" : "=v"(d) : "v"(h), "v"(b), "v"(c));
  return d;
}
__device__ __forceinline__ float fmix_hi(unsigned h, float b, float c) {
  float d;
  asm("v_fma_mix_f32 %0, %1, %2, %3 op_sel:[1,0,0] op_sel_hi:[1,0,0]" : "=v"(d) : "v"(h), "v"(b), "v"(c));
  return d;
}
__device__ __forceinline__ float vmul1(float a, float b) {
  float d;
  asm("v_mul_f32 %0, %1, %2" : "=v"(d) : "v"(a), "v"(b));
  return d;
}
struct RwOps { f16x4 r, k, a, b; float4 w; float vv; };
__device__ __forceinline__ RwOps rw_ld(const char* Ls, int q, int v) {
  RwOps o;
  o.r = *(const f16x4*)(Ls + q * 8);
  o.k = *(const f16x4*)(Ls + 128 + q * 8);
  o.a = *(const f16x4*)(Ls + 256 + q * 8);
  o.b = *(const f16x4*)(Ls + 384 + q * 8);
  o.w = *(const float4*)(Ls + 512 + q * 16);
  o.vv = *(const float*)(Ls + 768 + v * 4);
  return o;
}
__device__ __forceinline__ float rw_step(const RwOps& o, float4& S) {
  const u32x2 rw = __builtin_bit_cast(u32x2, o.r), kw = __builtin_bit_cast(u32x2, o.k),
              aw = __builtin_bit_cast(u32x2, o.a), bw = __builtin_bit_cast(u32x2, o.b);
  const float z = 0.f;
  float sa0 = fmix_lo(aw[0], S.x, z);
  float sa1 = fmix_lo(aw[1], S.z, z);
  sa0 = fmix_hi(aw[0], S.y, sa0);
  sa1 = fmix_hi(aw[1], S.w, sa1);
  float t0 = vmul1(S.x, o.w.x), t1 = vmul1(S.y, o.w.y), t2 = vmul1(S.z, o.w.z), t3 = vmul1(S.w, o.w.w);
  t0 = fmix_lo(kw[0], o.vv, t0);
  t1 = fmix_hi(kw[0], o.vv, t1);
  t2 = fmix_lo(kw[1], o.vv, t2);
  t3 = fmix_hi(kw[1], o.vv, t3);
  const float sa = rowsum16(sa0 + sa1);
  S.x = fmix_lo(bw[0], sa, t0);
  S.y = fmix_hi(bw[0], sa, t1);
  S.z = fmix_lo(bw[1], sa, t2);
  S.w = fmix_hi(bw[1], sa, t3);
  float y0 = fmix_lo(rw[0], S.x, z);
  float y1 = fmix_lo(rw[1], S.z, z);
  y0 = fmix_hi(rw[0], S.y, y0);
  y1 = fmix_hi(rw[1], S.w, y1);
  return rowsum16(y0 + y1);
}
__device__ __forceinline__ void rw_scan_run(const char* __restrict__ gsrc  , int len, float4& S,
                            float* __restrict__ yo  , int q, int v, char* smem) {
  const int tid = tid_l();
  const int nch = len >> 4;
  const int lstep = tid >> 6, loff = (tid & 63) * 16;
  u32x4 st[4];
#pragma unroll
  for (int i = 0; i < 4; i++) st[i] = *(const u32x4*)(gsrc + (size_t)(lstep + 4 * i) * RWS_ROWB + loff);
  __syncthreads();
#pragma unroll
  for (int i = 0; i < 4; i++) *(u32x4*)(smem + (lstep + 4 * i) * 1024 + loff) = st[i];
  u32x4 st2[4];
#pragma unroll
  for (int i = 0; i < 4; i++) st2[i] = st[i];
  if (nch > 1) {
#pragma unroll
    for (int i = 0; i < 4; i++) st[i] = *(const u32x4*)(gsrc + (size_t)(16 + lstep + 4 * i) * RWS_ROWB + loff);
  }
  if (nch > 2) {
#pragma unroll
    for (int i = 0; i < 4; i++) st2[i] = *(const u32x4*)(gsrc + (size_t)(32 + lstep + 4 * i) * RWS_ROWB + loff);
  }
  __syncthreads();
  for (int c = 0; c < nch; c++) {
    const char* L = smem + (c & 1) * 16384;
    float ykeep = 0.f;
    RwOps oa = rw_ld(L, q, v);
#pragma unroll 1
    for (int t = 0; t < 16; t += 2) {
      const RwOps ob = rw_ld(L + (t + 1) * 1024, q, v);
      asm volatile("" ::: "memory");
      const float ya = rw_step(oa, S);
      ykeep = (q == t) ? ya : ykeep;
      oa = rw_ld(L + ((t + 2) & 15) * 1024, q, v);
      asm volatile("" ::: "memory");
      const float yb = rw_step(ob, S);
      ykeep = (q == t + 1) ? yb : ykeep;
    }
    yo[(size_t)(c * 16 + q) * DM] = ykeep;
    if (c + 1 < nch) {
      char* Ln = smem + ((c + 1) & 1) * 16384;
#pragma unroll
      for (int i = 0; i < 4; i++) *(u32x4*)(Ln + (lstep + 4 * i) * 1024 + loff) = st[i];
#pragma unroll
      for (int i = 0; i < 4; i++) st[i] = st2[i];
      if (c + 3 < nch) {
#pragma unroll
        for (int i = 0; i < 4; i++)
          st2[i] = *(const u32x4*)(gsrc + (size_t)((c + 3) * 16 + lstep + 4 * i) * RWS_ROWB + loff);
      }
    }
    lds_barrier();
  }
}

struct GdOps { f16x8 qv, kv; float vv, eg; };
__device__ __forceinline__ GdOps gd_ld(const char* Ls, int q, int cl) {
  GdOps o;
  o.kv = *(const f16x8*)(Ls + 256 + q * 16);
  o.vv = (float)*(const f16*)(Ls + 512 + cl * 2);
  o.eg = *(const float*)(Ls + 768);
  o.qv = *(const f16x8*)(Ls + q * 16);
  return o;
}
__device__ __forceinline__ float gd_step(const GdOps& o, float (&s)[8]) {
  const u32x4 kw = __builtin_bit_cast(u32x4, o.kv), qw = __builtin_bit_cast(u32x4, o.qv);
  const float z = 0.f;
  float a0 = fmix_lo(kw[0], s[0], z);
  float a1 = fmix_lo(kw[2], s[4], z);
  a0 = fmix_hi(kw[0], s[1], a0);
  a1 = fmix_hi(kw[2], s[5], a1);
  a0 = fmix_lo(kw[1], s[2], a0);
  a1 = fmix_lo(kw[3], s[6], a1);
  a0 = fmix_hi(kw[1], s[3], a0);
  a1 = fmix_hi(kw[3], s[7], a1);
  float es[8];
#pragma unroll
  for (int i = 0; i < 8; i++) es[i] = vmul1(o.eg, s[i]);
  const float ks = rowsum16(a0 + a1);
  const float d = fmaf(-o.eg, ks, o.vv);
  s[0] = fmix_lo(kw[0], d, es[0]); s[1] = fmix_hi(kw[0], d, es[1]);
  s[2] = fmix_lo(kw[1], d, es[2]); s[3] = fmix_hi(kw[1], d, es[3]);
  s[4] = fmix_lo(kw[2], d, es[4]); s[5] = fmix_hi(kw[2], d, es[5]);
  s[6] = fmix_lo(kw[3], d, es[6]); s[7] = fmix_hi(kw[3], d, es[7]);
  float o0 = fmix_lo(qw[0], s[0], z);
  float o1 = fmix_lo(qw[2], s[4], z);
  o0 = fmix_hi(qw[0], s[1], o0);
  o1 = fmix_hi(qw[2], s[5], o1);
  o0 = fmix_lo(qw[1], s[2], o0);
  o1 = fmix_lo(qw[3], s[6], o1);
  o0 = fmix_hi(qw[1], s[3], o0);
  o1 = fmix_hi(qw[3], s[7], o1);
  return rowsum16(o0 + o1);
}
__device__ __forceinline__ void gd_scan_run(const char* __restrict__ gsrc  , int len, float (&s)[8],
                            float* __restrict__ oo  , int q, int cl, char* smem) {
  const int tid = tid_l();
  const int nch = len >> 4;
  u32x4 st[4];
  int lt[4], lo[4];
#pragma unroll
  for (int i = 0; i < 4; i++) {
    int id = tid + 256 * i;
    if (id > 783) id = 783;
    lt[i] = id / 49;
    lo[i] = (id % 49) * 16;
  }
#pragma unroll
  for (int i = 0; i < 4; i++) st[i] = *(const u32x4*)(gsrc + (size_t)lt[i] * GDS_ROWB + lo[i]);
  __syncthreads();
#pragma unroll
  for (int i = 0; i < 4; i++) *(u32x4*)(smem + lt[i] * GDS_HB + lo[i]) = st[i];
  u32x4 st2[4];
#pragma unroll
  for (int i = 0; i < 4; i++) st2[i] = st[i];
  if (nch > 1) {
#pragma unroll
    for (int i = 0; i < 4; i++) st[i] = *(const u32x4*)(gsrc + (size_t)(16 + lt[i]) * GDS_ROWB + lo[i]);
  }
  if (nch > 2) {
#pragma unroll
    for (int i = 0; i < 4; i++) st2[i] = *(const u32x4*)(gsrc + (size_t)(32 + lt[i]) * GDS_ROWB + lo[i]);
  }
  __syncthreads();
  for (int c = 0; c < nch; c++) {
    const char* L = smem + (c & 1) * 16384;
    float okeep = 0.f;
    GdOps oa = gd_ld(L, q, cl);
#pragma unroll 1
    for (int t = 0; t < 16; t += 2) {
      const GdOps ob = gd_ld(L + (t + 1) * GDS_HB, q, cl);
      asm volatile("" ::: "memory");
      const float ya = gd_step(oa, s);
      okeep = (q == t) ? ya : okeep;
      oa = gd_ld(L + ((t + 2) & 15) * GDS_HB, q, cl);
      asm volatile("" ::: "memory");
      const float yb = gd_step(ob, s);
      okeep = (q == t + 1) ? yb : okeep;
    }
    oo[(size_t)(c * 16 + q) * DM] = okeep;
    if (c + 1 < nch) {
      char* Ln = smem + ((c + 1) & 1) * 16384;
#pragma unroll
      for (int i = 0; i < 4; i++) *(u32x4*)(Ln + lt[i] * GDS_HB + lo[i]) = st[i];
#pragma unroll
      for (int i = 0; i < 4; i++) st[i] = st2[i];
      if (c + 3 < nch) {
#pragma unroll
        for (int i = 0; i < 4; i++) st2[i] = *(const u32x4*)(gsrc + (size_t)((c + 3) * 16 + lt[i]) * GDS_ROWB + lo[i]);
      }
    }
    lds_barrier();
  }
}

__device__ __forceinline__ void sample_scan_task(PP pp, int task, char* smem) {
  LAUNDER_PP;
  const int sj = task >> 7, j = task & 127, kind = j >> 6, jj = j & 63;
  const int tid = tid_l(), q = tid & 15;
  const int row0 = 1056 + sj * 16;
  if (kind == 0) {
    const int head = jj >> 2, v = (jj & 3) * 16 + (tid >> 4);
    const float* sin = p.st_wkv + ((size_t)sj * 16 + head) * 4096;
    float* sout = (p.out + OO_s_wkv) + ((size_t)sj * 16 + head) * 4096;
    float4 S = *(const float4*)(sin + v * 64 + 4 * q);
    rw_scan_run(((char*)(p.ws + OW_RWS)) + ((size_t)row0 * 16 + head) * 1024, 16, S, ((float*)(p.ws + OW_YRW)) + (size_t)row0 * DM + head * 64 + v, q, v, smem);
    *(float4*)(sout + v * 64 + 4 * q) = S;
  } else {
    const int head = jj >> 3, cl = (jj & 7) * 16 + (tid >> 4);
    const float* sin = p.st_ssm + ((size_t)sj * 8 + head) * 16384;
    float* sout = (p.out + OO_s_ssm) + ((size_t)sj * 8 + head) * 16384;
    float s[8];
#pragma unroll
    for (int i = 0; i < 8; i++) s[i] = sin[(size_t)(8 * q + i) * 128 + cl];
    gd_scan_run(((char*)(p.ws + OW_GDS)) + ((size_t)row0 * 8 + head) * GDS_HB, 16, s, ((float*)(p.ws + OW_OGD)) + (size_t)row0 * DM + head * 128 + cl, q, cl, smem);
#pragma unroll
    for (int i = 0; i < 8; i++) sout[(size_t)(8 * q + i) * 128 + cl] = s[i];
  }
}

__device__ __forceinline__ void scan_block_rw(PP pp, int j, char* smem) {
  LAUNDER_PP;
  const int seq = j >> 6, jj = j & 63;
  const int tid = tid_l(), q = tid & 15;
  const int head = jj >> 2, v = (jj & 3) * 16 + (tid >> 4);
  float4 S = make_float4(0.f, 0.f, 0.f, 0.f);
  for (int seg = 0; seg < NSEG; seg++) {
    wait_ge(((unsigned int*)(p.ws + OW_sync)) + SW_PRE, seg + 1);
    const int len = seg == 0 ? 528 : TS;
    const int row0 = slot_row0(seg) + (seg == 0 ? seq * 528 : seq * TS);
    rw_scan_run(((char*)(p.ws + OW_RWS)) + ((size_t)row0 * 16 + head) * 1024, len, S,
                ((float*)(p.ws + OW_YRW)) + (size_t)row0 * DM + head * 64 + v, q, v, smem);
    signal_add(((unsigned int*)(p.ws + OW_sync)) + SW_SCAN(seg));
  }
  {
    const int tid2 = tid_l(), q2 = tid2 & 15, v2 = (jj & 3) * 16 + (tid2 >> 4);
    *(float4*)((p.out + OO_p_wkv) + ((size_t)seq * 16 + head) * 4096 + v2 * 64 + 4 * q2) = S;
  }
}
__device__ __forceinline__ void scan_block_gd(PP pp, int j, char* smem) {
  LAUNDER_PP;
  const int seq = j >> 6, jj = j & 63;
  const int tid = tid_l(), q = tid & 15;
  const int head = jj >> 3, cl = (jj & 7) * 16 + (tid >> 4);
  float s[8];
#pragma unroll
  for (int i = 0; i < 8; i++) s[i] = 0.f;
  for (int seg = 0; seg < NSEG; seg++) {
    wait_ge(((unsigned int*)(p.ws + OW_sync)) + SW_PRE, seg + 1);
    const int len = seg == 0 ? 528 : TS;
    const int row0 = slot_row0(seg) + (seg == 0 ? seq * 528 : seq * TS);
    gd_scan_run(((char*)(p.ws + OW_GDS)) + ((size_t)row0 * 8 + head) * GDS_HB, len, s,
                ((float*)(p.ws + OW_OGD)) + (size_t)row0 * DM + head * 128 + cl, q, cl, smem);
    signal_add(((unsigned int*)(p.ws + OW_sync)) + SW_SCAN(seg));
  }
  {
    const int tid2 = tid_l(), q2 = tid2 & 15, cl2 = (jj & 7) * 16 + (tid2 >> 4);
    float* sout = (p.out + OO_p_ssm) + ((size_t)seq * 8 + head) * 16384;
#pragma unroll
    for (int i = 0; i < 8; i++) sout[(size_t)(8 * q2 + i) * 128 + cl2] = s[i];
  }
}

__device__ __forceinline__ void post_item(PP pp, int seg, int row) {
  LAUNDER_PP;
  const int tid = tid_l(), c4 = tid * 4;
  const int srow = slot_row0(seg) + row;
  const bf16_t* gt = ((bf16_t*)(p.ws + OW_GT)) + (size_t)(gt_row0(seg) + row) * GTW;
  {
    float4 y = *(const float4*)(((float*)(p.ws + OW_YRW)) + (size_t)srow * DM + c4);
    float mean = rowsum16(y.x + y.y + y.z + y.w) * (1.0f / 64.0f);
    float dx = y.x - mean, dy = y.y - mean, dz = y.z - mean, dw = y.w - mean;
    float var = rowsum16(dx * dx + dy * dy + dz * dz + dw * dw) * (1.0f / 64.0f);
    float rs = rsqrtf(var + 64e-5f);
    float4 lw = *(const float4*)(p.rw_ln_w + c4), lb = *(const float4*)(p.rw_ln_b + c4);
    float bon = ((float*)(p.ws + OW_RWB))[(size_t)srow * 16 + (tid >> 4)];
    float4 v = *(const float4*)(((char*)(p.ws + OW_RWS)) + ((size_t)srow * 16 + (tid >> 4)) * 1024 + 768 + (tid & 15) * 16);
    uint2 g = *(const uint2*)(gt + G_RW + c4);
    float o0 = (dx * rs * lw.x + lb.x + bon * v.x) * siluf_(bf2f(g.x & 0xffff));
    float o1 = (dy * rs * lw.y + lb.y + bon * v.y) * siluf_(bf2f(g.x >> 16));
    float o2 = (dz * rs * lw.z + lb.z + bon * v.z) * siluf_(bf2f(g.y & 0xffff));
    float o3 = (dw * rs * lw.w + lb.w + bon * v.w) * siluf_(bf2f(g.y >> 16));
    *(uint2*)(((bf16_t*)(p.ws + OW_YA)) + ((size_t)(seg & 1) * MP0 + row) * DM + c4) = make_uint2(pack2(o0, o1), pack2(o2, o3));
  }
  {
    float4 o = *(const float4*)(((float*)(p.ws + OW_OGD)) + (size_t)srow * DM + c4);
    float ss = rowsum16(o.x * o.x + o.y * o.y + o.z * o.z + o.w * o.w);
    ss += __shfl_xor(ss, 16);
    float rs = rsqrtf(ss * (1.0f / 128.0f) + 1e-6f);
    float4 nw = *(const float4*)(p.gd_norm_w + (c4 & 127));
    uint2 g = *(const uint2*)(gt + G_GD + c4);
    float o0 = o.x * rs * nw.x * siluf_(bf2f(g.x & 0xffff));
    float o1 = o.y * rs * nw.y * siluf_(bf2f(g.x >> 16));
    float o2 = o.z * rs * nw.z * siluf_(bf2f(g.y & 0xffff));
    float o3 = o.w * rs * nw.w * siluf_(bf2f(g.y >> 16));
    *(uint2*)(((bf16_t*)(p.ws + OW_YB)) + ((size_t)(seg & 1) * MP0 + row) * DM + c4) = make_uint2(pack2(o0, o1), pack2(o2, o3));
  }
}

#define SMEM_BYTES (32768 + 16)

__global__ void __launch_bounds__(256, 4) k_mega(Params p_arg) {
  PP pp = (PP)__builtin_amdgcn_kernarg_segment_ptr();
  __shared__ __attribute__((aligned(16))) char smem[SMEM_BYTES];
  cg::grid_group grid = cg::this_grid();
  const int bid = blockIdx.x, nb = gridDim.x;
  unsigned* sync = (unsigned*)(p.ws + OW_sync);
  const unsigned xcc = xcc_id() & 7u;
  if (bid >= NSCAN && threadIdx.x == 0) xb_add(&sync[SW_XCNT(xcc)], 1u);
  phase_weights(pp, bid, nb, smem);
  for (int it = bid; it < seg_MP(0) / 4; it += nb) xn_item(pp, 0, it);
  grid.sync();
  if (bid < NSCAN) {
    __builtin_amdgcn_s_setprio(3);
    if (bid < 128) scan_block_rw(pp, bid, smem);
    else scan_block_gd(pp, bid - 128, smem);
    return;
  }
  const int w = bid - NSCAN, NW = nb - NSCAN;
  unsigned* cfg = (unsigned*)(smem + 32768);
  if (threadIdx.x == 0) {
    unsigned mine = 0, nx = 0;
#pragma unroll
    for (unsigned j = 0; j < 8; j++) { unsigned c = xb_ld(&sync[SW_XCNT(j)]); nx += c > 0u ? 1u : 0u; mine = (j == xcc) ? c : mine; }
    cfg[0] = mine > 0u ? mine : 1u;
    cfg[1] = nx > 0u ? nx : 1u;
  }
  __syncthreads();
  for (int i = 0; i < NSEG + 5; i++) {
    const int sm = i - 4, snn = i - 5, sj = i - 3, so = i - 4, sp = i - 2;
    const bool front = i < NSEG;
    const bool mrg = sm >= 0 && sm < NSEG, nrm = snn >= 0 && snn < NSEG, back = sj >= 0 && sj < NSEG, outv = so >= 0 && so < NSEG,
               pst = sp >= 0 && sp < NSEG;
    {
      const int tmF = front ? seg_MP(i) / 128 : 1;
      const int nF = front ? tmF * (VW / 128) : 0;
      const int nM = mrg ? seg_MP(sm) / 4 : 0;
      const int nN = nrm ? seg_M(snn) / 4 : 0;
      for (int it = w; it < nF + nM + nN; it += NW) {
        int t = it;
        if (t < nF) { gemm_tile<0>(pp, i, t % tmF, t / tmF, smem); continue; }
        t -= nF;
        if (t < nM) { merge_item(pp, t); continue; }
        t -= nM;
        norm_item(pp, snn, t);
      }
      if (i == 1) {
        for (int it = w; it < 32 * 128; it += NW) sample_scan_task(pp, it, smem);
      }
    }
    worker_barrier((unsigned*)(p.ws + OW_sync), (const unsigned*)(smem + 32768));
    {
      const int nB = back ? (seg_MP(sj) / 128) * 8 : 0;
      const int nO = outv ? (seg_MP(so) / 128) * 8 : 0;
      const int nHeavy = 2 * nB + nO;
      const int nHeavyW = nHeavy < NW / 2 ? nHeavy : NW / 2;
      const int NL = NW - nHeavyW;
      const int ngrp = front ? seg_M(i) / 16 : 0;
      const int nRW = ngrp * 8, nGD = ngrp * 6;
      const int nX = (i + 1 < NSEG) ? seg_MP(i + 1) / 4 : 0;
      const int tot = nRW + nGD + nX;
      if (w >= NL) {
        for (int it = w - NL; it < nHeavy; it += nHeavyW) {
          int t = it;
          if (t < nB) { gemm_tile<1>(pp, sj, t >> 3, t & 7, smem); continue; }
          t -= nB;
          if (t < nB) { gemm_tile<3>(pp, sj, t >> 3, t & 7, smem); continue; }
          t -= nB;
          gemm_tile<2>(pp, so, t >> 3, t & 7, smem);
        }
      } else {
        for (int it = w; it < tot; it += NL) {
          int t = it;
          if (t < nRW) { rw_prepass_item(pp, i, t >> 2, t & 3, smem); continue; }
          t -= nRW;
          if (t < nGD) { gd_prepass_item(pp, i, t / 6, t % 6); continue; }
          t -= nGD;
          xn_item(pp, i + 1, t);
        }
      }
      if (pst) {
        wait_ge((unsigned*)(p.ws + OW_sync) + SW_SCAN(sp), NSCAN);
        const int n = seg_M(sp);
        for (int it = w; it < n; it += NW) post_item(pp, sp, it);
      }
    }
    worker_barrier((unsigned*)(p.ws + OW_sync), (const unsigned*)(smem + 32768));
    if (front && w == 0 && threadIdx.x == 0)
      __hip_atomic_store((unsigned*)(p.ws + OW_sync) + SW_PRE, (unsigned)(i + 1), __ATOMIC_RELAXED, __HIP_MEMORY_SCOPE_AGENT);
  }
}

static inline size_t align_up(size_t x) { return (x + 255) & ~(size_t)255; }

#undef p
extern "C" void kernel_launch(void* const* d_in, const int* in_sizes, int n_in, void* d_out, int out_size, void* d_ws,
                              size_t ws_size, hipStream_t stream) {
  Params p{};
  const float* const* in = (const float* const*)d_in;
  p.x_prompt = in[0]; p.x_sample = in[1]; p.st_shift = in[2]; p.st_wkv = in[3]; p.st_conv = in[4]; p.st_ssm = in[5];
  p.meta = in[6]; p.norm_pre = in[7]; p.w_in = in[8]; p.rw_mu = in[9]; p.rw_w0 = in[10]; p.rw_w2 = in[11];
  p.rw_a0 = in[12]; p.rw_a2 = in[13]; p.rw_k_k = in[14]; p.rw_k_a = in[15]; p.rw_r_k = in[16]; p.rw_ln_w = in[17];
  p.rw_ln_b = in[18]; p.gd_conv_w = in[19]; p.gd_a_log = in[20]; p.gd_dt_bias = in[21]; p.gd_norm_w = in[22];
  p.w_out_a = in[23]; p.w_out_b = in[24]; p.w_out = in[25]; p.norm_post = in[26];
  p.out = (float*)d_out;
  p.ws = (char*)d_ws;
  if (OW_END > ws_size) { fprintf(stderr, "workspace too small: need %zu have %zu\n", (size_t)OW_END, ws_size); return; }

  static int grid_blocks = 0;
  if (!grid_blocks) {
    int dev = 0, cus = 0, per_cu = 0;
    (void)hipGetDevice(&dev);
    (void)hipDeviceGetAttribute(&cus, hipDeviceAttributeMultiprocessorCount, dev);
    (void)hipOccupancyMaxActiveBlocksPerMultiprocessor(&per_cu, k_mega, 256, 0);
    if (per_cu > 4) per_cu = 4;
    grid_blocks = cus * per_cu;
  }
  (void)hipMemsetAsync(p.ws + OW_sync, 0, 16384, stream);
  void* args[] = {&p};
  hipError_t e = hipLaunchCooperativeKernel((void*)k_mega, dim3(grid_blocks), dim3(256), args, 0, stream);
  if (e != hipSuccess) fprintf(stderr, "cooperative launch failed: %s (grid %d)\n", hipGetErrorString(e), grid_blocks);
}
```

```cpp
#include <hip/hip_runtime.h>
#include <hip/hip_cooperative_groups.h>
#include <stdint.h>
#include <stdio.h>
namespace cg = cooperative_groups;

typedef unsigned short bf16_t;
typedef _Float16 f16;
using bf16x8 = __attribute__((ext_vector_type(8))) short;
using f32x4 = __attribute__((ext_vector_type(4))) float;
using u32x4 = __attribute__((ext_vector_type(4))) unsigned int;
using f32x16 = __attribute__((ext_vector_type(16))) float;
using f16x2 = __attribute__((ext_vector_type(2))) _Float16;
using f16x4 = __attribute__((ext_vector_type(4))) _Float16;
using f16x8 = __attribute__((ext_vector_type(8))) _Float16;

#define DM 1024
#define PW 10384
#define VW 10496
#define PJW 6400
#define GTW 4096
#define NSEG 16
#define TS 512
#define M0 1568
#define MP0 1664
#define M1 1024
#define SLOT_ROWS 3712
#define GT_ROWS 4736
#define NSCAN 256
#define C_GDC 3200
#define C_BETA 6272
#define C_ALPHA 6280
#define G_RW 0
#define G_GD 1024
#define G_MA 2048
#define G_MB 3072
#define RWS_ROWB 16384
#define GDS_HB 784
#define GDS_ROWB 6272

struct Params {
  const float *x_prompt, *x_sample, *st_shift, *st_wkv, *st_conv, *st_ssm, *meta, *norm_pre, *w_in, *rw_mu, *rw_w0,
      *rw_w2, *rw_a0, *rw_a2, *rw_k_k, *rw_k_a, *rw_r_k, *rw_ln_w, *rw_ln_b, *gd_conv_w, *gd_a_log, *gd_dt_bias,
      *gd_norm_w, *w_out_a, *w_out_b, *w_out, *norm_post;
  float* out;
  char* ws;
};
#define p (PV(pp))
#define GLOBAL_AS __attribute__((address_space(1)))
#define CONST_AS __attribute__((address_space(4)))
struct ParamsG {
  const GLOBAL_AS float *x_prompt, *x_sample, *st_shift, *st_wkv, *st_conv, *st_ssm, *meta, *norm_pre, *w_in, *rw_mu, *rw_w0,
      *rw_w2, *rw_a0, *rw_a2, *rw_k_k, *rw_k_a, *rw_r_k, *rw_ln_w, *rw_ln_b, *gd_conv_w, *gd_a_log, *gd_dt_bias,
      *gd_norm_w, *w_out_a, *w_out_b, *w_out, *norm_post;
  GLOBAL_AS float* out;
  GLOBAL_AS char* ws;
};
typedef const CONST_AS ParamsG* PP;
__device__ __forceinline__ Params PV(PP pp) {
  Params v;
  v.x_prompt = (const float*)pp->x_prompt;
  v.x_sample = (const float*)pp->x_sample;
  v.st_shift = (const float*)pp->st_shift;
  v.st_wkv = (const float*)pp->st_wkv;
  v.st_conv = (const float*)pp->st_conv;
  v.st_ssm = (const float*)pp->st_ssm;
  v.meta = (const float*)pp->meta;
  v.norm_pre = (const float*)pp->norm_pre;
  v.w_in = (const float*)pp->w_in;
  v.rw_mu = (const float*)pp->rw_mu;
  v.rw_w0 = (const float*)pp->rw_w0;
  v.rw_w2 = (const float*)pp->rw_w2;
  v.rw_a0 = (const float*)pp->rw_a0;
  v.rw_a2 = (const float*)pp->rw_a2;
  v.rw_k_k = (const float*)pp->rw_k_k;
  v.rw_k_a = (const float*)pp->rw_k_a;
  v.rw_r_k = (const float*)pp->rw_r_k;
  v.rw_ln_w = (const float*)pp->rw_ln_w;
  v.rw_ln_b = (const float*)pp->rw_ln_b;
  v.gd_conv_w = (const float*)pp->gd_conv_w;
  v.gd_a_log = (const float*)pp->gd_a_log;
  v.gd_dt_bias = (const float*)pp->gd_dt_bias;
  v.gd_norm_w = (const float*)pp->gd_norm_w;
  v.w_out_a = (const float*)pp->w_out_a;
  v.w_out_b = (const float*)pp->w_out_b;
  v.w_out = (const float*)pp->w_out;
  v.norm_post = (const float*)pp->norm_post;
  v.out = (float*)pp->out;
  v.ws = (char*)pp->ws;
  return v;
}
constexpr size_t al256(size_t x) { return (x + 255) & ~(size_t)255; }
constexpr size_t OO_y_prompt = 0;
constexpr size_t OO_y_sample = OO_y_prompt + (size_t)2 * 8192 * 1024;
constexpr size_t OO_p_shift = OO_y_sample + (size_t)32 * 16 * 1024;
constexpr size_t OO_p_wkv = OO_p_shift + 2 * 3200;
constexpr size_t OO_p_conv = OO_p_wkv + 2 * 16 * 4096;
constexpr size_t OO_p_ssm = OO_p_conv + 2 * 3 * 3072;
constexpr size_t OO_s_shift = OO_p_ssm + 2 * 8 * 16384;
constexpr size_t OO_s_wkv = OO_s_shift + 32 * 3200;
constexpr size_t OO_s_conv = OO_s_wkv + 32 * 16 * 4096;
constexpr size_t OO_s_ssm = OO_s_conv + 32 * 3 * 3072;
constexpr size_t OW_sync = 0;
constexpr size_t OW_WtIn = OW_sync + 16384;
constexpr size_t OW_WtA = OW_WtIn + al256((size_t)VW * DM * 2);
constexpr size_t OW_WtB = OW_WtA + al256((size_t)DM * DM * 2);
constexpr size_t OW_WtO = OW_WtB + al256((size_t)DM * DM * 2);
constexpr size_t OW_XN = OW_WtO + al256((size_t)DM * DM * 2);
constexpr size_t OW_PJA = OW_XN + al256((size_t)MP0 * DM * 2);
constexpr size_t OW_YA = OW_PJA + al256((size_t)MP0 * PJW * 2);
constexpr size_t OW_YB = OW_YA + al256((size_t)2 * MP0 * DM * 2);
constexpr size_t OW_MG = OW_YB + al256((size_t)2 * MP0 * DM * 2);
constexpr size_t OW_OUTB = OW_MG + al256((size_t)MP0 * DM * 2);
constexpr size_t OW_TMP = OW_OUTB + al256((size_t)2 * MP0 * DM * 4);
constexpr size_t OW_GT = OW_TMP + al256((size_t)2 * MP0 * DM * 4);
constexpr size_t OW_RWS = OW_GT + al256((size_t)GT_ROWS * GTW * 2);
constexpr size_t OW_GDS = OW_RWS + al256((size_t)SLOT_ROWS * RWS_ROWB);
constexpr size_t OW_RWB = OW_GDS + al256((size_t)SLOT_ROWS * GDS_ROWB + 256);
constexpr size_t OW_YRW = OW_RWB + al256((size_t)SLOT_ROWS * 16 * 4);
constexpr size_t OW_OGD = OW_YRW + al256((size_t)SLOT_ROWS * DM * 4);
constexpr size_t OW_CSH = OW_OGD + al256((size_t)SLOT_ROWS * DM * 4);
constexpr size_t OW_CCV = OW_CSH + al256((size_t)2 * 2 * 3200 * 4);
constexpr size_t OW_END = OW_CCV + al256((size_t)2 * 2 * 3 * 3072 * 4);


__device__ __forceinline__ bf16_t f2bf(float f) {
  uint32_t u = __float_as_uint(f);
  u += 0x7fffu + ((u >> 16) & 1u);
  return (bf16_t)(u >> 16);
}
__device__ __forceinline__ float bf2f(bf16_t h) { return __uint_as_float(((uint32_t)h) << 16); }
__device__ __forceinline__ uint32_t pack2(float a, float b) { return (uint32_t)f2bf(a) | ((uint32_t)f2bf(b) << 16); }
__device__ __forceinline__ float sigmoidf_(float x) { return 1.0f / (1.0f + __expf(-x)); }
__device__ __forceinline__ float siluf_(float x) { return x / (1.0f + __expf(-x)); }
__device__ __forceinline__ float softplusf_(float x) { return fmaxf(x, 0.0f) + log1pf(__expf(-fabsf(x))); }

__device__ __forceinline__ int tid_l() { int t = threadIdx.x; asm volatile("" : "+v"(t)); return t; }
#define LAUNDER_PP asm volatile("" : "+s"(pp))
template <int CTRL>
__device__ __forceinline__ float dppf(float x) {
  return __builtin_bit_cast(float, __builtin_amdgcn_update_dpp(0, __builtin_bit_cast(int, x), CTRL, 0xf, 0xf, true));
}
__device__ __forceinline__ float rowsum16(float x) {
  x += dppf<0xB1>(x);
  x += dppf<0x4E>(x);
  x += dppf<0x141>(x);
  x += dppf<0x140>(x);
  return x;
}
__device__ __forceinline__ float wavesum(float x) {
  x = rowsum16(x);
  x += __shfl_xor(x, 16);
  x += __shfl_xor(x, 32);
  return x;
}

#define SW_XCNT(j) (64 * (1 + (j)))
#define SW_XSUB(j) (64 * (9 + (j)))
#define SW_XGEN(j) (64 * (17 + (j)))
#define SW_TOP (64 * 25)
#define SW_TOPGEN (64 * 26)
#define SW_PRE (64 * 27)
#define SW_SCAN(s) (64 * (28 + (s)))
#define SYNC_BYTES 16384
__device__ __forceinline__ unsigned xb_ld(const unsigned* ptr) {
  return __hip_atomic_load(ptr, __ATOMIC_RELAXED, __HIP_MEMORY_SCOPE_AGENT);
}
__device__ __forceinline__ unsigned xb_add(unsigned* ptr, unsigned v) {
  return __hip_atomic_fetch_add(ptr, v, __ATOMIC_RELAXED, __HIP_MEMORY_SCOPE_AGENT);
}
__device__ __forceinline__ unsigned xcc_id() { return (unsigned)__builtin_amdgcn_s_getreg((3 << 11) | 20) & 0xFu; }
__device__ __forceinline__ void wait_ge(const unsigned* ptr, unsigned target) {
  if (threadIdx.x == 0) {
    while (xb_ld(ptr) < target) __builtin_amdgcn_s_sleep(8);
    __builtin_amdgcn_fence(__ATOMIC_ACQUIRE, "agent");
    asm volatile("s_waitcnt vmcnt(0)" ::: "memory");
  }
  __syncthreads();
}
__device__ __forceinline__ void signal_add(unsigned* ptr) {
  asm volatile("s_waitcnt vmcnt(0)" ::: "memory");
  __syncthreads();
  if (threadIdx.x == 0) {
    __builtin_amdgcn_fence(__ATOMIC_RELEASE, "agent");
    asm volatile("s_waitcnt vmcnt(0)" ::: "memory");
    xb_add(ptr, 1u);
  }
}
__device__ __forceinline__ void worker_barrier(unsigned* bar, const unsigned* lds_cfg) {
  asm volatile("s_waitcnt vmcnt(0)" ::: "memory");
  __syncthreads();
  if (threadIdx.x == 0) {
    const unsigned x = xcc_id() & 7u, nloc = lds_cfg[0], nx = lds_cfg[1];
    const unsigned old = xb_add(&bar[SW_XSUB(x)], 1u);
    const unsigned gen = old / nloc;
    if (old + 1u == (gen + 1u) * nloc) {
      __builtin_amdgcn_fence(__ATOMIC_RELEASE, "agent");
      asm volatile("s_waitcnt vmcnt(0)" ::: "memory");
      const unsigned og = xb_add(&bar[SW_TOP], 1u);
      const unsigned tg = og / nx;
      if (og + 1u == (tg + 1u) * nx) xb_add(&bar[SW_TOPGEN], 1u);
      else while (xb_ld(&bar[SW_TOPGEN]) == tg) __builtin_amdgcn_s_sleep(1);
      __builtin_amdgcn_fence(__ATOMIC_ACQUIRE, "agent");
      xb_add(&bar[SW_XGEN(x)], 1u);
      asm volatile("s_waitcnt vmcnt(0)" ::: "memory");
    } else {
      while (xb_ld(&bar[SW_XGEN(x)]) == gen) __builtin_amdgcn_s_sleep(1);
      __builtin_amdgcn_fence(__ATOMIC_ACQUIRE, "agent");
      asm volatile("s_waitcnt vmcnt(0)" ::: "memory");
    }
  }
  __syncthreads();
}

__device__ __forceinline__ void lds_barrier() {
  asm volatile("s_waitcnt lgkmcnt(0)" ::: "memory");
  __builtin_amdgcn_s_barrier();
  asm volatile("" ::: "memory");
}

__device__ __forceinline__ int seg_M(int seg) { return seg == 0 ? M0 : M1; }
__device__ __forceinline__ int seg_MP(int seg) { return seg == 0 ? MP0 : M1; }
__device__ __forceinline__ int slot_row0(int seg) { int s = seg % 3; return s == 0 ? 0 : MP0 + (s - 1) * M1; }
__device__ __forceinline__ int gt_row0(int seg) { int s = seg & 3; return s == 0 ? 0 : MP0 + (s - 1) * M1; }
__device__ __forceinline__ const float* row_src(PP pp, int seg, int r) {
  if (seg == 0) {
    if (r < 1056) {
      int b = r >= 528 ? 1 : 0, t = r - b * 528;
      if (t < 16) return p.meta + t * DM;
      return p.x_prompt + ((size_t)b * 8192 + (t - 16)) * DM;
    }
    return p.x_sample + (size_t)(r - 1056) * DM;
  }
  int b = r >> 9, t = r & 511;
  return p.x_prompt + ((size_t)b * 8192 + seg * TS + t) * DM;
}
__device__ __forceinline__ float* row_dst(PP pp, int seg, int r) {
  if (seg == 0) {
    if (r < 1056) {
      int b = r >= 528 ? 1 : 0, t = r - b * 528;
      if (t < 16) return nullptr;
      return (p.out + OO_y_prompt) + ((size_t)b * 8192 + (t - 16)) * DM;
    }
    return (p.out + OO_y_sample) + (size_t)(r - 1056) * DM;
  }
  int b = r >> 9, t = r & 511;
  return (p.out + OO_y_prompt) + ((size_t)b * 8192 + seg * TS + t) * DM;
}
__device__ __forceinline__ void row_seq(int seg, int r, int& seq, int& t, int& len) {
  if (seg == 0) {
    if (r < 528) { seq = 0; t = r; len = 528; }
    else if (r < 1056) { seq = 1; t = r - 528; len = 528; }
    else { seq = 2 + ((r - 1056) >> 4); t = (r - 1056) & 15; len = 16; }
  } else { seq = r >> 9; t = r & 511; len = TS; }
}

__device__ __forceinline__ int vcol_src(int n) {
  if (n < 3200) return n;
  if (n < 6288) return n + 1024;
  if (n < 6400) return -1;
  if (n < 7424) return n - 3200;
  return n - 112;
}
__device__ __forceinline__ void transpose_tile(const float* __restrict__ src, int ld, bool remap, bf16_t* __restrict__ dst, int k0, int n0,
                               float* tile  ) {
  int tid = tid_l();
  int i = tid >> 4, j = tid & 15;
  __syncthreads();
  int n = n0 + 4 * j;
  int sc = remap ? vcol_src(n) : n;
#pragma unroll
  for (int pass = 0; pass < 4; pass++) {
    int k = pass * 16 + i;
    float4 v = make_float4(0.f, 0.f, 0.f, 0.f);
    if (sc >= 0) v = *(const float4*)(src + (size_t)(k0 + k) * ld + sc);
    tile[k * 65 + 4 * j + 0] = v.x; tile[k * 65 + 4 * j + 1] = v.y; tile[k * 65 + 4 * j + 2] = v.z; tile[k * 65 + 4 * j + 3] = v.w;
  }
  __syncthreads();
  int nn = tid >> 2, kq = tid & 3;
  uint32_t o[8];
#pragma unroll
  for (int e = 0; e < 8; e++) o[e] = pack2(tile[(kq * 16 + 2 * e) * 65 + nn], tile[(kq * 16 + 2 * e + 1) * 65 + nn]);
  u32x4* d = (u32x4*)(dst + (size_t)(n0 + nn) * DM + k0 + kq * 16);
  d[0] = (u32x4){o[0], o[1], o[2], o[3]};
  d[1] = (u32x4){o[4], o[5], o[6], o[7]};
}
__device__ __forceinline__ void phase_weights(PP pp, int bid, int nb, char* smem) {
  LAUNDER_PP;
  float* tile = (float*)smem;
  const int nIn = 16 * (VW / 64);
  const int nSq = 16 * 16;
  for (int it = bid; it < nIn + 3 * nSq; it += nb) {
    if (it < nIn) {
      int kt = it & 15, nt = it >> 4;
      transpose_tile(p.w_in, PW, true, ((bf16_t*)(p.ws + OW_WtIn)), kt * 64, nt * 64, tile);
    } else {
      int j = it - nIn, w = j / nSq, r = j % nSq;
      int kt = r & 15, nt = r >> 4;
      const float* src = w == 0 ? p.w_out_a : (w == 1 ? p.w_out_b : p.w_out);
      bf16_t* dst = w == 0 ? ((bf16_t*)(p.ws + OW_WtA)) : (w == 1 ? ((bf16_t*)(p.ws + OW_WtB)) : ((bf16_t*)(p.ws + OW_WtO)));
      transpose_tile(src, DM, false, dst, kt * 64, nt * 64, tile);
    }
  }
}

__device__ __forceinline__ void xn_item(PP pp, int seg, int item) {
  LAUNDER_PP;
  int wave = tid_l() >> 6, lane = tid_l() & 63;
  int M = seg_M(seg);
  int r = item * 4 + wave;
  bf16_t* o = ((bf16_t*)(p.ws + OW_XN)) + (size_t)r * DM;
  if (r >= M) {
#pragma unroll
    for (int i = 0; i < 4; i++) *(uint2*)(o + (lane + 64 * i) * 4) = make_uint2(0u, 0u);
    return;
  }
  const float4* src = (const float4*)row_src(pp, seg, r);
  float4 v[4];
  float ss = 0.f;
#pragma unroll
  for (int i = 0; i < 4; i++) {
    v[i] = src[lane + 64 * i];
    ss += v[i].x * v[i].x + v[i].y * v[i].y + v[i].z * v[i].z + v[i].w * v[i].w;
  }
  ss = wavesum(ss);
  float rstd = rsqrtf(ss * (1.0f / DM) + 1e-6f);
#pragma unroll
  for (int i = 0; i < 4; i++) {
    float4 g = ((const float4*)p.norm_pre)[lane + 64 * i];
    *(uint2*)(o + (lane + 64 * i) * 4) =
        make_uint2(pack2(v[i].x * rstd * g.x, v[i].y * rstd * g.y), pack2(v[i].z * rstd * g.z, v[i].w * rstd * g.w));
  }
}

__device__ __forceinline__ void norm_item(PP pp, int seg, int item) {
  LAUNDER_PP;
  int wave = tid_l() >> 6, lane = tid_l() & 63;
  int r = item * 4 + wave;
  float* dst = row_dst(pp, seg, r);
  if (!dst) return;
  const float4* h = (const float4*)row_src(pp, seg, r);
  const float4* o = (const float4*)(((float*)(p.ws + OW_OUTB)) + ((size_t)(seg & 1) * MP0 + r) * DM);
  float4 v[4];
  float ss = 0.f;
#pragma unroll
  for (int i = 0; i < 4; i++) {
    v[i] = o[lane + 64 * i];
    ss += v[i].x * v[i].x + v[i].y * v[i].y + v[i].z * v[i].z + v[i].w * v[i].w;
  }
  ss = wavesum(ss);
  float rstd = rsqrtf(ss * (1.0f / DM) + 1e-6f);
#pragma unroll
  for (int i = 0; i < 4; i++) {
    float4 g = ((const float4*)p.norm_post)[lane + 64 * i];
    float4 hh = h[lane + 64 * i];
    ((float4*)dst)[lane + 64 * i] =
        make_float4(hh.x + v[i].x * rstd * g.x, hh.y + v[i].y * rstd * g.y, hh.z + v[i].z * rstd * g.z, hh.w + v[i].w * rstd * g.w);
  }
}

__device__ __forceinline__ void merge_item(PP pp, int item) {
  LAUNDER_PP;
  const int tid = tid_l();
  const int wave = tid >> 6, lane = tid & 63;
  const int r = item * 4 + wave;
  const float4* t1 = (const float4*)((const float*)(p.ws + OW_TMP) + (size_t)r * DM);
  const float4* t2 = (const float4*)((const float*)(p.ws + OW_TMP) + ((size_t)MP0 + r) * DM);
  bf16_t* o = (bf16_t*)(p.ws + OW_MG) + (size_t)r * DM;
#pragma unroll
  for (int i = 0; i < 4; i++) {
    float4 a = t1[lane + 64 * i], b = t2[lane + 64 * i];
    *(uint2*)(o + (lane + 64 * i) * 4) = make_uint2(pack2(a.x + b.x, a.y + b.y), pack2(a.z + b.z, a.w + b.w));
  }
}

#define LDT 32
template <int MODE>
__device__ __forceinline__ void gemm_tile(PP pp, int seg, int tm, int tn, char* smem) {
  LAUNDER_PP;
  const int tid = tid_l(), lane = tid & 63, wid = tid >> 6;
  const int wr = wid >> 1, wc = wid & 1, l31 = lane & 31, lh = lane >> 5;
  const int lrow = tid >> 2, lkc = tid & 3;
  const int m0 = tm * 128, n0 = tn * 128;
  bf16_t* GTs = ((bf16_t*)(p.ws + OW_GT)) + (size_t)gt_row0(seg) * GTW;
  f32x16 acc[2][2];
#pragma unroll
  for (int a = 0; a < 2; a++)
#pragma unroll
    for (int b = 0; b < 2; b++)
#pragma unroll
      for (int e = 0; e < 16; e++) acc[a][b][e] = 0.f;
  {
    const bf16_t* A = (MODE == 0) ? (const bf16_t*)(p.ws + OW_XN)
                    : (MODE == 1) ? (const bf16_t*)(p.ws + OW_YA) + (size_t)(seg & 1) * MP0 * DM
                    : (MODE == 3) ? (const bf16_t*)(p.ws + OW_YB) + (size_t)(seg & 1) * MP0 * DM
                                  : (const bf16_t*)(p.ws + OW_MG);
    const bf16_t* Bt = (const bf16_t*)(p.ws + (MODE == 0 ? OW_WtIn : (MODE == 1 ? OW_WtA : (MODE == 3 ? OW_WtB : OW_WtO))));
    u32x4 ra[2], rb[2];
    const bf16_t* gA = A + (size_t)(m0 + lrow) * DM + lkc * 8;
    const bf16_t* gB = Bt + (size_t)(n0 + lrow) * DM + lkc * 8;
    const int wofs = lrow * 64 + ((lkc ^ ((lrow >> 2) & 3)) << 4);
    const int sw = (l31 >> 2) & 3;
    const int rofs0 = l31 * 64 + (((0 + lh) ^ sw) << 4);
    const int rofs1 = l31 * 64 + (((2 + lh) ^ sw) << 4);
    __syncthreads();
#pragma unroll
    for (int i = 0; i < 2; i++) {
      ra[i] = *(const u32x4*)(gA + (size_t)i * 64 * DM);
      rb[i] = *(const u32x4*)(gB + (size_t)i * 64 * DM);
    }
#pragma unroll
    for (int i = 0; i < 2; i++) {
      *(u32x4*)(smem + wofs + i * 4096) = ra[i];
      *(u32x4*)(smem + 8192 + wofs + i * 4096) = rb[i];
    }
#pragma unroll
    for (int i = 0; i < 2; i++) {
      ra[i] = *(const u32x4*)(gA + (size_t)i * 64 * DM + 32);
      rb[i] = *(const u32x4*)(gB + (size_t)i * 64 * DM + 32);
    }
    lds_barrier();
#pragma unroll 1
    for (int kt = 0; kt < 32; kt++) {
      const char* cA = smem + (kt & 1) * 16384 + wr * 4096;
      const char* cB = smem + (kt & 1) * 16384 + 8192 + wc * 4096;
#pragma unroll
      for (int ks = 0; ks < 2; ks++) {
        const int ro = ks ? rofs1 : rofs0;
        const bf16x8 x0 = *(const bf16x8*)(cA + ro), x1 = *(const bf16x8*)(cA + 2048 + ro);
        const bf16x8 w0 = *(const bf16x8*)(cB + ro), w1 = *(const bf16x8*)(cB + 2048 + ro);
        acc[0][0] = __builtin_amdgcn_mfma_f32_32x32x16_bf16(w0, x0, acc[0][0], 0, 0, 0);
        acc[0][1] = __builtin_amdgcn_mfma_f32_32x32x16_bf16(w0, x1, acc[0][1], 0, 0, 0);
        acc[1][0] = __builtin_amdgcn_mfma_f32_32x32x16_bf16(w1, x0, acc[1][0], 0, 0, 0);
        acc[1][1] = __builtin_amdgcn_mfma_f32_32x32x16_bf16(w1, x1, acc[1][1], 0, 0, 0);
      }
      if (kt + 1 < 32) {
        char* nx = smem + ((kt + 1) & 1) * 16384;
#pragma unroll
        for (int i = 0; i < 2; i++) {
          *(u32x4*)(nx + wofs + i * 4096) = ra[i];
          *(u32x4*)(nx + 8192 + wofs + i * 4096) = rb[i];
        }
        if (kt + 2 < 32) {
#pragma unroll
          for (int i = 0; i < 2; i++) {
            ra[i] = *(const u32x4*)(gA + (size_t)i * 64 * DM + (kt + 2) * 32);
            rb[i] = *(const u32x4*)(gB + (size_t)i * 64 * DM + (kt + 2) * 32);
          }
        }
      }
      lds_barrier();
    }
  }
  float* OUTBp = (MODE == 2) ? (float*)(p.ws + OW_OUTB) + (size_t)(seg & 1) * MP0 * DM
                             : (float*)(p.ws + OW_TMP) + (size_t)(MODE == 3 ? 1 : 0) * MP0 * DM;
#pragma unroll
  for (int ni = 0; ni < 2; ni++)
#pragma unroll
    for (int mi = 0; mi < 2; mi++)
#pragma unroll
      for (int g = 0; g < 4; g++) {
        const int m = m0 + wr * 64 + mi * 32 + l31;
        const int n = n0 + wc * 64 + ni * 32 + 8 * g + 4 * lh;
        const float c0 = acc[ni][mi][4 * g], c1 = acc[ni][mi][4 * g + 1], c2 = acc[ni][mi][4 * g + 2], c3 = acc[ni][mi][4 * g + 3];
        if (MODE == 0) {
          uint2 o = make_uint2(pack2(c0, c1), pack2(c2, c3));
          if (tn < PJW / 128) *(uint2*)(((bf16_t*)(p.ws + OW_PJA)) + (size_t)m * PJW + n) = o;
          else *(uint2*)(GTs + (size_t)m * GTW + (n - PJW)) = o;
        } else if (MODE == 1 || MODE == 3) {
          uint2 ga = *(const uint2*)(GTs + (size_t)m * GTW + (MODE == 1 ? G_MA : G_MB) + n);
          *(float4*)(OUTBp + (size_t)m * DM + n) =
              make_float4(sigmoidf_(bf2f(ga.x & 0xffff)) * c0, sigmoidf_(bf2f(ga.x >> 16)) * c1,
                          sigmoidf_(bf2f(ga.y & 0xffff)) * c2, sigmoidf_(bf2f(ga.y >> 16)) * c3);
        } else {
          *(float4*)(OUTBp + (size_t)m * DM + n) = make_float4(c0, c1, c2, c3);
        }
      }
}

__device__ __forceinline__ void rw_prepass_item(PP pp, int seg, int grp, int slab, char* smem) {
  LAUNDER_PP;
  float* lwa = (float*)smem;
  const int tid = tid_l();
  const int r0 = grp * 8;
  int seq, t0, len;
  row_seq(seg, r0, seq, t0, len);
  const bool prompt = seq < 2;
  const float* prev0 = nullptr;
  if (t0 == 0) {
    if (seg == 0) prev0 = prompt ? nullptr : p.st_shift + (size_t)(seq - 2) * 3200;
    else prev0 = ((float*)(p.ws + OW_CSH)) + ((size_t)(seg & 1) * 2 + seq) * 3200;
  }
  __syncthreads();
  {
    const int j = tid & 127;
    const float mu = p.rw_mu[3072 + j];
#pragma unroll
    for (int i = 0; i < 4; i++) {
      int tok = (tid >> 7) + 2 * i;
      int row = r0 + tok;
      float ps = bf2f(((bf16_t*)(p.ws + OW_PJA))[(size_t)row * PJW + 3072 + j]);
      float pv;
      if (tok == 0 && t0 == 0) pv = prev0 ? prev0[3072 + j] : 0.f;
      else pv = bf2f(((bf16_t*)(p.ws + OW_PJA))[(size_t)(row - 1) * PJW + 3072 + j]);
      float xs = ps + mu * (pv - ps);
      lwa[tok * 128 + j] = j < 64 ? tanhf(xs) : xs;
      if (slab == 0 && t0 + tok == len - 1) {
        if (prompt) {
          ((float*)(p.ws + OW_CSH))[((size_t)((seg + 1) & 1) * 2 + seq) * 3200 + 3072 + j] = ps;
          if (seg == NSEG - 1) (p.out + OO_p_shift)[(size_t)seq * 3200 + 3072 + j] = ps;
        } else {
          (p.out + OO_s_shift)[(size_t)(seq - 2) * 3200 + 3072 + j] = ps;
        }
      }
    }
  }
  __syncthreads();
  const int c = slab * 256 + tid;
  float dw[8], da[8];
  {
    const float w0 = p.rw_w0[c], a0 = p.rw_a0[c];
#pragma unroll
    for (int t = 0; t < 8; t++) { dw[t] = w0; da[t] = a0; }
  }
  for (int j = 0; j < 64; j += 4) {
    float w2v[4], a2v[4];
#pragma unroll
    for (int e = 0; e < 4; e++) {
      w2v[e] = p.rw_w2[(size_t)(j + e) * DM + c];
      a2v[e] = p.rw_a2[(size_t)(j + e) * DM + c];
    }
#pragma unroll
    for (int t = 0; t < 8; t++) {
      float4 lw = *(const float4*)(lwa + t * 128 + j);
      float4 la = *(const float4*)(lwa + t * 128 + 64 + j);
      dw[t] += lw.x * w2v[0] + lw.y * w2v[1] + lw.z * w2v[2] + lw.w * w2v[3];
      da[t] += la.x * a2v[0] + la.y * a2v[1] + la.z * a2v[2] + la.w * a2v[3];
    }
  }
  const float mur = p.rw_mu[c], muk = p.rw_mu[1024 + c], muv = p.rw_mu[2048 + c];
  const float kk_w = p.rw_k_k[c], ka_w = p.rw_k_a[c], rk_w = p.rw_r_k[c];
  float pr, pk, pv;
  if (t0 == 0) {
    pr = prev0 ? prev0[c] : 0.f; pk = prev0 ? prev0[1024 + c] : 0.f; pv = prev0 ? prev0[2048 + c] : 0.f;
  } else {
    const bf16_t* q = ((bf16_t*)(p.ws + OW_PJA)) + (size_t)(r0 - 1) * PJW;
    pr = bf2f(q[c]); pk = bf2f(q[1024 + c]); pv = bf2f(q[2048 + c]);
  }
  const int head = c >> 6, e = c & 63;
  const int srow0 = slot_row0(seg);
  char* rws = ((char*)(p.ws + OW_RWS)) + ((size_t)(srow0 + r0) * 16 + head) * 1024;
  float* rwb = ((float*)(p.ws + OW_RWB)) + (size_t)(srow0 + r0) * 16 + head;
#pragma unroll
  for (int t = 0; t < 8; t++) {
    const int row = r0 + t;
    const bf16_t* q = ((bf16_t*)(p.ws + OW_PJA)) + (size_t)row * PJW;
    float cr = bf2f(q[c]), ck = bf2f(q[1024 + c]), cv = bf2f(q[2048 + c]);
    float xr = cr + mur * (pr - cr), xk = ck + muk * (pk - ck), xv = cv + muv * (pv - cv);
    pr = cr; pk = ck; pv = cv;
    float w_log = -softplusf_(-dw[t]) - 0.5f;
    float decay = __expf(-__expf(w_log));
    float a = sigmoidf_(da[t]);
    float kkr = xk * kk_w;
    float ss = wavesum(kkr * kkr);
    float kk = kkr * rsqrtf(ss + 1e-6f);
    float k2 = xk * (1.0f + (a - 1.0f) * ka_w);
    float bon = wavesum(xr * k2 * rk_w);
    char* o = rws + (size_t)t * RWS_ROWB;
    ((f16*)o)[e] = (f16)xr;
    ((f16*)(o + 128))[e] = (f16)k2;
    ((f16*)(o + 256))[e] = (f16)(-kk);
    ((f16*)(o + 384))[e] = (f16)(kk * a);
    ((float*)(o + 512))[e] = decay;
    ((float*)(o + 768))[e] = xv;
    if ((tid & 63) == 0) rwb[(size_t)t * 16] = bon;
    if (t0 + t == len - 1) {
      if (prompt) {
        float* cs = ((float*)(p.ws + OW_CSH)) + ((size_t)((seg + 1) & 1) * 2 + seq) * 3200;
        cs[c] = cr; cs[1024 + c] = ck; cs[2048 + c] = cv;
        if (seg == NSEG - 1) {
          float* ps = (p.out + OO_p_shift) + (size_t)seq * 3200;
          ps[c] = cr; ps[1024 + c] = ck; ps[2048 + c] = cv;
        }
      } else {
        float* ps = (p.out + OO_s_shift) + (size_t)(seq - 2) * 3200;
        ps[c] = cr; ps[1024 + c] = ck; ps[2048 + c] = cv;
      }
    }
  }
}

__device__ __forceinline__ void gd_prepass_item(PP pp, int seg, int grp, int slab) {
  LAUNDER_PP;
  const int tid = tid_l();
  const int r0 = grp * 16;
  int seq, t0, len;
  row_seq(seg, r0, seq, t0, len);
  const bool prompt = seq < 2;
  const int c = slab * 512 + 2 * tid;
  const int kind = slab >> 1;
  const int head = (c & 1023) >> 7, e = c & 127;
  float2 x0, x1, x2;
  if (t0 == 0) {
    const float* cp = nullptr;
    if (seg == 0) cp = prompt ? nullptr : p.st_conv + (size_t)(seq - 2) * 3 * 3072;
    else cp = ((float*)(p.ws + OW_CCV)) + ((size_t)(seg & 1) * 2 + seq) * 3 * 3072;
    if (cp) {
      x0 = *(const float2*)(cp + c); x1 = *(const float2*)(cp + 3072 + c); x2 = *(const float2*)(cp + 6144 + c);
    } else {
      x0 = x1 = x2 = make_float2(0.f, 0.f);
    }
  } else {
    uint32_t u0 = *(const uint32_t*)(((bf16_t*)(p.ws + OW_PJA)) + (size_t)(r0 - 3) * PJW + C_GDC + c);
    uint32_t u1 = *(const uint32_t*)(((bf16_t*)(p.ws + OW_PJA)) + (size_t)(r0 - 2) * PJW + C_GDC + c);
    uint32_t u2 = *(const uint32_t*)(((bf16_t*)(p.ws + OW_PJA)) + (size_t)(r0 - 1) * PJW + C_GDC + c);
    x0 = make_float2(bf2f(u0 & 0xffff), bf2f(u0 >> 16));
    x1 = make_float2(bf2f(u1 & 0xffff), bf2f(u1 >> 16));
    x2 = make_float2(bf2f(u2 & 0xffff), bf2f(u2 >> 16));
  }
  const float2 w0 = *(const float2*)(p.gd_conv_w + c), w1 = *(const float2*)(p.gd_conv_w + 3072 + c),
               w2 = *(const float2*)(p.gd_conv_w + 6144 + c), w3 = *(const float2*)(p.gd_conv_w + 9216 + c);
  const float a_exp = __expf(p.gd_a_log[head]);
  const float dtb = p.gd_dt_bias[head];
  char* gds = ((char*)(p.ws + OW_GDS)) + ((size_t)(slot_row0(seg) + r0) * 8 + head) * GDS_HB;
#pragma unroll 4
  for (int t = 0; t < 16; t++) {
    const int row = r0 + t;
    uint32_t u = *(const uint32_t*)(((bf16_t*)(p.ws + OW_PJA)) + (size_t)row * PJW + C_GDC + c);
    float2 x3 = make_float2(bf2f(u & 0xffff), bf2f(u >> 16));
    float cx = w0.x * x0.x + w1.x * x1.x + w2.x * x2.x + w3.x * x3.x;
    float cy = w0.y * x0.y + w1.y * x1.y + w2.y * x2.y + w3.y * x3.y;
    x0 = x1; x1 = x2; x2 = x3;
    float ax = siluf_(cx), ay = siluf_(cy);
    float sc = 1.0f;
    if (kind < 2) {
      float ss = wavesum(ax * ax + ay * ay);
      sc = rsqrtf(ss + 1e-6f);
      if (kind == 0) sc *= 0.08838834764831845f;
    }
    if (kind >= 1) {
      float beta = sigmoidf_(bf2f(((bf16_t*)(p.ws + OW_PJA))[(size_t)row * PJW + C_BETA + head]));
      sc *= sqrtf(beta);
    }
    ax *= sc; ay *= sc;
    char* o = gds + (size_t)t * GDS_ROWB;
    f16x2 hv = {(f16)ax, (f16)ay};
    *(f16x2*)(o + kind * 256 + e * 2) = hv;
    if (kind == 0 && (tid & 63) == 0) {
      float g = -a_exp * softplusf_(bf2f(((bf16_t*)(p.ws + OW_PJA))[(size_t)row * PJW + C_ALPHA + head]) + dtb);
      *(float*)(o + 768) = __expf(g);
    }
    int jj = t0 + t - (len - 3);
    if (jj >= 0) {
      if (prompt) {
        *(float2*)(((float*)(p.ws + OW_CCV)) + (((size_t)((seg + 1) & 1) * 2 + seq) * 3 + jj) * 3072 + c) = x3;
        if (seg == NSEG - 1) *(float2*)((p.out + OO_p_conv) + ((size_t)seq * 3 + jj) * 3072 + c) = x3;
      } else {
        *(float2*)((p.out + OO_s_conv) + ((size_t)(seq - 2) * 3 + jj) * 3072 + c) = x3;
      }
    }
  }
}


using u32x2 = __attribute__((ext_vector_type(2))) unsigned int;
__device__ __forceinline__ float fmix_lo(unsigned h, float b, float c) {
  float d;
  asm("v_fma_mix_f32 %0, %1, %2, %3 op_sel_hi:[1,0,0]" : "=v"(d) : "v"(h), "v"(b), "v"(c));
  return d;
}
__device__ __forceinline__ float fmix_hi(unsigned h, float b, float c) {
  float d;
  asm("v_fma_mix_f32 %0, %1, %2, %3 op_sel:[1,0,0] op_sel_hi:[1,0,0]" : "=v"(d) : "v"(h), "v"(b), "v"(c));
  return d;
}
__device__ __forceinline__ float vmul1(float a, float b) {
  float d;
  asm("v_mul_f32 %0, %1, %2" : "=v"(d) : "v"(a), "v"(b));
  return d;
}
struct RwOps { f16x4 r, k, a, b; float4 w; float vv; };
__device__ __forceinline__ RwOps rw_ld(const char* Ls, int q, int v) {
  RwOps o;
  o.r = *(const f16x4*)(Ls + q * 8);
  o.k = *(const f16x4*)(Ls + 128 + q * 8);
  o.a = *(const f16x4*)(Ls + 256 + q * 8);
  o.b = *(const f16x4*)(Ls + 384 + q * 8);
  o.w = *(const float4*)(Ls + 512 + q * 16);
  o.vv = *(const float*)(Ls + 768 + v * 4);
  return o;
}
__device__ __forceinline__ float rw_step(const RwOps& o, float4& S) {
  const u32x2 rw = __builtin_bit_cast(u32x2, o.r), kw = __builtin_bit_cast(u32x2, o.k),
              aw = __builtin_bit_cast(u32x2, o.a), bw = __builtin_bit_cast(u32x2, o.b);
  const float z = 0.f;
  float sa0 = fmix_lo(aw[0], S.x, z);
  float sa1 = fmix_lo(aw[1], S.z, z);
  sa0 = fmix_hi(aw[0], S.y, sa0);
  sa1 = fmix_hi(aw[1], S.w, sa1);
  float t0 = vmul1(S.x, o.w.x), t1 = vmul1(S.y, o.w.y), t2 = vmul1(S.z, o.w.z), t3 = vmul1(S.w, o.w.w);
  t0 = fmix_lo(kw[0], o.vv, t0);
  t1 = fmix_hi(kw[0], o.vv, t1);
  t2 = fmix_lo(kw[1], o.vv, t2);
  t3 = fmix_hi(kw[1], o.vv, t3);
  const float sa = rowsum16(sa0 + sa1);
  S.x = fmix_lo(bw[0], sa, t0);
  S.y = fmix_hi(bw[0], sa, t1);
  S.z = fmix_lo(bw[1], sa, t2);
  S.w = fmix_hi(bw[1], sa, t3);
  float y0 = fmix_lo(rw[0], S.x, z);
  float y1 = fmix_lo(rw[1], S.z, z);
  y0 = fmix_hi(rw[0], S.y, y0);
  y1 = fmix_hi(rw[1], S.w, y1);
  return rowsum16(y0 + y1);
}
__device__ __forceinline__ void rw_scan_run(const char* __restrict__ gsrc  , int len, float4& S,
                            float* __restrict__ yo  , int q, int v, char* smem) {
  const int tid = tid_l();
  const int nch = len >> 4;
  const int lstep = tid >> 6, loff = (tid & 63) * 16;
  u32x4 st[4];
#pragma unroll
  for (int i = 0; i < 4; i++) st[i] = *(const u32x4*)(gsrc + (size_t)(lstep + 4 * i) * RWS_ROWB + loff);
  __syncthreads();
#pragma unroll
  for (int i = 0; i < 4; i++) *(u32x4*)(smem + (lstep + 4 * i) * 1024 + loff) = st[i];
  u32x4 st2[4];
#pragma unroll
  for (int i = 0; i < 4; i++) st2[i] = st[i];
  if (nch > 1) {
#pragma unroll
    for (int i = 0; i < 4; i++) st[i] = *(const u32x4*)(gsrc + (size_t)(16 + lstep + 4 * i) * RWS_ROWB + loff);
  }
  if (nch > 2) {
#pragma unroll
    for (int i = 0; i < 4; i++) st2[i] = *(const u32x4*)(gsrc + (size_t)(32 + lstep + 4 * i) * RWS_ROWB + loff);
  }
  __syncthreads();
  for (int c = 0; c < nch; c++) {
    const char* L = smem + (c & 1) * 16384;
    float ykeep = 0.f;
    RwOps oa = rw_ld(L, q, v);
#pragma unroll 1
    for (int t = 0; t < 16; t += 2) {
      const RwOps ob = rw_ld(L + (t + 1) * 1024, q, v);
      asm volatile("" ::: "memory");
      const float ya = rw_step(oa, S);
      ykeep = (q == t) ? ya : ykeep;
      oa = rw_ld(L + ((t + 2) & 15) * 1024, q, v);
      asm volatile("" ::: "memory");
      const float yb = rw_step(ob, S);
      ykeep = (q == t + 1) ? yb : ykeep;
    }
    yo[(size_t)(c * 16 + q) * DM] = ykeep;
    if (c + 1 < nch) {
      char* Ln = smem + ((c + 1) & 1) * 16384;
#pragma unroll
      for (int i = 0; i < 4; i++) *(u32x4*)(Ln + (lstep + 4 * i) * 1024 + loff) = st[i];
#pragma unroll
      for (int i = 0; i < 4; i++) st[i] = st2[i];
      if (c + 3 < nch) {
#pragma unroll
        for (int i = 0; i < 4; i++)
          st2[i] = *(const u32x4*)(gsrc + (size_t)((c + 3) * 16 + lstep + 4 * i) * RWS_ROWB + loff);
      }
    }
    lds_barrier();
  }
}

struct GdOps { f16x8 qv, kv; float vv, eg; };
__device__ __forceinline__ GdOps gd_ld(const char* Ls, int q, int cl) {
  GdOps o;
  o.kv = *(const f16x8*)(Ls + 256 + q * 16);
  o.vv = (float)*(const f16*)(Ls + 512 + cl * 2);
  o.eg = *(const float*)(Ls + 768);
  o.qv = *(const f16x8*)(Ls + q * 16);
  return o;
}
__device__ __forceinline__ float gd_step(const GdOps& o, float (&s)[8]) {
  const u32x4 kw = __builtin_bit_cast(u32x4, o.kv), qw = __builtin_bit_cast(u32x4, o.qv);
  const float z = 0.f;
  float a0 = fmix_lo(kw[0], s[0], z);
  float a1 = fmix_lo(kw[2], s[4], z);
  a0 = fmix_hi(kw[0], s[1], a0);
  a1 = fmix_hi(kw[2], s[5], a1);
  a0 = fmix_lo(kw[1], s[2], a0);
  a1 = fmix_lo(kw[3], s[6], a1);
  a0 = fmix_hi(kw[1], s[3], a0);
  a1 = fmix_hi(kw[3], s[7], a1);
  float es[8];
#pragma unroll
  for (int i = 0; i < 8; i++) es[i] = vmul1(o.eg, s[i]);
  const float ks = rowsum16(a0 + a1);
  const float d = fmaf(-o.eg, ks, o.vv);
  s[0] = fmix_lo(kw[0], d, es[0]); s[1] = fmix_hi(kw[0], d, es[1]);
  s[2] = fmix_lo(kw[1], d, es[2]); s[3] = fmix_hi(kw[1], d, es[3]);
  s[4] = fmix_lo(kw[2], d, es[4]); s[5] = fmix_hi(kw[2], d, es[5]);
  s[6] = fmix_lo(kw[3], d, es[6]); s[7] = fmix_hi(kw[3], d, es[7]);
  float o0 = fmix_lo(qw[0], s[0], z);
  float o1 = fmix_lo(qw[2], s[4], z);
  o0 = fmix_hi(qw[0], s[1], o0);
  o1 = fmix_hi(qw[2], s[5], o1);
  o0 = fmix_lo(qw[1], s[2], o0);
  o1 = fmix_lo(qw[3], s[6], o1);
  o0 = fmix_hi(qw[1], s[3], o0);
  o1 = fmix_hi(qw[3], s[7], o1);
  return rowsum16(o0 + o1);
}
__device__ __forceinline__ void gd_scan_run(const char* __restrict__ gsrc  , int len, float (&s)[8],
                            float* __restrict__ oo  , int q, int cl, char* smem) {
  const int tid = tid_l();
  const int nch = len >> 4;
  u32x4 st[4];
  int lt[4], lo[4];
#pragma unroll
  for (int i = 0; i < 4; i++) {
    int id = tid + 256 * i;
    if (id > 783) id = 783;
    lt[i] = id / 49;
    lo[i] = (id % 49) * 16;
  }
#pragma unroll
  for (int i = 0; i < 4; i++) st[i] = *(const u32x4*)(gsrc + (size_t)lt[i] * GDS_ROWB + lo[i]);
  __syncthreads();
#pragma unroll
  for (int i = 0; i < 4; i++) *(u32x4*)(smem + lt[i] * GDS_HB + lo[i]) = st[i];
  u32x4 st2[4];
#pragma unroll
  for (int i = 0; i < 4; i++) st2[i] = st[i];
  if (nch > 1) {
#pragma unroll
    for (int i = 0; i < 4; i++) st[i] = *(const u32x4*)(gsrc + (size_t)(16 + lt[i]) * GDS_ROWB + lo[i]);
  }
  if (nch > 2) {
#pragma unroll
    for (int i = 0; i < 4; i++) st2[i] = *(const u32x4*)(gsrc + (size_t)(32 + lt[i]) * GDS_ROWB + lo[i]);
  }
  __syncthreads();
  for (int c = 0; c < nch; c++) {
    const char* L = smem + (c & 1) * 16384;
    float okeep = 0.f;
    GdOps oa = gd_ld(L, q, cl);
#pragma unroll 1
    for (int t = 0; t < 16; t += 2) {
      const GdOps ob = gd_ld(L + (t + 1) * GDS_HB, q, cl);
      asm volatile("" ::: "memory");
      const float ya = gd_step(oa, s);
      okeep = (q == t) ? ya : okeep;
      oa = gd_ld(L + ((t + 2) & 15) * GDS_HB, q, cl);
      asm volatile("" ::: "memory");
      const float yb = gd_step(ob, s);
      okeep = (q == t + 1) ? yb : okeep;
    }
    oo[(size_t)(c * 16 + q) * DM] = okeep;
    if (c + 1 < nch) {
      char* Ln = smem + ((c + 1) & 1) * 16384;
#pragma unroll
      for (int i = 0; i < 4; i++) *(u32x4*)(Ln + lt[i] * GDS_HB + lo[i]) = st[i];
#pragma unroll
      for (int i = 0; i < 4; i++) st[i] = st2[i];
      if (c + 3 < nch) {
#pragma unroll
        for (int i = 0; i < 4; i++) st2[i] = *(const u32x4*)(gsrc + (size_t)((c + 3) * 16 + lt[i]) * GDS_ROWB + lo[i]);
      }
    }
    lds_barrier();
  }
}

__device__ __forceinline__ void sample_scan_task(PP pp, int task, char* smem) {
  LAUNDER_PP;
  const int sj = task >> 7, j = task & 127, kind = j >> 6, jj = j & 63;
  const int tid = tid_l(), q = tid & 15;
  const int row0 = 1056 + sj * 16;
  if (kind == 0) {
    const int head = jj >> 2, v = (jj & 3) * 16 + (tid >> 4);
    const float* sin = p.st_wkv + ((size_t)sj * 16 + head) * 4096;
    float* sout = (p.out + OO_s_wkv) + ((size_t)sj * 16 + head) * 4096;
    float4 S = *(const float4*)(sin + v * 64 + 4 * q);
    rw_scan_run(((char*)(p.ws + OW_RWS)) + ((size_t)row0 * 16 + head) * 1024, 16, S, ((float*)(p.ws + OW_YRW)) + (size_t)row0 * DM + head * 64 + v, q, v, smem);
    *(float4*)(sout + v * 64 + 4 * q) = S;
  } else {
    const int head = jj >> 3, cl = (jj & 7) * 16 + (tid >> 4);
    const float* sin = p.st_ssm + ((size_t)sj * 8 + head) * 16384;
    float* sout = (p.out + OO_s_ssm) + ((size_t)sj * 8 + head) * 16384;
    float s[8];
#pragma unroll
    for (int i = 0; i < 8; i++) s[i] = sin[(size_t)(8 * q + i) * 128 + cl];
    gd_scan_run(((char*)(p.ws + OW_GDS)) + ((size_t)row0 * 8 + head) * GDS_HB, 16, s, ((float*)(p.ws + OW_OGD)) + (size_t)row0 * DM + head * 128 + cl, q, cl, smem);
#pragma unroll
    for (int i = 0; i < 8; i++) sout[(size_t)(8 * q + i) * 128 + cl] = s[i];
  }
}

__device__ __forceinline__ void scan_block_rw(PP pp, int j, char* smem) {
  LAUNDER_PP;
  const int seq = j >> 6, jj = j & 63;
  const int tid = tid_l(), q = tid & 15;
  const int head = jj >> 2, v = (jj & 3) * 16 + (tid >> 4);
  float4 S = make_float4(0.f, 0.f, 0.f, 0.f);
  for (int seg = 0; seg < NSEG; seg++) {
    wait_ge(((unsigned int*)(p.ws + OW_sync)) + SW_PRE, seg + 1);
    const int len = seg == 0 ? 528 : TS;
    const int row0 = slot_row0(seg) + (seg == 0 ? seq * 528 : seq * TS);
    rw_scan_run(((char*)(p.ws + OW_RWS)) + ((size_t)row0 * 16 + head) * 1024, len, S,
                ((float*)(p.ws + OW_YRW)) + (size_t)row0 * DM + head * 64 + v, q, v, smem);
    signal_add(((unsigned int*)(p.ws + OW_sync)) + SW_SCAN(seg));
  }
  {
    const int tid2 = tid_l(), q2 = tid2 & 15, v2 = (jj & 3) * 16 + (tid2 >> 4);
    *(float4*)((p.out + OO_p_wkv) + ((size_t)seq * 16 + head) * 4096 + v2 * 64 + 4 * q2) = S;
  }
}
__device__ __forceinline__ void scan_block_gd(PP pp, int j, char* smem) {
  LAUNDER_PP;
  const int seq = j >> 6, jj = j & 63;
  const int tid = tid_l(), q = tid & 15;
  const int head = jj >> 3, cl = (jj & 7) * 16 + (tid >> 4);
  float s[8];
#pragma unroll
  for (int i = 0; i < 8; i++) s[i] = 0.f;
  for (int seg = 0; seg < NSEG; seg++) {
    wait_ge(((unsigned int*)(p.ws + OW_sync)) + SW_PRE, seg + 1);
    const int len = seg == 0 ? 528 : TS;
    const int row0 = slot_row0(seg) + (seg == 0 ? seq * 528 : seq * TS);
    gd_scan_run(((char*)(p.ws + OW_GDS)) + ((size_t)row0 * 8 + head) * GDS_HB, len, s,
                ((float*)(p.ws + OW_OGD)) + (size_t)row0 * DM + head * 128 + cl, q, cl, smem);
    signal_add(((unsigned int*)(p.ws + OW_sync)) + SW_SCAN(seg));
  }
  {
    const int tid2 = tid_l(), q2 = tid2 & 15, cl2 = (jj & 7) * 16 + (tid2 >> 4);
    float* sout = (p.out + OO_p_ssm) + ((size_t)seq * 8 + head) * 16384;
#pragma unroll
    for (int i = 0; i < 8; i++) sout[(size_t)(8 * q2 + i) * 128 + cl2] = s[i];
  }
}

__device__ __forceinline__ void post_item(PP pp, int seg, int row) {
  LAUNDER_PP;
  const int tid = tid_l(), c4 = tid * 4;
  const int srow = slot_row0(seg) + row;
  const bf16_t* gt = ((bf16_t*)(p.ws + OW_GT)) + (size_t)(gt_row0(seg) + row) * GTW;
  {
    float4 y = *(const float4*)(((float*)(p.ws + OW_YRW)) + (size_t)srow * DM + c4);
    float mean = rowsum16(y.x + y.y + y.z + y.w) * (1.0f / 64.0f);
    float dx = y.x - mean, dy = y.y - mean, dz = y.z - mean, dw = y.w - mean;
    float var = rowsum16(dx * dx + dy * dy + dz * dz + dw * dw) * (1.0f / 64.0f);
    float rs = rsqrtf(var + 64e-5f);
    float4 lw = *(const float4*)(p.rw_ln_w + c4), lb = *(const float4*)(p.rw_ln_b + c4);
    float bon = ((float*)(p.ws + OW_RWB))[(size_t)srow * 16 + (tid >> 4)];
    float4 v = *(const float4*)(((char*)(p.ws + OW_RWS)) + ((size_t)srow * 16 + (tid >> 4)) * 1024 + 768 + (tid & 15) * 16);
    uint2 g = *(const uint2*)(gt + G_RW + c4);
    float o0 = (dx * rs * lw.x + lb.x + bon * v.x) * siluf_(bf2f(g.x & 0xffff));
    float o1 = (dy * rs * lw.y + lb.y + bon * v.y) * siluf_(bf2f(g.x >> 16));
    float o2 = (dz * rs * lw.z + lb.z + bon * v.z) * siluf_(bf2f(g.y & 0xffff));
    float o3 = (dw * rs * lw.w + lb.w + bon * v.w) * siluf_(bf2f(g.y >> 16));
    *(uint2*)(((bf16_t*)(p.ws + OW_YA)) + ((size_t)(seg & 1) * MP0 + row) * DM + c4) = make_uint2(pack2(o0, o1), pack2(o2, o3));
  }
  {
    float4 o = *(const float4*)(((float*)(p.ws + OW_OGD)) + (size_t)srow * DM + c4);
    float ss = rowsum16(o.x * o.x + o.y * o.y + o.z * o.z + o.w * o.w);
    ss += __shfl_xor(ss, 16);
    float rs = rsqrtf(ss * (1.0f / 128.0f) + 1e-6f);
    float4 nw = *(const float4*)(p.gd_norm_w + (c4 & 127));
    uint2 g = *(const uint2*)(gt + G_GD + c4);
    float o0 = o.x * rs * nw.x * siluf_(bf2f(g.x & 0xffff));
    float o1 = o.y * rs * nw.y * siluf_(bf2f(g.x >> 16));
    float o2 = o.z * rs * nw.z * siluf_(bf2f(g.y & 0xffff));
    float o3 = o.w * rs * nw.w * siluf_(bf2f(g.y >> 16));
    *(uint2*)(((bf16_t*)(p.ws + OW_YB)) + ((size_t)(seg & 1) * MP0 + row) * DM + c4) = make_uint2(pack2(o0, o1), pack2(o2, o3));
  }
}

#define SMEM_BYTES (32768 + 16)

__global__ void __launch_bounds__(256, 4) k_mega(Params p_arg) {
  PP pp = (PP)__builtin_amdgcn_kernarg_segment_ptr();
  __shared__ __attribute__((aligned(16))) char smem[SMEM_BYTES];
  cg::grid_group grid = cg::this_grid();
  const int bid = blockIdx.x, nb = gridDim.x;
  unsigned* sync = (unsigned*)(p.ws + OW_sync);
  const unsigned xcc = xcc_id() & 7u;
  if (bid >= NSCAN && threadIdx.x == 0) xb_add(&sync[SW_XCNT(xcc)], 1u);
  phase_weights(pp, bid, nb, smem);
  for (int it = bid; it < seg_MP(0) / 4; it += nb) xn_item(pp, 0, it);
  grid.sync();
  if (bid < NSCAN) {
    __builtin_amdgcn_s_setprio(3);
    if (bid < 128) scan_block_rw(pp, bid, smem);
    else scan_block_gd(pp, bid - 128, smem);
    return;
  }
  const int w = bid - NSCAN, NW = nb - NSCAN;
  unsigned* cfg = (unsigned*)(smem + 32768);
  if (threadIdx.x == 0) {
    unsigned mine = 0, nx = 0;
#pragma unroll
    for (unsigned j = 0; j < 8; j++) { unsigned c = xb_ld(&sync[SW_XCNT(j)]); nx += c > 0u ? 1u : 0u; mine = (j == xcc) ? c : mine; }
    cfg[0] = mine > 0u ? mine : 1u;
    cfg[1] = nx > 0u ? nx : 1u;
  }
  __syncthreads();
  for (int i = 0; i < NSEG + 5; i++) {
    const int sm = i - 4, snn = i - 5, sj = i - 3, so = i - 4, sp = i - 2;
    const bool front = i < NSEG;
    const bool mrg = sm >= 0 && sm < NSEG, nrm = snn >= 0 && snn < NSEG, back = sj >= 0 && sj < NSEG, outv = so >= 0 && so < NSEG,
               pst = sp >= 0 && sp < NSEG;
    {
      const int tmF = front ? seg_MP(i) / 128 : 1;
      const int nF = front ? tmF * (VW / 128) : 0;
      const int nM = mrg ? seg_MP(sm) / 4 : 0;
      const int nN = nrm ? seg_M(snn) / 4 : 0;
      if ((NW & 7) == 0) {
        const int x = w & 7, per = NW >> 3;
        const int ncol = front ? ((VW / 128 - x + 7) >> 3) : 0;
        for (int j = w >> 3; j < tmF * ncol; j += per) gemm_tile<0>(pp, i, j % tmF, x + 8 * (j / tmF), smem);
        for (int it = w; it < nM + nN; it += NW) {
          if (it < nM) merge_item(pp, it);
          else norm_item(pp, snn, it - nM);
        }
      } else {
        for (int it = w; it < nF + nM + nN; it += NW) {
          int t = it;
          if (t < nF) { gemm_tile<0>(pp, i, t % tmF, t / tmF, smem); continue; }
          t -= nF;
          if (t < nM) { merge_item(pp, t); continue; }
          t -= nM;
          norm_item(pp, snn, t);
        }
      }
      if (i == 1) {
        for (int it = w; it < 32 * 128; it += NW) sample_scan_task(pp, it, smem);
      }
    }
    worker_barrier((unsigned*)(p.ws + OW_sync), (const unsigned*)(smem + 32768));
    {
      const int nB = back ? (seg_MP(sj) / 128) * 8 : 0;
      const int nO = outv ? (seg_MP(so) / 128) * 8 : 0;
      const int nHeavy = 2 * nB + nO;
      const int nHeavyW = nHeavy < NW / 2 ? nHeavy : NW / 2;
      const int NL = NW - nHeavyW;
      const int ngrp = front ? seg_M(i) / 16 : 0;
      const int nRW = ngrp * 8, nGD = ngrp * 6;
      const int nX = (i + 1 < NSEG) ? seg_MP(i + 1) / 4 : 0;
      const int tot = nRW + nGD + nX;
      if (w >= NL) {
        for (int it = w - NL; it < nHeavy; it += nHeavyW) {
          int t = it;
          if (t < nB) { gemm_tile<1>(pp, sj, t >> 3, t & 7, smem); continue; }
          t -= nB;
          if (t < nB) { gemm_tile<3>(pp, sj, t >> 3, t & 7, smem); continue; }
          t -= nB;
          gemm_tile<2>(pp, so, t >> 3, t & 7, smem);
        }
      } else {
        for (int it = w; it < tot; it += NL) {
          int t = it;
          if (t < nRW) { rw_prepass_item(pp, i, t >> 2, t & 3, smem); continue; }
          t -= nRW;
          if (t < nGD) { gd_prepass_item(pp, i, t / 6, t % 6); continue; }
          t -= nGD;
          xn_item(pp, i + 1, t);
        }
      }
      if (pst) {
        wait_ge((unsigned*)(p.ws + OW_sync) + SW_SCAN(sp), NSCAN);
        const int n = seg_M(sp);
        for (int it = w; it < n; it += NW) post_item(pp, sp, it);
      }
    }
    worker_barrier((unsigned*)(p.ws + OW_sync), (const unsigned*)(smem + 32768));
    if (front && w == 0 && threadIdx.x == 0)
      __hip_atomic_store((unsigned*)(p.ws + OW_sync) + SW_PRE, (unsigned)(i + 1), __ATOMIC_RELAXED, __HIP_MEMORY_SCOPE_AGENT);
  }
}

static inline size_t align_up(size_t x) { return (x + 255) & ~(size_t)255; }

#undef p
extern "C" void kernel_launch(void* const* d_in, const int* in_sizes, int n_in, void* d_out, int out_size, void* d_ws,
                              size_t ws_size, hipStream_t stream) {
  Params p{};
  const float* const* in = (const float* const*)d_in;
  p.x_prompt = in[0]; p.x_sample = in[1]; p.st_shift = in[2]; p.st_wkv = in[3]; p.st_conv = in[4]; p.st_ssm = in[5];
  p.meta = in[6]; p.norm_pre = in[7]; p.w_in = in[8]; p.rw_mu = in[9]; p.rw_w0 = in[10]; p.rw_w2 = in[11];
  p.rw_a0 = in[12]; p.rw_a2 = in[13]; p.rw_k_k = in[14]; p.rw_k_a = in[15]; p.rw_r_k = in[16]; p.rw_ln_w = in[17];
  p.rw_ln_b = in[18]; p.gd_conv_w = in[19]; p.gd_a_log = in[20]; p.gd_dt_bias = in[21]; p.gd_norm_w = in[22];
  p.w_out_a = in[23]; p.w_out_b = in[24]; p.w_out = in[25]; p.norm_post = in[26];
  p.out = (float*)d_out;
  p.ws = (char*)d_ws;
  if (OW_END > ws_size) { fprintf(stderr, "workspace too small: need %zu have %zu\n", (size_t)OW_END, ws_size); return; }

  static int grid_blocks = 0;
  if (!grid_blocks) {
    int dev = 0, cus = 0, per_cu = 0;
    (void)hipGetDevice(&dev);
    (void)hipDeviceGetAttribute(&cus, hipDeviceAttributeMultiprocessorCount, dev);
    (void)hipOccupancyMaxActiveBlocksPerMultiprocessor(&per_cu, k_mega, 256, 0);
    if (per_cu > 4) per_cu = 4;
    grid_blocks = cus * per_cu;
  }
  (void)hipMemsetAsync(p.ws + OW_sync, 0, 16384, stream);
  void* args[] = {&p};
  hipError_t e = hipLaunchCooperativeKernel((void*)k_mega, dim3(grid_blocks), dim3(256), args, 0, stream);
  if (e != hipSuccess) fprintf(stderr, "cooperative launch failed: %s (grid %d)\n", hipGetErrorString(e), grid_blocks);
}
```

```cpp
#include <hip/hip_runtime.h>
#include <hip/hip_cooperative_groups.h>
#include <stdint.h>
#include <stdio.h>
namespace cg = cooperative_groups;

typedef unsigned short bf16_t;
typedef _Float16 f16;
using bf16x8 = __attribute__((ext_vector_type(8))) short;
using f32x4 = __attribute__((ext_vector_type(4))) float;
using u32x4 = __attribute__((ext_vector_type(4))) unsigned int;
using f32x16 = __attribute__((ext_vector_type(16))) float;
using f16x2 = __attribute__((ext_vector_type(2))) _Float16;
using f16x4 = __attribute__((ext_vector_type(4))) _Float16;
using f16x8 = __attribute__((ext_vector_type(8))) _Float16;

#define DM 1024
#define PW 10384
#define VW 10496
#define PJW 6400
#define GTW 4096
#define NSEG 16
#define TS 512
#define M0 1568
#define MP0 1664
#define M1 1024
#define SLOT_ROWS 3712
#define GT_ROWS 4736
#define NSCAN 256
#define C_GDC 3200
#define C_BETA 6272
#define C_ALPHA 6280
#define G_RW 0
#define G_GD 1024
#define G_MA 2048
#define G_MB 3072
#define RWS_ROWB 16384
#define GDS_HB 784
#define GDS_ROWB 6272

struct Params {
  const float *x_prompt, *x_sample, *st_shift, *st_wkv, *st_conv, *st_ssm, *meta, *norm_pre, *w_in, *rw_mu, *rw_w0,
      *rw_w2, *rw_a0, *rw_a2, *rw_k_k, *rw_k_a, *rw_r_k, *rw_ln_w, *rw_ln_b, *gd_conv_w, *gd_a_log, *gd_dt_bias,
      *gd_norm_w, *w_out_a, *w_out_b, *w_out, *norm_post;
  float* out;
  char* ws;
};
#define p (PV(pp))
#define GLOBAL_AS __attribute__((address_space(1)))
#define CONST_AS __attribute__((address_space(4)))
struct ParamsG {
  const GLOBAL_AS float *x_prompt, *x_sample, *st_shift, *st_wkv, *st_conv, *st_ssm, *meta, *norm_pre, *w_in, *rw_mu, *rw_w0,
      *rw_w2, *rw_a0, *rw_a2, *rw_k_k, *rw_k_a, *rw_r_k, *rw_ln_w, *rw_ln_b, *gd_conv_w, *gd_a_log, *gd_dt_bias,
      *gd_norm_w, *w_out_a, *w_out_b, *w_out, *norm_post;
  GLOBAL_AS float* out;
  GLOBAL_AS char* ws;
};
typedef const CONST_AS ParamsG* PP;
__device__ __forceinline__ Params PV(PP pp) {
  Params v;
  v.x_prompt = (const float*)pp->x_prompt;
  v.x_sample = (const float*)pp->x_sample;
  v.st_shift = (const float*)pp->st_shift;
  v.st_wkv = (const float*)pp->st_wkv;
  v.st_conv = (const float*)pp->st_conv;
  v.st_ssm = (const float*)pp->st_ssm;
  v.meta = (const float*)pp->meta;
  v.norm_pre = (const float*)pp->norm_pre;
  v.w_in = (const float*)pp->w_in;
  v.rw_mu = (const float*)pp->rw_mu;
  v.rw_w0 = (const float*)pp->rw_w0;
  v.rw_w2 = (const float*)pp->rw_w2;
  v.rw_a0 = (const float*)pp->rw_a0;
  v.rw_a2 = (const float*)pp->rw_a2;
  v.rw_k_k = (const float*)pp->rw_k_k;
  v.rw_k_a = (const float*)pp->rw_k_a;
  v.rw_r_k = (const float*)pp->rw_r_k;
  v.rw_ln_w = (const float*)pp->rw_ln_w;
  v.rw_ln_b = (const float*)pp->rw_ln_b;
  v.gd_conv_w = (const float*)pp->gd_conv_w;
  v.gd_a_log = (const float*)pp->gd_a_log;
  v.gd_dt_bias = (const float*)pp->gd_dt_bias;
  v.gd_norm_w = (const float*)pp->gd_norm_w;
  v.w_out_a = (const float*)pp->w_out_a;
  v.w_out_b = (const float*)pp->w_out_b;
  v.w_out = (const float*)pp->w_out;
  v.norm_post = (const float*)pp->norm_post;
  v.out = (float*)pp->out;
  v.ws = (char*)pp->ws;
  return v;
}
constexpr size_t al256(size_t x) { return (x + 255) & ~(size_t)255; }
constexpr size_t OO_y_prompt = 0;
constexpr size_t OO_y_sample = OO_y_prompt + (size_t)2 * 8192 * 1024;
constexpr size_t OO_p_shift = OO_y_sample + (size_t)32 * 16 * 1024;
constexpr size_t OO_p_wkv = OO_p_shift + 2 * 3200;
constexpr size_t OO_p_conv = OO_p_wkv + 2 * 16 * 4096;
constexpr size_t OO_p_ssm = OO_p_conv + 2 * 3 * 3072;
constexpr size_t OO_s_shift = OO_p_ssm + 2 * 8 * 16384;
constexpr size_t OO_s_wkv = OO_s_shift + 32 * 3200;
constexpr size_t OO_s_conv = OO_s_wkv + 32 * 16 * 4096;
constexpr size_t OO_s_ssm = OO_s_conv + 32 * 3 * 3072;
constexpr size_t OW_sync = 0;
constexpr size_t OW_WtIn = OW_sync + 16384;
constexpr size_t OW_WtA = OW_WtIn + al256((size_t)VW * DM * 2);
constexpr size_t OW_WtB = OW_WtA + al256((size_t)DM * DM * 2);
constexpr size_t OW_WtO = OW_WtB + al256((size_t)DM * DM * 2);
constexpr size_t OW_XN = OW_WtO + al256((size_t)DM * DM * 2);
constexpr size_t OW_PJA = OW_XN + al256((size_t)MP0 * DM * 2);
constexpr size_t OW_YA = OW_PJA + al256((size_t)MP0 * PJW * 2);
constexpr size_t OW_YB = OW_YA + al256((size_t)2 * MP0 * DM * 2);
constexpr size_t OW_MG = OW_YB + al256((size_t)2 * MP0 * DM * 2);
constexpr size_t OW_OUTB = OW_MG + al256((size_t)MP0 * DM * 2);
constexpr size_t OW_TMP = OW_OUTB + al256((size_t)2 * MP0 * DM * 4);
constexpr size_t OW_GT = OW_TMP + al256((size_t)2 * MP0 * DM * 4);
constexpr size_t OW_RWS = OW_GT + al256((size_t)GT_ROWS * GTW * 2);
constexpr size_t OW_GDS = OW_RWS + al256((size_t)SLOT_ROWS * RWS_ROWB);
constexpr size_t OW_RWB = OW_GDS + al256((size_t)SLOT_ROWS * GDS_ROWB + 256);
constexpr size_t OW_YRW = OW_RWB + al256((size_t)SLOT_ROWS * 16 * 4);
constexpr size_t OW_OGD = OW_YRW + al256((size_t)SLOT_ROWS * DM * 4);
constexpr size_t OW_CSH = OW_OGD + al256((size_t)SLOT_ROWS * DM * 4);
constexpr size_t OW_CCV = OW_CSH + al256((size_t)2 * 2 * 3200 * 4);
constexpr size_t OW_END = OW_CCV + al256((size_t)2 * 2 * 3 * 3072 * 4);


__device__ __forceinline__ bf16_t f2bf(float f) {
  uint32_t u = __float_as_uint(f);
  u += 0x7fffu + ((u >> 16) & 1u);
  return (bf16_t)(u >> 16);
}
__device__ __forceinline__ float bf2f(bf16_t h) { return __uint_as_float(((uint32_t)h) << 16); }
__device__ __forceinline__ uint32_t pack2(float a, float b) { return (uint32_t)f2bf(a) | ((uint32_t)f2bf(b) << 16); }
__device__ __forceinline__ float sigmoidf_(float x) { return 1.0f / (1.0f + __expf(-x)); }
__device__ __forceinline__ float siluf_(float x) { return x / (1.0f + __expf(-x)); }
__device__ __forceinline__ float softplusf_(float x) { return fmaxf(x, 0.0f) + log1pf(__expf(-fabsf(x))); }

__device__ __forceinline__ int tid_l() { int t = threadIdx.x; asm volatile("" : "+v"(t)); return t; }
#define LAUNDER_PP asm volatile("" : "+s"(pp))
template <int CTRL>
__device__ __forceinline__ float dppf(float x) {
  return __builtin_bit_cast(float, __builtin_amdgcn_update_dpp(0, __builtin_bit_cast(int, x), CTRL, 0xf, 0xf, true));
}
__device__ __forceinline__ float rowsum16(float x) {
  x += dppf<0xB1>(x);
  x += dppf<0x4E>(x);
  x += dppf<0x141>(x);
  x += dppf<0x140>(x);
  return x;
}
__device__ __forceinline__ float wavesum(float x) {
  x = rowsum16(x);
  x += __shfl_xor(x, 16);
  x += __shfl_xor(x, 32);
  return x;
}

#define SW_XCNT(j) (64 * (1 + (j)))
#define SW_XSUB(j) (64 * (9 + (j)))
#define SW_XGEN(j) (64 * (17 + (j)))
#define SW_TOP (64 * 25)
#define SW_TOPGEN (64 * 26)
#define SW_PRE (64 * 27)
#define SW_SCAN(s) (64 * (28 + (s)))
#define SYNC_BYTES 16384
__device__ __forceinline__ unsigned xb_ld(const unsigned* ptr) {
  return __hip_atomic_load(ptr, __ATOMIC_RELAXED, __HIP_MEMORY_SCOPE_AGENT);
}
__device__ __forceinline__ unsigned xb_add(unsigned* ptr, unsigned v) {
  return __hip_atomic_fetch_add(ptr, v, __ATOMIC_RELAXED, __HIP_MEMORY_SCOPE_AGENT);
}
__device__ __forceinline__ unsigned xcc_id() { return (unsigned)__builtin_amdgcn_s_getreg((3 << 11) | 20) & 0xFu; }
__device__ __forceinline__ void wait_ge(const unsigned* ptr, unsigned target) {
  if (threadIdx.x == 0) {
    while (xb_ld(ptr) < target) __builtin_amdgcn_s_sleep(8);
    __builtin_amdgcn_fence(__ATOMIC_ACQUIRE, "agent");
    asm volatile("s_waitcnt vmcnt(0)" ::: "memory");
  }
  __syncthreads();
}
__device__ __forceinline__ void signal_add(unsigned* ptr) {
  asm volatile("s_waitcnt vmcnt(0)" ::: "memory");
  __syncthreads();
  if (threadIdx.x == 0) {
    __builtin_amdgcn_fence(__ATOMIC_RELEASE, "agent");
    asm volatile("s_waitcnt vmcnt(0)" ::: "memory");
    xb_add(ptr, 1u);
  }
}
__device__ __forceinline__ void worker_barrier(unsigned* bar, const unsigned* lds_cfg) {
  asm volatile("s_waitcnt vmcnt(0)" ::: "memory");
  __syncthreads();
  if (threadIdx.x == 0) {
    const unsigned x = xcc_id() & 7u, nloc = lds_cfg[0], nx = lds_cfg[1];
    const unsigned old = xb_add(&bar[SW_XSUB(x)], 1u);
    const unsigned gen = old / nloc;
    if (old + 1u == (gen + 1u) * nloc) {
      __builtin_amdgcn_fence(__ATOMIC_RELEASE, "agent");
      asm volatile("s_waitcnt vmcnt(0)" ::: "memory");
      const unsigned og = xb_add(&bar[SW_TOP], 1u);
      const unsigned tg = og / nx;
      if (og + 1u == (tg + 1u) * nx) xb_add(&bar[SW_TOPGEN], 1u);
      else while (xb_ld(&bar[SW_TOPGEN]) == tg) __builtin_amdgcn_s_sleep(1);
      __builtin_amdgcn_fence(__ATOMIC_ACQUIRE, "agent");
      xb_add(&bar[SW_XGEN(x)], 1u);
      asm volatile("s_waitcnt vmcnt(0)" ::: "memory");
    } else {
      while (xb_ld(&bar[SW_XGEN(x)]) == gen) __builtin_amdgcn_s_sleep(1);
      __builtin_amdgcn_fence(__ATOMIC_ACQUIRE, "agent");
      asm volatile("s_waitcnt vmcnt(0)" ::: "memory");
    }
  }
  __syncthreads();
}

__device__ __forceinline__ void lds_barrier() {
  asm volatile("s_waitcnt lgkmcnt(0)" ::: "memory");
  __builtin_amdgcn_s_barrier();
  asm volatile("" ::: "memory");
}

__device__ __forceinline__ int seg_M(int seg) { return seg == 0 ? M0 : M1; }
__device__ __forceinline__ int seg_MP(int seg) { return seg == 0 ? MP0 : M1; }
__device__ __forceinline__ int slot_row0(int seg) { int s = seg % 3; return s == 0 ? 0 : MP0 + (s - 1) * M1; }
__device__ __forceinline__ int gt_row0(int seg) { int s = seg & 3; return s == 0 ? 0 : MP0 + (s - 1) * M1; }
__device__ __forceinline__ const float* row_src(PP pp, int seg, int r) {
  if (seg == 0) {
    if (r < 1056) {
      int b = r >= 528 ? 1 : 0, t = r - b * 528;
      if (t < 16) return p.meta + t * DM;
      return p.x_prompt + ((size_t)b * 8192 + (t - 16)) * DM;
    }
    return p.x_sample + (size_t)(r - 1056) * DM;
  }
  int b = r >> 9, t = r & 511;
  return p.x_prompt + ((size_t)b * 8192 + seg * TS + t) * DM;
}
__device__ __forceinline__ float* row_dst(PP pp, int seg, int r) {
  if (seg == 0) {
    if (r < 1056) {
      int b = r >= 528 ? 1 : 0, t = r - b * 528;
      if (t < 16) return nullptr;
      return (p.out + OO_y_prompt) + ((size_t)b * 8192 + (t - 16)) * DM;
    }
    return (p.out + OO_y_sample) + (size_t)(r - 1056) * DM;
  }
  int b = r >> 9, t = r & 511;
  return (p.out + OO_y_prompt) + ((size_t)b * 8192 + seg * TS + t) * DM;
}
__device__ __forceinline__ void row_seq(int seg, int r, int& seq, int& t, int& len) {
  if (seg == 0) {
    if (r < 528) { seq = 0; t = r; len = 528; }
    else if (r < 1056) { seq = 1; t = r - 528; len = 528; }
    else { seq = 2 + ((r - 1056) >> 4); t = (r - 1056) & 15; len = 16; }
  } else { seq = r >> 9; t = r & 511; len = TS; }
}

__device__ __forceinline__ int vcol_src(int n) {
  if (n < 3200) return n;
  if (n < 6288) return n + 1024;
  if (n < 6400) return -1;
  if (n < 7424) return n - 3200;
  return n - 112;
}
__device__ __forceinline__ void transpose_tile(const float* __restrict__ src, int ld, bool remap, bf16_t* __restrict__ dst, int k0, int n0,
                               float* tile  ) {
  int tid = tid_l();
  int i = tid >> 4, j = tid & 15;
  __syncthreads();
  int n = n0 + 4 * j;
  int sc = remap ? vcol_src(n) : n;
#pragma unroll
  for (int pass = 0; pass < 4; pass++) {
    int k = pass * 16 + i;
    float4 v = make_float4(0.f, 0.f, 0.f, 0.f);
    if (sc >= 0) v = *(const float4*)(src + (size_t)(k0 + k) * ld + sc);
    tile[k * 65 + 4 * j + 0] = v.x; tile[k * 65 + 4 * j + 1] = v.y; tile[k * 65 + 4 * j + 2] = v.z; tile[k * 65 + 4 * j + 3] = v.w;
  }
  __syncthreads();
  int nn = tid >> 2, kq = tid & 3;
  uint32_t o[8];
#pragma unroll
  for (int e = 0; e < 8; e++) o[e] = pack2(tile[(kq * 16 + 2 * e) * 65 + nn], tile[(kq * 16 + 2 * e + 1) * 65 + nn]);
  u32x4* d = (u32x4*)(dst + (size_t)(n0 + nn) * DM + k0 + kq * 16);
  d[0] = (u32x4){o[0], o[1], o[2], o[3]};
  d[1] = (u32x4){o[4], o[5], o[6], o[7]};
}
__device__ __forceinline__ void phase_weights(PP pp, int bid, int nb, char* smem) {
  LAUNDER_PP;
  float* tile = (float*)smem;
  const int nIn = 16 * (VW / 64);
  const int nSq = 16 * 16;
  for (int it = bid; it < nIn + 3 * nSq; it += nb) {
    if (it < nIn) {
      int kt = it & 15, nt = it >> 4;
      transpose_tile(p.w_in, PW, true, ((bf16_t*)(p.ws + OW_WtIn)), kt * 64, nt * 64, tile);
    } else {
      int j = it - nIn, w = j / nSq, r = j % nSq;
      int kt = r & 15, nt = r >> 4;
      const float* src = w == 0 ? p.w_out_a : (w == 1 ? p.w_out_b : p.w_out);
      bf16_t* dst = w == 0 ? ((bf16_t*)(p.ws + OW_WtA)) : (w == 1 ? ((bf16_t*)(p.ws + OW_WtB)) : ((bf16_t*)(p.ws + OW_WtO)));
      transpose_tile(src, DM, false, dst, kt * 64, nt * 64, tile);
    }
  }
}

__device__ __forceinline__ void xn_item(PP pp, int seg, int item) {
  LAUNDER_PP;
  int wave = tid_l() >> 6, lane = tid_l() & 63;
  int M = seg_M(seg);
  int r = item * 4 + wave;
  bf16_t* o = ((bf16_t*)(p.ws + OW_XN)) + (size_t)r * DM;
  if (r >= M) {
#pragma unroll
    for (int i = 0; i < 4; i++) *(uint2*)(o + (lane + 64 * i) * 4) = make_uint2(0u, 0u);
    return;
  }
  const float4* src = (const float4*)row_src(pp, seg, r);
  float4 v[4];
  float ss = 0.f;
#pragma unroll
  for (int i = 0; i < 4; i++) {
    v[i] = src[lane + 64 * i];
    ss += v[i].x * v[i].x + v[i].y * v[i].y + v[i].z * v[i].z + v[i].w * v[i].w;
  }
  ss = wavesum(ss);
  float rstd = rsqrtf(ss * (1.0f / DM) + 1e-6f);
#pragma unroll
  for (int i = 0; i < 4; i++) {
    float4 g = ((const float4*)p.norm_pre)[lane + 64 * i];
    *(uint2*)(o + (lane + 64 * i) * 4) =
        make_uint2(pack2(v[i].x * rstd * g.x, v[i].y * rstd * g.y), pack2(v[i].z * rstd * g.z, v[i].w * rstd * g.w));
  }
}

__device__ __forceinline__ void norm_item(PP pp, int seg, int item) {
  LAUNDER_PP;
  int wave = tid_l() >> 6, lane = tid_l() & 63;
  int r = item * 4 + wave;
  float* dst = row_dst(pp, seg, r);
  if (!dst) return;
  const float4* h = (const float4*)row_src(pp, seg, r);
  const float4* o = (const float4*)(((float*)(p.ws + OW_OUTB)) + ((size_t)(seg & 1) * MP0 + r) * DM);
  float4 v[4];
  float ss = 0.f;
#pragma unroll
  for (int i = 0; i < 4; i++) {
    v[i] = o[lane + 64 * i];
    ss += v[i].x * v[i].x + v[i].y * v[i].y + v[i].z * v[i].z + v[i].w * v[i].w;
  }
  ss = wavesum(ss);
  float rstd = rsqrtf(ss * (1.0f / DM) + 1e-6f);
#pragma unroll
  for (int i = 0; i < 4; i++) {
    float4 g = ((const float4*)p.norm_post)[lane + 64 * i];
    float4 hh = h[lane + 64 * i];
    ((float4*)dst)[lane + 64 * i] =
        make_float4(hh.x + v[i].x * rstd * g.x, hh.y + v[i].y * rstd * g.y, hh.z + v[i].z * rstd * g.z, hh.w + v[i].w * rstd * g.w);
  }
}

__device__ __forceinline__ void merge_item(PP pp, int item) {
  LAUNDER_PP;
  const int tid = tid_l();
  const int wave = tid >> 6, lane = tid & 63;
  const int r = item * 4 + wave;
  const float4* t1 = (const float4*)((const float*)(p.ws + OW_TMP) + (size_t)r * DM);
  const float4* t2 = (const float4*)((const float*)(p.ws + OW_TMP) + ((size_t)MP0 + r) * DM);
  bf16_t* o = (bf16_t*)(p.ws + OW_MG) + (size_t)r * DM;
#pragma unroll
  for (int i = 0; i < 4; i++) {
    float4 a = t1[lane + 64 * i], b = t2[lane + 64 * i];
    *(uint2*)(o + (lane + 64 * i) * 4) = make_uint2(pack2(a.x + b.x, a.y + b.y), pack2(a.z + b.z, a.w + b.w));
  }
}

#define LDT 32
template <int MODE>
__device__ __forceinline__ void gemm_tile(PP pp, int seg, int tm, int tn, char* smem) {
  LAUNDER_PP;
  const int tid = tid_l(), lane = tid & 63, wid = tid >> 6;
  const int wr = wid >> 1, wc = wid & 1, l31 = lane & 31, lh = lane >> 5;
  const int lrow = tid >> 2, lkc = tid & 3;
  const int m0 = tm * 128, n0 = tn * 128;
  bf16_t* GTs = ((bf16_t*)(p.ws + OW_GT)) + (size_t)gt_row0(seg) * GTW;
  f32x16 acc[2][2];
#pragma unroll
  for (int a = 0; a < 2; a++)
#pragma unroll
    for (int b = 0; b < 2; b++)
#pragma unroll
      for (int e = 0; e < 16; e++) acc[a][b][e] = 0.f;
  {
    const bf16_t* A = (MODE == 0) ? (const bf16_t*)(p.ws + OW_XN)
                    : (MODE == 1) ? (const bf16_t*)(p.ws + OW_YA) + (size_t)(seg & 1) * MP0 * DM
                    : (MODE == 3) ? (const bf16_t*)(p.ws + OW_YB) + (size_t)(seg & 1) * MP0 * DM
                                  : (const bf16_t*)(p.ws + OW_MG);
    const bf16_t* Bt = (const bf16_t*)(p.ws + (MODE == 0 ? OW_WtIn : (MODE == 1 ? OW_WtA : (MODE == 3 ? OW_WtB : OW_WtO))));
    u32x4 ra[2], rb[2];
    const bf16_t* gA = A + (size_t)(m0 + lrow) * DM + lkc * 8;
    const bf16_t* gB = Bt + (size_t)(n0 + lrow) * DM + lkc * 8;
    const int wofs = lrow * 64 + ((lkc ^ ((lrow >> 2) & 3)) << 4);
    const int sw = (l31 >> 2) & 3;
    const int rofs0 = l31 * 64 + (((0 + lh) ^ sw) << 4);
    const int rofs1 = l31 * 64 + (((2 + lh) ^ sw) << 4);
    __syncthreads();
#pragma unroll
    for (int i = 0; i < 2; i++) {
      ra[i] = *(const u32x4*)(gA + (size_t)i * 64 * DM);
      rb[i] = *(const u32x4*)(gB + (size_t)i * 64 * DM);
    }
#pragma unroll
    for (int i = 0; i < 2; i++) {
      *(u32x4*)(smem + wofs + i * 4096) = ra[i];
      *(u32x4*)(smem + 8192 + wofs + i * 4096) = rb[i];
    }
#pragma unroll
    for (int i = 0; i < 2; i++) {
      ra[i] = *(const u32x4*)(gA + (size_t)i * 64 * DM + 32);
      rb[i] = *(const u32x4*)(gB + (size_t)i * 64 * DM + 32);
    }
    lds_barrier();
#pragma unroll 1
    for (int kt = 0; kt < 32; kt++) {
      const char* cA = smem + (kt & 1) * 16384 + wr * 4096;
      const char* cB = smem + (kt & 1) * 16384 + 8192 + wc * 4096;
      const bf16x8 x00 = *(const bf16x8*)(cA + rofs0), x01 = *(const bf16x8*)(cA + 2048 + rofs0);
      const bf16x8 w00 = *(const bf16x8*)(cB + rofs0), w01 = *(const bf16x8*)(cB + 2048 + rofs0);
      const bf16x8 x10 = *(const bf16x8*)(cA + rofs1), x11 = *(const bf16x8*)(cA + 2048 + rofs1);
      const bf16x8 w10 = *(const bf16x8*)(cB + rofs1), w11 = *(const bf16x8*)(cB + 2048 + rofs1);
      asm volatile("" ::: "memory");
      acc[0][0] = __builtin_amdgcn_mfma_f32_32x32x16_bf16(w00, x00, acc[0][0], 0, 0, 0);
      acc[0][1] = __builtin_amdgcn_mfma_f32_32x32x16_bf16(w00, x01, acc[0][1], 0, 0, 0);
      acc[1][0] = __builtin_amdgcn_mfma_f32_32x32x16_bf16(w01, x00, acc[1][0], 0, 0, 0);
      acc[1][1] = __builtin_amdgcn_mfma_f32_32x32x16_bf16(w01, x01, acc[1][1], 0, 0, 0);
      acc[0][0] = __builtin_amdgcn_mfma_f32_32x32x16_bf16(w10, x10, acc[0][0], 0, 0, 0);
      acc[0][1] = __builtin_amdgcn_mfma_f32_32x32x16_bf16(w10, x11, acc[0][1], 0, 0, 0);
      acc[1][0] = __builtin_amdgcn_mfma_f32_32x32x16_bf16(w11, x10, acc[1][0], 0, 0, 0);
      acc[1][1] = __builtin_amdgcn_mfma_f32_32x32x16_bf16(w11, x11, acc[1][1], 0, 0, 0);
      if (kt + 1 < 32) {
        char* nx = smem + ((kt + 1) & 1) * 16384;
#pragma unroll
        for (int i = 0; i < 2; i++) {
          *(u32x4*)(nx + wofs + i * 4096) = ra[i];
          *(u32x4*)(nx + 8192 + wofs + i * 4096) = rb[i];
        }
        if (kt + 2 < 32) {
#pragma unroll
          for (int i = 0; i < 2; i++) {
            ra[i] = *(const u32x4*)(gA + (size_t)i * 64 * DM + (kt + 2) * 32);
            rb[i] = *(const u32x4*)(gB + (size_t)i * 64 * DM + (kt + 2) * 32);
          }
        }
      }
      lds_barrier();
    }
  }
  float* OUTBp = (MODE == 2) ? (float*)(p.ws + OW_OUTB) + (size_t)(seg & 1) * MP0 * DM
                             : (float*)(p.ws + OW_TMP) + (size_t)(MODE == 3 ? 1 : 0) * MP0 * DM;
#pragma unroll
  for (int ni = 0; ni < 2; ni++)
#pragma unroll
    for (int mi = 0; mi < 2; mi++)
#pragma unroll
      for (int g = 0; g < 4; g++) {
        const int m = m0 + wr * 64 + mi * 32 + l31;
        const int n = n0 + wc * 64 + ni * 32 + 8 * g + 4 * lh;
        const float c0 = acc[ni][mi][4 * g], c1 = acc[ni][mi][4 * g + 1], c2 = acc[ni][mi][4 * g + 2], c3 = acc[ni][mi][4 * g + 3];
        if (MODE == 0) {
          uint2 o = make_uint2(pack2(c0, c1), pack2(c2, c3));
          if (tn < PJW / 128) *(uint2*)(((bf16_t*)(p.ws + OW_PJA)) + (size_t)m * PJW + n) = o;
          else *(uint2*)(GTs + (size_t)m * GTW + (n - PJW)) = o;
        } else if (MODE == 1 || MODE == 3) {
          uint2 ga = *(const uint2*)(GTs + (size_t)m * GTW + (MODE == 1 ? G_MA : G_MB) + n);
          *(float4*)(OUTBp + (size_t)m * DM + n) =
              make_float4(sigmoidf_(bf2f(ga.x & 0xffff)) * c0, sigmoidf_(bf2f(ga.x >> 16)) * c1,
                          sigmoidf_(bf2f(ga.y & 0xffff)) * c2, sigmoidf_(bf2f(ga.y >> 16)) * c3);
        } else {
          *(float4*)(OUTBp + (size_t)m * DM + n) = make_float4(c0, c1, c2, c3);
        }
      }
}

__device__ __forceinline__ void rw_prepass_item(PP pp, int seg, int grp, int slab, char* smem) {
  LAUNDER_PP;
  float* lwa = (float*)smem;
  const int tid = tid_l();
  const int r0 = grp * 8;
  int seq, t0, len;
  row_seq(seg, r0, seq, t0, len);
  const bool prompt = seq < 2;
  const float* prev0 = nullptr;
  if (t0 == 0) {
    if (seg == 0) prev0 = prompt ? nullptr : p.st_shift + (size_t)(seq - 2) * 3200;
    else prev0 = ((float*)(p.ws + OW_CSH)) + ((size_t)(seg & 1) * 2 + seq) * 3200;
  }
  __syncthreads();
  {
    const int j = tid & 127;
    const float mu = p.rw_mu[3072 + j];
#pragma unroll
    for (int i = 0; i < 4; i++) {
      int tok = (tid >> 7) + 2 * i;
      int row = r0 + tok;
      float ps = bf2f(((bf16_t*)(p.ws + OW_PJA))[(size_t)row * PJW + 3072 + j]);
      float pv;
      if (tok == 0 && t0 == 0) pv = prev0 ? prev0[3072 + j] : 0.f;
      else pv = bf2f(((bf16_t*)(p.ws + OW_PJA))[(size_t)(row - 1) * PJW + 3072 + j]);
      float xs = ps + mu * (pv - ps);
      lwa[tok * 128 + j] = j < 64 ? tanhf(xs) : xs;
      if (slab == 0 && t0 + tok == len - 1) {
        if (prompt) {
          ((float*)(p.ws + OW_CSH))[((size_t)((seg + 1) & 1) * 2 + seq) * 3200 + 3072 + j] = ps;
          if (seg == NSEG - 1) (p.out + OO_p_shift)[(size_t)seq * 3200 + 3072 + j] = ps;
        } else {
          (p.out + OO_s_shift)[(size_t)(seq - 2) * 3200 + 3072 + j] = ps;
        }
      }
    }
  }
  __syncthreads();
  const int c = slab * 256 + tid;
  float dw[8], da[8];
  {
    const float w0 = p.rw_w0[c], a0 = p.rw_a0[c];
#pragma unroll
    for (int t = 0; t < 8; t++) { dw[t] = w0; da[t] = a0; }
  }
  for (int j = 0; j < 64; j += 4) {
    float w2v[4], a2v[4];
#pragma unroll
    for (int e = 0; e < 4; e++) {
      w2v[e] = p.rw_w2[(size_t)(j + e) * DM + c];
      a2v[e] = p.rw_a2[(size_t)(j + e) * DM + c];
    }
#pragma unroll
    for (int t = 0; t < 8; t++) {
      float4 lw = *(const float4*)(lwa + t * 128 + j);
      float4 la = *(const float4*)(lwa + t * 128 + 64 + j);
      dw[t] += lw.x * w2v[0] + lw.y * w2v[1] + lw.z * w2v[2] + lw.w * w2v[3];
      da[t] += la.x * a2v[0] + la.y * a2v[1] + la.z * a2v[2] + la.w * a2v[3];
    }
  }
  const float mur = p.rw_mu[c], muk = p.rw_mu[1024 + c], muv = p.rw_mu[2048 + c];
  const float kk_w = p.rw_k_k[c], ka_w = p.rw_k_a[c], rk_w = p.rw_r_k[c];
  float pr, pk, pv;
  if (t0 == 0) {
    pr = prev0 ? prev0[c] : 0.f; pk = prev0 ? prev0[1024 + c] : 0.f; pv = prev0 ? prev0[2048 + c] : 0.f;
  } else {
    const bf16_t* q = ((bf16_t*)(p.ws + OW_PJA)) + (size_t)(r0 - 1) * PJW;
    pr = bf2f(q[c]); pk = bf2f(q[1024 + c]); pv = bf2f(q[2048 + c]);
  }
  const int head = c >> 6, e = c & 63;
  const int srow0 = slot_row0(seg);
  char* rws = ((char*)(p.ws + OW_RWS)) + ((size_t)(srow0 + r0) * 16 + head) * 1024;
  float* rwb = ((float*)(p.ws + OW_RWB)) + (size_t)(srow0 + r0) * 16 + head;
#pragma unroll
  for (int t = 0; t < 8; t++) {
    const int row = r0 + t;
    const bf16_t* q = ((bf16_t*)(p.ws + OW_PJA)) + (size_t)row * PJW;
    float cr = bf2f(q[c]), ck = bf2f(q[1024 + c]), cv = bf2f(q[2048 + c]);
    float xr = cr + mur * (pr - cr), xk = ck + muk * (pk - ck), xv = cv + muv * (pv - cv);
    pr = cr; pk = ck; pv = cv;
    float w_log = -softplusf_(-dw[t]) - 0.5f;
    float decay = __expf(-__expf(w_log));
    float a = sigmoidf_(da[t]);
    float kkr = xk * kk_w;
    float ss = wavesum(kkr * kkr);
    float kk = kkr * rsqrtf(ss + 1e-6f);
    float k2 = xk * (1.0f + (a - 1.0f) * ka_w);
    float bon = wavesum(xr * k2 * rk_w);
    char* o = rws + (size_t)t * RWS_ROWB;
    ((f16*)o)[e] = (f16)xr;
    ((f16*)(o + 128))[e] = (f16)k2;
    ((f16*)(o + 256))[e] = (f16)(-kk);
    ((f16*)(o + 384))[e] = (f16)(kk * a);
    ((float*)(o + 512))[e] = decay;
    ((float*)(o + 768))[e] = xv;
    if ((tid & 63) == 0) rwb[(size_t)t * 16] = bon;
    if (t0 + t == len - 1) {
      if (prompt) {
        float* cs = ((float*)(p.ws + OW_CSH)) + ((size_t)((seg + 1) & 1) * 2 + seq) * 3200;
        cs[c] = cr; cs[1024 + c] = ck; cs[2048 + c] = cv;
        if (seg == NSEG - 1) {
          float* ps = (p.out + OO_p_shift) + (size_t)seq * 3200;
          ps[c] = cr; ps[1024 + c] = ck; ps[2048 + c] = cv;
        }
      } else {
        float* ps = (p.out + OO_s_shift) + (size_t)(seq - 2) * 3200;
        ps[c] = cr; ps[1024 + c] = ck; ps[2048 + c] = cv;
      }
    }
  }
}

__device__ __forceinline__ void gd_prepass_item(PP pp, int seg, int grp, int slab) {
  LAUNDER_PP;
  const int tid = tid_l();
  const int r0 = grp * 16;
  int seq, t0, len;
  row_seq(seg, r0, seq, t0, len);
  const bool prompt = seq < 2;
  const int c = slab * 512 + 2 * tid;
  const int kind = slab >> 1;
  const int head = (c & 1023) >> 7, e = c & 127;
  float2 x0, x1, x2;
  if (t0 == 0) {
    const float* cp = nullptr;
    if (seg == 0) cp = prompt ? nullptr : p.st_conv + (size_t)(seq - 2) * 3 * 3072;
    else cp = ((float*)(p.ws + OW_CCV)) + ((size_t)(seg & 1) * 2 + seq) * 3 * 3072;
    if (cp) {
      x0 = *(const float2*)(cp + c); x1 = *(const float2*)(cp + 3072 + c); x2 = *(const float2*)(cp + 6144 + c);
    } else {
      x0 = x1 = x2 = make_float2(0.f, 0.f);
    }
  } else {
    uint32_t u0 = *(const uint32_t*)(((bf16_t*)(p.ws + OW_PJA)) + (size_t)(r0 - 3) * PJW + C_GDC + c);
    uint32_t u1 = *(const uint32_t*)(((bf16_t*)(p.ws + OW_PJA)) + (size_t)(r0 - 2) * PJW + C_GDC + c);
    uint32_t u2 = *(const uint32_t*)(((bf16_t*)(p.ws + OW_PJA)) + (size_t)(r0 - 1) * PJW + C_GDC + c);
    x0 = make_float2(bf2f(u0 & 0xffff), bf2f(u0 >> 16));
    x1 = make_float2(bf2f(u1 & 0xffff), bf2f(u1 >> 16));
    x2 = make_float2(bf2f(u2 & 0xffff), bf2f(u2 >> 16));
  }
  const float2 w0 = *(const float2*)(p.gd_conv_w + c), w1 = *(const float2*)(p.gd_conv_w + 3072 + c),
               w2 = *(const float2*)(p.gd_conv_w + 6144 + c), w3 = *(const float2*)(p.gd_conv_w + 9216 + c);
  const float a_exp = __expf(p.gd_a_log[head]);
  const float dtb = p.gd_dt_bias[head];
  char* gds = ((char*)(p.ws + OW_GDS)) + ((size_t)(slot_row0(seg) + r0) * 8 + head) * GDS_HB;
#pragma unroll 4
  for (int t = 0; t < 16; t++) {
    const int row = r0 + t;
    uint32_t u = *(const uint32_t*)(((bf16_t*)(p.ws + OW_PJA)) + (size_t)row * PJW + C_GDC + c);
    float2 x3 = make_float2(bf2f(u & 0xffff), bf2f(u >> 16));
    float cx = w0.x * x0.x + w1.x * x1.x + w2.x * x2.x + w3.x * x3.x;
    float cy = w0.y * x0.y + w1.y * x1.y + w2.y * x2.y + w3.y * x3.y;
    x0 = x1; x1 = x2; x2 = x3;
    float ax = siluf_(cx), ay = siluf_(cy);
    float sc = 1.0f;
    if (kind < 2) {
      float ss = wavesum(ax * ax + ay * ay);
      sc = rsqrtf(ss + 1e-6f);
      if (kind == 0) sc *= 0.08838834764831845f;
    }
    if (kind >= 1) {
      float beta = sigmoidf_(bf2f(((bf16_t*)(p.ws + OW_PJA))[(size_t)row * PJW + C_BETA + head]));
      sc *= sqrtf(beta);
    }
    ax *= sc; ay *= sc;
    char* o = gds + (size_t)t * GDS_ROWB;
    f16x2 hv = {(f16)ax, (f16)ay};
    *(f16x2*)(o + kind * 256 + e * 2) = hv;
    if (kind == 0 && (tid & 63) == 0) {
      float g = -a_exp * softplusf_(bf2f(((bf16_t*)(p.ws + OW_PJA))[(size_t)row * PJW + C_ALPHA + head]) + dtb);
      *(float*)(o + 768) = __expf(g);
    }
    int jj = t0 + t - (len - 3);
    if (jj >= 0) {
      if (prompt) {
        *(float2*)(((float*)(p.ws + OW_CCV)) + (((size_t)((seg + 1) & 1) * 2 + seq) * 3 + jj) * 3072 + c) = x3;
        if (seg == NSEG - 1) *(float2*)((p.out + OO_p_conv) + ((size_t)seq * 3 + jj) * 3072 + c) = x3;
      } else {
        *(float2*)((p.out + OO_s_conv) + ((size_t)(seq - 2) * 3 + jj) * 3072 + c) = x3;
      }
    }
  }
}


using u32x2 = __attribute__((ext_vector_type(2))) unsigned int;
__device__ __forceinline__ float fmix_lo(unsigned h, float b, float c) {
  float d;
  asm("v_fma_mix_f32 %0, %1, %2, %3 op_sel_hi:[1,0,0]" : "=v"(d) : "v"(h), "v"(b), "v"(c));
  return d;
}
__device__ __forceinline__ float fmix_hi(unsigned h, float b, float c) {
  float d;
  asm("v_fma_mix_f32 %0, %1, %2, %3 op_sel:[1,0,0] op_sel_hi:[1,0,0]" : "=v"(d) : "v"(h), "v"(b), "v"(c));
  return d;
}
__device__ __forceinline__ float vmul1(float a, float b) {
  float d;
  asm("v_mul_f32 %0, %1, %2" : "=v"(d) : "v"(a), "v"(b));
  return d;
}
struct RwOps { f16x4 r, k, a, b; float4 w; float vv; };
__device__ __forceinline__ RwOps rw_ld(const char* Ls, int q, int v) {
  RwOps o;
  o.r = *(const f16x4*)(Ls + q * 8);
  o.k = *(const f16x4*)(Ls + 128 + q * 8);
  o.a = *(const f16x4*)(Ls + 256 + q * 8);
  o.b = *(const f16x4*)(Ls + 384 + q * 8);
  o.w = *(const float4*)(Ls + 512 + q * 16);
  o.vv = *(const float*)(Ls + 768 + v * 4);
  return o;
}
__device__ __forceinline__ float rw_step(const RwOps& o, float4& S) {
  const u32x2 rw = __builtin_bit_cast(u32x2, o.r), kw = __builtin_bit_cast(u32x2, o.k),
              aw = __builtin_bit_cast(u32x2, o.a), bw = __builtin_bit_cast(u32x2, o.b);
  const float z = 0.f;
  float sa0 = fmix_lo(aw[0], S.x, z);
  float sa1 = fmix_lo(aw[1], S.z, z);
  sa0 = fmix_hi(aw[0], S.y, sa0);
  sa1 = fmix_hi(aw[1], S.w, sa1);
  float t0 = vmul1(S.x, o.w.x), t1 = vmul1(S.y, o.w.y), t2 = vmul1(S.z, o.w.z), t3 = vmul1(S.w, o.w.w);
  t0 = fmix_lo(kw[0], o.vv, t0);
  t1 = fmix_hi(kw[0], o.vv, t1);
  t2 = fmix_lo(kw[1], o.vv, t2);
  t3 = fmix_hi(kw[1], o.vv, t3);
  const float sa = rowsum16(sa0 + sa1);
  S.x = fmix_lo(bw[0], sa, t0);
  S.y = fmix_hi(bw[0], sa, t1);
  S.z = fmix_lo(bw[1], sa, t2);
  S.w = fmix_hi(bw[1], sa, t3);
  float y0 = fmix_lo(rw[0], S.x, z);
  float y1 = fmix_lo(rw[1], S.z, z);
  y0 = fmix_hi(rw[0], S.y, y0);
  y1 = fmix_hi(rw[1], S.w, y1);
  return rowsum16(y0 + y1);
}
__device__ __forceinline__ void rw_scan_run(const char* __restrict__ gsrc  , int len, float4& S,
                            float* __restrict__ yo  , int q, int v, char* smem) {
  const int tid = tid_l();
  const int nch = len >> 4;
  const int lstep = tid >> 6, loff = (tid & 63) * 16;
  u32x4 st[4];
#pragma unroll
  for (int i = 0; i < 4; i++) st[i] = *(const u32x4*)(gsrc + (size_t)(lstep + 4 * i) * RWS_ROWB + loff);
  __syncthreads();
#pragma unroll
  for (int i = 0; i < 4; i++) *(u32x4*)(smem + (lstep + 4 * i) * 1024 + loff) = st[i];
  u32x4 st2[4];
#pragma unroll
  for (int i = 0; i < 4; i++) st2[i] = st[i];
  if (nch > 1) {
#pragma unroll
    for (int i = 0; i < 4; i++) st[i] = *(const u32x4*)(gsrc + (size_t)(16 + lstep + 4 * i) * RWS_ROWB + loff);
  }
  if (nch > 2) {
#pragma unroll
    for (int i = 0; i < 4; i++) st2[i] = *(const u32x4*)(gsrc + (size_t)(32 + lstep + 4 * i) * RWS_ROWB + loff);
  }
  __syncthreads();
  for (int c = 0; c < nch; c++) {
    const char* L = smem + (c & 1) * 16384;
    float ykeep = 0.f;
    RwOps oa = rw_ld(L, q, v);
#pragma unroll 1
    for (int t = 0; t < 16; t += 2) {
      const RwOps ob = rw_ld(L + (t + 1) * 1024, q, v);
      asm volatile("" ::: "memory");
      const float ya = rw_step(oa, S);
      ykeep = (q == t) ? ya : ykeep;
      oa = rw_ld(L + ((t + 2) & 15) * 1024, q, v);
      asm volatile("" ::: "memory");
      const float yb = rw_step(ob, S);
      ykeep = (q == t + 1) ? yb : ykeep;
    }
    yo[(size_t)(c * 16 + q) * DM] = ykeep;
    if (c + 1 < nch) {
      char* Ln = smem + ((c + 1) & 1) * 16384;
#pragma unroll
      for (int i = 0; i < 4; i++) *(u32x4*)(Ln + (lstep + 4 * i) * 1024 + loff) = st[i];
#pragma unroll
      for (int i = 0; i < 4; i++) st[i] = st2[i];
      if (c + 3 < nch) {
#pragma unroll
        for (int i = 0; i < 4; i++)
          st2[i] = *(const u32x4*)(gsrc + (size_t)((c + 3) * 16 + lstep + 4 * i) * RWS_ROWB + loff);
      }
    }
    lds_barrier();
  }
}

struct GdOps { f16x8 qv, kv; float vv, eg; };
__device__ __forceinline__ GdOps gd_ld(const char* Ls, int q, int cl) {
  GdOps o;
  o.kv = *(const f16x8*)(Ls + 256 + q * 16);
  o.vv = (float)*(const f16*)(Ls + 512 + cl * 2);
  o.eg = *(const float*)(Ls + 768);
  o.qv = *(const f16x8*)(Ls + q * 16);
  return o;
}
__device__ __forceinline__ float gd_step(const GdOps& o, float (&s)[8]) {
  const u32x4 kw = __builtin_bit_cast(u32x4, o.kv), qw = __builtin_bit_cast(u32x4, o.qv);
  const float z = 0.f;
  float a0 = fmix_lo(kw[0], s[0], z);
  float a1 = fmix_lo(kw[2], s[4], z);
  a0 = fmix_hi(kw[0], s[1], a0);
  a1 = fmix_hi(kw[2], s[5], a1);
  a0 = fmix_lo(kw[1], s[2], a0);
  a1 = fmix_lo(kw[3], s[6], a1);
  a0 = fmix_hi(kw[1], s[3], a0);
  a1 = fmix_hi(kw[3], s[7], a1);
  float es[8];
#pragma unroll
  for (int i = 0; i < 8; i++) es[i] = vmul1(o.eg, s[i]);
  const float ks = rowsum16(a0 + a1);
  const float d = fmaf(-o.eg, ks, o.vv);
  s[0] = fmix_lo(kw[0], d, es[0]); s[1] = fmix_hi(kw[0], d, es[1]);
  s[2] = fmix_lo(kw[1], d, es[2]); s[3] = fmix_hi(kw[1], d, es[3]);
  s[4] = fmix_lo(kw[2], d, es[4]); s[5] = fmix_hi(kw[2], d, es[5]);
  s[6] = fmix_lo(kw[3], d, es[6]); s[7] = fmix_hi(kw[3], d, es[7]);
  float o0 = fmix_lo(qw[0], s[0], z);
  float o1 = fmix_lo(qw[2], s[4], z);
  o0 = fmix_hi(qw[0], s[1], o0);
  o1 = fmix_hi(qw[2], s[5], o1);
  o0 = fmix_lo(qw[1], s[2], o0);
  o1 = fmix_lo(qw[3], s[6], o1);
  o0 = fmix_hi(qw[1], s[3], o0);
  o1 = fmix_hi(qw[3], s[7], o1);
  return rowsum16(o0 + o1);
}
__device__ __forceinline__ void gd_scan_run(const char* __restrict__ gsrc  , int len, float (&s)[8],
                            float* __restrict__ oo  , int q, int cl, char* smem) {
  const int tid = tid_l();
  const int nch = len >> 4;
  u32x4 st[4];
  int lt[4], lo[4];
#pragma unroll
  for (int i = 0; i < 4; i++) {
    int id = tid + 256 * i;
    if (id > 783) id = 783;
    lt[i] = id / 49;
    lo[i] = (id % 49) * 16;
  }
#pragma unroll
  for (int i = 0; i < 4; i++) st[i] = *(const u32x4*)(gsrc + (size_t)lt[i] * GDS_ROWB + lo[i]);
  __syncthreads();
#pragma unroll
  for (int i = 0; i < 4; i++) *(u32x4*)(smem + lt[i] * GDS_HB + lo[i]) = st[i];
  u32x4 st2[4];
#pragma unroll
  for (int i = 0; i < 4; i++) st2[i] = st[i];
  if (nch > 1) {
#pragma unroll
    for (int i = 0; i < 4; i++) st[i] = *(const u32x4*)(gsrc + (size_t)(16 + lt[i]) * GDS_ROWB + lo[i]);
  }
  if (nch > 2) {
#pragma unroll
    for (int i = 0; i < 4; i++) st2[i] = *(const u32x4*)(gsrc + (size_t)(32 + lt[i]) * GDS_ROWB + lo[i]);
  }
  __syncthreads();
  for (int c = 0; c < nch; c++) {
    const char* L = smem + (c & 1) * 16384;
    float okeep = 0.f;
    GdOps oa = gd_ld(L, q, cl);
#pragma unroll 1
    for (int t = 0; t < 16; t += 2) {
      const GdOps ob = gd_ld(L + (t + 1) * GDS_HB, q, cl);
      asm volatile("" ::: "memory");
      const float ya = gd_step(oa, s);
      okeep = (q == t) ? ya : okeep;
      oa = gd_ld(L + ((t + 2) & 15) * GDS_HB, q, cl);
      asm volatile("" ::: "memory");
      const float yb = gd_step(ob, s);
      okeep = (q == t + 1) ? yb : okeep;
    }
    oo[(size_t)(c * 16 + q) * DM] = okeep;
    if (c + 1 < nch) {
      char* Ln = smem + ((c + 1) & 1) * 16384;
#pragma unroll
      for (int i = 0; i < 4; i++) *(u32x4*)(Ln + lt[i] * GDS_HB + lo[i]) = st[i];
#pragma unroll
      for (int i = 0; i < 4; i++) st[i] = st2[i];
      if (c + 3 < nch) {
#pragma unroll
        for (int i = 0; i < 4; i++) st2[i] = *(const u32x4*)(gsrc + (size_t)((c + 3) * 16 + lt[i]) * GDS_ROWB + lo[i]);
      }
    }
    lds_barrier();
  }
}

__device__ __forceinline__ void sample_scan_task(PP pp, int task, char* smem) {
  LAUNDER_PP;
  const int sj = task >> 7, j = task & 127, kind = j >> 6, jj = j & 63;
  const int tid = tid_l(), q = tid & 15;
  const int row0 = 1056 + sj * 16;
  if (kind == 0) {
    const int head = jj >> 2, v = (jj & 3) * 16 + (tid >> 4);
    const float* sin = p.st_wkv + ((size_t)sj * 16 + head) * 4096;
    float* sout = (p.out + OO_s_wkv) + ((size_t)sj * 16 + head) * 4096;
    float4 S = *(const float4*)(sin + v * 64 + 4 * q);
    rw_scan_run(((char*)(p.ws + OW_RWS)) + ((size_t)row0 * 16 + head) * 1024, 16, S, ((float*)(p.ws + OW_YRW)) + (size_t)row0 * DM + head * 64 + v, q, v, smem);
    *(float4*)(sout + v * 64 + 4 * q) = S;
  } else {
    const int head = jj >> 3, cl = (jj & 7) * 16 + (tid >> 4);
    const float* sin = p.st_ssm + ((size_t)sj * 8 + head) * 16384;
    float* sout = (p.out + OO_s_ssm) + ((size_t)sj * 8 + head) * 16384;
    float s[8];
#pragma unroll
    for (int i = 0; i < 8; i++) s[i] = sin[(size_t)(8 * q + i) * 128 + cl];
    gd_scan_run(((char*)(p.ws + OW_GDS)) + ((size_t)row0 * 8 + head) * GDS_HB, 16, s, ((float*)(p.ws + OW_OGD)) + (size_t)row0 * DM + head * 128 + cl, q, cl, smem);
#pragma unroll
    for (int i = 0; i < 8; i++) sout[(size_t)(8 * q + i) * 128 + cl] = s[i];
  }
}

__device__ __forceinline__ void scan_block_rw(PP pp, int j, char* smem) {
  LAUNDER_PP;
  const int seq = j >> 6, jj = j & 63;
  const int tid = tid_l(), q = tid & 15;
  const int head = jj >> 2, v = (jj & 3) * 16 + (tid >> 4);
  float4 S = make_float4(0.f, 0.f, 0.f, 0.f);
  for (int seg = 0; seg < NSEG; seg++) {
    wait_ge(((unsigned int*)(p.ws + OW_sync)) + SW_PRE, seg + 1);
    const int len = seg == 0 ? 528 : TS;
    const int row0 = slot_row0(seg) + (seg == 0 ? seq * 528 : seq * TS);
    rw_scan_run(((char*)(p.ws + OW_RWS)) + ((size_t)row0 * 16 + head) * 1024, len, S,
                ((float*)(p.ws + OW_YRW)) + (size_t)row0 * DM + head * 64 + v, q, v, smem);
    signal_add(((unsigned int*)(p.ws + OW_sync)) + SW_SCAN(seg));
  }
  {
    const int tid2 = tid_l(), q2 = tid2 & 15, v2 = (jj & 3) * 16 + (tid2 >> 4);
    *(float4*)((p.out + OO_p_wkv) + ((size_t)seq * 16 + head) * 4096 + v2 * 64 + 4 * q2) = S;
  }
}
__device__ __forceinline__ void scan_block_gd(PP pp, int j, char* smem) {
  LAUNDER_PP;
  const int seq = j >> 6, jj = j & 63;
  const int tid = tid_l(), q = tid & 15;
  const int head = jj >> 3, cl = (jj & 7) * 16 + (tid >> 4);
  float s[8];
#pragma unroll
  for (int i = 0; i < 8; i++) s[i] = 0.f;
  for (int seg = 0; seg < NSEG; seg++) {
    wait_ge(((unsigned int*)(p.ws + OW_sync)) + SW_PRE, seg + 1);
    const int len = seg == 0 ? 528 : TS;
    const int row0 = slot_row0(seg) + (seg == 0 ? seq * 528 : seq * TS);
    gd_scan_run(((char*)(p.ws + OW_GDS)) + ((size_t)row0 * 8 + head) * GDS_HB, len, s,
                ((float*)(p.ws + OW_OGD)) + (size_t)row0 * DM + head * 128 + cl, q, cl, smem);
    signal_add(((unsigned int*)(p.ws + OW_sync)) + SW_SCAN(seg));
  }
  {
    const int tid2 = tid_l(), q2 = tid2 & 15, cl2 = (jj & 7) * 16 + (tid2 >> 4);
    float* sout = (p.out + OO_p_ssm) + ((size_t)seq * 8 + head) * 16384;
#pragma unroll
    for (int i = 0; i < 8; i++) sout[(size_t)(8 * q2 + i) * 128 + cl2] = s[i];
  }
}

__device__ __forceinline__ void post_item(PP pp, int seg, int row) {
  LAUNDER_PP;
  const int tid = tid_l(), c4 = tid * 4;
  const int srow = slot_row0(seg) + row;
  const bf16_t* gt = ((bf16_t*)(p.ws + OW_GT)) + (size_t)(gt_row0(seg) + row) * GTW;
  {
    float4 y = *(const float4*)(((float*)(p.ws + OW_YRW)) + (size_t)srow * DM + c4);
    float mean = rowsum16(y.x + y.y + y.z + y.w) * (1.0f / 64.0f);
    float dx = y.x - mean, dy = y.y - mean, dz = y.z - mean, dw = y.w - mean;
    float var = rowsum16(dx * dx + dy * dy + dz * dz + dw * dw) * (1.0f / 64.0f);
    float rs = rsqrtf(var + 64e-5f);
    float4 lw = *(const float4*)(p.rw_ln_w + c4), lb = *(const float4*)(p.rw_ln_b + c4);
    float bon = ((float*)(p.ws + OW_RWB))[(size_t)srow * 16 + (tid >> 4)];
    float4 v = *(const float4*)(((char*)(p.ws + OW_RWS)) + ((size_t)srow * 16 + (tid >> 4)) * 1024 + 768 + (tid & 15) * 16);
    uint2 g = *(const uint2*)(gt + G_RW + c4);
    float o0 = (dx * rs * lw.x + lb.x + bon * v.x) * siluf_(bf2f(g.x & 0xffff));
    float o1 = (dy * rs * lw.y + lb.y + bon * v.y) * siluf_(bf2f(g.x >> 16));
    float o2 = (dz * rs * lw.z + lb.z + bon * v.z) * siluf_(bf2f(g.y & 0xffff));
    float o3 = (dw * rs * lw.w + lb.w + bon * v.w) * siluf_(bf2f(g.y >> 16));
    *(uint2*)(((bf16_t*)(p.ws + OW_YA)) + ((size_t)(seg & 1) * MP0 + row) * DM + c4) = make_uint2(pack2(o0, o1), pack2(o2, o3));
  }
  {
    float4 o = *(const float4*)(((float*)(p.ws + OW_OGD)) + (size_t)srow * DM + c4);
    float ss = rowsum16(o.x * o.x + o.y * o.y + o.z * o.z + o.w * o.w);
    ss += __shfl_xor(ss, 16);
    float rs = rsqrtf(ss * (1.0f / 128.0f) + 1e-6f);
    float4 nw = *(const float4*)(p.gd_norm_w + (c4 & 127));
    uint2 g = *(const uint2*)(gt + G_GD + c4);
    float o0 = o.x * rs * nw.x * siluf_(bf2f(g.x & 0xffff));
    float o1 = o.y * rs * nw.y * siluf_(bf2f(g.x >> 16));
    float o2 = o.z * rs * nw.z * siluf_(bf2f(g.y & 0xffff));
    float o3 = o.w * rs * nw.w * siluf_(bf2f(g.y >> 16));
    *(uint2*)(((bf16_t*)(p.ws + OW_YB)) + ((size_t)(seg & 1) * MP0 + row) * DM + c4) = make_uint2(pack2(o0, o1), pack2(o2, o3));
  }
}

#define SMEM_BYTES (32768 + 16)

__global__ void __launch_bounds__(256, 4) k_mega(Params p_arg) {
  PP pp = (PP)__builtin_amdgcn_kernarg_segment_ptr();
  __shared__ __attribute__((aligned(16))) char smem[SMEM_BYTES];
  cg::grid_group grid = cg::this_grid();
  const int bid = blockIdx.x, nb = gridDim.x;
  unsigned* sync = (unsigned*)(p.ws + OW_sync);
  const unsigned xcc = xcc_id() & 7u;
  if (bid >= NSCAN && threadIdx.x == 0) xb_add(&sync[SW_XCNT(xcc)], 1u);
  phase_weights(pp, bid, nb, smem);
  for (int it = bid; it < seg_MP(0) / 4; it += nb) xn_item(pp, 0, it);
  grid.sync();
  if (bid < NSCAN) {
    __builtin_amdgcn_s_setprio(3);
    if (bid < 128) scan_block_rw(pp, bid, smem);
    else scan_block_gd(pp, bid - 128, smem);
    return;
  }
  const int w = bid - NSCAN, NW = nb - NSCAN;
  unsigned* cfg = (unsigned*)(smem + 32768);
  if (threadIdx.x == 0) {
    unsigned mine = 0, nx = 0;
#pragma unroll
    for (unsigned j = 0; j < 8; j++) { unsigned c = xb_ld(&sync[SW_XCNT(j)]); nx += c > 0u ? 1u : 0u; mine = (j == xcc) ? c : mine; }
    cfg[0] = mine > 0u ? mine : 1u;
    cfg[1] = nx > 0u ? nx : 1u;
  }
  __syncthreads();
  for (int i = 0; i < NSEG + 5; i++) {
    const int sm = i - 4, snn = i - 5, sj = i - 3, so = i - 4, sp = i - 2;
    const bool front = i < NSEG;
    const bool mrg = sm >= 0 && sm < NSEG, nrm = snn >= 0 && snn < NSEG, back = sj >= 0 && sj < NSEG, outv = so >= 0 && so < NSEG,
               pst = sp >= 0 && sp < NSEG;
    {
      const int tmF = front ? seg_MP(i) / 128 : 1;
      const int nF = front ? tmF * (VW / 128) : 0;
      const int nM = mrg ? seg_MP(sm) / 4 : 0;
      const int nN = nrm ? seg_M(snn) / 4 : 0;
      if ((NW & 7) == 0) {
        const int x = w & 7, per = NW >> 3;
        const int ncol = front ? ((VW / 128 - x + 7) >> 3) : 0;
        for (int j = w >> 3; j < tmF * ncol; j += per) gemm_tile<0>(pp, i, j % tmF, x + 8 * (j / tmF), smem);
        for (int it = w; it < nM + nN; it += NW) {
          if (it < nM) merge_item(pp, it);
          else norm_item(pp, snn, it - nM);
        }
      } else {
        for (int it = w; it < nF + nM + nN; it += NW) {
          int t = it;
          if (t < nF) { gemm_tile<0>(pp, i, t % tmF, t / tmF, smem); continue; }
          t -= nF;
          if (t < nM) { merge_item(pp, t); continue; }
          t -= nM;
          norm_item(pp, snn, t);
        }
      }
      if (i == 1) {
        for (int it = w; it < 32 * 128; it += NW) sample_scan_task(pp, it, smem);
      }
    }
    worker_barrier((unsigned*)(p.ws + OW_sync), (const unsigned*)(smem + 32768));
    {
      const int nB = back ? (seg_MP(sj) / 128) * 8 : 0;
      const int nO = outv ? (seg_MP(so) / 128) * 8 : 0;
      const int nHeavy = 2 * nB + nO;
      const int nHeavyW = nHeavy < NW / 2 ? nHeavy : NW / 2;
      const int NL = NW - nHeavyW;
      const int ngrp = front ? seg_M(i) / 16 : 0;
      const int nRW = ngrp * 8, nGD = ngrp * 6;
      const int nX = (i + 1 < NSEG) ? seg_MP(i + 1) / 4 : 0;
      const int tot = nRW + nGD + nX;
      if (w >= NL) {
        for (int it = w - NL; it < nHeavy; it += nHeavyW) {
          int t = it;
          if (t < nB) { gemm_tile<1>(pp, sj, t >> 3, t & 7, smem); continue; }
          t -= nB;
          if (t < nB) { gemm_tile<3>(pp, sj, t >> 3, t & 7, smem); continue; }
          t -= nB;
          gemm_tile<2>(pp, so, t >> 3, t & 7, smem);
        }
      } else {
        for (int it = w; it < tot; it += NL) {
          int t = it;
          if (t < nRW) { rw_prepass_item(pp, i, t >> 2, t & 3, smem); continue; }
          t -= nRW;
          if (t < nGD) { gd_prepass_item(pp, i, t / 6, t % 6); continue; }
          t -= nGD;
          xn_item(pp, i + 1, t);
        }
      }
      if (pst) {
        wait_ge((unsigned*)(p.ws + OW_sync) + SW_SCAN(sp), NSCAN);
        const int n = seg_M(sp);
        for (int it = w; it < n; it += NW) post_item(pp, sp, it);
      }
    }
    worker_barrier((unsigned*)(p.ws + OW_sync), (const unsigned*)(smem + 32768));
    if (front && w == 0 && threadIdx.x == 0)
      __hip_atomic_store((unsigned*)(p.ws + OW_sync) + SW_PRE, (unsigned)(i + 1), __ATOMIC_RELAXED, __HIP_MEMORY_SCOPE_AGENT);
  }
}

static inline size_t align_up(size_t x) { return (x + 255) & ~(size_t)255; }

#undef p
extern "C" void kernel_launch(void* const* d_in, const int* in_sizes, int n_in, void* d_out, int out_size, void* d_ws,
                              size_t ws_size, hipStream_t stream) {
  Params p{};
  const float* const* in = (const float* const*)d_in;
  p.x_prompt = in[0]; p.x_sample = in[1]; p.st_shift = in[2]; p.st_wkv = in[3]; p.st_conv = in[4]; p.st_ssm = in[5];
  p.meta = in[6]; p.norm_pre = in[7]; p.w_in = in[8]; p.rw_mu = in[9]; p.rw_w0 = in[10]; p.rw_w2 = in[11];
  p.rw_a0 = in[12]; p.rw_a2 = in[13]; p.rw_k_k = in[14]; p.rw_k_a = in[15]; p.rw_r_k = in[16]; p.rw_ln_w = in[17];
  p.rw_ln_b = in[18]; p.gd_conv_w = in[19]; p.gd_a_log = in[20]; p.gd_dt_bias = in[21]; p.gd_norm_w = in[22];
  p.w_out_a = in[23]; p.w_out_b = in[24]; p.w_out = in[25]; p.norm_post = in[26];
  p.out = (float*)d_out;
  p.ws = (char*)d_ws;
  if (OW_END > ws_size) { fprintf(stderr, "workspace too small: need %zu have %zu\n", (size_t)OW_END, ws_size); return; }

  static int grid_blocks = 0;
  if (!grid_blocks) {
    int dev = 0, cus = 0, per_cu = 0;
    (void)hipGetDevice(&dev);
    (void)hipDeviceGetAttribute(&cus, hipDeviceAttributeMultiprocessorCount, dev);
    (void)hipOccupancyMaxActiveBlocksPerMultiprocessor(&per_cu, k_mega, 256, 0);
    if (per_cu > 4) per_cu = 4;
    grid_blocks = cus * per_cu;
  }
  (void)hipMemsetAsync(p.ws + OW_sync, 0, 16384, stream);
  void* args[] = {&p};
  hipError_t e = hipLaunchCooperativeKernel((void*)k_mega, dim3(grid_blocks), dim3(256), args, 0, stream);
  if (e != hipSuccess) fprintf(stderr, "cooperative launch failed: %s (grid %d)\n", hipGetErrorString(e), grid_blocks);
}
```

```cpp
#include <hip/hip_runtime.h>
#include <hip/hip_cooperative_groups.h>
#include <stdint.h>
#include <stdio.h>
namespace cg = cooperative_groups;

typedef unsigned short bf16_t;
typedef _Float16 f16;
using bf16x8 = __attribute__((ext_vector_type(8))) short;
using f32x4 = __attribute__((ext_vector_type(4))) float;
using u32x4 = __attribute__((ext_vector_type(4))) unsigned int;
using f32x16 = __attribute__((ext_vector_type(16))) float;
using f16x2 = __attribute__((ext_vector_type(2))) _Float16;
using f16x4 = __attribute__((ext_vector_type(4))) _Float16;
using f16x8 = __attribute__((ext_vector_type(8))) _Float16;

#define DM 1024
#define PW 10384
#define VW 10496
#define PJW 6400
#define GTW 4096
#define NSEG 16
#define TS 512
#define M0 1568
#define MP0 1664
#define M1 1024
#define SLOT_ROWS 3712
#define GT_ROWS 4736
#define NSCAN 256
#define C_GDC 3200
#define C_BETA 6272
#define C_ALPHA 6280
#define G_RW 0
#define G_GD 1024
#define G_MA 2048
#define G_MB 3072
#define RWS_ROWB 16384
#define GDS_HB 784
#define GDS_ROWB 6272

struct Params {
  const float *x_prompt, *x_sample, *st_shift, *st_wkv, *st_conv, *st_ssm, *meta, *norm_pre, *w_in, *rw_mu, *rw_w0,
      *rw_w2, *rw_a0, *rw_a2, *rw_k_k, *rw_k_a, *rw_r_k, *rw_ln_w, *rw_ln_b, *gd_conv_w, *gd_a_log, *gd_dt_bias,
      *gd_norm_w, *w_out_a, *w_out_b, *w_out, *norm_post;
  float* out;
  char* ws;
};
#define p (PV(pp))
#define GLOBAL_AS __attribute__((address_space(1)))
#define CONST_AS __attribute__((address_space(4)))
struct ParamsG {
  const GLOBAL_AS float *x_prompt, *x_sample, *st_shift, *st_wkv, *st_conv, *st_ssm, *meta, *norm_pre, *w_in, *rw_mu, *rw_w0,
      *rw_w2, *rw_a0, *rw_a2, *rw_k_k, *rw_k_a, *rw_r_k, *rw_ln_w, *rw_ln_b, *gd_conv_w, *gd_a_log, *gd_dt_bias,
      *gd_norm_w, *w_out_a, *w_out_b, *w_out, *norm_post;
  GLOBAL_AS float* out;
  GLOBAL_AS char* ws;
};
typedef const CONST_AS ParamsG* PP;
__device__ __forceinline__ Params PV(PP pp) {
  Params v;
  v.x_prompt = (const float*)pp->x_prompt;
  v.x_sample = (const float*)pp->x_sample;
  v.st_shift = (const float*)pp->st_shift;
  v.st_wkv = (const float*)pp->st_wkv;
  v.st_conv = (const float*)pp->st_conv;
  v.st_ssm = (const float*)pp->st_ssm;
  v.meta = (const float*)pp->meta;
  v.norm_pre = (const float*)pp->norm_pre;
  v.w_in = (const float*)pp->w_in;
  v.rw_mu = (const float*)pp->rw_mu;
  v.rw_w0 = (const float*)pp->rw_w0;
  v.rw_w2 = (const float*)pp->rw_w2;
  v.rw_a0 = (const float*)pp->rw_a0;
  v.rw_a2 = (const float*)pp->rw_a2;
  v.rw_k_k = (const float*)pp->rw_k_k;
  v.rw_k_a = (const float*)pp->rw_k_a;
  v.rw_r_k = (const float*)pp->rw_r_k;
  v.rw_ln_w = (const float*)pp->rw_ln_w;
  v.rw_ln_b = (const float*)pp->rw_ln_b;
  v.gd_conv_w = (const float*)pp->gd_conv_w;
  v.gd_a_log = (const float*)pp->gd_a_log;
  v.gd_dt_bias = (const float*)pp->gd_dt_bias;
  v.gd_norm_w = (const float*)pp->gd_norm_w;
  v.w_out_a = (const float*)pp->w_out_a;
  v.w_out_b = (const float*)pp->w_out_b;
  v.w_out = (const float*)pp->w_out;
  v.norm_post = (const float*)pp->norm_post;
  v.out = (float*)pp->out;
  v.ws = (char*)pp->ws;
  return v;
}
constexpr size_t al256(size_t x) { return (x + 255) & ~(size_t)255; }
constexpr size_t OO_y_prompt = 0;
constexpr size_t OO_y_sample = OO_y_prompt + (size_t)2 * 8192 * 1024;
constexpr size_t OO_p_shift = OO_y_sample + (size_t)32 * 16 * 1024;
constexpr size_t OO_p_wkv = OO_p_shift + 2 * 3200;
constexpr size_t OO_p_conv = OO_p_wkv + 2 * 16 * 4096;
constexpr size_t OO_p_ssm = OO_p_conv + 2 * 3 * 3072;
constexpr size_t OO_s_shift = OO_p_ssm + 2 * 8 * 16384;
constexpr size_t OO_s_wkv = OO_s_shift + 32 * 3200;
constexpr size_t OO_s_conv = OO_s_wkv + 32 * 16 * 4096;
constexpr size_t OO_s_ssm = OO_s_conv + 32 * 3 * 3072;
constexpr size_t OW_sync = 0;
constexpr size_t OW_WtIn = OW_sync + 16384;
constexpr size_t OW_WtA = OW_WtIn + al256((size_t)VW * DM * 2);
constexpr size_t OW_WtB = OW_WtA + al256((size_t)DM * DM * 2);
constexpr size_t OW_WtO = OW_WtB + al256((size_t)DM * DM * 2);
constexpr size_t OW_XN = OW_WtO + al256((size_t)DM * DM * 2);
constexpr size_t OW_PJA = OW_XN + al256((size_t)MP0 * DM * 2);
constexpr size_t OW_YA = OW_PJA + al256((size_t)MP0 * PJW * 2);
constexpr size_t OW_YB = OW_YA + al256((size_t)2 * MP0 * DM * 2);
constexpr size_t OW_MG = OW_YB + al256((size_t)2 * MP0 * DM * 2);
constexpr size_t OW_OUTB = OW_MG + al256((size_t)MP0 * DM * 2);
constexpr size_t OW_TMP = OW_OUTB + al256((size_t)2 * MP0 * DM * 4);
constexpr size_t OW_GT = OW_TMP + al256((size_t)2 * MP0 * DM * 4);
constexpr size_t OW_RWS = OW_GT + al256((size_t)GT_ROWS * GTW * 2);
constexpr size_t OW_GDS = OW_RWS + al256((size_t)SLOT_ROWS * RWS_ROWB);
constexpr size_t OW_RWB = OW_GDS + al256((size_t)SLOT_ROWS * GDS_ROWB + 256);
constexpr size_t OW_YRW = OW_RWB + al256((size_t)SLOT_ROWS * 16 * 4);
constexpr size_t OW_OGD = OW_YRW + al256((size_t)SLOT_ROWS * DM * 4);
constexpr size_t OW_CSH = OW_OGD + al256((size_t)SLOT_ROWS * DM * 4);
constexpr size_t OW_CCV = OW_CSH + al256((size_t)2 * 2 * 3200 * 4);
constexpr size_t OW_END = OW_CCV + al256((size_t)2 * 2 * 3 * 3072 * 4);


__device__ __forceinline__ bf16_t f2bf(float f) {
  uint32_t u = __float_as_uint(f);
  u += 0x7fffu + ((u >> 16) & 1u);
  return (bf16_t)(u >> 16);
}
__device__ __forceinline__ float bf2f(bf16_t h) { return __uint_as_float(((uint32_t)h) << 16); }
__device__ __forceinline__ uint32_t pack2(float a, float b) { return (uint32_t)f2bf(a) | ((uint32_t)f2bf(b) << 16); }
__device__ __forceinline__ float sigmoidf_(float x) { return 1.0f / (1.0f + __expf(-x)); }
__device__ __forceinline__ float siluf_(float x) { return x / (1.0f + __expf(-x)); }
__device__ __forceinline__ float softplusf_(float x) { return fmaxf(x, 0.0f) + log1pf(__expf(-fabsf(x))); }

__device__ __forceinline__ int tid_l() { int t = threadIdx.x; asm volatile("" : "+v"(t)); return t; }
#define LAUNDER_PP asm volatile("" : "+s"(pp))
template <int CTRL>
__device__ __forceinline__ float dppf(float x) {
  return __builtin_bit_cast(float, __builtin_amdgcn_update_dpp(0, __builtin_bit_cast(int, x), CTRL, 0xf, 0xf, true));
}
__device__ __forceinline__ float rowsum16(float x) {
  x += dppf<0xB1>(x);
  x += dppf<0x4E>(x);
  x += dppf<0x141>(x);
  x += dppf<0x140>(x);
  return x;
}
__device__ __forceinline__ float wavesum(float x) {
  x = rowsum16(x);
  x += __shfl_xor(x, 16);
  x += __shfl_xor(x, 32);
  return x;
}

#define SW_XCNT(j) (64 * (1 + (j)))
#define SW_XSUB(j) (64 * (9 + (j)))
#define SW_XGEN(j) (64 * (17 + (j)))
#define SW_TOP (64 * 25)
#define SW_TOPGEN (64 * 26)
#define SW_PRE (64 * 27)
#define SW_SCAN(s) (64 * (28 + (s)))
#define SYNC_BYTES 16384
__device__ __forceinline__ unsigned xb_ld(const unsigned* ptr) {
  return __hip_atomic_load(ptr, __ATOMIC_RELAXED, __HIP_MEMORY_SCOPE_AGENT);
}
__device__ __forceinline__ unsigned xb_add(unsigned* ptr, unsigned v) {
  return __hip_atomic_fetch_add(ptr, v, __ATOMIC_RELAXED, __HIP_MEMORY_SCOPE_AGENT);
}
__device__ __forceinline__ unsigned xcc_id() { return (unsigned)__builtin_amdgcn_s_getreg((3 << 11) | 20) & 0xFu; }
__device__ __forceinline__ void wait_ge(const unsigned* ptr, unsigned target) {
  if (threadIdx.x == 0) {
    while (xb_ld(ptr) < target) __builtin_amdgcn_s_sleep(8);
    __builtin_amdgcn_fence(__ATOMIC_ACQUIRE, "agent");
    asm volatile("s_waitcnt vmcnt(0)" ::: "memory");
  }
  __syncthreads();
}
__device__ __forceinline__ void signal_add(unsigned* ptr) {
  asm volatile("s_waitcnt vmcnt(0)" ::: "memory");
  __syncthreads();
  if (threadIdx.x == 0) {
    __builtin_amdgcn_fence(__ATOMIC_RELEASE, "agent");
    asm volatile("s_waitcnt vmcnt(0)" ::: "memory");
    xb_add(ptr, 1u);
  }
}
__device__ __forceinline__ void worker_barrier(unsigned* bar, const unsigned* lds_cfg) {
  asm volatile("s_waitcnt vmcnt(0)" ::: "memory");
  __syncthreads();
  if (threadIdx.x == 0) {
    const unsigned x = xcc_id() & 7u, nloc = lds_cfg[0], nx = lds_cfg[1];
    const unsigned old = xb_add(&bar[SW_XSUB(x)], 1u);
    const unsigned gen = old / nloc;
    if (old + 1u == (gen + 1u) * nloc) {
      __builtin_amdgcn_fence(__ATOMIC_RELEASE, "agent");
      asm volatile("s_waitcnt vmcnt(0)" ::: "memory");
      const unsigned og = xb_add(&bar[SW_TOP], 1u);
      const unsigned tg = og / nx;
      if (og + 1u == (tg + 1u) * nx) xb_add(&bar[SW_TOPGEN], 1u);
      else while (xb_ld(&bar[SW_TOPGEN]) == tg) __builtin_amdgcn_s_sleep(1);
      __builtin_amdgcn_fence(__ATOMIC_ACQUIRE, "agent");
      xb_add(&bar[SW_XGEN(x)], 1u);
      asm volatile("s_waitcnt vmcnt(0)" ::: "memory");
    } else {
      while (xb_ld(&bar[SW_XGEN(x)]) == gen) __builtin_amdgcn_s_sleep(1);
      __builtin_amdgcn_fence(__ATOMIC_ACQUIRE, "agent");
      asm volatile("s_waitcnt vmcnt(0)" ::: "memory");
    }
  }
  __syncthreads();
}

__device__ __forceinline__ void lds_barrier() {
  asm volatile("s_waitcnt lgkmcnt(0)" ::: "memory");
  __builtin_amdgcn_s_barrier();
  asm volatile("" ::: "memory");
}

__device__ __forceinline__ int seg_M(int seg) { return seg == 0 ? M0 : M1; }
__device__ __forceinline__ int seg_MP(int seg) { return seg == 0 ? MP0 : M1; }
__device__ __forceinline__ int slot_row0(int seg) { int s = seg % 3; return s == 0 ? 0 : MP0 + (s - 1) * M1; }
__device__ __forceinline__ int gt_row0(int seg) { int s = seg & 3; return s == 0 ? 0 : MP0 + (s - 1) * M1; }
__device__ __forceinline__ const float* row_src(PP pp, int seg, int r) {
  if (seg == 0) {
    if (r < 1056) {
      int b = r >= 528 ? 1 : 0, t = r - b * 528;
      if (t < 16) return p.meta + t * DM;
      return p.x_prompt + ((size_t)b * 8192 + (t - 16)) * DM;
    }
    return p.x_sample + (size_t)(r - 1056) * DM;
  }
  int b = r >> 9, t = r & 511;
  return p.x_prompt + ((size_t)b * 8192 + seg * TS + t) * DM;
}
__device__ __forceinline__ float* row_dst(PP pp, int seg, int r) {
  if (seg == 0) {
    if (r < 1056) {
      int b = r >= 528 ? 1 : 0, t = r - b * 528;
      if (t < 16) return nullptr;
      return (p.out + OO_y_prompt) + ((size_t)b * 8192 + (t - 16)) * DM;
    }
    return (p.out + OO_y_sample) + (size_t)(r - 1056) * DM;
  }
  int b = r >> 9, t = r & 511;
  return (p.out + OO_y_prompt) + ((size_t)b * 8192 + seg * TS + t) * DM;
}
__device__ __forceinline__ void row_seq(int seg, int r, int& seq, int& t, int& len) {
  if (seg == 0) {
    if (r < 528) { seq = 0; t = r; len = 528; }
    else if (r < 1056) { seq = 1; t = r - 528; len = 528; }
    else { seq = 2 + ((r - 1056) >> 4); t = (r - 1056) & 15; len = 16; }
  } else { seq = r >> 9; t = r & 511; len = TS; }
}

__device__ __forceinline__ size_t blk_off(int row, int k) {
  return ((size_t)((row >> 7) * 32 + (k >> 5)) * 128 + (row & 127)) * 32 + (k & 31);
}

__device__ __forceinline__ int vcol_src(int n) {
  if (n < 3200) return n;
  if (n < 6288) return n + 1024;
  if (n < 6400) return -1;
  if (n < 7424) return n - 3200;
  return n - 112;
}
__device__ __forceinline__ void transpose_tile(const float* __restrict__ src, int ld, bool remap, bf16_t* __restrict__ dst, int k0, int n0,
                               float* tile  ) {
  int tid = tid_l();
  int i = tid >> 4, j = tid & 15;
  __syncthreads();
  int n = n0 + 4 * j;
  int sc = remap ? vcol_src(n) : n;
#pragma unroll
  for (int pass = 0; pass < 4; pass++) {
    int k = pass * 16 + i;
    float4 v = make_float4(0.f, 0.f, 0.f, 0.f);
    if (sc >= 0) v = *(const float4*)(src + (size_t)(k0 + k) * ld + sc);
    tile[k * 65 + 4 * j + 0] = v.x; tile[k * 65 + 4 * j + 1] = v.y; tile[k * 65 + 4 * j + 2] = v.z; tile[k * 65 + 4 * j + 3] = v.w;
  }
  __syncthreads();
  int nn = tid >> 2, kq = tid & 3;
  uint32_t o[8];
#pragma unroll
  for (int e = 0; e < 8; e++) o[e] = pack2(tile[(kq * 16 + 2 * e) * 65 + nn], tile[(kq * 16 + 2 * e + 1) * 65 + nn]);
  u32x4* d = (u32x4*)(dst + blk_off(n0 + nn, k0 + kq * 16));
  d[0] = (u32x4){o[0], o[1], o[2], o[3]};
  d[1] = (u32x4){o[4], o[5], o[6], o[7]};
}
__device__ __forceinline__ void phase_weights(PP pp, int bid, int nb, char* smem) {
  LAUNDER_PP;
  float* tile = (float*)smem;
  const int nIn = 16 * (VW / 64);
  const int nSq = 16 * 16;
  for (int it = bid; it < nIn + 3 * nSq; it += nb) {
    if (it < nIn) {
      int kt = it & 15, nt = it >> 4;
      transpose_tile(p.w_in, PW, true, ((bf16_t*)(p.ws + OW_WtIn)), kt * 64, nt * 64, tile);
    } else {
      int j = it - nIn, w = j / nSq, r = j % nSq;
      int kt = r & 15, nt = r >> 4;
      const float* src = w == 0 ? p.w_out_a : (w == 1 ? p.w_out_b : p.w_out);
      bf16_t* dst = w == 0 ? ((bf16_t*)(p.ws + OW_WtA)) : (w == 1 ? ((bf16_t*)(p.ws + OW_WtB)) : ((bf16_t*)(p.ws + OW_WtO)));
      transpose_tile(src, DM, false, dst, kt * 64, nt * 64, tile);
    }
  }
}

__device__ __forceinline__ void xn_item(PP pp, int seg, int item) {
  LAUNDER_PP;
  int wave = tid_l() >> 6, lane = tid_l() & 63;
  int M = seg_M(seg);
  int r = item * 4 + wave;
  bf16_t* o = ((bf16_t*)(p.ws + OW_XN));
  if (r >= M) {
#pragma unroll
    for (int i = 0; i < 4; i++) *(uint2*)(o + blk_off(r, (lane + 64 * i) * 4)) = make_uint2(0u, 0u);
    return;
  }
  const float4* src = (const float4*)row_src(pp, seg, r);
  float4 v[4];
  float ss = 0.f;
#pragma unroll
  for (int i = 0; i < 4; i++) {
    v[i] = src[lane + 64 * i];
    ss += v[i].x * v[i].x + v[i].y * v[i].y + v[i].z * v[i].z + v[i].w * v[i].w;
  }
  ss = wavesum(ss);
  float rstd = rsqrtf(ss * (1.0f / DM) + 1e-6f);
#pragma unroll
  for (int i = 0; i < 4; i++) {
    float4 g = ((const float4*)p.norm_pre)[lane + 64 * i];
    *(uint2*)(o + blk_off(r, (lane + 64 * i) * 4)) =
        make_uint2(pack2(v[i].x * rstd * g.x, v[i].y * rstd * g.y), pack2(v[i].z * rstd * g.z, v[i].w * rstd * g.w));
  }
}

__device__ __forceinline__ void norm_item(PP pp, int seg, int item) {
  LAUNDER_PP;
  int wave = tid_l() >> 6, lane = tid_l() & 63;
  int r = item * 4 + wave;
  float* dst = row_dst(pp, seg, r);
  if (!dst) return;
  const float4* h = (const float4*)row_src(pp, seg, r);
  const float4* o = (const float4*)(((float*)(p.ws + OW_OUTB)) + ((size_t)(seg & 1) * MP0 + r) * DM);
  float4 v[4];
  float ss = 0.f;
#pragma unroll
  for (int i = 0; i < 4; i++) {
    v[i] = o[lane + 64 * i];
    ss += v[i].x * v[i].x + v[i].y * v[i].y + v[i].z * v[i].z + v[i].w * v[i].w;
  }
  ss = wavesum(ss);
  float rstd = rsqrtf(ss * (1.0f / DM) + 1e-6f);
#pragma unroll
  for (int i = 0; i < 4; i++) {
    float4 g = ((const float4*)p.norm_post)[lane + 64 * i];
    float4 hh = h[lane + 64 * i];
    ((float4*)dst)[lane + 64 * i] =
        make_float4(hh.x + v[i].x * rstd * g.x, hh.y + v[i].y * rstd * g.y, hh.z + v[i].z * rstd * g.z, hh.w + v[i].w * rstd * g.w);
  }
}

__device__ __forceinline__ void merge_item(PP pp, int item) {
  LAUNDER_PP;
  const int tid = tid_l();
  const int wave = tid >> 6, lane = tid & 63;
  const int r = item * 4 + wave;
  const float4* t1 = (const float4*)((const float*)(p.ws + OW_TMP) + (size_t)r * DM);
  const float4* t2 = (const float4*)((const float*)(p.ws + OW_TMP) + ((size_t)MP0 + r) * DM);
  bf16_t* o = (bf16_t*)(p.ws + OW_MG);
#pragma unroll
  for (int i = 0; i < 4; i++) {
    float4 a = t1[lane + 64 * i], b = t2[lane + 64 * i];
    *(uint2*)(o + blk_off(r, (lane + 64 * i) * 4)) = make_uint2(pack2(a.x + b.x, a.y + b.y), pack2(a.z + b.z, a.w + b.w));
  }
}

#define LDT 32
template <int MODE>
__device__ __forceinline__ void gemm_tile(PP pp, int seg, int tm, int tn, char* smem) {
  LAUNDER_PP;
  const int tid = tid_l(), lane = tid & 63, wid = tid >> 6;
  const int wr = wid >> 1, wc = wid & 1, l31 = lane & 31, lh = lane >> 5;
  const int lrow = tid >> 2, lkc = tid & 3;
  const int m0 = tm * 128, n0 = tn * 128;
  bf16_t* GTs = ((bf16_t*)(p.ws + OW_GT)) + (size_t)gt_row0(seg) * GTW;
  f32x16 acc[2][2];
#pragma unroll
  for (int a = 0; a < 2; a++)
#pragma unroll
    for (int b = 0; b < 2; b++)
#pragma unroll
      for (int e = 0; e < 16; e++) acc[a][b][e] = 0.f;
  {
    const bf16_t* A = (MODE == 0) ? (const bf16_t*)(p.ws + OW_XN)
                    : (MODE == 1) ? (const bf16_t*)(p.ws + OW_YA) + (size_t)(seg & 1) * MP0 * DM
                    : (MODE == 3) ? (const bf16_t*)(p.ws + OW_YB) + (size_t)(seg & 1) * MP0 * DM
                                  : (const bf16_t*)(p.ws + OW_MG);
    const bf16_t* Bt = (const bf16_t*)(p.ws + (MODE == 0 ? OW_WtIn : (MODE == 1 ? OW_WtA : (MODE == 3 ? OW_WtB : OW_WtO))));
    u32x4 ra[2], rb[2];
    const bf16_t* gA = A + ((size_t)(tm * 32) * 128 + lrow) * 32 + lkc * 8;
    const bf16_t* gB = Bt + ((size_t)(tn * 32) * 128 + lrow) * 32 + lkc * 8;
    const int wofs = lrow * 64 + ((lkc ^ ((lrow >> 2) & 3)) << 4);
    const int sw = (l31 >> 2) & 3;
    const int rofs0 = l31 * 64 + (((0 + lh) ^ sw) << 4);
    const int rofs1 = l31 * 64 + (((2 + lh) ^ sw) << 4);
    __syncthreads();
#pragma unroll
    for (int i = 0; i < 2; i++) {
      ra[i] = *(const u32x4*)(gA + (size_t)i * 2048);
      rb[i] = *(const u32x4*)(gB + (size_t)i * 2048);
    }
#pragma unroll
    for (int i = 0; i < 2; i++) {
      *(u32x4*)(smem + wofs + i * 4096) = ra[i];
      *(u32x4*)(smem + 8192 + wofs + i * 4096) = rb[i];
    }
#pragma unroll
    for (int i = 0; i < 2; i++) {
      ra[i] = *(const u32x4*)(gA + (size_t)i * 2048 + 4096);
      rb[i] = *(const u32x4*)(gB + (size_t)i * 2048 + 4096);
    }
    lds_barrier();
#pragma unroll 1
    for (int kt = 0; kt < 32; kt++) {
      const char* cA = smem + (kt & 1) * 16384 + wr * 4096;
      const char* cB = smem + (kt & 1) * 16384 + 8192 + wc * 4096;
      const bf16x8 x00 = *(const bf16x8*)(cA + rofs0), x01 = *(const bf16x8*)(cA + 2048 + rofs0);
      const bf16x8 w00 = *(const bf16x8*)(cB + rofs0), w01 = *(const bf16x8*)(cB + 2048 + rofs0);
      const bf16x8 x10 = *(const bf16x8*)(cA + rofs1), x11 = *(const bf16x8*)(cA + 2048 + rofs1);
      const bf16x8 w10 = *(const bf16x8*)(cB + rofs1), w11 = *(const bf16x8*)(cB + 2048 + rofs1);
      asm volatile("" ::: "memory");
      acc[0][0] = __builtin_amdgcn_mfma_f32_32x32x16_bf16(w00, x00, acc[0][0], 0, 0, 0);
      acc[0][1] = __builtin_amdgcn_mfma_f32_32x32x16_bf16(w00, x01, acc[0][1], 0, 0, 0);
      acc[1][0] = __builtin_amdgcn_mfma_f32_32x32x16_bf16(w01, x00, acc[1][0], 0, 0, 0);
      acc[1][1] = __builtin_amdgcn_mfma_f32_32x32x16_bf16(w01, x01, acc[1][1], 0, 0, 0);
      acc[0][0] = __builtin_amdgcn_mfma_f32_32x32x16_bf16(w10, x10, acc[0][0], 0, 0, 0);
      acc[0][1] = __builtin_amdgcn_mfma_f32_32x32x16_bf16(w10, x11, acc[0][1], 0, 0, 0);
      acc[1][0] = __builtin_amdgcn_mfma_f32_32x32x16_bf16(w11, x10, acc[1][0], 0, 0, 0);
      acc[1][1] = __builtin_amdgcn_mfma_f32_32x32x16_bf16(w11, x11, acc[1][1], 0, 0, 0);
      if (kt + 1 < 32) {
        char* nx = smem + ((kt + 1) & 1) * 16384;
#pragma unroll
        for (int i = 0; i < 2; i++) {
          *(u32x4*)(nx + wofs + i * 4096) = ra[i];
          *(u32x4*)(nx + 8192 + wofs + i * 4096) = rb[i];
        }
        if (kt + 2 < 32) {
#pragma unroll
          for (int i = 0; i < 2; i++) {
            ra[i] = *(const u32x4*)(gA + (size_t)i * 2048 + (size_t)(kt + 2) * 4096);
            rb[i] = *(const u32x4*)(gB + (size_t)i * 2048 + (size_t)(kt + 2) * 4096);
          }
        }
      }
      lds_barrier();
    }
  }
  float* OUTBp = (MODE == 2) ? (float*)(p.ws + OW_OUTB) + (size_t)(seg & 1) * MP0 * DM
                             : (float*)(p.ws + OW_TMP) + (size_t)(MODE == 3 ? 1 : 0) * MP0 * DM;
#pragma unroll
  for (int ni = 0; ni < 2; ni++)
#pragma unroll
    for (int mi = 0; mi < 2; mi++)
#pragma unroll
      for (int g = 0; g < 4; g++) {
        const int m = m0 + wr * 64 + mi * 32 + l31;
        const int n = n0 + wc * 64 + ni * 32 + 8 * g + 4 * lh;
        const float c0 = acc[ni][mi][4 * g], c1 = acc[ni][mi][4 * g + 1], c2 = acc[ni][mi][4 * g + 2], c3 = acc[ni][mi][4 * g + 3];
        if (MODE == 0) {
          uint2 o = make_uint2(pack2(c0, c1), pack2(c2, c3));
          if (tn < PJW / 128) *(uint2*)(((bf16_t*)(p.ws + OW_PJA)) + (size_t)m * PJW + n) = o;
          else *(uint2*)(GTs + (size_t)m * GTW + (n - PJW)) = o;
        } else if (MODE == 1 || MODE == 3) {
          uint2 ga = *(const uint2*)(GTs + (size_t)m * GTW + (MODE == 1 ? G_MA : G_MB) + n);
          *(float4*)(OUTBp + (size_t)m * DM + n) =
              make_float4(sigmoidf_(bf2f(ga.x & 0xffff)) * c0, sigmoidf_(bf2f(ga.x >> 16)) * c1,
                          sigmoidf_(bf2f(ga.y & 0xffff)) * c2, sigmoidf_(bf2f(ga.y >> 16)) * c3);
        } else {
          *(float4*)(OUTBp + (size_t)m * DM + n) = make_float4(c0, c1, c2, c3);
        }
      }
}

__device__ __forceinline__ void rw_prepass_item(PP pp, int seg, int grp, int slab, char* smem) {
  LAUNDER_PP;
  float* lwa = (float*)smem;
  const int tid = tid_l();
  const int r0 = grp * 8;
  int seq, t0, len;
  row_seq(seg, r0, seq, t0, len);
  const bool prompt = seq < 2;
  const float* prev0 = nullptr;
  if (t0 == 0) {
    if (seg == 0) prev0 = prompt ? nullptr : p.st_shift + (size_t)(seq - 2) * 3200;
    else prev0 = ((float*)(p.ws + OW_CSH)) + ((size_t)(seg & 1) * 2 + seq) * 3200;
  }
  __syncthreads();
  {
    const int j = tid & 127;
    const float mu = p.rw_mu[3072 + j];
#pragma unroll
    for (int i = 0; i < 4; i++) {
      int tok = (tid >> 7) + 2 * i;
      int row = r0 + tok;
      float ps = bf2f(((bf16_t*)(p.ws + OW_PJA))[(size_t)row * PJW + 3072 + j]);
      float pv;
      if (tok == 0 && t0 == 0) pv = prev0 ? prev0[3072 + j] : 0.f;
      else pv = bf2f(((bf16_t*)(p.ws + OW_PJA))[(size_t)(row - 1) * PJW + 3072 + j]);
      float xs = ps + mu * (pv - ps);
      lwa[tok * 128 + j] = j < 64 ? tanhf(xs) : xs;
      if (slab == 0 && t0 + tok == len - 1) {
        if (prompt) {
          ((float*)(p.ws + OW_CSH))[((size_t)((seg + 1) & 1) * 2 + seq) * 3200 + 3072 + j] = ps;
          if (seg == NSEG - 1) (p.out + OO_p_shift)[(size_t)seq * 3200 + 3072 + j] = ps;
        } else {
          (p.out + OO_s_shift)[(size_t)(seq - 2) * 3200 + 3072 + j] = ps;
        }
      }
    }
  }
  __syncthreads();
  const int c = slab * 256 + tid;
  float dw[8], da[8];
  {
    const float w0 = p.rw_w0[c], a0 = p.rw_a0[c];
#pragma unroll
    for (int t = 0; t < 8; t++) { dw[t] = w0; da[t] = a0; }
  }
  for (int j = 0; j < 64; j += 4) {
    float w2v[4], a2v[4];
#pragma unroll
    for (int e = 0; e < 4; e++) {
      w2v[e] = p.rw_w2[(size_t)(j + e) * DM + c];
      a2v[e] = p.rw_a2[(size_t)(j + e) * DM + c];
    }
#pragma unroll
    for (int t = 0; t < 8; t++) {
      float4 lw = *(const float4*)(lwa + t * 128 + j);
      float4 la = *(const float4*)(lwa + t * 128 + 64 + j);
      dw[t] += lw.x * w2v[0] + lw.y * w2v[1] + lw.z * w2v[2] + lw.w * w2v[3];
      da[t] += la.x * a2v[0] + la.y * a2v[1] + la.z * a2v[2] + la.w * a2v[3];
    }
  }
  const float mur = p.rw_mu[c], muk = p.rw_mu[1024 + c], muv = p.rw_mu[2048 + c];
  const float kk_w = p.rw_k_k[c], ka_w = p.rw_k_a[c], rk_w = p.rw_r_k[c];
  float pr, pk, pv;
  if (t0 == 0) {
    pr = prev0 ? prev0[c] : 0.f; pk = prev0 ? prev0[1024 + c] : 0.f; pv = prev0 ? prev0[2048 + c] : 0.f;
  } else {
    const bf16_t* q = ((bf16_t*)(p.ws + OW_PJA)) + (size_t)(r0 - 1) * PJW;
    pr = bf2f(q[c]); pk = bf2f(q[1024 + c]); pv = bf2f(q[2048 + c]);
  }
  const int head = c >> 6, e = c & 63;
  const int srow0 = slot_row0(seg);
  char* rws = ((char*)(p.ws + OW_RWS)) + ((size_t)(srow0 + r0) * 16 + head) * 1024;
  float* rwb = ((float*)(p.ws + OW_RWB)) + (size_t)(srow0 + r0) * 16 + head;
#pragma unroll
  for (int t = 0; t < 8; t++) {
    const int row = r0 + t;
    const bf16_t* q = ((bf16_t*)(p.ws + OW_PJA)) + (size_t)row * PJW;
    float cr = bf2f(q[c]), ck = bf2f(q[1024 + c]), cv = bf2f(q[2048 + c]);
    float xr = cr + mur * (pr - cr), xk = ck + muk * (pk - ck), xv = cv + muv * (pv - cv);
    pr = cr; pk = ck; pv = cv;
    float w_log = -softplusf_(-dw[t]) - 0.5f;
    float decay = __expf(-__expf(w_log));
    float a = sigmoidf_(da[t]);
    float kkr = xk * kk_w;
    float ss = wavesum(kkr * kkr);
    float kk = kkr * rsqrtf(ss + 1e-6f);
    float k2 = xk * (1.0f + (a - 1.0f) * ka_w);
    float bon = wavesum(xr * k2 * rk_w);
    char* o = rws + (size_t)t * RWS_ROWB;
    ((f16*)o)[e] = (f16)xr;
    ((f16*)(o + 128))[e] = (f16)k2;
    ((f16*)(o + 256))[e] = (f16)(-kk);
    ((f16*)(o + 384))[e] = (f16)(kk * a);
    ((float*)(o + 512))[e] = decay;
    ((float*)(o + 768))[e] = xv;
    if ((tid & 63) == 0) rwb[(size_t)t * 16] = bon;
    if (t0 + t == len - 1) {
      if (prompt) {
        float* cs = ((float*)(p.ws + OW_CSH)) + ((size_t)((seg + 1) & 1) * 2 + seq) * 3200;
        cs[c] = cr; cs[1024 + c] = ck; cs[2048 + c] = cv;
        if (seg == NSEG - 1) {
          float* ps = (p.out + OO_p_shift) + (size_t)seq * 3200;
          ps[c] = cr; ps[1024 + c] = ck; ps[2048 + c] = cv;
        }
      } else {
        float* ps = (p.out + OO_s_shift) + (size_t)(seq - 2) * 3200;
        ps[c] = cr; ps[1024 + c] = ck; ps[2048 + c] = cv;
      }
    }
  }
}

__device__ __forceinline__ void gd_prepass_item(PP pp, int seg, int grp, int slab) {
  LAUNDER_PP;
  const int tid = tid_l();
  const int r0 = grp * 16;
  int seq, t0, len;
  row_seq(seg, r0, seq, t0, len);
  const bool prompt = seq < 2;
  const int c = slab * 512 + 2 * tid;
  const int kind = slab >> 1;
  const int head = (c & 1023) >> 7, e = c & 127;
  float2 x0, x1, x2;
  if (t0 == 0) {
    const float* cp = nullptr;
    if (seg == 0) cp = prompt ? nullptr : p.st_conv + (size_t)(seq - 2) * 3 * 3072;
    else cp = ((float*)(p.ws + OW_CCV)) + ((size_t)(seg & 1) * 2 + seq) * 3 * 3072;
    if (cp) {
      x0 = *(const float2*)(cp + c); x1 = *(const float2*)(cp + 3072 + c); x2 = *(const float2*)(cp + 6144 + c);
    } else {
      x0 = x1 = x2 = make_float2(0.f, 0.f);
    }
  } else {
    uint32_t u0 = *(const uint32_t*)(((bf16_t*)(p.ws + OW_PJA)) + (size_t)(r0 - 3) * PJW + C_GDC + c);
    uint32_t u1 = *(const uint32_t*)(((bf16_t*)(p.ws + OW_PJA)) + (size_t)(r0 - 2) * PJW + C_GDC + c);
    uint32_t u2 = *(const uint32_t*)(((bf16_t*)(p.ws + OW_PJA)) + (size_t)(r0 - 1) * PJW + C_GDC + c);
    x0 = make_float2(bf2f(u0 & 0xffff), bf2f(u0 >> 16));
    x1 = make_float2(bf2f(u1 & 0xffff), bf2f(u1 >> 16));
    x2 = make_float2(bf2f(u2 & 0xffff), bf2f(u2 >> 16));
  }
  const float2 w0 = *(const float2*)(p.gd_conv_w + c), w1 = *(const float2*)(p.gd_conv_w + 3072 + c),
               w2 = *(const float2*)(p.gd_conv_w + 6144 + c), w3 = *(const float2*)(p.gd_conv_w + 9216 + c);
  const float a_exp = __expf(p.gd_a_log[head]);
  const float dtb = p.gd_dt_bias[head];
  char* gds = ((char*)(p.ws + OW_GDS)) + ((size_t)(slot_row0(seg) + r0) * 8 + head) * GDS_HB;
#pragma unroll 4
  for (int t = 0; t < 16; t++) {
    const int row = r0 + t;
    uint32_t u = *(const uint32_t*)(((bf16_t*)(p.ws + OW_PJA)) + (size_t)row * PJW + C_GDC + c);
    float2 x3 = make_float2(bf2f(u & 0xffff), bf2f(u >> 16));
    float cx = w0.x * x0.x + w1.x * x1.x + w2.x * x2.x + w3.x * x3.x;
    float cy = w0.y * x0.y + w1.y * x1.y + w2.y * x2.y + w3.y * x3.y;
    x0 = x1; x1 = x2; x2 = x3;
    float ax = siluf_(cx), ay = siluf_(cy);
    float sc = 1.0f;
    if (kind < 2) {
      float ss = wavesum(ax * ax + ay * ay);
      sc = rsqrtf(ss + 1e-6f);
      if (kind == 0) sc *= 0.08838834764831845f;
    }
    if (kind >= 1) {
      float beta = sigmoidf_(bf2f(((bf16_t*)(p.ws + OW_PJA))[(size_t)row * PJW + C_BETA + head]));
      sc *= sqrtf(beta);
    }
    ax *= sc; ay *= sc;
    char* o = gds + (size_t)t * GDS_ROWB;
    f16x2 hv = {(f16)ax, (f16)ay};
    *(f16x2*)(o + kind * 256 + e * 2) = hv;
    if (kind == 0 && (tid & 63) == 0) {
      float g = -a_exp * softplusf_(bf2f(((bf16_t*)(p.ws + OW_PJA))[(size_t)row * PJW + C_ALPHA + head]) + dtb);
      *(float*)(o + 768) = __expf(g);
    }
    int jj = t0 + t - (len - 3);
    if (jj >= 0) {
      if (prompt) {
        *(float2*)(((float*)(p.ws + OW_CCV)) + (((size_t)((seg + 1) & 1) * 2 + seq) * 3 + jj) * 3072 + c) = x3;
        if (seg == NSEG - 1) *(float2*)((p.out + OO_p_conv) + ((size_t)seq * 3 + jj) * 3072 + c) = x3;
      } else {
        *(float2*)((p.out + OO_s_conv) + ((size_t)(seq - 2) * 3 + jj) * 3072 + c) = x3;
      }
    }
  }
}


using u32x2 = __attribute__((ext_vector_type(2))) unsigned int;
__device__ __forceinline__ float fmix_lo(unsigned h, float b, float c) {
  float d;
  asm("v_fma_mix_f32 %0, %1, %2, %3 op_sel_hi:[1,0,0]" : "=v"(d) : "v"(h), "v"(b), "v"(c));
  return d;
}
__device__ __forceinline__ float fmix_hi(unsigned h, float b, float c) {
  float d;
  asm("v_fma_mix_f32 %0, %1, %2, %3 op_sel:[1,0,0] op_sel_hi:[1,0,0]" : "=v"(d) : "v"(h), "v"(b), "v"(c));
  return d;
}
__device__ __forceinline__ float vmul1(float a, float b) {
  float d;
  asm("v_mul_f32 %0, %1, %2" : "=v"(d) : "v"(a), "v"(b));
  return d;
}
struct RwOps { f16x4 r, k, a, b; float4 w; float vv; };
__device__ __forceinline__ RwOps rw_ld(const char* Ls, int q, int v) {
  RwOps o;
  o.r = *(const f16x4*)(Ls + q * 8);
  o.k = *(const f16x4*)(Ls + 128 + q * 8);
  o.a = *(const f16x4*)(Ls + 256 + q * 8);
  o.b = *(const f16x4*)(Ls + 384 + q * 8);
  o.w = *(const float4*)(Ls + 512 + q * 16);
  o.vv = *(const float*)(Ls + 768 + v * 4);
  return o;
}
__device__ __forceinline__ float rw_step(const RwOps& o, float4& S) {
  const u32x2 rw = __builtin_bit_cast(u32x2, o.r), kw = __builtin_bit_cast(u32x2, o.k),
              aw = __builtin_bit_cast(u32x2, o.a), bw = __builtin_bit_cast(u32x2, o.b);
  const float z = 0.f;
  float sa0 = fmix_lo(aw[0], S.x, z);
  float sa1 = fmix_lo(aw[1], S.z, z);
  sa0 = fmix_hi(aw[0], S.y, sa0);
  sa1 = fmix_hi(aw[1], S.w, sa1);
  float t0 = vmul1(S.x, o.w.x), t1 = vmul1(S.y, o.w.y), t2 = vmul1(S.z, o.w.z), t3 = vmul1(S.w, o.w.w);
  t0 = fmix_lo(kw[0], o.vv, t0);
  t1 = fmix_hi(kw[0], o.vv, t1);
  t2 = fmix_lo(kw[1], o.vv, t2);
  t3 = fmix_hi(kw[1], o.vv, t3);
  const float sa = rowsum16(sa0 + sa1);
  S.x = fmix_lo(bw[0], sa, t0);
  S.y = fmix_hi(bw[0], sa, t1);
  S.z = fmix_lo(bw[1], sa, t2);
  S.w = fmix_hi(bw[1], sa, t3);
  float y0 = fmix_lo(rw[0], S.x, z);
  float y1 = fmix_lo(rw[1], S.z, z);
  y0 = fmix_hi(rw[0], S.y, y0);
  y1 = fmix_hi(rw[1], S.w, y1);
  return rowsum16(y0 + y1);
}
__device__ __forceinline__ void rw_scan_run(const char* __restrict__ gsrc  , int len, float4& S,
                            float* __restrict__ yo  , int q, int v, char* smem) {
  const int tid = tid_l();
  const int nch = len >> 4;
  const int lstep = tid >> 6, loff = (tid & 63) * 16;
  u32x4 st[4];
#pragma unroll
  for (int i = 0; i < 4; i++) st[i] = *(const u32x4*)(gsrc + (size_t)(lstep + 4 * i) * RWS_ROWB + loff);
  __syncthreads();
#pragma unroll
  for (int i = 0; i < 4; i++) *(u32x4*)(smem + (lstep + 4 * i) * 1024 + loff) = st[i];
  u32x4 st2[4];
#pragma unroll
  for (int i = 0; i < 4; i++) st2[i] = st[i];
  if (nch > 1) {
#pragma unroll
    for (int i = 0; i < 4; i++) st[i] = *(const u32x4*)(gsrc + (size_t)(16 + lstep + 4 * i) * RWS_ROWB + loff);
  }
  if (nch > 2) {
#pragma unroll
    for (int i = 0; i < 4; i++) st2[i] = *(const u32x4*)(gsrc + (size_t)(32 + lstep + 4 * i) * RWS_ROWB + loff);
  }
  __syncthreads();
  for (int c = 0; c < nch; c++) {
    const char* L = smem + (c & 1) * 16384;
    float ykeep = 0.f;
    RwOps oa = rw_ld(L, q, v);
#pragma unroll 1
    for (int t = 0; t < 16; t += 2) {
      const RwOps ob = rw_ld(L + (t + 1) * 1024, q, v);
      asm volatile("" ::: "memory");
      const float ya = rw_step(oa, S);
      ykeep = (q == t) ? ya : ykeep;
      oa = rw_ld(L + ((t + 2) & 15) * 1024, q, v);
      asm volatile("" ::: "memory");
      const float yb = rw_step(ob, S);
      ykeep = (q == t + 1) ? yb : ykeep;
    }
    yo[(size_t)(c * 16 + q) * DM] = ykeep;
    if (c + 1 < nch) {
      char* Ln = smem + ((c + 1) & 1) * 16384;
#pragma unroll
      for (int i = 0; i < 4; i++) *(u32x4*)(Ln + (lstep + 4 * i) * 1024 + loff) = st[i];
#pragma unroll
      for (int i = 0; i < 4; i++) st[i] = st2[i];
      if (c + 3 < nch) {
#pragma unroll
        for (int i = 0; i < 4; i++)
          st2[i] = *(const u32x4*)(gsrc + (size_t)((c + 3) * 16 + lstep + 4 * i) * RWS_ROWB + loff);
      }
    }
    lds_barrier();
  }
}

struct GdOps { f16x8 qv, kv; float vv, eg; };
__device__ __forceinline__ GdOps gd_ld(const char* Ls, int q, int cl) {
  GdOps o;
  o.kv = *(const f16x8*)(Ls + 256 + q * 16);
  o.vv = (float)*(const f16*)(Ls + 512 + cl * 2);
  o.eg = *(const float*)(Ls + 768);
  o.qv = *(const f16x8*)(Ls + q * 16);
  return o;
}
__device__ __forceinline__ float gd_step(const GdOps& o, float (&s)[8]) {
  const u32x4 kw = __builtin_bit_cast(u32x4, o.kv), qw = __builtin_bit_cast(u32x4, o.qv);
  const float z = 0.f;
  float a0 = fmix_lo(kw[0], s[0], z);
  float a1 = fmix_lo(kw[2], s[4], z);
  a0 = fmix_hi(kw[0], s[1], a0);
  a1 = fmix_hi(kw[2], s[5], a1);
  a0 = fmix_lo(kw[1], s[2], a0);
  a1 = fmix_lo(kw[3], s[6], a1);
  a0 = fmix_hi(kw[1], s[3], a0);
  a1 = fmix_hi(kw[3], s[7], a1);
  float es[8];
#pragma unroll
  for (int i = 0; i < 8; i++) es[i] = vmul1(o.eg, s[i]);
  const float ks = rowsum16(a0 + a1);
  const float d = fmaf(-o.eg, ks, o.vv);
  s[0] = fmix_lo(kw[0], d, es[0]); s[1] = fmix_hi(kw[0], d, es[1]);
  s[2] = fmix_lo(kw[1], d, es[2]); s[3] = fmix_hi(kw[1], d, es[3]);
  s[4] = fmix_lo(kw[2], d, es[4]); s[5] = fmix_hi(kw[2], d, es[5]);
  s[6] = fmix_lo(kw[3], d, es[6]); s[7] = fmix_hi(kw[3], d, es[7]);
  float o0 = fmix_lo(qw[0], s[0], z);
  float o1 = fmix_lo(qw[2], s[4], z);
  o0 = fmix_hi(qw[0], s[1], o0);
  o1 = fmix_hi(qw[2], s[5], o1);
  o0 = fmix_lo(qw[1], s[2], o0);
  o1 = fmix_lo(qw[3], s[6], o1);
  o0 = fmix_hi(qw[1], s[3], o0);
  o1 = fmix_hi(qw[3], s[7], o1);
  return rowsum16(o0 + o1);
}
__device__ __forceinline__ void gd_scan_run(const char* __restrict__ gsrc  , int len, float (&s)[8],
                            float* __restrict__ oo  , int q, int cl, char* smem) {
  const int tid = tid_l();
  const int nch = len >> 4;
  u32x4 st[4];
  int lt[4], lo[4];
#pragma unroll
  for (int i = 0; i < 4; i++) {
    int id = tid + 256 * i;
    if (id > 783) id = 783;
    lt[i] = id / 49;
    lo[i] = (id % 49) * 16;
  }
#pragma unroll
  for (int i = 0; i < 4; i++) st[i] = *(const u32x4*)(gsrc + (size_t)lt[i] * GDS_ROWB + lo[i]);
  __syncthreads();
#pragma unroll
  for (int i = 0; i < 4; i++) *(u32x4*)(smem + lt[i] * GDS_HB + lo[i]) = st[i];
  u32x4 st2[4];
#pragma unroll
  for (int i = 0; i < 4; i++) st2[i] = st[i];
  if (nch > 1) {
#pragma unroll
    for (int i = 0; i < 4; i++) st[i] = *(const u32x4*)(gsrc + (size_t)(16 + lt[i]) * GDS_ROWB + lo[i]);
  }
  if (nch > 2) {
#pragma unroll
    for (int i = 0; i < 4; i++) st2[i] = *(const u32x4*)(gsrc + (size_t)(32 + lt[i]) * GDS_ROWB + lo[i]);
  }
  __syncthreads();
  for (int c = 0; c < nch; c++) {
    const char* L = smem + (c & 1) * 16384;
    float okeep = 0.f;
    GdOps oa = gd_ld(L, q, cl);
#pragma unroll 1
    for (int t = 0; t < 16; t += 2) {
      const GdOps ob = gd_ld(L + (t + 1) * GDS_HB, q, cl);
      asm volatile("" ::: "memory");
      const float ya = gd_step(oa, s);
      okeep = (q == t) ? ya : okeep;
      oa = gd_ld(L + ((t + 2) & 15) * GDS_HB, q, cl);
      asm volatile("" ::: "memory");
      const float yb = gd_step(ob, s);
      okeep = (q == t + 1) ? yb : okeep;
    }
    oo[(size_t)(c * 16 + q) * DM] = okeep;
    if (c + 1 < nch) {
      char* Ln = smem + ((c + 1) & 1) * 16384;
#pragma unroll
      for (int i = 0; i < 4; i++) *(u32x4*)(Ln + lt[i] * GDS_HB + lo[i]) = st[i];
#pragma unroll
      for (int i = 0; i < 4; i++) st[i] = st2[i];
      if (c + 3 < nch) {
#pragma unroll
        for (int i = 0; i < 4; i++) st2[i] = *(const u32x4*)(gsrc + (size_t)((c + 3) * 16 + lt[i]) * GDS_ROWB + lo[i]);
      }
    }
    lds_barrier();
  }
}

__device__ __forceinline__ void sample_scan_task(PP pp, int task, char* smem) {
  LAUNDER_PP;
  const int sj = task >> 7, j = task & 127, kind = j >> 6, jj = j & 63;
  const int tid = tid_l(), q = tid & 15;
  const int row0 = 1056 + sj * 16;
  if (kind == 0) {
    const int head = jj >> 2, v = (jj & 3) * 16 + (tid >> 4);
    const float* sin = p.st_wkv + ((size_t)sj * 16 + head) * 4096;
    float* sout = (p.out + OO_s_wkv) + ((size_t)sj * 16 + head) * 4096;
    float4 S = *(const float4*)(sin + v * 64 + 4 * q);
    rw_scan_run(((char*)(p.ws + OW_RWS)) + ((size_t)row0 * 16 + head) * 1024, 16, S, ((float*)(p.ws + OW_YRW)) + (size_t)row0 * DM + head * 64 + v, q, v, smem);
    *(float4*)(sout + v * 64 + 4 * q) = S;
  } else {
    const int head = jj >> 3, cl = (jj & 7) * 16 + (tid >> 4);
    const float* sin = p.st_ssm + ((size_t)sj * 8 + head) * 16384;
    float* sout = (p.out + OO_s_ssm) + ((size_t)sj * 8 + head) * 16384;
    float s[8];
#pragma unroll
    for (int i = 0; i < 8; i++) s[i] = sin[(size_t)(8 * q + i) * 128 + cl];
    gd_scan_run(((char*)(p.ws + OW_GDS)) + ((size_t)row0 * 8 + head) * GDS_HB, 16, s, ((float*)(p.ws + OW_OGD)) + (size_t)row0 * DM + head * 128 + cl, q, cl, smem);
#pragma unroll
    for (int i = 0; i < 8; i++) sout[(size_t)(8 * q + i) * 128 + cl] = s[i];
  }
}

__device__ __forceinline__ void scan_block_rw(PP pp, int j, char* smem) {
  LAUNDER_PP;
  const int seq = j >> 6, jj = j & 63;
  const int tid = tid_l(), q = tid & 15;
  const int head = jj >> 2, v = (jj & 3) * 16 + (tid >> 4);
  float4 S = make_float4(0.f, 0.f, 0.f, 0.f);
  for (int seg = 0; seg < NSEG; seg++) {
    wait_ge(((unsigned int*)(p.ws + OW_sync)) + SW_PRE, seg + 1);
    const int len = seg == 0 ? 528 : TS;
    const int row0 = slot_row0(seg) + (seg == 0 ? seq * 528 : seq * TS);
    rw_scan_run(((char*)(p.ws + OW_RWS)) + ((size_t)row0 * 16 + head) * 1024, len, S,
                ((float*)(p.ws + OW_YRW)) + (size_t)row0 * DM + head * 64 + v, q, v, smem);
    signal_add(((unsigned int*)(p.ws + OW_sync)) + SW_SCAN(seg));
  }
  {
    const int tid2 = tid_l(), q2 = tid2 & 15, v2 = (jj & 3) * 16 + (tid2 >> 4);
    *(float4*)((p.out + OO_p_wkv) + ((size_t)seq * 16 + head) * 4096 + v2 * 64 + 4 * q2) = S;
  }
}
__device__ __forceinline__ void scan_block_gd(PP pp, int j, char* smem) {
  LAUNDER_PP;
  const int seq = j >> 6, jj = j & 63;
  const int tid = tid_l(), q = tid & 15;
  const int head = jj >> 3, cl = (jj & 7) * 16 + (tid >> 4);
  float s[8];
#pragma unroll
  for (int i = 0; i < 8; i++) s[i] = 0.f;
  for (int seg = 0; seg < NSEG; seg++) {
    wait_ge(((unsigned int*)(p.ws + OW_sync)) + SW_PRE, seg + 1);
    const int len = seg == 0 ? 528 : TS;
    const int row0 = slot_row0(seg) + (seg == 0 ? seq * 528 : seq * TS);
    gd_scan_run(((char*)(p.ws + OW_GDS)) + ((size_t)row0 * 8 + head) * GDS_HB, len, s,
                ((float*)(p.ws + OW_OGD)) + (size_t)row0 * DM + head * 128 + cl, q, cl, smem);
    signal_add(((unsigned int*)(p.ws + OW_sync)) + SW_SCAN(seg));
  }
  {
    const int tid2 = tid_l(), q2 = tid2 & 15, cl2 = (jj & 7) * 16 + (tid2 >> 4);
    float* sout = (p.out + OO_p_ssm) + ((size_t)seq * 8 + head) * 16384;
#pragma unroll
    for (int i = 0; i < 8; i++) sout[(size_t)(8 * q2 + i) * 128 + cl2] = s[i];
  }
}

__device__ __forceinline__ void post_item(PP pp, int seg, int row) {
  LAUNDER_PP;
  const int tid = tid_l(), c4 = tid * 4;
  const int srow = slot_row0(seg) + row;
  const bf16_t* gt = ((bf16_t*)(p.ws + OW_GT)) + (size_t)(gt_row0(seg) + row) * GTW;
  {
    float4 y = *(const float4*)(((float*)(p.ws + OW_YRW)) + (size_t)srow * DM + c4);
    float mean = rowsum16(y.x + y.y + y.z + y.w) * (1.0f / 64.0f);
    float dx = y.x - mean, dy = y.y - mean, dz = y.z - mean, dw = y.w - mean;
    float var = rowsum16(dx * dx + dy * dy + dz * dz + dw * dw) * (1.0f / 64.0f);
    float rs = rsqrtf(var + 64e-5f);
    float4 lw = *(const float4*)(p.rw_ln_w + c4), lb = *(const float4*)(p.rw_ln_b + c4);
    float bon = ((float*)(p.ws + OW_RWB))[(size_t)srow * 16 + (tid >> 4)];
    float4 v = *(const float4*)(((char*)(p.ws + OW_RWS)) + ((size_t)srow * 16 + (tid >> 4)) * 1024 + 768 + (tid & 15) * 16);
    uint2 g = *(const uint2*)(gt + G_RW + c4);
    float o0 = (dx * rs * lw.x + lb.x + bon * v.x) * siluf_(bf2f(g.x & 0xffff));
    float o1 = (dy * rs * lw.y + lb.y + bon * v.y) * siluf_(bf2f(g.x >> 16));
    float o2 = (dz * rs * lw.z + lb.z + bon * v.z) * siluf_(bf2f(g.y & 0xffff));
    float o3 = (dw * rs * lw.w + lb.w + bon * v.w) * siluf_(bf2f(g.y >> 16));
    *(uint2*)(((bf16_t*)(p.ws + OW_YA)) + (size_t)(seg & 1) * MP0 * DM + blk_off(row, c4)) = make_uint2(pack2(o0, o1), pack2(o2, o3));
  }
  {
    float4 o = *(const float4*)(((float*)(p.ws + OW_OGD)) + (size_t)srow * DM + c4);
    float ss = rowsum16(o.x * o.x + o.y * o.y + o.z * o.z + o.w * o.w);
    ss += __shfl_xor(ss, 16);
    float rs = rsqrtf(ss * (1.0f / 128.0f) + 1e-6f);
    float4 nw = *(const float4*)(p.gd_norm_w + (c4 & 127));
    uint2 g = *(const uint2*)(gt + G_GD + c4);
    float o0 = o.x * rs * nw.x * siluf_(bf2f(g.x & 0xffff));
    float o1 = o.y * rs * nw.y * siluf_(bf2f(g.x >> 16));
    float o2 = o.z * rs * nw.z * siluf_(bf2f(g.y & 0xffff));
    float o3 = o.w * rs * nw.w * siluf_(bf2f(g.y >> 16));
    *(uint2*)(((bf16_t*)(p.ws + OW_YB)) + (size_t)(seg & 1) * MP0 * DM + blk_off(row, c4)) = make_uint2(pack2(o0, o1), pack2(o2, o3));
  }
}

#define SMEM_BYTES (32768 + 16)

__global__ void __launch_bounds__(256, 4) k_mega(Params p_arg) {
  PP pp = (PP)__builtin_amdgcn_kernarg_segment_ptr();
  __shared__ __attribute__((aligned(16))) char smem[SMEM_BYTES];
  cg::grid_group grid = cg::this_grid();
  const int bid = blockIdx.x, nb = gridDim.x;
  unsigned* sync = (unsigned*)(p.ws + OW_sync);
  const unsigned xcc = xcc_id() & 7u;
  if (bid >= NSCAN && threadIdx.x == 0) xb_add(&sync[SW_XCNT(xcc)], 1u);
  phase_weights(pp, bid, nb, smem);
  for (int it = bid; it < seg_MP(0) / 4; it += nb) xn_item(pp, 0, it);
  grid.sync();
  if (bid < NSCAN) {
    __builtin_amdgcn_s_setprio(3);
    if (bid < 128) scan_block_rw(pp, bid, smem);
    else scan_block_gd(pp, bid - 128, smem);
    return;
  }
  const int w = bid - NSCAN, NW = nb - NSCAN;
  unsigned* cfg = (unsigned*)(smem + 32768);
  if (threadIdx.x == 0) {
    unsigned mine = 0, nx = 0;
#pragma unroll
    for (unsigned j = 0; j < 8; j++) { unsigned c = xb_ld(&sync[SW_XCNT(j)]); nx += c > 0u ? 1u : 0u; mine = (j == xcc) ? c : mine; }
    cfg[0] = mine > 0u ? mine : 1u;
    cfg[1] = nx > 0u ? nx : 1u;
  }
  __syncthreads();
  for (int i = 0; i < NSEG + 5; i++) {
    const int sm = i - 4, snn = i - 5, sj = i - 3, so = i - 4, sp = i - 2;
    const bool front = i < NSEG;
    const bool mrg = sm >= 0 && sm < NSEG, nrm = snn >= 0 && snn < NSEG, back = sj >= 0 && sj < NSEG, outv = so >= 0 && so < NSEG,
               pst = sp >= 0 && sp < NSEG;
    {
      const int tmF = front ? seg_MP(i) / 128 : 1;
      const int nF = front ? tmF * (VW / 128) : 0;
      const int nM = mrg ? seg_MP(sm) / 4 : 0;
      const int nN = nrm ? seg_M(snn) / 4 : 0;
      if ((NW & 7) == 0) {
        const int x = w & 7, per = NW >> 3;
        const int ncol = front ? ((VW / 128 - x + 7) >> 3) : 0;
        for (int j = w >> 3; j < tmF * ncol; j += per) gemm_tile<0>(pp, i, j % tmF, x + 8 * (j / tmF), smem);
        for (int it = w; it < nM + nN; it += NW) {
          if (it < nM) merge_item(pp, it);
          else norm_item(pp, snn, it - nM);
        }
      } else {
        for (int it = w; it < nF + nM + nN; it += NW) {
          int t = it;
          if (t < nF) { gemm_tile<0>(pp, i, t % tmF, t / tmF, smem); continue; }
          t -= nF;
          if (t < nM) { merge_item(pp, t); continue; }
          t -= nM;
          norm_item(pp, snn, t);
        }
      }
      if (i == 1) {
        for (int it = w; it < 32 * 128; it += NW) sample_scan_task(pp, it, smem);
      }
    }
    worker_barrier((unsigned*)(p.ws + OW_sync), (const unsigned*)(smem + 32768));
    {
      const int nB = back ? (seg_MP(sj) / 128) * 8 : 0;
      const int nO = outv ? (seg_MP(so) / 128) * 8 : 0;
      const int nHeavy = 2 * nB + nO;
      const int nHeavyW = nHeavy < NW / 2 ? nHeavy : NW / 2;
      const int NL = NW - nHeavyW;
      const int ngrp = front ? seg_M(i) / 16 : 0;
      const int nRW = ngrp * 8, nGD = ngrp * 6;
      const int nX = (i + 1 < NSEG) ? seg_MP(i + 1) / 4 : 0;
      const int tot = nRW + nGD + nX;
      if (w >= NL) {
        for (int it = w - NL; it < nHeavy; it += nHeavyW) {
          int t = it;
          if (t < nB) { gemm_tile<1>(pp, sj, t >> 3, t & 7, smem); continue; }
          t -= nB;
          if (t < nB) { gemm_tile<3>(pp, sj, t >> 3, t & 7, smem); continue; }
          t -= nB;
          gemm_tile<2>(pp, so, t >> 3, t & 7, smem);
        }
      } else {
        for (int it = w; it < tot; it += NL) {
          int t = it;
          if (t < nRW) { rw_prepass_item(pp, i, t >> 2, t & 3, smem); continue; }
          t -= nRW;
          if (t < nGD) { gd_prepass_item(pp, i, t / 6, t % 6); continue; }
          t -= nGD;
          xn_item(pp, i + 1, t);
        }
      }
      if (pst) {
        wait_ge((unsigned*)(p.ws + OW_sync) + SW_SCAN(sp), NSCAN);
        const int n = seg_M(sp);
        for (int it = w; it < n; it += NW) post_item(pp, sp, it);
      }
    }
    worker_barrier((unsigned*)(p.ws + OW_sync), (const unsigned*)(smem + 32768));
    if (front && w == 0 && threadIdx.x == 0)
      __hip_atomic_store((unsigned*)(p.ws + OW_sync) + SW_PRE, (unsigned)(i + 1), __ATOMIC_RELAXED, __HIP_MEMORY_SCOPE_AGENT);
  }
}

static inline size_t align_up(size_t x) { return (x + 255) & ~(size_t)255; }

#undef p
extern "C" void kernel_launch(void* const* d_in, const int* in_sizes, int n_in, void* d_out, int out_size, void* d_ws,
                              size_t ws_size, hipStream_t stream) {
  Params p{};
  const float* const* in = (const float* const*)d_in;
  p.x_prompt = in[0]; p.x_sample = in[1]; p.st_shift = in[2]; p.st_wkv = in[3]; p.st_conv = in[4]; p.st_ssm = in[5];
  p.meta = in[6]; p.norm_pre = in[7]; p.w_in = in[8]; p.rw_mu = in[9]; p.rw_w0 = in[10]; p.rw_w2 = in[11];
  p.rw_a0 = in[12]; p.rw_a2 = in[13]; p.rw_k_k = in[14]; p.rw_k_a = in[15]; p.rw_r_k = in[16]; p.rw_ln_w = in[17];
  p.rw_ln_b = in[18]; p.gd_conv_w = in[19]; p.gd_a_log = in[20]; p.gd_dt_bias = in[21]; p.gd_norm_w = in[22];
  p.w_out_a = in[23]; p.w_out_b = in[24]; p.w_out = in[25]; p.norm_post = in[26];
  p.out = (float*)d_out;
  p.ws = (char*)d_ws;
  if (OW_END > ws_size) { fprintf(stderr, "workspace too small: need %zu have %zu\n", (size_t)OW_END, ws_size); return; }

  static int grid_blocks = 0;
  if (!grid_blocks) {
    int dev = 0, cus = 0, per_cu = 0;
    (void)hipGetDevice(&dev);
    (void)hipDeviceGetAttribute(&cus, hipDeviceAttributeMultiprocessorCount, dev);
    (void)hipOccupancyMaxActiveBlocksPerMultiprocessor(&per_cu, k_mega, 256, 0);
    if (per_cu > 4) per_cu = 4;
    grid_blocks = cus * per_cu;
  }
  (void)hipMemsetAsync(p.ws + OW_sync, 0, 16384, stream);
  void* args[] = {&p};
  hipError_t e = hipLaunchCooperativeKernel((void*)k_mega, dim3(grid_blocks), dim3(256), args, 0, stream);
  if (e != hipSuccess) fprintf(stderr, "cooperative launch failed: %s (grid %d)\n", hipGetErrorString(e), grid_blocks);
}
```

```cpp
#include <hip/hip_runtime.h>
#include <hip/hip_cooperative_groups.h>
#include <stdint.h>
#include <stdio.h>
namespace cg = cooperative_groups;

typedef unsigned short bf16_t;
typedef _Float16 f16;
using bf16x8 = __attribute__((ext_vector_type(8))) short;
using f32x4 = __attribute__((ext_vector_type(4))) float;
using u32x4 = __attribute__((ext_vector_type(4))) unsigned int;
using f32x16 = __attribute__((ext_vector_type(16))) float;
using f16x2 = __attribute__((ext_vector_type(2))) _Float16;
using f16x4 = __attribute__((ext_vector_type(4))) _Float16;
using f16x8 = __attribute__((ext_vector_type(8))) _Float16;

#define DM 1024
#define PW 10384
#define VW 10496
#define PJW 6400
#define GTW 4096
#define NSEG 16
#define TS 512
#define M0 1568
#define MP0 1664
#define M1 1024
#define SLOT_ROWS 3712
#define GT_ROWS 4736
#define NSCAN 256
#define C_GDC 3200
#define C_BETA 6272
#define C_ALPHA 6280
#define G_RW 0
#define G_GD 1024
#define G_MA 2048
#define G_MB 3072
#define RWS_ROWB 16384
#define GDS_HB 784
#define GDS_ROWB 6272

struct Params {
  const float *x_prompt, *x_sample, *st_shift, *st_wkv, *st_conv, *st_ssm, *meta, *norm_pre, *w_in, *rw_mu, *rw_w0,
      *rw_w2, *rw_a0, *rw_a2, *rw_k_k, *rw_k_a, *rw_r_k, *rw_ln_w, *rw_ln_b, *gd_conv_w, *gd_a_log, *gd_dt_bias,
      *gd_norm_w, *w_out_a, *w_out_b, *w_out, *norm_post;
  float* out;
  char* ws;
};
#define p (PV(pp))
#define GLOBAL_AS __attribute__((address_space(1)))
#define CONST_AS __attribute__((address_space(4)))
struct ParamsG {
  const GLOBAL_AS float *x_prompt, *x_sample, *st_shift, *st_wkv, *st_conv, *st_ssm, *meta, *norm_pre, *w_in, *rw_mu, *rw_w0,
      *rw_w2, *rw_a0, *rw_a2, *rw_k_k, *rw_k_a, *rw_r_k, *rw_ln_w, *rw_ln_b, *gd_conv_w, *gd_a_log, *gd_dt_bias,
      *gd_norm_w, *w_out_a, *w_out_b, *w_out, *norm_post;
  GLOBAL_AS float* out;
  GLOBAL_AS char* ws;
};
typedef const CONST_AS ParamsG* PP;
__device__ __forceinline__ Params PV(PP pp) {
  Params v;
  v.x_prompt = (const float*)pp->x_prompt;
  v.x_sample = (const float*)pp->x_sample;
  v.st_shift = (const float*)pp->st_shift;
  v.st_wkv = (const float*)pp->st_wkv;
  v.st_conv = (const float*)pp->st_conv;
  v.st_ssm = (const float*)pp->st_ssm;
  v.meta = (const float*)pp->meta;
  v.norm_pre = (const float*)pp->norm_pre;
  v.w_in = (const float*)pp->w_in;
  v.rw_mu = (const float*)pp->rw_mu;
  v.rw_w0 = (const float*)pp->rw_w0;
  v.rw_w2 = (const float*)pp->rw_w2;
  v.rw_a0 = (const float*)pp->rw_a0;
  v.rw_a2 = (const float*)pp->rw_a2;
  v.rw_k_k = (const float*)pp->rw_k_k;
  v.rw_k_a = (const float*)pp->rw_k_a;
  v.rw_r_k = (const float*)pp->rw_r_k;
  v.rw_ln_w = (const float*)pp->rw_ln_w;
  v.rw_ln_b = (const float*)pp->rw_ln_b;
  v.gd_conv_w = (const float*)pp->gd_conv_w;
  v.gd_a_log = (const float*)pp->gd_a_log;
  v.gd_dt_bias = (const float*)pp->gd_dt_bias;
  v.gd_norm_w = (const float*)pp->gd_norm_w;
  v.w_out_a = (const float*)pp->w_out_a;
  v.w_out_b = (const float*)pp->w_out_b;
  v.w_out = (const float*)pp->w_out;
  v.norm_post = (const float*)pp->norm_post;
  v.out = (float*)pp->out;
  v.ws = (char*)pp->ws;
  return v;
}
constexpr size_t al256(size_t x) { return (x + 255) & ~(size_t)255; }
constexpr size_t OO_y_prompt = 0;
constexpr size_t OO_y_sample = OO_y_prompt + (size_t)2 * 8192 * 1024;
constexpr size_t OO_p_shift = OO_y_sample + (size_t)32 * 16 * 1024;
constexpr size_t OO_p_wkv = OO_p_shift + 2 * 3200;
constexpr size_t OO_p_conv = OO_p_wkv + 2 * 16 * 4096;
constexpr size_t OO_p_ssm = OO_p_conv + 2 * 3 * 3072;
constexpr size_t OO_s_shift = OO_p_ssm + 2 * 8 * 16384;
constexpr size_t OO_s_wkv = OO_s_shift + 32 * 3200;
constexpr size_t OO_s_conv = OO_s_wkv + 32 * 16 * 4096;
constexpr size_t OO_s_ssm = OO_s_conv + 32 * 3 * 3072;
constexpr size_t OW_sync = 0;
constexpr size_t OW_WtIn = OW_sync + 16384;
constexpr size_t OW_WtA = OW_WtIn + al256((size_t)VW * DM * 2);
constexpr size_t OW_WtB = OW_WtA + al256((size_t)DM * DM * 2);
constexpr size_t OW_WtO = OW_WtB + al256((size_t)DM * DM * 2);
constexpr size_t OW_XN = OW_WtO + al256((size_t)DM * DM * 2);
constexpr size_t OW_PJA = OW_XN + al256((size_t)MP0 * DM * 2);
constexpr size_t OW_YA = OW_PJA + al256((size_t)MP0 * PJW * 2);
constexpr size_t OW_YB = OW_YA + al256((size_t)2 * MP0 * DM * 2);
constexpr size_t OW_MG = OW_YB + al256((size_t)2 * MP0 * DM * 2);
constexpr size_t OW_OUTB = OW_MG + al256((size_t)MP0 * DM * 2);
constexpr size_t OW_TMP = OW_OUTB + al256((size_t)2 * MP0 * DM * 4);
constexpr size_t OW_GT = OW_TMP + al256((size_t)2 * MP0 * DM * 4);
constexpr size_t OW_RWS = OW_GT + al256((size_t)GT_ROWS * GTW * 2);
constexpr size_t OW_GDS = OW_RWS + al256((size_t)SLOT_ROWS * RWS_ROWB);
constexpr size_t OW_RWB = OW_GDS + al256((size_t)SLOT_ROWS * GDS_ROWB + 256);
constexpr size_t OW_YRW = OW_RWB + al256((size_t)SLOT_ROWS * 16 * 4);
constexpr size_t OW_OGD = OW_YRW + al256((size_t)SLOT_ROWS * DM * 4);
constexpr size_t OW_CSH = OW_OGD + al256((size_t)SLOT_ROWS * DM * 4);
constexpr size_t OW_CCV = OW_CSH + al256((size_t)2 * 2 * 3200 * 4);
constexpr size_t OW_END = OW_CCV + al256((size_t)2 * 2 * 3 * 3072 * 4);


__device__ __forceinline__ bf16_t f2bf(float f) {
  uint32_t u = __float_as_uint(f);
  u += 0x7fffu + ((u >> 16) & 1u);
  return (bf16_t)(u >> 16);
}
__device__ __forceinline__ float bf2f(bf16_t h) { return __uint_as_float(((uint32_t)h) << 16); }
__device__ __forceinline__ uint32_t pack2(float a, float b) { return (uint32_t)f2bf(a) | ((uint32_t)f2bf(b) << 16); }
__device__ __forceinline__ float sigmoidf_(float x) { return 1.0f / (1.0f + __expf(-x)); }
__device__ __forceinline__ float siluf_(float x) { return x / (1.0f + __expf(-x)); }
__device__ __forceinline__ float softplusf_(float x) { return fmaxf(x, 0.0f) + log1pf(__expf(-fabsf(x))); }

__device__ __forceinline__ int tid_l() { int t = threadIdx.x; asm volatile("" : "+v"(t)); return t; }
#define LAUNDER_PP asm volatile("" : "+s"(pp))
template <int CTRL>
__device__ __forceinline__ float dppf(float x) {
  return __builtin_bit_cast(float, __builtin_amdgcn_update_dpp(0, __builtin_bit_cast(int, x), CTRL, 0xf, 0xf, true));
}
__device__ __forceinline__ float rowsum16(float x) {
  x += dppf<0xB1>(x);
  x += dppf<0x4E>(x);
  x += dppf<0x141>(x);
  x += dppf<0x140>(x);
  return x;
}
__device__ __forceinline__ float wavesum(float x) {
  x = rowsum16(x);
  x += __shfl_xor(x, 16);
  x += __shfl_xor(x, 32);
  return x;
}

#define SW_XCNT(j) (64 * (1 + (j)))
#define SW_XSUB(j) (64 * (9 + (j)))
#define SW_XGEN(j) (64 * (17 + (j)))
#define SW_TOP (64 * 25)
#define SW_TOPGEN (64 * 26)
#define SW_PRE (64 * 27)
#define SW_SCAN(s) (64 * (28 + (s)))
#define SYNC_BYTES 16384
__device__ __forceinline__ unsigned xb_ld(const unsigned* ptr) {
  return __hip_atomic_load(ptr, __ATOMIC_RELAXED, __HIP_MEMORY_SCOPE_AGENT);
}
__device__ __forceinline__ unsigned xb_add(unsigned* ptr, unsigned v) {
  return __hip_atomic_fetch_add(ptr, v, __ATOMIC_RELAXED, __HIP_MEMORY_SCOPE_AGENT);
}
__device__ __forceinline__ unsigned xcc_id() { return (unsigned)__builtin_amdgcn_s_getreg((3 << 11) | 20) & 0xFu; }
__device__ __forceinline__ void wait_ge(const unsigned* ptr, unsigned target) {
  if (threadIdx.x == 0) {
    while (xb_ld(ptr) < target) __builtin_amdgcn_s_sleep(8);
    __builtin_amdgcn_fence(__ATOMIC_ACQUIRE, "agent");
    asm volatile("s_waitcnt vmcnt(0)" ::: "memory");
  }
  __syncthreads();
}
__device__ __forceinline__ void signal_add(unsigned* ptr) {
  asm volatile("s_waitcnt vmcnt(0)" ::: "memory");
  __syncthreads();
  if (threadIdx.x == 0) {
    __builtin_amdgcn_fence(__ATOMIC_RELEASE, "agent");
    asm volatile("s_waitcnt vmcnt(0)" ::: "memory");
    xb_add(ptr, 1u);
  }
}
__device__ __forceinline__ void worker_barrier(unsigned* bar, const unsigned* lds_cfg) {
  asm volatile("s_waitcnt vmcnt(0)" ::: "memory");
  __syncthreads();
  if (threadIdx.x == 0) {
    const unsigned x = xcc_id() & 7u, nloc = lds_cfg[0], nx = lds_cfg[1];
    const unsigned old = xb_add(&bar[SW_XSUB(x)], 1u);
    const unsigned gen = old / nloc;
    if (old + 1u == (gen + 1u) * nloc) {
      __builtin_amdgcn_fence(__ATOMIC_RELEASE, "agent");
      asm volatile("s_waitcnt vmcnt(0)" ::: "memory");
      const unsigned og = xb_add(&bar[SW_TOP], 1u);
      const unsigned tg = og / nx;
      if (og + 1u == (tg + 1u) * nx) xb_add(&bar[SW_TOPGEN], 1u);
      else while (xb_ld(&bar[SW_TOPGEN]) == tg) __builtin_amdgcn_s_sleep(1);
      __builtin_amdgcn_fence(__ATOMIC_ACQUIRE, "agent");
      xb_add(&bar[SW_XGEN(x)], 1u);
      asm volatile("s_waitcnt vmcnt(0)" ::: "memory");
    } else {
      while (xb_ld(&bar[SW_XGEN(x)]) == gen) __builtin_amdgcn_s_sleep(1);
      __builtin_amdgcn_fence(__ATOMIC_ACQUIRE, "agent");
      asm volatile("s_waitcnt vmcnt(0)" ::: "memory");
    }
  }
  __syncthreads();
}

__device__ __forceinline__ void lds_barrier() {
  asm volatile("s_waitcnt lgkmcnt(0)" ::: "memory");
  __builtin_amdgcn_s_barrier();
  asm volatile("" ::: "memory");
}

__device__ __forceinline__ int seg_M(int seg) { return seg == 0 ? M0 : M1; }
__device__ __forceinline__ int seg_MP(int seg) { return seg == 0 ? MP0 : M1; }
__device__ __forceinline__ int slot_row0(int seg) { int s = seg % 3; return s == 0 ? 0 : MP0 + (s - 1) * M1; }
__device__ __forceinline__ int gt_row0(int seg) { int s = seg & 3; return s == 0 ? 0 : MP0 + (s - 1) * M1; }
__device__ __forceinline__ const float* row_src(PP pp, int seg, int r) {
  if (seg == 0) {
    if (r < 1056) {
      int b = r >= 528 ? 1 : 0, t = r - b * 528;
      if (t < 16) return p.meta + t * DM;
      return p.x_prompt + ((size_t)b * 8192 + (t - 16)) * DM;
    }
    return p.x_sample + (size_t)(r - 1056) * DM;
  }
  int b = r >> 9, t = r & 511;
  return p.x_prompt + ((size_t)b * 8192 + seg * TS + t) * DM;
}
__device__ __forceinline__ float* row_dst(PP pp, int seg, int r) {
  if (seg == 0) {
    if (r < 1056) {
      int b = r >= 528 ? 1 : 0, t = r - b * 528;
      if (t < 16) return nullptr;
      return (p.out + OO_y_prompt) + ((size_t)b * 8192 + (t - 16)) * DM;
    }
    return (p.out + OO_y_sample) + (size_t)(r - 1056) * DM;
  }
  int b = r >> 9, t = r & 511;
  return (p.out + OO_y_prompt) + ((size_t)b * 8192 + seg * TS + t) * DM;
}
__device__ __forceinline__ void row_seq(int seg, int r, int& seq, int& t, int& len) {
  if (seg == 0) {
    if (r < 528) { seq = 0; t = r; len = 528; }
    else if (r < 1056) { seq = 1; t = r - 528; len = 528; }
    else { seq = 2 + ((r - 1056) >> 4); t = (r - 1056) & 15; len = 16; }
  } else { seq = r >> 9; t = r & 511; len = TS; }
}

__device__ __forceinline__ size_t blk_off(int row, int k) {
  const int kk = (k & 7) | (((((k >> 3) & 3) ^ ((row >> 2) & 3))) << 3);
  return ((size_t)((row >> 7) * 32 + (k >> 5)) * 128 + (row & 127)) * 32 + kk;
}

__device__ __forceinline__ int vcol_src(int n) {
  if (n < 3200) return n;
  if (n < 6288) return n + 1024;
  if (n < 6400) return -1;
  if (n < 7424) return n - 3200;
  return n - 112;
}
__device__ __forceinline__ void transpose_tile(const float* __restrict__ src, int ld, bool remap, bf16_t* __restrict__ dst, int k0, int n0,
                               float* tile  ) {
  int tid = tid_l();
  int i = tid >> 4, j = tid & 15;
  __syncthreads();
  int n = n0 + 4 * j;
  int sc = remap ? vcol_src(n) : n;
#pragma unroll
  for (int pass = 0; pass < 4; pass++) {
    int k = pass * 16 + i;
    float4 v = make_float4(0.f, 0.f, 0.f, 0.f);
    if (sc >= 0) v = *(const float4*)(src + (size_t)(k0 + k) * ld + sc);
    tile[k * 65 + 4 * j + 0] = v.x; tile[k * 65 + 4 * j + 1] = v.y; tile[k * 65 + 4 * j + 2] = v.z; tile[k * 65 + 4 * j + 3] = v.w;
  }
  __syncthreads();
  int nn = tid >> 2, kq = tid & 3;
  uint32_t o[8];
#pragma unroll
  for (int e = 0; e < 8; e++) o[e] = pack2(tile[(kq * 16 + 2 * e) * 65 + nn], tile[(kq * 16 + 2 * e + 1) * 65 + nn]);
  *(u32x4*)(dst + blk_off(n0 + nn, k0 + kq * 16)) = (u32x4){o[0], o[1], o[2], o[3]};
  *(u32x4*)(dst + blk_off(n0 + nn, k0 + kq * 16 + 8)) = (u32x4){o[4], o[5], o[6], o[7]};
}
__device__ __forceinline__ void phase_weights(PP pp, int bid, int nb, char* smem) {
  LAUNDER_PP;
  float* tile = (float*)smem;
  const int nIn = 16 * (VW / 64);
  const int nSq = 16 * 16;
  for (int it = bid; it < nIn + 3 * nSq; it += nb) {
    if (it < nIn) {
      int kt = it & 15, nt = it >> 4;
      transpose_tile(p.w_in, PW, true, ((bf16_t*)(p.ws + OW_WtIn)), kt * 64, nt * 64, tile);
    } else {
      int j = it - nIn, w = j / nSq, r = j % nSq;
      int kt = r & 15, nt = r >> 4;
      const float* src = w == 0 ? p.w_out_a : (w == 1 ? p.w_out_b : p.w_out);
      bf16_t* dst = w == 0 ? ((bf16_t*)(p.ws + OW_WtA)) : (w == 1 ? ((bf16_t*)(p.ws + OW_WtB)) : ((bf16_t*)(p.ws + OW_WtO)));
      transpose_tile(src, DM, false, dst, kt * 64, nt * 64, tile);
    }
  }
}

__device__ __forceinline__ void xn_item(PP pp, int seg, int item) {
  LAUNDER_PP;
  int wave = tid_l() >> 6, lane = tid_l() & 63;
  int M = seg_M(seg);
  int r = item * 4 + wave;
  bf16_t* o = ((bf16_t*)(p.ws + OW_XN));
  if (r >= M) {
#pragma unroll
    for (int i = 0; i < 4; i++) *(uint2*)(o + blk_off(r, (lane + 64 * i) * 4)) = make_uint2(0u, 0u);
    return;
  }
  const float4* src = (const float4*)row_src(pp, seg, r);
  float4 v[4];
  float ss = 0.f;
#pragma unroll
  for (int i = 0; i < 4; i++) {
    v[i] = src[lane + 64 * i];
    ss += v[i].x * v[i].x + v[i].y * v[i].y + v[i].z * v[i].z + v[i].w * v[i].w;
  }
  ss = wavesum(ss);
  float rstd = rsqrtf(ss * (1.0f / DM) + 1e-6f);
#pragma unroll
  for (int i = 0; i < 4; i++) {
    float4 g = ((const float4*)p.norm_pre)[lane + 64 * i];
    *(uint2*)(o + blk_off(r, (lane + 64 * i) * 4)) =
        make_uint2(pack2(v[i].x * rstd * g.x, v[i].y * rstd * g.y), pack2(v[i].z * rstd * g.z, v[i].w * rstd * g.w));
  }
}

__device__ __forceinline__ void norm_item(PP pp, int seg, int item) {
  LAUNDER_PP;
  int wave = tid_l() >> 6, lane = tid_l() & 63;
  int r = item * 4 + wave;
  float* dst = row_dst(pp, seg, r);
  if (!dst) return;
  const float4* h = (const float4*)row_src(pp, seg, r);
  const float4* o = (const float4*)(((float*)(p.ws + OW_OUTB)) + ((size_t)(seg & 1) * MP0 + r) * DM);
  float4 v[4];
  float ss = 0.f;
#pragma unroll
  for (int i = 0; i < 4; i++) {
    v[i] = o[lane + 64 * i];
    ss += v[i].x * v[i].x + v[i].y * v[i].y + v[i].z * v[i].z + v[i].w * v[i].w;
  }
  ss = wavesum(ss);
  float rstd = rsqrtf(ss * (1.0f / DM) + 1e-6f);
#pragma unroll
  for (int i = 0; i < 4; i++) {
    float4 g = ((const float4*)p.norm_post)[lane + 64 * i];
    float4 hh = h[lane + 64 * i];
    ((float4*)dst)[lane + 64 * i] =
        make_float4(hh.x + v[i].x * rstd * g.x, hh.y + v[i].y * rstd * g.y, hh.z + v[i].z * rstd * g.z, hh.w + v[i].w * rstd * g.w);
  }
}

__device__ __forceinline__ void merge_item(PP pp, int item) {
  LAUNDER_PP;
  const int tid = tid_l();
  const int wave = tid >> 6, lane = tid & 63;
  const int r = item * 4 + wave;
  const float4* t1 = (const float4*)((const float*)(p.ws + OW_TMP) + (size_t)r * DM);
  const float4* t2 = (const float4*)((const float*)(p.ws + OW_TMP) + ((size_t)MP0 + r) * DM);
  bf16_t* o = (bf16_t*)(p.ws + OW_MG);
#pragma unroll
  for (int i = 0; i < 4; i++) {
    float4 a = t1[lane + 64 * i], b = t2[lane + 64 * i];
    *(uint2*)(o + blk_off(r, (lane + 64 * i) * 4)) = make_uint2(pack2(a.x + b.x, a.y + b.y), pack2(a.z + b.z, a.w + b.w));
  }
}

#define LDT 32
template <int MODE>
__device__ __forceinline__ void gemm_tile(PP pp, int seg, int tm, int tn, char* smem) {
  LAUNDER_PP;
  const int tid = tid_l(), lane = tid & 63, wid = tid >> 6;
  const int wr = wid >> 1, wc = wid & 1, l31 = lane & 31, lh = lane >> 5;
  const int lrow = tid >> 2, lkc = tid & 3;
  const int m0 = tm * 128, n0 = tn * 128;
  bf16_t* GTs = ((bf16_t*)(p.ws + OW_GT)) + (size_t)gt_row0(seg) * GTW;
  f32x16 acc[2][2];
#pragma unroll
  for (int a = 0; a < 2; a++)
#pragma unroll
    for (int b = 0; b < 2; b++)
#pragma unroll
      for (int e = 0; e < 16; e++) acc[a][b][e] = 0.f;
  {
    const bf16_t* A = (MODE == 0) ? (const bf16_t*)(p.ws + OW_XN)
                    : (MODE == 1) ? (const bf16_t*)(p.ws + OW_YA) + (size_t)(seg & 1) * MP0 * DM
                    : (MODE == 3) ? (const bf16_t*)(p.ws + OW_YB) + (size_t)(seg & 1) * MP0 * DM
                                  : (const bf16_t*)(p.ws + OW_MG);
    const bf16_t* Bt = (const bf16_t*)(p.ws + (MODE == 0 ? OW_WtIn : (MODE == 1 ? OW_WtA : (MODE == 3 ? OW_WtB : OW_WtO))));
    u32x4 ra[2], rb[2];
    const bf16_t* gA = A + ((size_t)(tm * 32) * 128 + lrow) * 32 + lkc * 8;
    const bf16_t* gB = Bt + ((size_t)(tn * 32) * 128 + lrow) * 32 + lkc * 8;
    const int wofs = lrow * 64 + (lkc << 4);
    const int sw = (l31 >> 2) & 3;
    const int rofs0 = l31 * 64 + (((0 + lh) ^ sw) << 4);
    const int rofs1 = l31 * 64 + (((2 + lh) ^ sw) << 4);
    __syncthreads();
#pragma unroll
    for (int i = 0; i < 2; i++) {
      ra[i] = *(const u32x4*)(gA + (size_t)i * 2048);
      rb[i] = *(const u32x4*)(gB + (size_t)i * 2048);
    }
#pragma unroll
    for (int i = 0; i < 2; i++) {
      *(u32x4*)(smem + wofs + i * 4096) = ra[i];
      *(u32x4*)(smem + 8192 + wofs + i * 4096) = rb[i];
    }
#pragma unroll
    for (int i = 0; i < 2; i++) {
      ra[i] = *(const u32x4*)(gA + (size_t)i * 2048 + 4096);
      rb[i] = *(const u32x4*)(gB + (size_t)i * 2048 + 4096);
    }
    lds_barrier();
#pragma unroll 1
    for (int kt = 0; kt < 32; kt++) {
      const char* cA = smem + (kt & 1) * 16384 + wr * 4096;
      const char* cB = smem + (kt & 1) * 16384 + 8192 + wc * 4096;
      const bf16x8 x00 = *(const bf16x8*)(cA + rofs0), x01 = *(const bf16x8*)(cA + 2048 + rofs0);
      const bf16x8 w00 = *(const bf16x8*)(cB + rofs0), w01 = *(const bf16x8*)(cB + 2048 + rofs0);
      const bf16x8 x10 = *(const bf16x8*)(cA + rofs1), x11 = *(const bf16x8*)(cA + 2048 + rofs1);
      const bf16x8 w10 = *(const bf16x8*)(cB + rofs1), w11 = *(const bf16x8*)(cB + 2048 + rofs1);
      asm volatile("" ::: "memory");
      acc[0][0] = __builtin_amdgcn_mfma_f32_32x32x16_bf16(w00, x00, acc[0][0], 0, 0, 0);
      acc[0][1] = __builtin_amdgcn_mfma_f32_32x32x16_bf16(w00, x01, acc[0][1], 0, 0, 0);
      acc[1][0] = __builtin_amdgcn_mfma_f32_32x32x16_bf16(w01, x00, acc[1][0], 0, 0, 0);
      acc[1][1] = __builtin_amdgcn_mfma_f32_32x32x16_bf16(w01, x01, acc[1][1], 0, 0, 0);
      acc[0][0] = __builtin_amdgcn_mfma_f32_32x32x16_bf16(w10, x10, acc[0][0], 0, 0, 0);
      acc[0][1] = __builtin_amdgcn_mfma_f32_32x32x16_bf16(w10, x11, acc[0][1], 0, 0, 0);
      acc[1][0] = __builtin_amdgcn_mfma_f32_32x32x16_bf16(w11, x10, acc[1][0], 0, 0, 0);
      acc[1][1] = __builtin_amdgcn_mfma_f32_32x32x16_bf16(w11, x11, acc[1][1], 0, 0, 0);
      if (kt + 1 < 32) {
        char* nx = smem + ((kt + 1) & 1) * 16384;
#pragma unroll
        for (int i = 0; i < 2; i++) {
          *(u32x4*)(nx + wofs + i * 4096) = ra[i];
          *(u32x4*)(nx + 8192 + wofs + i * 4096) = rb[i];
        }
        if (kt + 2 < 32) {
#pragma unroll
          for (int i = 0; i < 2; i++) {
            ra[i] = *(const u32x4*)(gA + (size_t)i * 2048 + (size_t)(kt + 2) * 4096);
            rb[i] = *(const u32x4*)(gB + (size_t)i * 2048 + (size_t)(kt + 2) * 4096);
          }
        }
      }
      lds_barrier();
    }
  }
  float* OUTBp = (MODE == 2) ? (float*)(p.ws + OW_OUTB) + (size_t)(seg & 1) * MP0 * DM
                             : (float*)(p.ws + OW_TMP) + (size_t)(MODE == 3 ? 1 : 0) * MP0 * DM;
#pragma unroll
  for (int ni = 0; ni < 2; ni++)
#pragma unroll
    for (int mi = 0; mi < 2; mi++)
#pragma unroll
      for (int g = 0; g < 4; g++) {
        const int m = m0 + wr * 64 + mi * 32 + l31;
        const int n = n0 + wc * 64 + ni * 32 + 8 * g + 4 * lh;
        const float c0 = acc[ni][mi][4 * g], c1 = acc[ni][mi][4 * g + 1], c2 = acc[ni][mi][4 * g + 2], c3 = acc[ni][mi][4 * g + 3];
        if (MODE == 0) {
          uint2 o = make_uint2(pack2(c0, c1), pack2(c2, c3));
          if (tn < PJW / 128) *(uint2*)(((bf16_t*)(p.ws + OW_PJA)) + (size_t)m * PJW + n) = o;
          else *(uint2*)(GTs + (size_t)m * GTW + (n - PJW)) = o;
        } else if (MODE == 1 || MODE == 3) {
          uint2 ga = *(const uint2*)(GTs + (size_t)m * GTW + (MODE == 1 ? G_MA : G_MB) + n);
          *(float4*)(OUTBp + (size_t)m * DM + n) =
              make_float4(sigmoidf_(bf2f(ga.x & 0xffff)) * c0, sigmoidf_(bf2f(ga.x >> 16)) * c1,
                          sigmoidf_(bf2f(ga.y & 0xffff)) * c2, sigmoidf_(bf2f(ga.y >> 16)) * c3);
        } else {
          *(float4*)(OUTBp + (size_t)m * DM + n) = make_float4(c0, c1, c2, c3);
        }
      }
}

__device__ __forceinline__ void rw_prepass_item(PP pp, int seg, int grp, int slab, char* smem) {
  LAUNDER_PP;
  float* lwa = (float*)smem;
  const int tid = tid_l();
  const int r0 = grp * 8;
  int seq, t0, len;
  row_seq(seg, r0, seq, t0, len);
  const bool prompt = seq < 2;
  const float* prev0 = nullptr;
  if (t0 == 0) {
    if (seg == 0) prev0 = prompt ? nullptr : p.st_shift + (size_t)(seq - 2) * 3200;
    else prev0 = ((float*)(p.ws + OW_CSH)) + ((size_t)(seg & 1) * 2 + seq) * 3200;
  }
  __syncthreads();
  {
    const int j = tid & 127;
    const float mu = p.rw_mu[3072 + j];
#pragma unroll
    for (int i = 0; i < 4; i++) {
      int tok = (tid >> 7) + 2 * i;
      int row = r0 + tok;
      float ps = bf2f(((bf16_t*)(p.ws + OW_PJA))[(size_t)row * PJW + 3072 + j]);
      float pv;
      if (tok == 0 && t0 == 0) pv = prev0 ? prev0[3072 + j] : 0.f;
      else pv = bf2f(((bf16_t*)(p.ws + OW_PJA))[(size_t)(row - 1) * PJW + 3072 + j]);
      float xs = ps + mu * (pv - ps);
      lwa[tok * 128 + j] = j < 64 ? tanhf(xs) : xs;
      if (slab == 0 && t0 + tok == len - 1) {
        if (prompt) {
          ((float*)(p.ws + OW_CSH))[((size_t)((seg + 1) & 1) * 2 + seq) * 3200 + 3072 + j] = ps;
          if (seg == NSEG - 1) (p.out + OO_p_shift)[(size_t)seq * 3200 + 3072 + j] = ps;
        } else {
          (p.out + OO_s_shift)[(size_t)(seq - 2) * 3200 + 3072 + j] = ps;
        }
      }
    }
  }
  __syncthreads();
  const int c = slab * 256 + tid;
  float dw[8], da[8];
  {
    const float w0 = p.rw_w0[c], a0 = p.rw_a0[c];
#pragma unroll
    for (int t = 0; t < 8; t++) { dw[t] = w0; da[t] = a0; }
  }
  for (int j = 0; j < 64; j += 4) {
    float w2v[4], a2v[4];
#pragma unroll
    for (int e = 0; e < 4; e++) {
      w2v[e] = p.rw_w2[(size_t)(j + e) * DM + c];
      a2v[e] = p.rw_a2[(size_t)(j + e) * DM + c];
    }
#pragma unroll
    for (int t = 0; t < 8; t++) {
      float4 lw = *(const float4*)(lwa + t * 128 + j);
      float4 la = *(const float4*)(lwa + t * 128 + 64 + j);
      dw[t] += lw.x * w2v[0] + lw.y * w2v[1] + lw.z * w2v[2] + lw.w * w2v[3];
      da[t] += la.x * a2v[0] + la.y * a2v[1] + la.z * a2v[2] + la.w * a2v[3];
    }
  }
  const float mur = p.rw_mu[c], muk = p.rw_mu[1024 + c], muv = p.rw_mu[2048 + c];
  const float kk_w = p.rw_k_k[c], ka_w = p.rw_k_a[c], rk_w = p.rw_r_k[c];
  float pr, pk, pv;
  if (t0 == 0) {
    pr = prev0 ? prev0[c] : 0.f; pk = prev0 ? prev0[1024 + c] : 0.f; pv = prev0 ? prev0[2048 + c] : 0.f;
  } else {
    const bf16_t* q = ((bf16_t*)(p.ws + OW_PJA)) + (size_t)(r0 - 1) * PJW;
    pr = bf2f(q[c]); pk = bf2f(q[1024 + c]); pv = bf2f(q[2048 + c]);
  }
  const int head = c >> 6, e = c & 63;
  const int srow0 = slot_row0(seg);
  char* rws = ((char*)(p.ws + OW_RWS)) + ((size_t)(srow0 + r0) * 16 + head) * 1024;
  float* rwb = ((float*)(p.ws + OW_RWB)) + (size_t)(srow0 + r0) * 16 + head;
#pragma unroll
  for (int t = 0; t < 8; t++) {
    const int row = r0 + t;
    const bf16_t* q = ((bf16_t*)(p.ws + OW_PJA)) + (size_t)row * PJW;
    float cr = bf2f(q[c]), ck = bf2f(q[1024 + c]), cv = bf2f(q[2048 + c]);
    float xr = cr + mur * (pr - cr), xk = ck + muk * (pk - ck), xv = cv + muv * (pv - cv);
    pr = cr; pk = ck; pv = cv;
    float w_log = -softplusf_(-dw[t]) - 0.5f;
    float decay = __expf(-__expf(w_log));
    float a = sigmoidf_(da[t]);
    float kkr = xk * kk_w;
    float ss = wavesum(kkr * kkr);
    float kk = kkr * rsqrtf(ss + 1e-6f);
    float k2 = xk * (1.0f + (a - 1.0f) * ka_w);
    float bon = wavesum(xr * k2 * rk_w);
    char* o = rws + (size_t)t * RWS_ROWB;
    ((f16*)o)[e] = (f16)xr;
    ((f16*)(o + 128))[e] = (f16)k2;
    ((f16*)(o + 256))[e] = (f16)(-kk);
    ((f16*)(o + 384))[e] = (f16)(kk * a);
    ((float*)(o + 512))[e] = decay;
    ((float*)(o + 768))[e] = xv;
    if ((tid & 63) == 0) rwb[(size_t)t * 16] = bon;
    if (t0 + t == len - 1) {
      if (prompt) {
        float* cs = ((float*)(p.ws + OW_CSH)) + ((size_t)((seg + 1) & 1) * 2 + seq) * 3200;
        cs[c] = cr; cs[1024 + c] = ck; cs[2048 + c] = cv;
        if (seg == NSEG - 1) {
          float* ps = (p.out + OO_p_shift) + (size_t)seq * 3200;
          ps[c] = cr; ps[1024 + c] = ck; ps[2048 + c] = cv;
        }
      } else {
        float* ps = (p.out + OO_s_shift) + (size_t)(seq - 2) * 3200;
        ps[c] = cr; ps[1024 + c] = ck; ps[2048 + c] = cv;
      }
    }
  }
}

__device__ __forceinline__ void gd_prepass_item(PP pp, int seg, int grp, int slab) {
  LAUNDER_PP;
  const int tid = tid_l();
  const int r0 = grp * 16;
  int seq, t0, len;
  row_seq(seg, r0, seq, t0, len);
  const bool prompt = seq < 2;
  const int c = slab * 512 + 2 * tid;
  const int kind = slab >> 1;
  const int head = (c & 1023) >> 7, e = c & 127;
  float2 x0, x1, x2;
  if (t0 == 0) {
    const float* cp = nullptr;
    if (seg == 0) cp = prompt ? nullptr : p.st_conv + (size_t)(seq - 2) * 3 * 3072;
    else cp = ((float*)(p.ws + OW_CCV)) + ((size_t)(seg & 1) * 2 + seq) * 3 * 3072;
    if (cp) {
      x0 = *(const float2*)(cp + c); x1 = *(const float2*)(cp + 3072 + c); x2 = *(const float2*)(cp + 6144 + c);
    } else {
      x0 = x1 = x2 = make_float2(0.f, 0.f);
    }
  } else {
    uint32_t u0 = *(const uint32_t*)(((bf16_t*)(p.ws + OW_PJA)) + (size_t)(r0 - 3) * PJW + C_GDC + c);
    uint32_t u1 = *(const uint32_t*)(((bf16_t*)(p.ws + OW_PJA)) + (size_t)(r0 - 2) * PJW + C_GDC + c);
    uint32_t u2 = *(const uint32_t*)(((bf16_t*)(p.ws + OW_PJA)) + (size_t)(r0 - 1) * PJW + C_GDC + c);
    x0 = make_float2(bf2f(u0 & 0xffff), bf2f(u0 >> 16));
    x1 = make_float2(bf2f(u1 & 0xffff), bf2f(u1 >> 16));
    x2 = make_float2(bf2f(u2 & 0xffff), bf2f(u2 >> 16));
  }
  const float2 w0 = *(const float2*)(p.gd_conv_w + c), w1 = *(const float2*)(p.gd_conv_w + 3072 + c),
               w2 = *(const float2*)(p.gd_conv_w + 6144 + c), w3 = *(const float2*)(p.gd_conv_w + 9216 + c);
  const float a_exp = __expf(p.gd_a_log[head]);
  const float dtb = p.gd_dt_bias[head];
  char* gds = ((char*)(p.ws + OW_GDS)) + ((size_t)(slot_row0(seg) + r0) * 8 + head) * GDS_HB;
#pragma unroll 4
  for (int t = 0; t < 16; t++) {
    const int row = r0 + t;
    uint32_t u = *(const uint32_t*)(((bf16_t*)(p.ws + OW_PJA)) + (size_t)row * PJW + C_GDC + c);
    float2 x3 = make_float2(bf2f(u & 0xffff), bf2f(u >> 16));
    float cx = w0.x * x0.x + w1.x * x1.x + w2.x * x2.x + w3.x * x3.x;
    float cy = w0.y * x0.y + w1.y * x1.y + w2.y * x2.y + w3.y * x3.y;
    x0 = x1; x1 = x2; x2 = x3;
    float ax = siluf_(cx), ay = siluf_(cy);
    float sc = 1.0f;
    if (kind < 2) {
      float ss = wavesum(ax * ax + ay * ay);
      sc = rsqrtf(ss + 1e-6f);
      if (kind == 0) sc *= 0.08838834764831845f;
    }
    if (kind >= 1) {
      float beta = sigmoidf_(bf2f(((bf16_t*)(p.ws + OW_PJA))[(size_t)row * PJW + C_BETA + head]));
      sc *= sqrtf(beta);
    }
    ax *= sc; ay *= sc;
    char* o = gds + (size_t)t * GDS_ROWB;
    f16x2 hv = {(f16)ax, (f16)ay};
    *(f16x2*)(o + kind * 256 + e * 2) = hv;
    if (kind == 0 && (tid & 63) == 0) {
      float g = -a_exp * softplusf_(bf2f(((bf16_t*)(p.ws + OW_PJA))[(size_t)row * PJW + C_ALPHA + head]) + dtb);
      *(float*)(o + 768) = __expf(g);
    }
    int jj = t0 + t - (len - 3);
    if (jj >= 0) {
      if (prompt) {
        *(float2*)(((float*)(p.ws + OW_CCV)) + (((size_t)((seg + 1) & 1) * 2 + seq) * 3 + jj) * 3072 + c) = x3;
        if (seg == NSEG - 1) *(float2*)((p.out + OO_p_conv) + ((size_t)seq * 3 + jj) * 3072 + c) = x3;
      } else {
        *(float2*)((p.out + OO_s_conv) + ((size_t)(seq - 2) * 3 + jj) * 3072 + c) = x3;
      }
    }
  }
}


using u32x2 = __attribute__((ext_vector_type(2))) unsigned int;
__device__ __forceinline__ float fmix_lo(unsigned h, float b, float c) {
  float d;
  asm("v_fma_mix_f32 %0, %1, %2, %3 op_sel_hi:[1,0,0]" : "=v"(d) : "v"(h), "v"(b), "v"(c));
  return d;
}
__device__ __forceinline__ float fmix_hi(unsigned h, float b, float c) {
  float d;
  asm("v_fma_mix_f32 %0, %1, %2, %3 op_sel:[1,0,0] op_sel_hi:[1,0,0]" : "=v"(d) : "v"(h), "v"(b), "v"(c));
  return d;
}
__device__ __forceinline__ float vmul1(float a, float b) {
  float d;
  asm("v_mul_f32 %0, %1, %2" : "=v"(d) : "v"(a), "v"(b));
  return d;
}
struct RwOps { f16x4 r, k, a, b; float4 w; float vv; };
__device__ __forceinline__ RwOps rw_ld(const char* Ls, int q, int v) {
  RwOps o;
  o.r = *(const f16x4*)(Ls + q * 8);
  o.k = *(const f16x4*)(Ls + 128 + q * 8);
  o.a = *(const f16x4*)(Ls + 256 + q * 8);
  o.b = *(const f16x4*)(Ls + 384 + q * 8);
  o.w = *(const float4*)(Ls + 512 + q * 16);
  o.vv = *(const float*)(Ls + 768 + v * 4);
  return o;
}
__device__ __forceinline__ float rw_step(const RwOps& o, float4& S) {
  const u32x2 rw = __builtin_bit_cast(u32x2, o.r), kw = __builtin_bit_cast(u32x2, o.k),
              aw = __builtin_bit_cast(u32x2, o.a), bw = __builtin_bit_cast(u32x2, o.b);
  const float z = 0.f;
  float sa0 = fmix_lo(aw[0], S.x, z);
  float sa1 = fmix_lo(aw[1], S.z, z);
  sa0 = fmix_hi(aw[0], S.y, sa0);
  sa1 = fmix_hi(aw[1], S.w, sa1);
  float t0 = vmul1(S.x, o.w.x), t1 = vmul1(S.y, o.w.y), t2 = vmul1(S.z, o.w.z), t3 = vmul1(S.w, o.w.w);
  t0 = fmix_lo(kw[0], o.vv, t0);
  t1 = fmix_hi(kw[0], o.vv, t1);
  t2 = fmix_lo(kw[1], o.vv, t2);
  t3 = fmix_hi(kw[1], o.vv, t3);
  const float sa = rowsum16(sa0 + sa1);
  S.x = fmix_lo(bw[0], sa, t0);
  S.y = fmix_hi(bw[0], sa, t1);
  S.z = fmix_lo(bw[1], sa, t2);
  S.w = fmix_hi(bw[1], sa, t3);
  float y0 = fmix_lo(rw[0], S.x, z);
  float y1 = fmix_lo(rw[1], S.z, z);
  y0 = fmix_hi(rw[0], S.y, y0);
  y1 = fmix_hi(rw[1], S.w, y1);
  return rowsum16(y0 + y1);
}
__device__ __forceinline__ void rw_scan_run(const char* __restrict__ gsrc  , int len, float4& S,
                            float* __restrict__ yo  , int q, int v, char* smem) {
  const int tid = tid_l();
  const int nch = len >> 4;
  const int lstep = tid >> 6, loff = (tid & 63) * 16;
  u32x4 st[4];
#pragma unroll
  for (int i = 0; i < 4; i++) st[i] = *(const u32x4*)(gsrc + (size_t)(lstep + 4 * i) * RWS_ROWB + loff);
  __syncthreads();
#pragma unroll
  for (int i = 0; i < 4; i++) *(u32x4*)(smem + (lstep + 4 * i) * 1024 + loff) = st[i];
  u32x4 st2[4];
#pragma unroll
  for (int i = 0; i < 4; i++) st2[i] = st[i];
  if (nch > 1) {
#pragma unroll
    for (int i = 0; i < 4; i++) st[i] = *(const u32x4*)(gsrc + (size_t)(16 + lstep + 4 * i) * RWS_ROWB + loff);
  }
  if (nch > 2) {
#pragma unroll
    for (int i = 0; i < 4; i++) st2[i] = *(const u32x4*)(gsrc + (size_t)(32 + lstep + 4 * i) * RWS_ROWB + loff);
  }
  __syncthreads();
  for (int c = 0; c < nch; c++) {
    const char* L = smem + (c & 1) * 16384;
    float ykeep = 0.f;
    RwOps oa = rw_ld(L, q, v);
#pragma unroll 1
    for (int t = 0; t < 16; t += 2) {
      const RwOps ob = rw_ld(L + (t + 1) * 1024, q, v);
      asm volatile("" ::: "memory");
      const float ya = rw_step(oa, S);
      ykeep = (q == t) ? ya : ykeep;
      oa = rw_ld(L + ((t + 2) & 15) * 1024, q, v);
      asm volatile("" ::: "memory");
      const float yb = rw_step(ob, S);
      ykeep = (q == t + 1) ? yb : ykeep;
    }
    yo[(size_t)(c * 16 + q) * DM] = ykeep;
    if (c + 1 < nch) {
      char* Ln = smem + ((c + 1) & 1) * 16384;
#pragma unroll
      for (int i = 0; i < 4; i++) *(u32x4*)(Ln + (lstep + 4 * i) * 1024 + loff) = st[i];
#pragma unroll
      for (int i = 0; i < 4; i++) st[i] = st2[i];
      if (c + 3 < nch) {
#pragma unroll
        for (int i = 0; i < 4; i++)
          st2[i] = *(const u32x4*)(gsrc + (size_t)((c + 3) * 16 + lstep + 4 * i) * RWS_ROWB + loff);
      }
    }
    lds_barrier();
  }
}

struct GdOps { f16x8 qv, kv; float vv, eg; };
__device__ __forceinline__ GdOps gd_ld(const char* Ls, int q, int cl) {
  GdOps o;
  o.kv = *(const f16x8*)(Ls + 256 + q * 16);
  o.vv = (float)*(const f16*)(Ls + 512 + cl * 2);
  o.eg = *(const float*)(Ls + 768);
  o.qv = *(const f16x8*)(Ls + q * 16);
  return o;
}
__device__ __forceinline__ float gd_step(const GdOps& o, float (&s)[8]) {
  const u32x4 kw = __builtin_bit_cast(u32x4, o.kv), qw = __builtin_bit_cast(u32x4, o.qv);
  const float z = 0.f;
  float a0 = fmix_lo(kw[0], s[0], z);
  float a1 = fmix_lo(kw[2], s[4], z);
  a0 = fmix_hi(kw[0], s[1], a0);
  a1 = fmix_hi(kw[2], s[5], a1);
  a0 = fmix_lo(kw[1], s[2], a0);
  a1 = fmix_lo(kw[3], s[6], a1);
  a0 = fmix_hi(kw[1], s[3], a0);
  a1 = fmix_hi(kw[3], s[7], a1);
  float es[8];
#pragma unroll
  for (int i = 0; i < 8; i++) es[i] = vmul1(o.eg, s[i]);
  const float ks = rowsum16(a0 + a1);
  const float d = fmaf(-o.eg, ks, o.vv);
  s[0] = fmix_lo(kw[0], d, es[0]); s[1] = fmix_hi(kw[0], d, es[1]);
  s[2] = fmix_lo(kw[1], d, es[2]); s[3] = fmix_hi(kw[1], d, es[3]);
  s[4] = fmix_lo(kw[2], d, es[4]); s[5] = fmix_hi(kw[2], d, es[5]);
  s[6] = fmix_lo(kw[3], d, es[6]); s[7] = fmix_hi(kw[3], d, es[7]);
  float o0 = fmix_lo(qw[0], s[0], z);
  float o1 = fmix_lo(qw[2], s[4], z);
  o0 = fmix_hi(qw[0], s[1], o0);
  o1 = fmix_hi(qw[2], s[5], o1);
  o0 = fmix_lo(qw[1], s[2], o0);
  o1 = fmix_lo(qw[3], s[6], o1);
  o0 = fmix_hi(qw[1], s[3], o0);
  o1 = fmix_hi(qw[3], s[7], o1);
  return rowsum16(o0 + o1);
}
__device__ __forceinline__ void gd_scan_run(const char* __restrict__ gsrc  , int len, float (&s)[8],
                            float* __restrict__ oo  , int q, int cl, char* smem) {
  const int tid = tid_l();
  const int nch = len >> 4;
  u32x4 st[4];
  int lt[4], lo[4];
#pragma unroll
  for (int i = 0; i < 4; i++) {
    int id = tid + 256 * i;
    if (id > 783) id = 783;
    lt[i] = id / 49;
    lo[i] = (id % 49) * 16;
  }
#pragma unroll
  for (int i = 0; i < 4; i++) st[i] = *(const u32x4*)(gsrc + (size_t)lt[i] * GDS_ROWB + lo[i]);
  __syncthreads();
#pragma unroll
  for (int i = 0; i < 4; i++) *(u32x4*)(smem + lt[i] * GDS_HB + lo[i]) = st[i];
  u32x4 st2[4];
#pragma unroll
  for (int i = 0; i < 4; i++) st2[i] = st[i];
  if (nch > 1) {
#pragma unroll
    for (int i = 0; i < 4; i++) st[i] = *(const u32x4*)(gsrc + (size_t)(16 + lt[i]) * GDS_ROWB + lo[i]);
  }
  if (nch > 2) {
#pragma unroll
    for (int i = 0; i < 4; i++) st2[i] = *(const u32x4*)(gsrc + (size_t)(32 + lt[i]) * GDS_ROWB + lo[i]);
  }
  __syncthreads();
  for (int c = 0; c < nch; c++) {
    const char* L = smem + (c & 1) * 16384;
    float okeep = 0.f;
    GdOps oa = gd_ld(L, q, cl);
#pragma unroll 1
    for (int t = 0; t < 16; t += 2) {
      const GdOps ob = gd_ld(L + (t + 1) * GDS_HB, q, cl);
      asm volatile("" ::: "memory");
      const float ya = gd_step(oa, s);
      okeep = (q == t) ? ya : okeep;
      oa = gd_ld(L + ((t + 2) & 15) * GDS_HB, q, cl);
      asm volatile("" ::: "memory");
      const float yb = gd_step(ob, s);
      okeep = (q == t + 1) ? yb : okeep;
    }
    oo[(size_t)(c * 16 + q) * DM] = okeep;
    if (c + 1 < nch) {
      char* Ln = smem + ((c + 1) & 1) * 16384;
#pragma unroll
      for (int i = 0; i < 4; i++) *(u32x4*)(Ln + lt[i] * GDS_HB + lo[i]) = st[i];
#pragma unroll
      for (int i = 0; i < 4; i++) st[i] = st2[i];
      if (c + 3 < nch) {
#pragma unroll
        for (int i = 0; i < 4; i++) st2[i] = *(const u32x4*)(gsrc + (size_t)((c + 3) * 16 + lt[i]) * GDS_ROWB + lo[i]);
      }
    }
    lds_barrier();
  }
}

__device__ __forceinline__ void sample_scan_task(PP pp, int task, char* smem) {
  LAUNDER_PP;
  const int sj = task >> 7, j = task & 127, kind = j >> 6, jj = j & 63;
  const int tid = tid_l(), q = tid & 15;
  const int row0 = 1056 + sj * 16;
  if (kind == 0) {
    const int head = jj >> 2, v = (jj & 3) * 16 + (tid >> 4);
    const float* sin = p.st_wkv + ((size_t)sj * 16 + head) * 4096;
    float* sout = (p.out + OO_s_wkv) + ((size_t)sj * 16 + head) * 4096;
    float4 S = *(const float4*)(sin + v * 64 + 4 * q);
    rw_scan_run(((char*)(p.ws + OW_RWS)) + ((size_t)row0 * 16 + head) * 1024, 16, S, ((float*)(p.ws + OW_YRW)) + (size_t)row0 * DM + head * 64 + v, q, v, smem);
    *(float4*)(sout + v * 64 + 4 * q) = S;
  } else {
    const int head = jj >> 3, cl = (jj & 7) * 16 + (tid >> 4);
    const float* sin = p.st_ssm + ((size_t)sj * 8 + head) * 16384;
    float* sout = (p.out + OO_s_ssm) + ((size_t)sj * 8 + head) * 16384;
    float s[8];
#pragma unroll
    for (int i = 0; i < 8; i++) s[i] = sin[(size_t)(8 * q + i) * 128 + cl];
    gd_scan_run(((char*)(p.ws + OW_GDS)) + ((size_t)row0 * 8 + head) * GDS_HB, 16, s, ((float*)(p.ws + OW_OGD)) + (size_t)row0 * DM + head * 128 + cl, q, cl, smem);
#pragma unroll
    for (int i = 0; i < 8; i++) sout[(size_t)(8 * q + i) * 128 + cl] = s[i];
  }
}

__device__ __forceinline__ void scan_block_rw(PP pp, int j, char* smem) {
  LAUNDER_PP;
  const int seq = j >> 6, jj = j & 63;
  const int tid = tid_l(), q = tid & 15;
  const int head = jj >> 2, v = (jj & 3) * 16 + (tid >> 4);
  float4 S = make_float4(0.f, 0.f, 0.f, 0.f);
  for (int seg = 0; seg < NSEG; seg++) {
    wait_ge(((unsigned int*)(p.ws + OW_sync)) + SW_PRE, seg + 1);
    const int len = seg == 0 ? 528 : TS;
    const int row0 = slot_row0(seg) + (seg == 0 ? seq * 528 : seq * TS);
    rw_scan_run(((char*)(p.ws + OW_RWS)) + ((size_t)row0 * 16 + head) * 1024, len, S,
                ((float*)(p.ws + OW_YRW)) + (size_t)row0 * DM + head * 64 + v, q, v, smem);
    signal_add(((unsigned int*)(p.ws + OW_sync)) + SW_SCAN(seg));
  }
  {
    const int tid2 = tid_l(), q2 = tid2 & 15, v2 = (jj & 3) * 16 + (tid2 >> 4);
    *(float4*)((p.out + OO_p_wkv) + ((size_t)seq * 16 + head) * 4096 + v2 * 64 + 4 * q2) = S;
  }
}
__device__ __forceinline__ void scan_block_gd(PP pp, int j, char* smem) {
  LAUNDER_PP;
  const int seq = j >> 6, jj = j & 63;
  const int tid = tid_l(), q = tid & 15;
  const int head = jj >> 3, cl = (jj & 7) * 16 + (tid >> 4);
  float s[8];
#pragma unroll
  for (int i = 0; i < 8; i++) s[i] = 0.f;
  for (int seg = 0; seg < NSEG; seg++) {
    wait_ge(((unsigned int*)(p.ws + OW_sync)) + SW_PRE, seg + 1);
    const int len = seg == 0 ? 528 : TS;
    const int row0 = slot_row0(seg) + (seg == 0 ? seq * 528 : seq * TS);
    gd_scan_run(((char*)(p.ws + OW_GDS)) + ((size_t)row0 * 8 + head) * GDS_HB, len, s,
                ((float*)(p.ws + OW_OGD)) + (size_t)row0 * DM + head * 128 + cl, q, cl, smem);
    signal_add(((unsigned int*)(p.ws + OW_sync)) + SW_SCAN(seg));
  }
  {
    const int tid2 = tid_l(), q2 = tid2 & 15, cl2 = (jj & 7) * 16 + (tid2 >> 4);
    float* sout = (p.out + OO_p_ssm) + ((size_t)seq * 8 + head) * 16384;
#pragma unroll
    for (int i = 0; i < 8; i++) sout[(size_t)(8 * q2 + i) * 128 + cl2] = s[i];
  }
}

__device__ __forceinline__ void post_item(PP pp, int seg, int row) {
  LAUNDER_PP;
  const int tid = tid_l(), c4 = tid * 4;
  const int srow = slot_row0(seg) + row;
  const bf16_t* gt = ((bf16_t*)(p.ws + OW_GT)) + (size_t)(gt_row0(seg) + row) * GTW;
  {
    float4 y = *(const float4*)(((float*)(p.ws + OW_YRW)) + (size_t)srow * DM + c4);
    float mean = rowsum16(y.x + y.y + y.z + y.w) * (1.0f / 64.0f);
    float dx = y.x - mean, dy = y.y - mean, dz = y.z - mean, dw = y.w - mean;
    float var = rowsum16(dx * dx + dy * dy + dz * dz + dw * dw) * (1.0f / 64.0f);
    float rs = rsqrtf(var + 64e-5f);
    float4 lw = *(const float4*)(p.rw_ln_w + c4), lb = *(const float4*)(p.rw_ln_b + c4);
    float bon = ((float*)(p.ws + OW_RWB))[(size_t)srow * 16 + (tid >> 4)];
    float4 v = *(const float4*)(((char*)(p.ws + OW_RWS)) + ((size_t)srow * 16 + (tid >> 4)) * 1024 + 768 + (tid & 15) * 16);
    uint2 g = *(const uint2*)(gt + G_RW + c4);
    float o0 = (dx * rs * lw.x + lb.x + bon * v.x) * siluf_(bf2f(g.x & 0xffff));
    float o1 = (dy * rs * lw.y + lb.y + bon * v.y) * siluf_(bf2f(g.x >> 16));
    float o2 = (dz * rs * lw.z + lb.z + bon * v.z) * siluf_(bf2f(g.y & 0xffff));
    float o3 = (dw * rs * lw.w + lb.w + bon * v.w) * siluf_(bf2f(g.y >> 16));
    *(uint2*)(((bf16_t*)(p.ws + OW_YA)) + (size_t)(seg & 1) * MP0 * DM + blk_off(row, c4)) = make_uint2(pack2(o0, o1), pack2(o2, o3));
  }
  {
    float4 o = *(const float4*)(((float*)(p.ws + OW_OGD)) + (size_t)srow * DM + c4);
    float ss = rowsum16(o.x * o.x + o.y * o.y + o.z * o.z + o.w * o.w);
    ss += __shfl_xor(ss, 16);
    float rs = rsqrtf(ss * (1.0f / 128.0f) + 1e-6f);
    float4 nw = *(const float4*)(p.gd_norm_w + (c4 & 127));
    uint2 g = *(const uint2*)(gt + G_GD + c4);
    float o0 = o.x * rs * nw.x * siluf_(bf2f(g.x & 0xffff));
    float o1 = o.y * rs * nw.y * siluf_(bf2f(g.x >> 16));
    float o2 = o.z * rs * nw.z * siluf_(bf2f(g.y & 0xffff));
    float o3 = o.w * rs * nw.w * siluf_(bf2f(g.y >> 16));
    *(uint2*)(((bf16_t*)(p.ws + OW_YB)) + (size_t)(seg & 1) * MP0 * DM + blk_off(row, c4)) = make_uint2(pack2(o0, o1), pack2(o2, o3));
  }
}

#define SMEM_BYTES (32768 + 16)

__global__ void __launch_bounds__(256, 4) k_mega(Params p_arg) {
  PP pp = (PP)__builtin_amdgcn_kernarg_segment_ptr();
  __shared__ __attribute__((aligned(16))) char smem[SMEM_BYTES];
  cg::grid_group grid = cg::this_grid();
  const int bid = blockIdx.x, nb = gridDim.x;
  unsigned* sync = (unsigned*)(p.ws + OW_sync);
  const unsigned xcc = xcc_id() & 7u;
  if (bid >= NSCAN && threadIdx.x == 0) xb_add(&sync[SW_XCNT(xcc)], 1u);
  phase_weights(pp, bid, nb, smem);
  for (int it = bid; it < seg_MP(0) / 4; it += nb) xn_item(pp, 0, it);
  grid.sync();
  if (bid < NSCAN) {
    __builtin_amdgcn_s_setprio(3);
    if (bid < 128) scan_block_rw(pp, bid, smem);
    else scan_block_gd(pp, bid - 128, smem);
    return;
  }
  const int w = bid - NSCAN, NW = nb - NSCAN;
  unsigned* cfg = (unsigned*)(smem + 32768);
  if (threadIdx.x == 0) {
    unsigned mine = 0, nx = 0;
#pragma unroll
    for (unsigned j = 0; j < 8; j++) { unsigned c = xb_ld(&sync[SW_XCNT(j)]); nx += c > 0u ? 1u : 0u; mine = (j == xcc) ? c : mine; }
    cfg[0] = mine > 0u ? mine : 1u;
    cfg[1] = nx > 0u ? nx : 1u;
  }
  __syncthreads();
  for (int i = 0; i < NSEG + 5; i++) {
    const int sm = i - 4, snn = i - 5, sj = i - 3, so = i - 4, sp = i - 2;
    const bool front = i < NSEG;
    const bool mrg = sm >= 0 && sm < NSEG, nrm = snn >= 0 && snn < NSEG, back = sj >= 0 && sj < NSEG, outv = so >= 0 && so < NSEG,
               pst = sp >= 0 && sp < NSEG;
    {
      const int tmF = front ? seg_MP(i) / 128 : 1;
      const int nF = front ? tmF * (VW / 128) : 0;
      const int nM = mrg ? seg_MP(sm) / 4 : 0;
      const int nN = nrm ? seg_M(snn) / 4 : 0;
      if ((NW & 7) == 0) {
        const int x = w & 7, per = NW >> 3;
        const int ncol = front ? ((VW / 128 - x + 7) >> 3) : 0;
        for (int j = w >> 3; j < tmF * ncol; j += per) gemm_tile<0>(pp, i, j % tmF, x + 8 * (j / tmF), smem);
        for (int it = w; it < nM + nN; it += NW) {
          if (it < nM) merge_item(pp, it);
          else norm_item(pp, snn, it - nM);
        }
      } else {
        for (int it = w; it < nF + nM + nN; it += NW) {
          int t = it;
          if (t < nF) { gemm_tile<0>(pp, i, t % tmF, t / tmF, smem); continue; }
          t -= nF;
          if (t < nM) { merge_item(pp, t); continue; }
          t -= nM;
          norm_item(pp, snn, t);
        }
      }
      if (i == 1) {
        for (int it = w; it < 32 * 128; it += NW) sample_scan_task(pp, it, smem);
      }
    }
    worker_barrier((unsigned*)(p.ws + OW_sync), (const unsigned*)(smem + 32768));
    {
      const int nB = back ? (seg_MP(sj) / 128) * 8 : 0;
      const int nO = outv ? (seg_MP(so) / 128) * 8 : 0;
      const int nHeavy = 2 * nB + nO;
      const int nHeavyW = nHeavy < NW / 2 ? nHeavy : NW / 2;
      const int NL = NW - nHeavyW;
      const int ngrp = front ? seg_M(i) / 16 : 0;
      const int nRW = ngrp * 8, nGD = ngrp * 6;
      const int nX = (i + 1 < NSEG) ? seg_MP(i + 1) / 4 : 0;
      const int tot = nRW + nGD + nX;
      if (w >= NL) {
        for (int it = w - NL; it < nHeavy; it += nHeavyW) {
          int t = it;
          if (t < nB) { gemm_tile<1>(pp, sj, t >> 3, t & 7, smem); continue; }
          t -= nB;
          if (t < nB) { gemm_tile<3>(pp, sj, t >> 3, t & 7, smem); continue; }
          t -= nB;
          gemm_tile<2>(pp, so, t >> 3, t & 7, smem);
        }
      } else {
        for (int it = w; it < tot; it += NL) {
          int t = it;
          if (t < nRW) { rw_prepass_item(pp, i, t >> 2, t & 3, smem); continue; }
          t -= nRW;
          if (t < nGD) { gd_prepass_item(pp, i, t / 6, t % 6); continue; }
          t -= nGD;
          xn_item(pp, i + 1, t);
        }
      }
      if (pst) {
        wait_ge((unsigned*)(p.ws + OW_sync) + SW_SCAN(sp), NSCAN);
        const int n = seg_M(sp);
        for (int it = w; it < n; it += NW) post_item(pp, sp, it);
      }
    }
    worker_barrier((unsigned*)(p.ws + OW_sync), (const unsigned*)(smem + 32768));
    if (front && w == 0 && threadIdx.x == 0)
      __hip_atomic_store((unsigned*)(p.ws + OW_sync) + SW_PRE, (unsigned)(i + 1), __ATOMIC_RELAXED, __HIP_MEMORY_SCOPE_AGENT);
  }
}

static inline size_t align_up(size_t x) { return (x + 255) & ~(size_t)255; }

#undef p
extern "C" void kernel_launch(void* const* d_in, const int* in_sizes, int n_in, void* d_out, int out_size, void* d_ws,
                              size_t ws_size, hipStream_t stream) {
  Params p{};
  const float* const* in = (const float* const*)d_in;
  p.x_prompt = in[0]; p.x_sample = in[1]; p.st_shift = in[2]; p.st_wkv = in[3]; p.st_conv = in[4]; p.st_ssm = in[5];
  p.meta = in[6]; p.norm_pre = in[7]; p.w_in = in[8]; p.rw_mu = in[9]; p.rw_w0 = in[10]; p.rw_w2 = in[11];
  p.rw_a0 = in[12]; p.rw_a2 = in[13]; p.rw_k_k = in[14]; p.rw_k_a = in[15]; p.rw_r_k = in[16]; p.rw_ln_w = in[17];
  p.rw_ln_b = in[18]; p.gd_conv_w = in[19]; p.gd_a_log = in[20]; p.gd_dt_bias = in[21]; p.gd_norm_w = in[22];
  p.w_out_a = in[23]; p.w_out_b = in[24]; p.w_out = in[25]; p.norm_post = in[26];
  p.out = (float*)d_out;
  p.ws = (char*)d_ws;
  if (OW_END > ws_size) { fprintf(stderr, "workspace too small: need %zu have %zu\n", (size_t)OW_END, ws_size); return; }

  static int grid_blocks = 0;
  if (!grid_blocks) {
    int dev = 0, cus = 0, per_cu = 0;
    (void)hipGetDevice(&dev);
    (void)hipDeviceGetAttribute(&cus, hipDeviceAttributeMultiprocessorCount, dev);
    (void)hipOccupancyMaxActiveBlocksPerMultiprocessor(&per_cu, k_mega, 256, 0);
    if (per_cu > 4) per_cu = 4;
    grid_blocks = cus * per_cu;
  }
  (void)hipMemsetAsync(p.ws + OW_sync, 0, 16384, stream);
  void* args[] = {&p};
  hipError_t e = hipLaunchCooperativeKernel((void*)k_mega, dim3(grid_blocks), dim3(256), args, 0, stream);
  if (e != hipSuccess) fprintf(stderr, "cooperative launch failed: %s (grid %d)\n", hipGetErrorString(e), grid_blocks);
}
```

```cpp
#include <hip/hip_runtime.h>
#include <hip/hip_cooperative_groups.h>
#include <stdint.h>
#include <stdio.h>
namespace cg = cooperative_groups;

typedef unsigned short bf16_t;
typedef _Float16 f16;
using bf16x8 = __attribute__((ext_vector_type(8))) short;
using f32x4 = __attribute__((ext_vector_type(4))) float;
using u32x4 = __attribute__((ext_vector_type(4))) unsigned int;
using f32x16 = __attribute__((ext_vector_type(16))) float;
using f16x2 = __attribute__((ext_vector_type(2))) _Float16;
using f16x4 = __attribute__((ext_vector_type(4))) _Float16;
using f16x8 = __attribute__((ext_vector_type(8))) _Float16;

#define DM 1024
#define PW 10384
#define VW 10496
#define PJW 6400
#define GTW 4096
#define NSEG 16
#define TS 512
#define M0 1568
#define MP0 1664
#define M1 1024
#define SLOT_ROWS 3712
#define GT_ROWS 4736
#define NSCAN 256
#define C_GDC 3200
#define C_BETA 6272
#define C_ALPHA 6280
#define G_RW 0
#define G_GD 1024
#define G_MA 2048
#define G_MB 3072
#define RWS_ROWB 16384
#define GDS_HB 784
#define GDS_ROWB 6272

struct Params {
  const float *x_prompt, *x_sample, *st_shift, *st_wkv, *st_conv, *st_ssm, *meta, *norm_pre, *w_in, *rw_mu, *rw_w0,
      *rw_w2, *rw_a0, *rw_a2, *rw_k_k, *rw_k_a, *rw_r_k, *rw_ln_w, *rw_ln_b, *gd_conv_w, *gd_a_log, *gd_dt_bias,
      *gd_norm_w, *w_out_a, *w_out_b, *w_out, *norm_post;
  float* out;
  char* ws;
};
#define p (PV(pp))
#define GLOBAL_AS __attribute__((address_space(1)))
#define CONST_AS __attribute__((address_space(4)))
struct ParamsG {
  const GLOBAL_AS float *x_prompt, *x_sample, *st_shift, *st_wkv, *st_conv, *st_ssm, *meta, *norm_pre, *w_in, *rw_mu, *rw_w0,
      *rw_w2, *rw_a0, *rw_a2, *rw_k_k, *rw_k_a, *rw_r_k, *rw_ln_w, *rw_ln_b, *gd_conv_w, *gd_a_log, *gd_dt_bias,
      *gd_norm_w, *w_out_a, *w_out_b, *w_out, *norm_post;
  GLOBAL_AS float* out;
  GLOBAL_AS char* ws;
};
typedef const CONST_AS ParamsG* PP;
__device__ __forceinline__ Params PV(PP pp) {
  Params v;
  v.x_prompt = (const float*)pp->x_prompt;
  v.x_sample = (const float*)pp->x_sample;
  v.st_shift = (const float*)pp->st_shift;
  v.st_wkv = (const float*)pp->st_wkv;
  v.st_conv = (const float*)pp->st_conv;
  v.st_ssm = (const float*)pp->st_ssm;
  v.meta = (const float*)pp->meta;
  v.norm_pre = (const float*)pp->norm_pre;
  v.w_in = (const float*)pp->w_in;
  v.rw_mu = (const float*)pp->rw_mu;
  v.rw_w0 = (const float*)pp->rw_w0;
  v.rw_w2 = (const float*)pp->rw_w2;
  v.rw_a0 = (const float*)pp->rw_a0;
  v.rw_a2 = (const float*)pp->rw_a2;
  v.rw_k_k = (const float*)pp->rw_k_k;
  v.rw_k_a = (const float*)pp->rw_k_a;
  v.rw_r_k = (const float*)pp->rw_r_k;
  v.rw_ln_w = (const float*)pp->rw_ln_w;
  v.rw_ln_b = (const float*)pp->rw_ln_b;
  v.gd_conv_w = (const float*)pp->gd_conv_w;
  v.gd_a_log = (const float*)pp->gd_a_log;
  v.gd_dt_bias = (const float*)pp->gd_dt_bias;
  v.gd_norm_w = (const float*)pp->gd_norm_w;
  v.w_out_a = (const float*)pp->w_out_a;
  v.w_out_b = (const float*)pp->w_out_b;
  v.w_out = (const float*)pp->w_out;
  v.norm_post = (const float*)pp->norm_post;
  v.out = (float*)pp->out;
  v.ws = (char*)pp->ws;
  return v;
}
constexpr size_t al256(size_t x) { return (x + 255) & ~(size_t)255; }
constexpr size_t OO_y_prompt = 0;
constexpr size_t OO_y_sample = OO_y_prompt + (size_t)2 * 8192 * 1024;
constexpr size_t OO_p_shift = OO_y_sample + (size_t)32 * 16 * 1024;
constexpr size_t OO_p_wkv = OO_p_shift + 2 * 3200;
constexpr size_t OO_p_conv = OO_p_wkv + 2 * 16 * 4096;
constexpr size_t OO_p_ssm = OO_p_conv + 2 * 3 * 3072;
constexpr size_t OO_s_shift = OO_p_ssm + 2 * 8 * 16384;
constexpr size_t OO_s_wkv = OO_s_shift + 32 * 3200;
constexpr size_t OO_s_conv = OO_s_wkv + 32 * 16 * 4096;
constexpr size_t OO_s_ssm = OO_s_conv + 32 * 3 * 3072;
constexpr size_t OW_sync = 0;
constexpr size_t OW_WtIn = OW_sync + 16384;
constexpr size_t OW_WtA = OW_WtIn + al256((size_t)VW * DM * 2);
constexpr size_t OW_WtB = OW_WtA + al256((size_t)DM * DM * 2);
constexpr size_t OW_WtO = OW_WtB + al256((size_t)DM * DM * 2);
constexpr size_t OW_XN = OW_WtO + al256((size_t)DM * DM * 2);
constexpr size_t OW_PJA = OW_XN + al256((size_t)MP0 * DM * 2);
constexpr size_t OW_YA = OW_PJA + al256((size_t)MP0 * PJW * 2);
constexpr size_t OW_YB = OW_YA + al256((size_t)2 * MP0 * DM * 2);
constexpr size_t OW_MG = OW_YB + al256((size_t)2 * MP0 * DM * 2);
constexpr size_t OW_OUTB = OW_MG + al256((size_t)MP0 * DM * 2);
constexpr size_t OW_TMP = OW_OUTB + al256((size_t)2 * MP0 * DM * 4);
constexpr size_t OW_GT = OW_TMP + al256((size_t)2 * MP0 * DM * 4);
constexpr size_t OW_RWS = OW_GT + al256((size_t)GT_ROWS * GTW * 2);
constexpr size_t OW_GDS = OW_RWS + al256((size_t)SLOT_ROWS * RWS_ROWB);
constexpr size_t OW_RWB = OW_GDS + al256((size_t)SLOT_ROWS * GDS_ROWB + 256);
constexpr size_t OW_YRW = OW_RWB + al256((size_t)SLOT_ROWS * 16 * 4);
constexpr size_t OW_OGD = OW_YRW + al256((size_t)SLOT_ROWS * DM * 4);
constexpr size_t OW_CSH = OW_OGD + al256((size_t)SLOT_ROWS * DM * 4);
constexpr size_t OW_CCV = OW_CSH + al256((size_t)2 * 2 * 3200 * 4);
constexpr size_t OW_END = OW_CCV + al256((size_t)2 * 2 * 3 * 3072 * 4);


__device__ __forceinline__ bf16_t f2bf(float f) {
  uint32_t u = __float_as_uint(f);
  u += 0x7fffu + ((u >> 16) & 1u);
  return (bf16_t)(u >> 16);
}
__device__ __forceinline__ float bf2f(bf16_t h) { return __uint_as_float(((uint32_t)h) << 16); }
__device__ __forceinline__ uint32_t pack2(float a, float b) { return (uint32_t)f2bf(a) | ((uint32_t)f2bf(b) << 16); }
__device__ __forceinline__ float sigmoidf_(float x) { return 1.0f / (1.0f + __expf(-x)); }
__device__ __forceinline__ float siluf_(float x) { return x / (1.0f + __expf(-x)); }
__device__ __forceinline__ float softplusf_(float x) { return fmaxf(x, 0.0f) + log1pf(__expf(-fabsf(x))); }

__device__ __forceinline__ int tid_l() { int t = threadIdx.x; asm volatile("" : "+v"(t)); return t; }
#define LAUNDER_PP asm volatile("" : "+s"(pp))
template <int CTRL>
__device__ __forceinline__ float dppf(float x) {
  return __builtin_bit_cast(float, __builtin_amdgcn_update_dpp(0, __builtin_bit_cast(int, x), CTRL, 0xf, 0xf, true));
}
__device__ __forceinline__ float rowsum16(float x) {
  x += dppf<0xB1>(x);
  x += dppf<0x4E>(x);
  x += dppf<0x141>(x);
  x += dppf<0x140>(x);
  return x;
}
__device__ __forceinline__ float wavesum(float x) {
  x = rowsum16(x);
  x += __shfl_xor(x, 16);
  x += __shfl_xor(x, 32);
  return x;
}

#define SW_XCNT(j) (64 * (1 + (j)))
#define SW_XSUB(j) (64 * (9 + (j)))
#define SW_XGEN(j) (64 * (17 + (j)))
#define SW_TOP (64 * 25)
#define SW_TOPGEN (64 * 26)
#define SW_PRE (64 * 27)
#define SW_SCAN(s) (64 * (28 + (s)))
#define SW_SCNT(j) (64 * (44 + (j)))
#define SW_SSUB(seg, x) (3328 + ((seg) * 8 + (x)) * 4)
#define SYNC_BYTES 16384
__device__ __forceinline__ unsigned xb_ld(const unsigned* ptr) {
  return __hip_atomic_load(ptr, __ATOMIC_RELAXED, __HIP_MEMORY_SCOPE_AGENT);
}
__device__ __forceinline__ unsigned xb_add(unsigned* ptr, unsigned v) {
  return __hip_atomic_fetch_add(ptr, v, __ATOMIC_RELAXED, __HIP_MEMORY_SCOPE_AGENT);
}
__device__ __forceinline__ unsigned xcc_id() { return (unsigned)__builtin_amdgcn_s_getreg((3 << 11) | 20) & 0xFu; }
__device__ __forceinline__ void wait_ge(const unsigned* ptr, unsigned target) {
  if (threadIdx.x == 0) {
    while (xb_ld(ptr) < target) __builtin_amdgcn_s_sleep(8);
    __builtin_amdgcn_fence(__ATOMIC_ACQUIRE, "agent");
    asm volatile("s_waitcnt vmcnt(0)" ::: "memory");
  }
  __syncthreads();
}
__device__ __forceinline__ void signal_scan_done(unsigned* sync, int seg) {
  asm volatile("s_waitcnt vmcnt(0)" ::: "memory");
  __syncthreads();
  if (threadIdx.x == 0) {
    const unsigned x = xcc_id() & 7u;
    const unsigned nloc = xb_ld(&sync[SW_SCNT(x)]);
    const unsigned old = xb_add(&sync[SW_SSUB(seg, x)], 1u);
    if (old + 1u == nloc) {
      __builtin_amdgcn_fence(__ATOMIC_RELEASE, "agent");
      asm volatile("s_waitcnt vmcnt(0)" ::: "memory");
      xb_add(&sync[SW_SCAN(seg)], nloc);
    }
  }
}
__device__ __forceinline__ void worker_barrier(unsigned* bar, const unsigned* lds_cfg) {
  asm volatile("s_waitcnt vmcnt(0)" ::: "memory");
  __syncthreads();
  if (threadIdx.x == 0) {
    const unsigned x = xcc_id() & 7u, nloc = lds_cfg[0], nx = lds_cfg[1];
    const unsigned old = xb_add(&bar[SW_XSUB(x)], 1u);
    const unsigned gen = old / nloc;
    if (old + 1u == (gen + 1u) * nloc) {
      __builtin_amdgcn_fence(__ATOMIC_RELEASE, "agent");
      asm volatile("s_waitcnt vmcnt(0)" ::: "memory");
      const unsigned og = xb_add(&bar[SW_TOP], 1u);
      const unsigned tg = og / nx;
      if (og + 1u == (tg + 1u) * nx) xb_add(&bar[SW_TOPGEN], 1u);
      else while (xb_ld(&bar[SW_TOPGEN]) == tg) __builtin_amdgcn_s_sleep(1);
      __builtin_amdgcn_fence(__ATOMIC_ACQUIRE, "agent");
      xb_add(&bar[SW_XGEN(x)], 1u);
      asm volatile("s_waitcnt vmcnt(0)" ::: "memory");
    } else {
      while (xb_ld(&bar[SW_XGEN(x)]) == gen) __builtin_amdgcn_s_sleep(1);
      __builtin_amdgcn_fence(__ATOMIC_ACQUIRE, "agent");
      asm volatile("s_waitcnt vmcnt(0)" ::: "memory");
    }
  }
  __syncthreads();
}

__device__ __forceinline__ void lds_barrier() {
  asm volatile("s_waitcnt lgkmcnt(0)" ::: "memory");
  __builtin_amdgcn_s_barrier();
  asm volatile("" ::: "memory");
}

__device__ __forceinline__ int seg_M(int seg) { return seg == 0 ? M0 : M1; }
__device__ __forceinline__ int seg_MP(int seg) { return seg == 0 ? MP0 : M1; }
__device__ __forceinline__ int slot_row0(int seg) { int s = seg % 3; return s == 0 ? 0 : MP0 + (s - 1) * M1; }
__device__ __forceinline__ int gt_row0(int seg) { int s = seg & 3; return s == 0 ? 0 : MP0 + (s - 1) * M1; }
__device__ __forceinline__ const float* row_src(PP pp, int seg, int r) {
  if (seg == 0) {
    if (r < 1056) {
      int b = r >= 528 ? 1 : 0, t = r - b * 528;
      if (t < 16) return p.meta + t * DM;
      return p.x_prompt + ((size_t)b * 8192 + (t - 16)) * DM;
    }
    return p.x_sample + (size_t)(r - 1056) * DM;
  }
  int b = r >> 9, t = r & 511;
  return p.x_prompt + ((size_t)b * 8192 + seg * TS + t) * DM;
}
__device__ __forceinline__ float* row_dst(PP pp, int seg, int r) {
  if (seg == 0) {
    if (r < 1056) {
      int b = r >= 528 ? 1 : 0, t = r - b * 528;
      if (t < 16) return nullptr;
      return (p.out + OO_y_prompt) + ((size_t)b * 8192 + (t - 16)) * DM;
    }
    return (p.out + OO_y_sample) + (size_t)(r - 1056) * DM;
  }
  int b = r >> 9, t = r & 511;
  return (p.out + OO_y_prompt) + ((size_t)b * 8192 + seg * TS + t) * DM;
}
__device__ __forceinline__ void row_seq(int seg, int r, int& seq, int& t, int& len) {
  if (seg == 0) {
    if (r < 528) { seq = 0; t = r; len = 528; }
    else if (r < 1056) { seq = 1; t = r - 528; len = 528; }
    else { seq = 2 + ((r - 1056) >> 4); t = (r - 1056) & 15; len = 16; }
  } else { seq = r >> 9; t = r & 511; len = TS; }
}

__device__ __forceinline__ size_t blk_off(int row, int k) {
  const int kk = (k & 7) | (((((k >> 3) & 3) ^ ((row >> 2) & 3))) << 3);
  return ((size_t)((row >> 7) * 32 + (k >> 5)) * 128 + (row & 127)) * 32 + kk;
}

__device__ __forceinline__ int vcol_src(int n) {
  if (n < 3200) return n;
  if (n < 6288) return n + 1024;
  if (n < 6400) return -1;
  if (n < 7424) return n - 3200;
  return n - 112;
}
__device__ __forceinline__ void transpose_tile(const float* __restrict__ src, int ld, bool remap, bf16_t* __restrict__ dst, int k0, int n0,
                               float* tile  ) {
  int tid = tid_l();
  int i = tid >> 4, j = tid & 15;
  __syncthreads();
  int n = n0 + 4 * j;
  int sc = remap ? vcol_src(n) : n;
#pragma unroll
  for (int pass = 0; pass < 4; pass++) {
    int k = pass * 16 + i;
    float4 v = make_float4(0.f, 0.f, 0.f, 0.f);
    if (sc >= 0) v = *(const float4*)(src + (size_t)(k0 + k) * ld + sc);
    tile[k * 65 + 4 * j + 0] = v.x; tile[k * 65 + 4 * j + 1] = v.y; tile[k * 65 + 4 * j + 2] = v.z; tile[k * 65 + 4 * j + 3] = v.w;
  }
  __syncthreads();
  int nn = tid >> 2, kq = tid & 3;
  uint32_t o[8];
#pragma unroll
  for (int e = 0; e < 8; e++) o[e] = pack2(tile[(kq * 16 + 2 * e) * 65 + nn], tile[(kq * 16 + 2 * e + 1) * 65 + nn]);
  *(u32x4*)(dst + blk_off(n0 + nn, k0 + kq * 16)) = (u32x4){o[0], o[1], o[2], o[3]};
  *(u32x4*)(dst + blk_off(n0 + nn, k0 + kq * 16 + 8)) = (u32x4){o[4], o[5], o[6], o[7]};
}
__device__ __forceinline__ void phase_weights(PP pp, int bid, int nb, char* smem) {
  LAUNDER_PP;
  float* tile = (float*)smem;
  const int nIn = 16 * (VW / 64);
  const int nSq = 16 * 16;
  for (int it = bid; it < nIn + 3 * nSq; it += nb) {
    if (it < nIn) {
      int kt = it & 15, nt = it >> 4;
      transpose_tile(p.w_in, PW, true, ((bf16_t*)(p.ws + OW_WtIn)), kt * 64, nt * 64, tile);
    } else {
      int j = it - nIn, w = j / nSq, r = j % nSq;
      int kt = r & 15, nt = r >> 4;
      const float* src = w == 0 ? p.w_out_a : (w == 1 ? p.w_out_b : p.w_out);
      bf16_t* dst = w == 0 ? ((bf16_t*)(p.ws + OW_WtA)) : (w == 1 ? ((bf16_t*)(p.ws + OW_WtB)) : ((bf16_t*)(p.ws + OW_WtO)));
      transpose_tile(src, DM, false, dst, kt * 64, nt * 64, tile);
    }
  }
}

__device__ __forceinline__ void xn_item(PP pp, int seg, int item) {
  LAUNDER_PP;
  int wave = tid_l() >> 6, lane = tid_l() & 63;
  int M = seg_M(seg);
  int r = item * 4 + wave;
  bf16_t* o = ((bf16_t*)(p.ws + OW_XN));
  if (r >= M) {
#pragma unroll
    for (int i = 0; i < 4; i++) *(uint2*)(o + blk_off(r, (lane + 64 * i) * 4)) = make_uint2(0u, 0u);
    return;
  }
  const float4* src = (const float4*)row_src(pp, seg, r);
  float4 v[4];
  float ss = 0.f;
#pragma unroll
  for (int i = 0; i < 4; i++) {
    v[i] = src[lane + 64 * i];
    ss += v[i].x * v[i].x + v[i].y * v[i].y + v[i].z * v[i].z + v[i].w * v[i].w;
  }
  ss = wavesum(ss);
  float rstd = rsqrtf(ss * (1.0f / DM) + 1e-6f);
#pragma unroll
  for (int i = 0; i < 4; i++) {
    float4 g = ((const float4*)p.norm_pre)[lane + 64 * i];
    *(uint2*)(o + blk_off(r, (lane + 64 * i) * 4)) =
        make_uint2(pack2(v[i].x * rstd * g.x, v[i].y * rstd * g.y), pack2(v[i].z * rstd * g.z, v[i].w * rstd * g.w));
  }
}

__device__ __forceinline__ void norm_item(PP pp, int seg, int item) {
  LAUNDER_PP;
  int wave = tid_l() >> 6, lane = tid_l() & 63;
  int r = item * 4 + wave;
  float* dst = row_dst(pp, seg, r);
  if (!dst) return;
  const float4* h = (const float4*)row_src(pp, seg, r);
  const float4* o = (const float4*)(((float*)(p.ws + OW_OUTB)) + ((size_t)(seg & 1) * MP0 + r) * DM);
  float4 v[4];
  float ss = 0.f;
#pragma unroll
  for (int i = 0; i < 4; i++) {
    v[i] = o[lane + 64 * i];
    ss += v[i].x * v[i].x + v[i].y * v[i].y + v[i].z * v[i].z + v[i].w * v[i].w;
  }
  ss = wavesum(ss);
  float rstd = rsqrtf(ss * (1.0f / DM) + 1e-6f);
#pragma unroll
  for (int i = 0; i < 4; i++) {
    float4 g = ((const float4*)p.norm_post)[lane + 64 * i];
    float4 hh = h[lane + 64 * i];
    ((float4*)dst)[lane + 64 * i] =
        make_float4(hh.x + v[i].x * rstd * g.x, hh.y + v[i].y * rstd * g.y, hh.z + v[i].z * rstd * g.z, hh.w + v[i].w * rstd * g.w);
  }
}

__device__ __forceinline__ void merge_item(PP pp, int item) {
  LAUNDER_PP;
  const int tid = tid_l();
  const int wave = tid >> 6, lane = tid & 63;
  const int r = item * 4 + wave;
  const float4* t1 = (const float4*)((const float*)(p.ws + OW_TMP) + (size_t)r * DM);
  const float4* t2 = (const float4*)((const float*)(p.ws + OW_TMP) + ((size_t)MP0 + r) * DM);
  bf16_t* o = (bf16_t*)(p.ws + OW_MG);
#pragma unroll
  for (int i = 0; i < 4; i++) {
    float4 a = t1[lane + 64 * i], b = t2[lane + 64 * i];
    *(uint2*)(o + blk_off(r, (lane + 64 * i) * 4)) = make_uint2(pack2(a.x + b.x, a.y + b.y), pack2(a.z + b.z, a.w + b.w));
  }
}

#define LDT 32
template <int MODE>
__device__ __forceinline__ void gemm_tile(PP pp, int seg, int tm, int tn, char* smem) {
  LAUNDER_PP;
  const int tid = tid_l(), lane = tid & 63, wid = tid >> 6;
  const int wr = wid >> 1, wc = wid & 1, l31 = lane & 31, lh = lane >> 5;
  const int lrow = tid >> 2, lkc = tid & 3;
  const int m0 = tm * 128, n0 = tn * 128;
  bf16_t* GTs = ((bf16_t*)(p.ws + OW_GT)) + (size_t)gt_row0(seg) * GTW;
  f32x16 acc[2][2];
#pragma unroll
  for (int a = 0; a < 2; a++)
#pragma unroll
    for (int b = 0; b < 2; b++)
#pragma unroll
      for (int e = 0; e < 16; e++) acc[a][b][e] = 0.f;
  {
    const bf16_t* A = (MODE == 0) ? (const bf16_t*)(p.ws + OW_XN)
                    : (MODE == 1) ? (const bf16_t*)(p.ws + OW_YA) + (size_t)(seg & 1) * MP0 * DM
                    : (MODE == 3) ? (const bf16_t*)(p.ws + OW_YB) + (size_t)(seg & 1) * MP0 * DM
                                  : (const bf16_t*)(p.ws + OW_MG);
    const bf16_t* Bt = (const bf16_t*)(p.ws + (MODE == 0 ? OW_WtIn : (MODE == 1 ? OW_WtA : (MODE == 3 ? OW_WtB : OW_WtO))));
    u32x4 ra[2], rb[2];
    const bf16_t* gA = A + ((size_t)(tm * 32) * 128 + lrow) * 32 + lkc * 8;
    const bf16_t* gB = Bt + ((size_t)(tn * 32) * 128 + lrow) * 32 + lkc * 8;
    const int wofs = lrow * 64 + (lkc << 4);
    const int sw = (l31 >> 2) & 3;
    const int rofs0 = l31 * 64 + (((0 + lh) ^ sw) << 4);
    const int rofs1 = l31 * 64 + (((2 + lh) ^ sw) << 4);
    __syncthreads();
#pragma unroll
    for (int i = 0; i < 2; i++) {
      ra[i] = *(const u32x4*)(gA + (size_t)i * 2048);
      rb[i] = *(const u32x4*)(gB + (size_t)i * 2048);
    }
#pragma unroll
    for (int i = 0; i < 2; i++) {
      *(u32x4*)(smem + wofs + i * 4096) = ra[i];
      *(u32x4*)(smem + 8192 + wofs + i * 4096) = rb[i];
    }
#pragma unroll
    for (int i = 0; i < 2; i++) {
      ra[i] = *(const u32x4*)(gA + (size_t)i * 2048 + 4096);
      rb[i] = *(const u32x4*)(gB + (size_t)i * 2048 + 4096);
    }
    lds_barrier();
#pragma unroll 1
    for (int kt = 0; kt < 32; kt++) {
      const char* cA = smem + (kt & 1) * 16384 + wr * 4096;
      const char* cB = smem + (kt & 1) * 16384 + 8192 + wc * 4096;
      const bf16x8 x00 = *(const bf16x8*)(cA + rofs0), x01 = *(const bf16x8*)(cA + 2048 + rofs0);
      const bf16x8 w00 = *(const bf16x8*)(cB + rofs0), w01 = *(const bf16x8*)(cB + 2048 + rofs0);
      const bf16x8 x10 = *(const bf16x8*)(cA + rofs1), x11 = *(const bf16x8*)(cA + 2048 + rofs1);
      const bf16x8 w10 = *(const bf16x8*)(cB + rofs1), w11 = *(const bf16x8*)(cB + 2048 + rofs1);
      asm volatile("" ::: "memory");
      acc[0][0] = __builtin_amdgcn_mfma_f32_32x32x16_bf16(w00, x00, acc[0][0], 0, 0, 0);
      acc[0][1] = __builtin_amdgcn_mfma_f32_32x32x16_bf16(w00, x01, acc[0][1], 0, 0, 0);
      acc[1][0] = __builtin_amdgcn_mfma_f32_32x32x16_bf16(w01, x00, acc[1][0], 0, 0, 0);
      acc[1][1] = __builtin_amdgcn_mfma_f32_32x32x16_bf16(w01, x01, acc[1][1], 0, 0, 0);
      acc[0][0] = __builtin_amdgcn_mfma_f32_32x32x16_bf16(w10, x10, acc[0][0], 0, 0, 0);
      acc[0][1] = __builtin_amdgcn_mfma_f32_32x32x16_bf16(w10, x11, acc[0][1], 0, 0, 0);
      acc[1][0] = __builtin_amdgcn_mfma_f32_32x32x16_bf16(w11, x10, acc[1][0], 0, 0, 0);
      acc[1][1] = __builtin_amdgcn_mfma_f32_32x32x16_bf16(w11, x11, acc[1][1], 0, 0, 0);
      if (kt + 1 < 32) {
        char* nx = smem + ((kt + 1) & 1) * 16384;
#pragma unroll
        for (int i = 0; i < 2; i++) {
          *(u32x4*)(nx + wofs + i * 4096) = ra[i];
          *(u32x4*)(nx + 8192 + wofs + i * 4096) = rb[i];
        }
        if (kt + 2 < 32) {
#pragma unroll
          for (int i = 0; i < 2; i++) {
            ra[i] = *(const u32x4*)(gA + (size_t)i * 2048 + (size_t)(kt + 2) * 4096);
            rb[i] = *(const u32x4*)(gB + (size_t)i * 2048 + (size_t)(kt + 2) * 4096);
          }
        }
      }
      lds_barrier();
    }
  }
  float* OUTBp = (MODE == 2) ? (float*)(p.ws + OW_OUTB) + (size_t)(seg & 1) * MP0 * DM
                             : (float*)(p.ws + OW_TMP) + (size_t)(MODE == 3 ? 1 : 0) * MP0 * DM;
#pragma unroll
  for (int ni = 0; ni < 2; ni++)
#pragma unroll
    for (int mi = 0; mi < 2; mi++)
#pragma unroll
      for (int g = 0; g < 4; g++) {
        const int m = m0 + wr * 64 + mi * 32 + l31;
        const int n = n0 + wc * 64 + ni * 32 + 8 * g + 4 * lh;
        const float c0 = acc[ni][mi][4 * g], c1 = acc[ni][mi][4 * g + 1], c2 = acc[ni][mi][4 * g + 2], c3 = acc[ni][mi][4 * g + 3];
        if (MODE == 0) {
          uint2 o = make_uint2(pack2(c0, c1), pack2(c2, c3));
          if (tn < PJW / 128) *(uint2*)(((bf16_t*)(p.ws + OW_PJA)) + (size_t)m * PJW + n) = o;
          else *(uint2*)(GTs + (size_t)m * GTW + (n - PJW)) = o;
        } else if (MODE == 1 || MODE == 3) {
          uint2 ga = *(const uint2*)(GTs + (size_t)m * GTW + (MODE == 1 ? G_MA : G_MB) + n);
          *(float4*)(OUTBp + (size_t)m * DM + n) =
              make_float4(sigmoidf_(bf2f(ga.x & 0xffff)) * c0, sigmoidf_(bf2f(ga.x >> 16)) * c1,
                          sigmoidf_(bf2f(ga.y & 0xffff)) * c2, sigmoidf_(bf2f(ga.y >> 16)) * c3);
        } else {
          *(float4*)(OUTBp + (size_t)m * DM + n) = make_float4(c0, c1, c2, c3);
        }
      }
}

__device__ __forceinline__ void rw_prepass_item(PP pp, int seg, int grp, int slab, char* smem) {
  LAUNDER_PP;
  float* lwa = (float*)smem;
  const int tid = tid_l();
  const int r0 = grp * 8;
  int seq, t0, len;
  row_seq(seg, r0, seq, t0, len);
  const bool prompt = seq < 2;
  const float* prev0 = nullptr;
  if (t0 == 0) {
    if (seg == 0) prev0 = prompt ? nullptr : p.st_shift + (size_t)(seq - 2) * 3200;
    else prev0 = ((float*)(p.ws + OW_CSH)) + ((size_t)(seg & 1) * 2 + seq) * 3200;
  }
  __syncthreads();
  {
    const int j = tid & 127;
    const float mu = p.rw_mu[3072 + j];
#pragma unroll
    for (int i = 0; i < 4; i++) {
      int tok = (tid >> 7) + 2 * i;
      int row = r0 + tok;
      float ps = bf2f(((bf16_t*)(p.ws + OW_PJA))[(size_t)row * PJW + 3072 + j]);
      float pv;
      if (tok == 0 && t0 == 0) pv = prev0 ? prev0[3072 + j] : 0.f;
      else pv = bf2f(((bf16_t*)(p.ws + OW_PJA))[(size_t)(row - 1) * PJW + 3072 + j]);
      float xs = ps + mu * (pv - ps);
      lwa[tok * 128 + j] = j < 64 ? tanhf(xs) : xs;
      if (slab == 0 && t0 + tok == len - 1) {
        if (prompt) {
          ((float*)(p.ws + OW_CSH))[((size_t)((seg + 1) & 1) * 2 + seq) * 3200 + 3072 + j] = ps;
          if (seg == NSEG - 1) (p.out + OO_p_shift)[(size_t)seq * 3200 + 3072 + j] = ps;
        } else {
          (p.out + OO_s_shift)[(size_t)(seq - 2) * 3200 + 3072 + j] = ps;
        }
      }
    }
  }
  __syncthreads();
  const int c = slab * 256 + tid;
  float dw[8], da[8];
  {
    const float w0 = p.rw_w0[c], a0 = p.rw_a0[c];
#pragma unroll
    for (int t = 0; t < 8; t++) { dw[t] = w0; da[t] = a0; }
  }
  for (int j = 0; j < 64; j += 4) {
    float w2v[4], a2v[4];
#pragma unroll
    for (int e = 0; e < 4; e++) {
      w2v[e] = p.rw_w2[(size_t)(j + e) * DM + c];
      a2v[e] = p.rw_a2[(size_t)(j + e) * DM + c];
    }
#pragma unroll
    for (int t = 0; t < 8; t++) {
      float4 lw = *(const float4*)(lwa + t * 128 + j);
      float4 la = *(const float4*)(lwa + t * 128 + 64 + j);
      dw[t] += lw.x * w2v[0] + lw.y * w2v[1] + lw.z * w2v[2] + lw.w * w2v[3];
      da[t] += la.x * a2v[0] + la.y * a2v[1] + la.z * a2v[2] + la.w * a2v[3];
    }
  }
  const float mur = p.rw_mu[c], muk = p.rw_mu[1024 + c], muv = p.rw_mu[2048 + c];
  const float kk_w = p.rw_k_k[c], ka_w = p.rw_k_a[c], rk_w = p.rw_r_k[c];
  float pr, pk, pv;
  if (t0 == 0) {
    pr = prev0 ? prev0[c] : 0.f; pk = prev0 ? prev0[1024 + c] : 0.f; pv = prev0 ? prev0[2048 + c] : 0.f;
  } else {
    const bf16_t* q = ((bf16_t*)(p.ws + OW_PJA)) + (size_t)(r0 - 1) * PJW;
    pr = bf2f(q[c]); pk = bf2f(q[1024 + c]); pv = bf2f(q[2048 + c]);
  }
  const int head = c >> 6, e = c & 63;
  const int srow0 = slot_row0(seg);
  char* rws = ((char*)(p.ws + OW_RWS)) + ((size_t)(srow0 + r0) * 16 + head) * 1024;
  float* rwb = ((float*)(p.ws + OW_RWB)) + (size_t)(srow0 + r0) * 16 + head;
#pragma unroll
  for (int t = 0; t < 8; t++) {
    const int row = r0 + t;
    const bf16_t* q = ((bf16_t*)(p.ws + OW_PJA)) + (size_t)row * PJW;
    float cr = bf2f(q[c]), ck = bf2f(q[1024 + c]), cv = bf2f(q[2048 + c]);
    float xr = cr + mur * (pr - cr), xk = ck + muk * (pk - ck), xv = cv + muv * (pv - cv);
    pr = cr; pk = ck; pv = cv;
    float w_log = -softplusf_(-dw[t]) - 0.5f;
    float decay = __expf(-__expf(w_log));
    float a = sigmoidf_(da[t]);
    float kkr = xk * kk_w;
    float ss = wavesum(kkr * kkr);
    float kk = kkr * rsqrtf(ss + 1e-6f);
    float k2 = xk * (1.0f + (a - 1.0f) * ka_w);
    float bon = wavesum(xr * k2 * rk_w);
    char* o = rws + (size_t)t * RWS_ROWB;
    ((f16*)o)[e] = (f16)xr;
    ((f16*)(o + 128))[e] = (f16)k2;
    ((f16*)(o + 256))[e] = (f16)(-kk);
    ((f16*)(o + 384))[e] = (f16)(kk * a);
    ((float*)(o + 512))[e] = decay;
    ((float*)(o + 768))[e] = xv;
    if ((tid & 63) == 0) rwb[(size_t)t * 16] = bon;
    if (t0 + t == len - 1) {
      if (prompt) {
        float* cs = ((float*)(p.ws + OW_CSH)) + ((size_t)((seg + 1) & 1) * 2 + seq) * 3200;
        cs[c] = cr; cs[1024 + c] = ck; cs[2048 + c] = cv;
        if (seg == NSEG - 1) {
          float* ps = (p.out + OO_p_shift) + (size_t)seq * 3200;
          ps[c] = cr; ps[1024 + c] = ck; ps[2048 + c] = cv;
        }
      } else {
        float* ps = (p.out + OO_s_shift) + (size_t)(seq - 2) * 3200;
        ps[c] = cr; ps[1024 + c] = ck; ps[2048 + c] = cv;
      }
    }
  }
}

__device__ __forceinline__ void gd_prepass_item(PP pp, int seg, int grp, int slab) {
  LAUNDER_PP;
  const int tid = tid_l();
  const int r0 = grp * 16;
  int seq, t0, len;
  row_seq(seg, r0, seq, t0, len);
  const bool prompt = seq < 2;
  const int c = slab * 512 + 2 * tid;
  const int kind = slab >> 1;
  const int head = (c & 1023) >> 7, e = c & 127;
  float2 x0, x1, x2;
  if (t0 == 0) {
    const float* cp = nullptr;
    if (seg == 0) cp = prompt ? nullptr : p.st_conv + (size_t)(seq - 2) * 3 * 3072;
    else cp = ((float*)(p.ws + OW_CCV)) + ((size_t)(seg & 1) * 2 + seq) * 3 * 3072;
    if (cp) {
      x0 = *(const float2*)(cp + c); x1 = *(const float2*)(cp + 3072 + c); x2 = *(const float2*)(cp + 6144 + c);
    } else {
      x0 = x1 = x2 = make_float2(0.f, 0.f);
    }
  } else {
    uint32_t u0 = *(const uint32_t*)(((bf16_t*)(p.ws + OW_PJA)) + (size_t)(r0 - 3) * PJW + C_GDC + c);
    uint32_t u1 = *(const uint32_t*)(((bf16_t*)(p.ws + OW_PJA)) + (size_t)(r0 - 2) * PJW + C_GDC + c);
    uint32_t u2 = *(const uint32_t*)(((bf16_t*)(p.ws + OW_PJA)) + (size_t)(r0 - 1) * PJW + C_GDC + c);
    x0 = make_float2(bf2f(u0 & 0xffff), bf2f(u0 >> 16));
    x1 = make_float2(bf2f(u1 & 0xffff), bf2f(u1 >> 16));
    x2 = make_float2(bf2f(u2 & 0xffff), bf2f(u2 >> 16));
  }
  const float2 w0 = *(const float2*)(p.gd_conv_w + c), w1 = *(const float2*)(p.gd_conv_w + 3072 + c),
               w2 = *(const float2*)(p.gd_conv_w + 6144 + c), w3 = *(const float2*)(p.gd_conv_w + 9216 + c);
  const float a_exp = __expf(p.gd_a_log[head]);
  const float dtb = p.gd_dt_bias[head];
  char* gds = ((char*)(p.ws + OW_GDS)) + ((size_t)(slot_row0(seg) + r0) * 8 + head) * GDS_HB;
#pragma unroll 4
  for (int t = 0; t < 16; t++) {
    const int row = r0 + t;
    uint32_t u = *(const uint32_t*)(((bf16_t*)(p.ws + OW_PJA)) + (size_t)row * PJW + C_GDC + c);
    float2 x3 = make_float2(bf2f(u & 0xffff), bf2f(u >> 16));
    float cx = w0.x * x0.x + w1.x * x1.x + w2.x * x2.x + w3.x * x3.x;
    float cy = w0.y * x0.y + w1.y * x1.y + w2.y * x2.y + w3.y * x3.y;
    x0 = x1; x1 = x2; x2 = x3;
    float ax = siluf_(cx), ay = siluf_(cy);
    float sc = 1.0f;
    if (kind < 2) {
      float ss = wavesum(ax * ax + ay * ay);
      sc = rsqrtf(ss + 1e-6f);
      if (kind == 0) sc *= 0.08838834764831845f;
    }
    if (kind >= 1) {
      float beta = sigmoidf_(bf2f(((bf16_t*)(p.ws + OW_PJA))[(size_t)row * PJW + C_BETA + head]));
      sc *= sqrtf(beta);
    }
    ax *= sc; ay *= sc;
    char* o = gds + (size_t)t * GDS_ROWB;
    f16x2 hv = {(f16)ax, (f16)ay};
    *(f16x2*)(o + kind * 256 + e * 2) = hv;
    if (kind == 0 && (tid & 63) == 0) {
      float g = -a_exp * softplusf_(bf2f(((bf16_t*)(p.ws + OW_PJA))[(size_t)row * PJW + C_ALPHA + head]) + dtb);
      *(float*)(o + 768) = __expf(g);
    }
    int jj = t0 + t - (len - 3);
    if (jj >= 0) {
      if (prompt) {
        *(float2*)(((float*)(p.ws + OW_CCV)) + (((size_t)((seg + 1) & 1) * 2 + seq) * 3 + jj) * 3072 + c) = x3;
        if (seg == NSEG - 1) *(float2*)((p.out + OO_p_conv) + ((size_t)seq * 3 + jj) * 3072 + c) = x3;
      } else {
        *(float2*)((p.out + OO_s_conv) + ((size_t)(seq - 2) * 3 + jj) * 3072 + c) = x3;
      }
    }
  }
}


using u32x2 = __attribute__((ext_vector_type(2))) unsigned int;
__device__ __forceinline__ float fmix_lo(unsigned h, float b, float c) {
  float d;
  asm("v_fma_mix_f32 %0, %1, %2, %3 op_sel_hi:[1,0,0]" : "=v"(d) : "v"(h), "v"(b), "v"(c));
  return d;
}
__device__ __forceinline__ float fmix_hi(unsigned h, float b, float c) {
  float d;
  asm("v_fma_mix_f32 %0, %1, %2, %3 op_sel:[1,0,0] op_sel_hi:[1,0,0]" : "=v"(d) : "v"(h), "v"(b), "v"(c));
  return d;
}
__device__ __forceinline__ float vmul1(float a, float b) {
  float d;
  asm("v_mul_f32 %0, %1, %2" : "=v"(d) : "v"(a), "v"(b));
  return d;
}
struct RwOps { f16x4 r, k, a, b; float4 w; float vv; };
__device__ __forceinline__ RwOps rw_ld(const char* Ls, int q, int v) {
  RwOps o;
  o.r = *(const f16x4*)(Ls + q * 8);
  o.k = *(const f16x4*)(Ls + 128 + q * 8);
  o.a = *(const f16x4*)(Ls + 256 + q * 8);
  o.b = *(const f16x4*)(Ls + 384 + q * 8);
  o.w = *(const float4*)(Ls + 512 + q * 16);
  o.vv = *(const float*)(Ls + 768 + v * 4);
  return o;
}
__device__ __forceinline__ float rw_step(const RwOps& o, float4& S) {
  const u32x2 rw = __builtin_bit_cast(u32x2, o.r), kw = __builtin_bit_cast(u32x2, o.k),
              aw = __builtin_bit_cast(u32x2, o.a), bw = __builtin_bit_cast(u32x2, o.b);
  const float z = 0.f;
  float sa0 = fmix_lo(aw[0], S.x, z);
  float sa1 = fmix_lo(aw[1], S.z, z);
  sa0 = fmix_hi(aw[0], S.y, sa0);
  sa1 = fmix_hi(aw[1], S.w, sa1);
  float t0 = vmul1(S.x, o.w.x), t1 = vmul1(S.y, o.w.y), t2 = vmul1(S.z, o.w.z), t3 = vmul1(S.w, o.w.w);
  t0 = fmix_lo(kw[0], o.vv, t0);
  t1 = fmix_hi(kw[0], o.vv, t1);
  t2 = fmix_lo(kw[1], o.vv, t2);
  t3 = fmix_hi(kw[1], o.vv, t3);
  const float sa = rowsum16(sa0 + sa1);
  S.x = fmix_lo(bw[0], sa, t0);
  S.y = fmix_hi(bw[0], sa, t1);
  S.z = fmix_lo(bw[1], sa, t2);
  S.w = fmix_hi(bw[1], sa, t3);
  float y0 = fmix_lo(rw[0], S.x, z);
  float y1 = fmix_lo(rw[1], S.z, z);
  y0 = fmix_hi(rw[0], S.y, y0);
  y1 = fmix_hi(rw[1], S.w, y1);
  return rowsum16(y0 + y1);
}
__device__ __forceinline__ void rw_scan_run(const char* __restrict__ gsrc  , int len, float4& S,
                            float* __restrict__ yo  , int q, int v, char* smem) {
  const int tid = tid_l();
  const int nch = len >> 4;
  const int lstep = tid >> 6, loff = (tid & 63) * 16;
  u32x4 st[4];
#pragma unroll
  for (int i = 0; i < 4; i++) st[i] = *(const u32x4*)(gsrc + (size_t)(lstep + 4 * i) * RWS_ROWB + loff);
  __syncthreads();
#pragma unroll
  for (int i = 0; i < 4; i++) *(u32x4*)(smem + (lstep + 4 * i) * 1024 + loff) = st[i];
  u32x4 st2[4];
#pragma unroll
  for (int i = 0; i < 4; i++) st2[i] = st[i];
  if (nch > 1) {
#pragma unroll
    for (int i = 0; i < 4; i++) st[i] = *(const u32x4*)(gsrc + (size_t)(16 + lstep + 4 * i) * RWS_ROWB + loff);
  }
  if (nch > 2) {
#pragma unroll
    for (int i = 0; i < 4; i++) st2[i] = *(const u32x4*)(gsrc + (size_t)(32 + lstep + 4 * i) * RWS_ROWB + loff);
  }
  __syncthreads();
  for (int c = 0; c < nch; c++) {
    const char* L = smem + (c & 1) * 16384;
    float ykeep = 0.f;
    RwOps oa = rw_ld(L, q, v);
#pragma unroll 1
    for (int t = 0; t < 16; t += 2) {
      const RwOps ob = rw_ld(L + (t + 1) * 1024, q, v);
      asm volatile("" ::: "memory");
      const float ya = rw_step(oa, S);
      ykeep = (q == t) ? ya : ykeep;
      oa = rw_ld(L + ((t + 2) & 15) * 1024, q, v);
      asm volatile("" ::: "memory");
      const float yb = rw_step(ob, S);
      ykeep = (q == t + 1) ? yb : ykeep;
    }
    yo[(size_t)(c * 16 + q) * DM] = ykeep;
    if (c + 1 < nch) {
      char* Ln = smem + ((c + 1) & 1) * 16384;
#pragma unroll
      for (int i = 0; i < 4; i++) *(u32x4*)(Ln + (lstep + 4 * i) * 1024 + loff) = st[i];
#pragma unroll
      for (int i = 0; i < 4; i++) st[i] = st2[i];
      if (c + 3 < nch) {
#pragma unroll
        for (int i = 0; i < 4; i++)
          st2[i] = *(const u32x4*)(gsrc + (size_t)((c + 3) * 16 + lstep + 4 * i) * RWS_ROWB + loff);
      }
    }
    lds_barrier();
  }
}

struct GdOps { f16x8 qv, kv; float vv, eg; };
__device__ __forceinline__ GdOps gd_ld(const char* Ls, int q, int cl) {
  GdOps o;
  o.kv = *(const f16x8*)(Ls + 256 + q * 16);
  o.vv = (float)*(const f16*)(Ls + 512 + cl * 2);
  o.eg = *(const float*)(Ls + 768);
  o.qv = *(const f16x8*)(Ls + q * 16);
  return o;
}
__device__ __forceinline__ float gd_step(const GdOps& o, float (&s)[8]) {
  const u32x4 kw = __builtin_bit_cast(u32x4, o.kv), qw = __builtin_bit_cast(u32x4, o.qv);
  const float z = 0.f;
  float a0 = fmix_lo(kw[0], s[0], z);
  float a1 = fmix_lo(kw[2], s[4], z);
  a0 = fmix_hi(kw[0], s[1], a0);
  a1 = fmix_hi(kw[2], s[5], a1);
  a0 = fmix_lo(kw[1], s[2], a0);
  a1 = fmix_lo(kw[3], s[6], a1);
  a0 = fmix_hi(kw[1], s[3], a0);
  a1 = fmix_hi(kw[3], s[7], a1);
  float es[8];
#pragma unroll
  for (int i = 0; i < 8; i++) es[i] = vmul1(o.eg, s[i]);
  const float ks = rowsum16(a0 + a1);
  const float d = fmaf(-o.eg, ks, o.vv);
  s[0] = fmix_lo(kw[0], d, es[0]); s[1] = fmix_hi(kw[0], d, es[1]);
  s[2] = fmix_lo(kw[1], d, es[2]); s[3] = fmix_hi(kw[1], d, es[3]);
  s[4] = fmix_lo(kw[2], d, es[4]); s[5] = fmix_hi(kw[2], d, es[5]);
  s[6] = fmix_lo(kw[3], d, es[6]); s[7] = fmix_hi(kw[3], d, es[7]);
  float o0 = fmix_lo(qw[0], s[0], z);
  float o1 = fmix_lo(qw[2], s[4], z);
  o0 = fmix_hi(qw[0], s[1], o0);
  o1 = fmix_hi(qw[2], s[5], o1);
  o0 = fmix_lo(qw[1], s[2], o0);
  o1 = fmix_lo(qw[3], s[6], o1);
  o0 = fmix_hi(qw[1], s[3], o0);
  o1 = fmix_hi(qw[3], s[7], o1);
  return rowsum16(o0 + o1);
}
__device__ __forceinline__ void gd_scan_run(const char* __restrict__ gsrc  , int len, float (&s)[8],
                            float* __restrict__ oo  , int q, int cl, char* smem) {
  const int tid = tid_l();
  const int nch = len >> 4;
  u32x4 st[4];
  int lt[4], lo[4];
#pragma unroll
  for (int i = 0; i < 4; i++) {
    int id = tid + 256 * i;
    if (id > 783) id = 783;
    lt[i] = id / 49;
    lo[i] = (id % 49) * 16;
  }
#pragma unroll
  for (int i = 0; i < 4; i++) st[i] = *(const u32x4*)(gsrc + (size_t)lt[i] * GDS_ROWB + lo[i]);
  __syncthreads();
#pragma unroll
  for (int i = 0; i < 4; i++) *(u32x4*)(smem + lt[i] * GDS_HB + lo[i]) = st[i];
  u32x4 st2[4];
#pragma unroll
  for (int i = 0; i < 4; i++) st2[i] = st[i];
  if (nch > 1) {
#pragma unroll
    for (int i = 0; i < 4; i++) st[i] = *(const u32x4*)(gsrc + (size_t)(16 + lt[i]) * GDS_ROWB + lo[i]);
  }
  if (nch > 2) {
#pragma unroll
    for (int i = 0; i < 4; i++) st2[i] = *(const u32x4*)(gsrc + (size_t)(32 + lt[i]) * GDS_ROWB + lo[i]);
  }
  __syncthreads();
  for (int c = 0; c < nch; c++) {
    const char* L = smem + (c & 1) * 16384;
    float okeep = 0.f;
    GdOps oa = gd_ld(L, q, cl);
#pragma unroll 1
    for (int t = 0; t < 16; t += 2) {
      const GdOps ob = gd_ld(L + (t + 1) * GDS_HB, q, cl);
      asm volatile("" ::: "memory");
      const float ya = gd_step(oa, s);
      okeep = (q == t) ? ya : okeep;
      oa = gd_ld(L + ((t + 2) & 15) * GDS_HB, q, cl);
      asm volatile("" ::: "memory");
      const float yb = gd_step(ob, s);
      okeep = (q == t + 1) ? yb : okeep;
    }
    oo[(size_t)(c * 16 + q) * DM] = okeep;
    if (c + 1 < nch) {
      char* Ln = smem + ((c + 1) & 1) * 16384;
#pragma unroll
      for (int i = 0; i < 4; i++) *(u32x4*)(Ln + lt[i] * GDS_HB + lo[i]) = st[i];
#pragma unroll
      for (int i = 0; i < 4; i++) st[i] = st2[i];
      if (c + 3 < nch) {
#pragma unroll
        for (int i = 0; i < 4; i++) st2[i] = *(const u32x4*)(gsrc + (size_t)((c + 3) * 16 + lt[i]) * GDS_ROWB + lo[i]);
      }
    }
    lds_barrier();
  }
}

__device__ __forceinline__ void sample_scan_task(PP pp, int task, char* smem) {
  LAUNDER_PP;
  const int sj = task >> 7, j = task & 127, kind = j >> 6, jj = j & 63;
  const int tid = tid_l(), q = tid & 15;
  const int row0 = 1056 + sj * 16;
  if (kind == 0) {
    const int head = jj >> 2, v = (jj & 3) * 16 + (tid >> 4);
    const float* sin = p.st_wkv + ((size_t)sj * 16 + head) * 4096;
    float* sout = (p.out + OO_s_wkv) + ((size_t)sj * 16 + head) * 4096;
    float4 S = *(const float4*)(sin + v * 64 + 4 * q);
    rw_scan_run(((char*)(p.ws + OW_RWS)) + ((size_t)row0 * 16 + head) * 1024, 16, S, ((float*)(p.ws + OW_YRW)) + (size_t)row0 * DM + head * 64 + v, q, v, smem);
    *(float4*)(sout + v * 64 + 4 * q) = S;
  } else {
    const int head = jj >> 3, cl = (jj & 7) * 16 + (tid >> 4);
    const float* sin = p.st_ssm + ((size_t)sj * 8 + head) * 16384;
    float* sout = (p.out + OO_s_ssm) + ((size_t)sj * 8 + head) * 16384;
    float s[8];
#pragma unroll
    for (int i = 0; i < 8; i++) s[i] = sin[(size_t)(8 * q + i) * 128 + cl];
    gd_scan_run(((char*)(p.ws + OW_GDS)) + ((size_t)row0 * 8 + head) * GDS_HB, 16, s, ((float*)(p.ws + OW_OGD)) + (size_t)row0 * DM + head * 128 + cl, q, cl, smem);
#pragma unroll
    for (int i = 0; i < 8; i++) sout[(size_t)(8 * q + i) * 128 + cl] = s[i];
  }
}

__device__ __forceinline__ void scan_block_rw(PP pp, int j, char* smem) {
  LAUNDER_PP;
  const int seq = j >> 6, jj = j & 63;
  const int tid = tid_l(), q = tid & 15;
  const int head = jj >> 2, v = (jj & 3) * 16 + (tid >> 4);
  float4 S = make_float4(0.f, 0.f, 0.f, 0.f);
  for (int seg = 0; seg < NSEG; seg++) {
    wait_ge(((unsigned int*)(p.ws + OW_sync)) + SW_PRE, seg + 1);
    const int len = seg == 0 ? 528 : TS;
    const int row0 = slot_row0(seg) + (seg == 0 ? seq * 528 : seq * TS);
    rw_scan_run(((char*)(p.ws + OW_RWS)) + ((size_t)row0 * 16 + head) * 1024, len, S,
                ((float*)(p.ws + OW_YRW)) + (size_t)row0 * DM + head * 64 + v, q, v, smem);
    signal_scan_done((unsigned int*)(p.ws + OW_sync), seg);
  }
  {
    const int tid2 = tid_l(), q2 = tid2 & 15, v2 = (jj & 3) * 16 + (tid2 >> 4);
    *(float4*)((p.out + OO_p_wkv) + ((size_t)seq * 16 + head) * 4096 + v2 * 64 + 4 * q2) = S;
  }
}
__device__ __forceinline__ void scan_block_gd(PP pp, int j, char* smem) {
  LAUNDER_PP;
  const int seq = j >> 6, jj = j & 63;
  const int tid = tid_l(), q = tid & 15;
  const int head = jj >> 3, cl = (jj & 7) * 16 + (tid >> 4);
  float s[8];
#pragma unroll
  for (int i = 0; i < 8; i++) s[i] = 0.f;
  for (int seg = 0; seg < NSEG; seg++) {
    wait_ge(((unsigned int*)(p.ws + OW_sync)) + SW_PRE, seg + 1);
    const int len = seg == 0 ? 528 : TS;
    const int row0 = slot_row0(seg) + (seg == 0 ? seq * 528 : seq * TS);
    gd_scan_run(((char*)(p.ws + OW_GDS)) + ((size_t)row0 * 8 + head) * GDS_HB, len, s,
                ((float*)(p.ws + OW_OGD)) + (size_t)row0 * DM + head * 128 + cl, q, cl, smem);
    signal_scan_done((unsigned int*)(p.ws + OW_sync), seg);
  }
  {
    const int tid2 = tid_l(), q2 = tid2 & 15, cl2 = (jj & 7) * 16 + (tid2 >> 4);
    float* sout = (p.out + OO_p_ssm) + ((size_t)seq * 8 + head) * 16384;
#pragma unroll
    for (int i = 0; i < 8; i++) sout[(size_t)(8 * q2 + i) * 128 + cl2] = s[i];
  }
}

__device__ __forceinline__ void post_item(PP pp, int seg, int row) {
  LAUNDER_PP;
  const int tid = tid_l(), c4 = tid * 4;
  const int srow = slot_row0(seg) + row;
  const bf16_t* gt = ((bf16_t*)(p.ws + OW_GT)) + (size_t)(gt_row0(seg) + row) * GTW;
  {
    float4 y = *(const float4*)(((float*)(p.ws + OW_YRW)) + (size_t)srow * DM + c4);
    float mean = rowsum16(y.x + y.y + y.z + y.w) * (1.0f / 64.0f);
    float dx = y.x - mean, dy = y.y - mean, dz = y.z - mean, dw = y.w - mean;
    float var = rowsum16(dx * dx + dy * dy + dz * dz + dw * dw) * (1.0f / 64.0f);
    float rs = rsqrtf(var + 64e-5f);
    float4 lw = *(const float4*)(p.rw_ln_w + c4), lb = *(const float4*)(p.rw_ln_b + c4);
    float bon = ((float*)(p.ws + OW_RWB))[(size_t)srow * 16 + (tid >> 4)];
    float4 v = *(const float4*)(((char*)(p.ws + OW_RWS)) + ((size_t)srow * 16 + (tid >> 4)) * 1024 + 768 + (tid & 15) * 16);
    uint2 g = *(const uint2*)(gt + G_RW + c4);
    float o0 = (dx * rs * lw.x + lb.x + bon * v.x) * siluf_(bf2f(g.x & 0xffff));
    float o1 = (dy * rs * lw.y + lb.y + bon * v.y) * siluf_(bf2f(g.x >> 16));
    float o2 = (dz * rs * lw.z + lb.z + bon * v.z) * siluf_(bf2f(g.y & 0xffff));
    float o3 = (dw * rs * lw.w + lb.w + bon * v.w) * siluf_(bf2f(g.y >> 16));
    *(uint2*)(((bf16_t*)(p.ws + OW_YA)) + (size_t)(seg & 1) * MP0 * DM + blk_off(row, c4)) = make_uint2(pack2(o0, o1), pack2(o2, o3));
  }
  {
    float4 o = *(const float4*)(((float*)(p.ws + OW_OGD)) + (size_t)srow * DM + c4);
    float ss = rowsum16(o.x * o.x + o.y * o.y + o.z * o.z + o.w * o.w);
    ss += __shfl_xor(ss, 16);
    float rs = rsqrtf(ss * (1.0f / 128.0f) + 1e-6f);
    float4 nw = *(const float4*)(p.gd_norm_w + (c4 & 127));
    uint2 g = *(const uint2*)(gt + G_GD + c4);
    float o0 = o.x * rs * nw.x * siluf_(bf2f(g.x & 0xffff));
    float o1 = o.y * rs * nw.y * siluf_(bf2f(g.x >> 16));
    float o2 = o.z * rs * nw.z * siluf_(bf2f(g.y & 0xffff));
    float o3 = o.w * rs * nw.w * siluf_(bf2f(g.y >> 16));
    *(uint2*)(((bf16_t*)(p.ws + OW_YB)) + (size_t)(seg & 1) * MP0 * DM + blk_off(row, c4)) = make_uint2(pack2(o0, o1), pack2(o2, o3));
  }
}

#define SMEM_BYTES (32768 + 16)

__global__ void __launch_bounds__(256, 4) k_mega(Params p_arg) {
  PP pp = (PP)__builtin_amdgcn_kernarg_segment_ptr();
  __shared__ __attribute__((aligned(16))) char smem[SMEM_BYTES];
  cg::grid_group grid = cg::this_grid();
  const int bid = blockIdx.x, nb = gridDim.x;
  unsigned* sync = (unsigned*)(p.ws + OW_sync);
  const unsigned xcc = xcc_id() & 7u;
  if (threadIdx.x == 0) xb_add(&sync[bid >= NSCAN ? SW_XCNT(xcc) : SW_SCNT(xcc)], 1u);
  phase_weights(pp, bid, nb, smem);
  for (int it = bid; it < seg_MP(0) / 4; it += nb) xn_item(pp, 0, it);
  grid.sync();
  if (bid < NSCAN) {
    __builtin_amdgcn_s_setprio(3);
    if (bid < 128) scan_block_rw(pp, bid, smem);
    else scan_block_gd(pp, bid - 128, smem);
    return;
  }
  const int w = bid - NSCAN, NW = nb - NSCAN;
  unsigned* cfg = (unsigned*)(smem + 32768);
  if (threadIdx.x == 0) {
    unsigned mine = 0, nx = 0;
#pragma unroll
    for (unsigned j = 0; j < 8; j++) { unsigned c = xb_ld(&sync[SW_XCNT(j)]); nx += c > 0u ? 1u : 0u; mine = (j == xcc) ? c : mine; }
    cfg[0] = mine > 0u ? mine : 1u;
    cfg[1] = nx > 0u ? nx : 1u;
  }
  __syncthreads();
  for (int i = 0; i < NSEG + 5; i++) {
    const int sm = i - 4, snn = i - 5, sj = i - 3, so = i - 4, sp = i - 2;
    const bool front = i < NSEG;
    const bool mrg = sm >= 0 && sm < NSEG, nrm = snn >= 0 && snn < NSEG, back = sj >= 0 && sj < NSEG, outv = so >= 0 && so < NSEG,
               pst = sp >= 0 && sp < NSEG;
    {
      const int tmF = front ? seg_MP(i) / 128 : 1;
      const int nF = front ? tmF * (VW / 128) : 0;
      const int nM = mrg ? seg_MP(sm) / 4 : 0;
      const int nN = nrm ? seg_M(snn) / 4 : 0;
      if ((NW & 7) == 0) {
        const int x = w & 7, per = NW >> 3;
        const int ncol = front ? ((VW / 128 - x + 7) >> 3) : 0;
        for (int j = w >> 3; j < tmF * ncol; j += per) gemm_tile<0>(pp, i, j % tmF, x + 8 * (j / tmF), smem);
        for (int it = w; it < nM + nN; it += NW) {
          if (it < nM) merge_item(pp, it);
          else norm_item(pp, snn, it - nM);
        }
      } else {
        for (int it = w; it < nF + nM + nN; it += NW) {
          int t = it;
          if (t < nF) { gemm_tile<0>(pp, i, t % tmF, t / tmF, smem); continue; }
          t -= nF;
          if (t < nM) { merge_item(pp, t); continue; }
          t -= nM;
          norm_item(pp, snn, t);
        }
      }
      if (i == 1) {
        for (int it = w; it < 32 * 128; it += NW) sample_scan_task(pp, it, smem);
      }
    }
    worker_barrier((unsigned*)(p.ws + OW_sync), (const unsigned*)(smem + 32768));
    {
      const int nB = back ? (seg_MP(sj) / 128) * 8 : 0;
      const int nO = outv ? (seg_MP(so) / 128) * 8 : 0;
      const int nHeavy = 2 * nB + nO;
      const int nHeavyW = nHeavy < NW / 2 ? nHeavy : NW / 2;
      const int NL = NW - nHeavyW;
      const int ngrp = front ? seg_M(i) / 16 : 0;
      const int nRW = ngrp * 8, nGD = ngrp * 6;
      const int nX = (i + 1 < NSEG) ? seg_MP(i + 1) / 4 : 0;
      const int tot = nRW + nGD + nX;
      if (w >= NL) {
        for (int it = w - NL; it < nHeavy; it += nHeavyW) {
          int t = it;
          if (t < nB) { gemm_tile<1>(pp, sj, t >> 3, t & 7, smem); continue; }
          t -= nB;
          if (t < nB) { gemm_tile<3>(pp, sj, t >> 3, t & 7, smem); continue; }
          t -= nB;
          gemm_tile<2>(pp, so, t >> 3, t & 7, smem);
        }
      } else {
        for (int it = w; it < tot; it += NL) {
          int t = it;
          if (t < nRW) { rw_prepass_item(pp, i, t >> 2, t & 3, smem); continue; }
          t -= nRW;
          if (t < nGD) { gd_prepass_item(pp, i, t / 6, t % 6); continue; }
          t -= nGD;
          xn_item(pp, i + 1, t);
        }
      }
      if (pst) {
        wait_ge((unsigned*)(p.ws + OW_sync) + SW_SCAN(sp), NSCAN);
        const int n = seg_M(sp);
        for (int it = w; it < n; it += NW) post_item(pp, sp, it);
      }
    }
    worker_barrier((unsigned*)(p.ws + OW_sync), (const unsigned*)(smem + 32768));
    if (front && w == 0 && threadIdx.x == 0)
      __hip_atomic_store((unsigned*)(p.ws + OW_sync) + SW_PRE, (unsigned)(i + 1), __ATOMIC_RELAXED, __HIP_MEMORY_SCOPE_AGENT);
  }
}

static inline size_t align_up(size_t x) { return (x + 255) & ~(size_t)255; }

#undef p
extern "C" void kernel_launch(void* const* d_in, const int* in_sizes, int n_in, void* d_out, int out_size, void* d_ws,
                              size_t ws_size, hipStream_t stream) {
  Params p{};
  const float* const* in = (const float* const*)d_in;
  p.x_prompt = in[0]; p.x_sample = in[1]; p.st_shift = in[2]; p.st_wkv = in[3]; p.st_conv = in[4]; p.st_ssm = in[5];
  p.meta = in[6]; p.norm_pre = in[7]; p.w_in = in[8]; p.rw_mu = in[9]; p.rw_w0 = in[10]; p.rw_w2 = in[11];
  p.rw_a0 = in[12]; p.rw_a2 = in[13]; p.rw_k_k = in[14]; p.rw_k_a = in[15]; p.rw_r_k = in[16]; p.rw_ln_w = in[17];
  p.rw_ln_b = in[18]; p.gd_conv_w = in[19]; p.gd_a_log = in[20]; p.gd_dt_bias = in[21]; p.gd_norm_w = in[22];
  p.w_out_a = in[23]; p.w_out_b = in[24]; p.w_out = in[25]; p.norm_post = in[26];
  p.out = (float*)d_out;
  p.ws = (char*)d_ws;
  if (OW_END > ws_size) { fprintf(stderr, "workspace too small: need %zu have %zu\n", (size_t)OW_END, ws_size); return; }

  static int grid_blocks = 0;
  if (!grid_blocks) {
    int dev = 0, cus = 0, per_cu = 0;
    (void)hipGetDevice(&dev);
    (void)hipDeviceGetAttribute(&cus, hipDeviceAttributeMultiprocessorCount, dev);
    (void)hipOccupancyMaxActiveBlocksPerMultiprocessor(&per_cu, k_mega, 256, 0);
    if (per_cu > 4) per_cu = 4;
    grid_blocks = cus * per_cu;
  }
  (void)hipMemsetAsync(p.ws + OW_sync, 0, 16384, stream);
  void* args[] = {&p};
  hipError_t e = hipLaunchCooperativeKernel((void*)k_mega, dim3(grid_blocks), dim3(256), args, 0, stream);
  if (e != hipSuccess) fprintf(stderr, "cooperative launch failed: %s (grid %d)\n", hipGetErrorString(e), grid_blocks);
}
```

```cpp
#include <hip/hip_runtime.h>
#include <hip/hip_cooperative_groups.h>
#include <stdint.h>
#include <stdio.h>
namespace cg = cooperative_groups;

typedef unsigned short bf16_t;
typedef _Float16 f16;
using bf16x8 = __attribute__((ext_vector_type(8))) short;
using f32x4 = __attribute__((ext_vector_type(4))) float;
using u32x4 = __attribute__((ext_vector_type(4))) unsigned int;
using f32x16 = __attribute__((ext_vector_type(16))) float;
using f16x2 = __attribute__((ext_vector_type(2))) _Float16;
using f16x4 = __attribute__((ext_vector_type(4))) _Float16;
using f16x8 = __attribute__((ext_vector_type(8))) _Float16;

#define DM 1024
#define PW 10384
#define VW 10496
#define PJW 6400
#define GTW 4096
#define NSEG 16
#define TS 512
#define M0 1568
#define MP0 1664
#define M1 1024
#define SLOT_ROWS 3712
#define GT_ROWS 4736
#define NSCAN 256
#define C_GDC 3200
#define C_BETA 6272
#define C_ALPHA 6280
#define G_RW 0
#define G_GD 1024
#define G_MA 2048
#define G_MB 3072
#define RWS_ROWB 16384
#define GDS_HB 784
#define GDS_ROWB 6272

struct Params {
  const float *x_prompt, *x_sample, *st_shift, *st_wkv, *st_conv, *st_ssm, *meta, *norm_pre, *w_in, *rw_mu, *rw_w0,
      *rw_w2, *rw_a0, *rw_a2, *rw_k_k, *rw_k_a, *rw_r_k, *rw_ln_w, *rw_ln_b, *gd_conv_w, *gd_a_log, *gd_dt_bias,
      *gd_norm_w, *w_out_a, *w_out_b, *w_out, *norm_post;
  float* out;
  char* ws;
};
#define p (PV(pp))
#define GLOBAL_AS __attribute__((address_space(1)))
#define CONST_AS __attribute__((address_space(4)))
struct ParamsG {
  const GLOBAL_AS float *x_prompt, *x_sample, *st_shift, *st_wkv, *st_conv, *st_ssm, *meta, *norm_pre, *w_in, *rw_mu, *rw_w0,
      *rw_w2, *rw_a0, *rw_a2, *rw_k_k, *rw_k_a, *rw_r_k, *rw_ln_w, *rw_ln_b, *gd_conv_w, *gd_a_log, *gd_dt_bias,
      *gd_norm_w, *w_out_a, *w_out_b, *w_out, *norm_post;
  GLOBAL_AS float* out;
  GLOBAL_AS char* ws;
};
typedef const CONST_AS ParamsG* PP;
__device__ __forceinline__ Params PV(PP pp) {
  Params v;
  v.x_prompt = (const float*)pp->x_prompt;
  v.x_sample = (const float*)pp->x_sample;
  v.st_shift = (const float*)pp->st_shift;
  v.st_wkv = (const float*)pp->st_wkv;
  v.st_conv = (const float*)pp->st_conv;
  v.st_ssm = (const float*)pp->st_ssm;
  v.meta = (const float*)pp->meta;
  v.norm_pre = (const float*)pp->norm_pre;
  v.w_in = (const float*)pp->w_in;
  v.rw_mu = (const float*)pp->rw_mu;
  v.rw_w0 = (const float*)pp->rw_w0;
  v.rw_w2 = (const float*)pp->rw_w2;
  v.rw_a0 = (const float*)pp->rw_a0;
  v.rw_a2 = (const float*)pp->rw_a2;
  v.rw_k_k = (const float*)pp->rw_k_k;
  v.rw_k_a = (const float*)pp->rw_k_a;
  v.rw_r_k = (const float*)pp->rw_r_k;
  v.rw_ln_w = (const float*)pp->rw_ln_w;
  v.rw_ln_b = (const float*)pp->rw_ln_b;
  v.gd_conv_w = (const float*)pp->gd_conv_w;
  v.gd_a_log = (const float*)pp->gd_a_log;
  v.gd_dt_bias = (const float*)pp->gd_dt_bias;
  v.gd_norm_w = (const float*)pp->gd_norm_w;
  v.w_out_a = (const float*)pp->w_out_a;
  v.w_out_b = (const float*)pp->w_out_b;
  v.w_out = (const float*)pp->w_out;
  v.norm_post = (const float*)pp->norm_post;
  v.out = (float*)pp->out;
  v.ws = (char*)pp->ws;
  return v;
}
constexpr size_t al256(size_t x) { return (x + 255) & ~(size_t)255; }
constexpr size_t OO_y_prompt = 0;
constexpr size_t OO_y_sample = OO_y_prompt + (size_t)2 * 8192 * 1024;
constexpr size_t OO_p_shift = OO_y_sample + (size_t)32 * 16 * 1024;
constexpr size_t OO_p_wkv = OO_p_shift + 2 * 3200;
constexpr size_t OO_p_conv = OO_p_wkv + 2 * 16 * 4096;
constexpr size_t OO_p_ssm = OO_p_conv + 2 * 3 * 3072;
constexpr size_t OO_s_shift = OO_p_ssm + 2 * 8 * 16384;
constexpr size_t OO_s_wkv = OO_s_shift + 32 * 3200;
constexpr size_t OO_s_conv = OO_s_wkv + 32 * 16 * 4096;
constexpr size_t OO_s_ssm = OO_s_conv + 32 * 3 * 3072;
constexpr size_t OW_sync = 0;
constexpr size_t OW_WtIn = OW_sync + 16384;
constexpr size_t OW_WtA = OW_WtIn + al256((size_t)VW * DM * 2);
constexpr size_t OW_WtB = OW_WtA + al256((size_t)DM * DM * 2);
constexpr size_t OW_WtO = OW_WtB + al256((size_t)DM * DM * 2);
constexpr size_t OW_XN = OW_WtO + al256((size_t)DM * DM * 2);
constexpr size_t OW_PJA = OW_XN + al256((size_t)MP0 * DM * 2);
constexpr size_t OW_YA = OW_PJA + al256((size_t)MP0 * PJW * 2);
constexpr size_t OW_YB = OW_YA + al256((size_t)2 * MP0 * DM * 2);
constexpr size_t OW_MG = OW_YB + al256((size_t)2 * MP0 * DM * 2);
constexpr size_t OW_OUTB = OW_MG + al256((size_t)MP0 * DM * 2);
constexpr size_t OW_TMP = OW_OUTB + al256((size_t)2 * MP0 * DM * 4);
constexpr size_t OW_GT = OW_TMP + al256((size_t)2 * MP0 * DM * 4);
constexpr size_t OW_RWS = OW_GT + al256((size_t)GT_ROWS * GTW * 2);
constexpr size_t OW_GDS = OW_RWS + al256((size_t)SLOT_ROWS * RWS_ROWB);
constexpr size_t OW_RWB = OW_GDS + al256((size_t)SLOT_ROWS * GDS_ROWB + 256);
constexpr size_t OW_YRW = OW_RWB + al256((size_t)SLOT_ROWS * 16 * 4);
constexpr size_t OW_OGD = OW_YRW + al256((size_t)SLOT_ROWS * DM * 4);
constexpr size_t OW_CSH = OW_OGD + al256((size_t)SLOT_ROWS * DM * 4);
constexpr size_t OW_CCV = OW_CSH + al256((size_t)2 * 2 * 3200 * 4);
constexpr size_t OW_END = OW_CCV + al256((size_t)2 * 2 * 3 * 3072 * 4);


__device__ __forceinline__ bf16_t f2bf(float f) {
  uint32_t u = __float_as_uint(f);
  u += 0x7fffu + ((u >> 16) & 1u);
  return (bf16_t)(u >> 16);
}
__device__ __forceinline__ float bf2f(bf16_t h) { return __uint_as_float(((uint32_t)h) << 16); }
__device__ __forceinline__ uint32_t pack2(float a, float b) { return (uint32_t)f2bf(a) | ((uint32_t)f2bf(b) << 16); }
__device__ __forceinline__ float sigmoidf_(float x) { return 1.0f / (1.0f + __expf(-x)); }
__device__ __forceinline__ float siluf_(float x) { return x / (1.0f + __expf(-x)); }
__device__ __forceinline__ float softplusf_(float x) { return fmaxf(x, 0.0f) + log1pf(__expf(-fabsf(x))); }

__device__ __forceinline__ int tid_l() { int t = threadIdx.x; asm volatile("" : "+v"(t)); return t; }
#define LAUNDER_PP asm volatile("" : "+s"(pp))
template <int CTRL>
__device__ __forceinline__ float dppf(float x) {
  return __builtin_bit_cast(float, __builtin_amdgcn_update_dpp(0, __builtin_bit_cast(int, x), CTRL, 0xf, 0xf, true));
}
__device__ __forceinline__ float rowsum16(float x) {
  x += dppf<0xB1>(x);
  x += dppf<0x4E>(x);
  x += dppf<0x141>(x);
  x += dppf<0x140>(x);
  return x;
}
__device__ __forceinline__ float wavesum(float x) {
  x = rowsum16(x);
  x += __shfl_xor(x, 16);
  x += __shfl_xor(x, 32);
  return x;
}

#define SW_XCNT(j) (64 * (1 + (j)))
#define SW_XSUB(j) (64 * (9 + (j)))
#define SW_XGEN(j) (64 * (17 + (j)))
#define SW_TOP (64 * 25)
#define SW_TOPGEN (64 * 26)
#define SW_PRE (64 * 27)
#define SW_SCAN(s) (64 * (28 + (s)))
#define SW_SCNT(j) (64 * (44 + (j)))
#define SW_SSUB(seg, x) (3328 + ((seg) * 8 + (x)) * 4)
#define SYNC_BYTES 16384
__device__ __forceinline__ unsigned xb_ld(const unsigned* ptr) {
  return __hip_atomic_load(ptr, __ATOMIC_RELAXED, __HIP_MEMORY_SCOPE_AGENT);
}
__device__ __forceinline__ unsigned xb_add(unsigned* ptr, unsigned v) {
  return __hip_atomic_fetch_add(ptr, v, __ATOMIC_RELAXED, __HIP_MEMORY_SCOPE_AGENT);
}
__device__ __forceinline__ unsigned xcc_id() { return (unsigned)__builtin_amdgcn_s_getreg((3 << 11) | 20) & 0xFu; }
__device__ __forceinline__ void wait_ge(const unsigned* ptr, unsigned target) {
  if (threadIdx.x == 0) {
    while (xb_ld(ptr) < target) __builtin_amdgcn_s_sleep(8);
    __builtin_amdgcn_fence(__ATOMIC_ACQUIRE, "agent");
    asm volatile("s_waitcnt vmcnt(0)" ::: "memory");
  }
  __syncthreads();
}
__device__ __forceinline__ void signal_scan_done(unsigned* sync, int seg) {
  asm volatile("s_waitcnt vmcnt(0)" ::: "memory");
  __syncthreads();
  if (threadIdx.x == 0) {
    const unsigned x = xcc_id() & 7u;
    const unsigned nloc = xb_ld(&sync[SW_SCNT(x)]);
    const unsigned old = xb_add(&sync[SW_SSUB(seg, x)], 1u);
    if (old + 1u == nloc) {
      __builtin_amdgcn_fence(__ATOMIC_RELEASE, "agent");
      asm volatile("s_waitcnt vmcnt(0)" ::: "memory");
      xb_add(&sync[SW_SCAN(seg)], nloc);
    }
  }
}
__device__ __forceinline__ void worker_barrier(unsigned* bar, const unsigned* lds_cfg) {
  asm volatile("s_waitcnt vmcnt(0)" ::: "memory");
  __syncthreads();
  if (threadIdx.x == 0) {
    const unsigned x = xcc_id() & 7u, nloc = lds_cfg[0], nx = lds_cfg[1];
    const unsigned old = xb_add(&bar[SW_XSUB(x)], 1u);
    const unsigned gen = old / nloc;
    if (old + 1u == (gen + 1u) * nloc) {
      __builtin_amdgcn_fence(__ATOMIC_RELEASE, "agent");
      asm volatile("s_waitcnt vmcnt(0)" ::: "memory");
      const unsigned og = xb_add(&bar[SW_TOP], 1u);
      const unsigned tg = og / nx;
      if (og + 1u == (tg + 1u) * nx) xb_add(&bar[SW_TOPGEN], 1u);
      else while (xb_ld(&bar[SW_TOPGEN]) == tg) __builtin_amdgcn_s_sleep(1);
      __builtin_amdgcn_fence(__ATOMIC_ACQUIRE, "agent");
      xb_add(&bar[SW_XGEN(x)], 1u);
      asm volatile("s_waitcnt vmcnt(0)" ::: "memory");
    } else {
      while (xb_ld(&bar[SW_XGEN(x)]) == gen) __builtin_amdgcn_s_sleep(1);
      __builtin_amdgcn_fence(__ATOMIC_ACQUIRE, "agent");
      asm volatile("s_waitcnt vmcnt(0)" ::: "memory");
    }
  }
  __syncthreads();
}

__device__ __forceinline__ void lds_barrier() {
  asm volatile("s_waitcnt lgkmcnt(0)" ::: "memory");
  __builtin_amdgcn_s_barrier();
  asm volatile("" ::: "memory");
}

__device__ __forceinline__ int seg_M(int seg) { return seg == 0 ? M0 : M1; }
__device__ __forceinline__ int seg_MP(int seg) { return seg == 0 ? MP0 : M1; }
__device__ __forceinline__ int slot_row0(int seg) { int s = seg % 3; return s == 0 ? 0 : MP0 + (s - 1) * M1; }
__device__ __forceinline__ int gt_row0(int seg) { int s = seg & 3; return s == 0 ? 0 : MP0 + (s - 1) * M1; }
__device__ __forceinline__ const float* row_src(PP pp, int seg, int r) {
  if (seg == 0) {
    if (r < 1056) {
      int b = r >= 528 ? 1 : 0, t = r - b * 528;
      if (t < 16) return p.meta + t * DM;
      return p.x_prompt + ((size_t)b * 8192 + (t - 16)) * DM;
    }
    return p.x_sample + (size_t)(r - 1056) * DM;
  }
  int b = r >> 9, t = r & 511;
  return p.x_prompt + ((size_t)b * 8192 + seg * TS + t) * DM;
}
__device__ __forceinline__ float* row_dst(PP pp, int seg, int r) {
  if (seg == 0) {
    if (r < 1056) {
      int b = r >= 528 ? 1 : 0, t = r - b * 528;
      if (t < 16) return nullptr;
      return (p.out + OO_y_prompt) + ((size_t)b * 8192 + (t - 16)) * DM;
    }
    return (p.out + OO_y_sample) + (size_t)(r - 1056) * DM;
  }
  int b = r >> 9, t = r & 511;
  return (p.out + OO_y_prompt) + ((size_t)b * 8192 + seg * TS + t) * DM;
}
__device__ __forceinline__ void row_seq(int seg, int r, int& seq, int& t, int& len) {
  if (seg == 0) {
    if (r < 528) { seq = 0; t = r; len = 528; }
    else if (r < 1056) { seq = 1; t = r - 528; len = 528; }
    else { seq = 2 + ((r - 1056) >> 4); t = (r - 1056) & 15; len = 16; }
  } else { seq = r >> 9; t = r & 511; len = TS; }
}

__device__ __forceinline__ size_t blk_off(int row, int k) {
  const int kk = (k & 7) | (((((k >> 3) & 3) ^ ((row >> 2) & 3))) << 3);
  return ((size_t)((row >> 7) * 32 + (k >> 5)) * 128 + (row & 127)) * 32 + kk;
}

__device__ __forceinline__ int vcol_src(int n) {
  if (n < 3200) return n;
  if (n < 6288) return n + 1024;
  if (n < 6400) return -1;
  if (n < 7424) return n - 3200;
  return n - 112;
}
__device__ __forceinline__ void transpose_tile(const float* __restrict__ src, int ld, bool remap, bf16_t* __restrict__ dst, int k0, int n0,
                               float* tile  ) {
  int tid = tid_l();
  int i = tid >> 4, j = tid & 15;
  __syncthreads();
  int n = n0 + 4 * j;
  int sc = remap ? vcol_src(n) : n;
#pragma unroll
  for (int pass = 0; pass < 4; pass++) {
    int k = pass * 16 + i;
    float4 v = make_float4(0.f, 0.f, 0.f, 0.f);
    if (sc >= 0) v = *(const float4*)(src + (size_t)(k0 + k) * ld + sc);
    tile[k * 65 + 4 * j + 0] = v.x; tile[k * 65 + 4 * j + 1] = v.y; tile[k * 65 + 4 * j + 2] = v.z; tile[k * 65 + 4 * j + 3] = v.w;
  }
  __syncthreads();
  int nn = tid >> 2, kq = tid & 3;
  uint32_t o[8];
#pragma unroll
  for (int e = 0; e < 8; e++) o[e] = pack2(tile[(kq * 16 + 2 * e) * 65 + nn], tile[(kq * 16 + 2 * e + 1) * 65 + nn]);
  *(u32x4*)(dst + blk_off(n0 + nn, k0 + kq * 16)) = (u32x4){o[0], o[1], o[2], o[3]};
  *(u32x4*)(dst + blk_off(n0 + nn, k0 + kq * 16 + 8)) = (u32x4){o[4], o[5], o[6], o[7]};
}
__device__ __forceinline__ void phase_weights(PP pp, int bid, int nb, char* smem) {
  LAUNDER_PP;
  float* tile = (float*)smem;
  const int nIn = 16 * (VW / 64);
  const int nSq = 16 * 16;
  for (int it = bid; it < nIn + 3 * nSq; it += nb) {
    if (it < nIn) {
      int kt = it & 15, nt = it >> 4;
      transpose_tile(p.w_in, PW, true, ((bf16_t*)(p.ws + OW_WtIn)), kt * 64, nt * 64, tile);
    } else {
      int j = it - nIn, w = j / nSq, r = j % nSq;
      int kt = r & 15, nt = r >> 4;
      const float* src = w == 0 ? p.w_out_a : (w == 1 ? p.w_out_b : p.w_out);
      bf16_t* dst = w == 0 ? ((bf16_t*)(p.ws + OW_WtA)) : (w == 1 ? ((bf16_t*)(p.ws + OW_WtB)) : ((bf16_t*)(p.ws + OW_WtO)));
      transpose_tile(src, DM, false, dst, kt * 64, nt * 64, tile);
    }
  }
}

__device__ __forceinline__ void xn_item(PP pp, int seg, int item) {
  LAUNDER_PP;
  int wave = tid_l() >> 6, lane = tid_l() & 63;
  int M = seg_M(seg);
  int r = item * 4 + wave;
  bf16_t* o = ((bf16_t*)(p.ws + OW_XN));
  if (r >= M) {
#pragma unroll
    for (int i = 0; i < 4; i++) *(uint2*)(o + blk_off(r, (lane + 64 * i) * 4)) = make_uint2(0u, 0u);
    return;
  }
  const float4* src = (const float4*)row_src(pp, seg, r);
  float4 v[4];
  float ss = 0.f;
#pragma unroll
  for (int i = 0; i < 4; i++) {
    v[i] = src[lane + 64 * i];
    ss += v[i].x * v[i].x + v[i].y * v[i].y + v[i].z * v[i].z + v[i].w * v[i].w;
  }
  ss = wavesum(ss);
  float rstd = rsqrtf(ss * (1.0f / DM) + 1e-6f);
#pragma unroll
  for (int i = 0; i < 4; i++) {
    float4 g = ((const float4*)p.norm_pre)[lane + 64 * i];
    *(uint2*)(o + blk_off(r, (lane + 64 * i) * 4)) =
        make_uint2(pack2(v[i].x * rstd * g.x, v[i].y * rstd * g.y), pack2(v[i].z * rstd * g.z, v[i].w * rstd * g.w));
  }
}

__device__ __forceinline__ void norm_item(PP pp, int seg, int item) {
  LAUNDER_PP;
  int wave = tid_l() >> 6, lane = tid_l() & 63;
  int r = item * 4 + wave;
  float* dst = row_dst(pp, seg, r);
  if (!dst) return;
  const float4* h = (const float4*)row_src(pp, seg, r);
  const float4* o = (const float4*)(((float*)(p.ws + OW_OUTB)) + ((size_t)(seg & 1) * MP0 + r) * DM);
  float4 v[4];
  float ss = 0.f;
#pragma unroll
  for (int i = 0; i < 4; i++) {
    v[i] = o[lane + 64 * i];
    ss += v[i].x * v[i].x + v[i].y * v[i].y + v[i].z * v[i].z + v[i].w * v[i].w;
  }
  ss = wavesum(ss);
  float rstd = rsqrtf(ss * (1.0f / DM) + 1e-6f);
#pragma unroll
  for (int i = 0; i < 4; i++) {
    float4 g = ((const float4*)p.norm_post)[lane + 64 * i];
    float4 hh = h[lane + 64 * i];
    ((float4*)dst)[lane + 64 * i] =
        make_float4(hh.x + v[i].x * rstd * g.x, hh.y + v[i].y * rstd * g.y, hh.z + v[i].z * rstd * g.z, hh.w + v[i].w * rstd * g.w);
  }
}

__device__ __forceinline__ void merge_item(PP pp, int item) {
  LAUNDER_PP;
  const int tid = tid_l();
  const int wave = tid >> 6, lane = tid & 63;
  const int r = item * 4 + wave;
  const float4* t1 = (const float4*)((const float*)(p.ws + OW_TMP) + (size_t)r * DM);
  const float4* t2 = (const float4*)((const float*)(p.ws + OW_TMP) + ((size_t)MP0 + r) * DM);
  bf16_t* o = (bf16_t*)(p.ws + OW_MG);
#pragma unroll
  for (int i = 0; i < 4; i++) {
    float4 a = t1[lane + 64 * i], b = t2[lane + 64 * i];
    *(uint2*)(o + blk_off(r, (lane + 64 * i) * 4)) = make_uint2(pack2(a.x + b.x, a.y + b.y), pack2(a.z + b.z, a.w + b.w));
  }
}

#define LDT 32
template <int MODE>
__device__ __forceinline__ void gemm_tile(PP pp, int seg, int tm, int tn, char* smem) {
  LAUNDER_PP;
  const int tid = tid_l(), lane = tid & 63, wid = tid >> 6;
  const int wr = wid >> 1, wc = wid & 1, l31 = lane & 31, lh = lane >> 5;
  const int lrow = tid >> 2, lkc = tid & 3;
  const int m0 = tm * 128, n0 = tn * 128;
  bf16_t* GTs = ((bf16_t*)(p.ws + OW_GT)) + (size_t)gt_row0(seg) * GTW;
  f32x16 acc[2][2];
#pragma unroll
  for (int a = 0; a < 2; a++)
#pragma unroll
    for (int b = 0; b < 2; b++)
#pragma unroll
      for (int e = 0; e < 16; e++) acc[a][b][e] = 0.f;
  {
    const bf16_t* A = (MODE == 0) ? (const bf16_t*)(p.ws + OW_XN)
                    : (MODE == 1) ? (const bf16_t*)(p.ws + OW_YA) + (size_t)(seg & 1) * MP0 * DM
                    : (MODE == 3) ? (const bf16_t*)(p.ws + OW_YB) + (size_t)(seg & 1) * MP0 * DM
                                  : (const bf16_t*)(p.ws + OW_MG);
    const bf16_t* Bt = (const bf16_t*)(p.ws + (MODE == 0 ? OW_WtIn : (MODE == 1 ? OW_WtA : (MODE == 3 ? OW_WtB : OW_WtO))));
    u32x4 ra[2], rb[2];
    const bf16_t* gA = A + ((size_t)(tm * 32) * 128 + lrow) * 32 + lkc * 8;
    const bf16_t* gB = Bt + ((size_t)(tn * 32) * 128 + lrow) * 32 + lkc * 8;
    const int wofs = lrow * 64 + (lkc << 4);
    const int sw = (l31 >> 2) & 3;
    const int rofs0 = l31 * 64 + (((0 + lh) ^ sw) << 4);
    const int rofs1 = l31 * 64 + (((2 + lh) ^ sw) << 4);
    __syncthreads();
#pragma unroll
    for (int i = 0; i < 2; i++) {
      ra[i] = *(const u32x4*)(gA + (size_t)i * 2048);
      rb[i] = *(const u32x4*)(gB + (size_t)i * 2048);
    }
#pragma unroll
    for (int i = 0; i < 2; i++) {
      *(u32x4*)(smem + wofs + i * 4096) = ra[i];
      *(u32x4*)(smem + 8192 + wofs + i * 4096) = rb[i];
    }
#pragma unroll
    for (int i = 0; i < 2; i++) {
      ra[i] = *(const u32x4*)(gA + (size_t)i * 2048 + 4096);
      rb[i] = *(const u32x4*)(gB + (size_t)i * 2048 + 4096);
    }
    lds_barrier();
#pragma unroll 1
    for (int kt = 0; kt < 32; kt++) {
      const char* cA = smem + (kt & 1) * 16384 + wr * 4096;
      const char* cB = smem + (kt & 1) * 16384 + 8192 + wc * 4096;
      const bf16x8 x00 = *(const bf16x8*)(cA + rofs0), x01 = *(const bf16x8*)(cA + 2048 + rofs0);
      const bf16x8 w00 = *(const bf16x8*)(cB + rofs0), w01 = *(const bf16x8*)(cB + 2048 + rofs0);
      const bf16x8 x10 = *(const bf16x8*)(cA + rofs1), x11 = *(const bf16x8*)(cA + 2048 + rofs1);
      const bf16x8 w10 = *(const bf16x8*)(cB + rofs1), w11 = *(const bf16x8*)(cB + 2048 + rofs1);
      asm volatile("" ::: "memory");
      acc[0][0] = __builtin_amdgcn_mfma_f32_32x32x16_bf16(w00, x00, acc[0][0], 0, 0, 0);
      acc[0][1] = __builtin_amdgcn_mfma_f32_32x32x16_bf16(w00, x01, acc[0][1], 0, 0, 0);
      acc[1][0] = __builtin_amdgcn_mfma_f32_32x32x16_bf16(w01, x00, acc[1][0], 0, 0, 0);
      acc[1][1] = __builtin_amdgcn_mfma_f32_32x32x16_bf16(w01, x01, acc[1][1], 0, 0, 0);
      acc[0][0] = __builtin_amdgcn_mfma_f32_32x32x16_bf16(w10, x10, acc[0][0], 0, 0, 0);
      acc[0][1] = __builtin_amdgcn_mfma_f32_32x32x16_bf16(w10, x11, acc[0][1], 0, 0, 0);
      acc[1][0] = __builtin_amdgcn_mfma_f32_32x32x16_bf16(w11, x10, acc[1][0], 0, 0, 0);
      acc[1][1] = __builtin_amdgcn_mfma_f32_32x32x16_bf16(w11, x11, acc[1][1], 0, 0, 0);
      if (kt + 1 < 32) {
        char* nx = smem + ((kt + 1) & 1) * 16384;
#pragma unroll
        for (int i = 0; i < 2; i++) {
          *(u32x4*)(nx + wofs + i * 4096) = ra[i];
          *(u32x4*)(nx + 8192 + wofs + i * 4096) = rb[i];
        }
        if (kt + 2 < 32) {
#pragma unroll
          for (int i = 0; i < 2; i++) {
            ra[i] = *(const u32x4*)(gA + (size_t)i * 2048 + (size_t)(kt + 2) * 4096);
            rb[i] = *(const u32x4*)(gB + (size_t)i * 2048 + (size_t)(kt + 2) * 4096);
          }
        }
      }
      lds_barrier();
    }
  }
  float* OUTBp = (MODE == 2) ? (float*)(p.ws + OW_OUTB) + (size_t)(seg & 1) * MP0 * DM
                             : (float*)(p.ws + OW_TMP) + (size_t)(MODE == 3 ? 1 : 0) * MP0 * DM;
#pragma unroll
  for (int ni = 0; ni < 2; ni++)
#pragma unroll
    for (int mi = 0; mi < 2; mi++)
#pragma unroll
      for (int g = 0; g < 4; g++) {
        const int m = m0 + wr * 64 + mi * 32 + l31;
        const int n = n0 + wc * 64 + ni * 32 + 8 * g + 4 * lh;
        const float c0 = acc[ni][mi][4 * g], c1 = acc[ni][mi][4 * g + 1], c2 = acc[ni][mi][4 * g + 2], c3 = acc[ni][mi][4 * g + 3];
        if (MODE == 0) {
          uint2 o = make_uint2(pack2(c0, c1), pack2(c2, c3));
          if (tn < PJW / 128) *(uint2*)(((bf16_t*)(p.ws + OW_PJA)) + (size_t)m * PJW + n) = o;
          else *(uint2*)(GTs + (size_t)m * GTW + (n - PJW)) = o;
        } else if (MODE == 1 || MODE == 3) {
          uint2 ga = *(const uint2*)(GTs + (size_t)m * GTW + (MODE == 1 ? G_MA : G_MB) + n);
          *(float4*)(OUTBp + (size_t)m * DM + n) =
              make_float4(sigmoidf_(bf2f(ga.x & 0xffff)) * c0, sigmoidf_(bf2f(ga.x >> 16)) * c1,
                          sigmoidf_(bf2f(ga.y & 0xffff)) * c2, sigmoidf_(bf2f(ga.y >> 16)) * c3);
        } else {
          *(float4*)(OUTBp + (size_t)m * DM + n) = make_float4(c0, c1, c2, c3);
        }
      }
}

__device__ __forceinline__ void rw_prepass_item(PP pp, int seg, int grp, int slab, char* smem) {
  LAUNDER_PP;
  float* lwa = (float*)smem;
  const int tid = tid_l();
  const int r0 = grp * 8;
  int seq, t0, len;
  row_seq(seg, r0, seq, t0, len);
  const bool prompt = seq < 2;
  const float* prev0 = nullptr;
  if (t0 == 0) {
    if (seg == 0) prev0 = prompt ? nullptr : p.st_shift + (size_t)(seq - 2) * 3200;
    else prev0 = ((float*)(p.ws + OW_CSH)) + ((size_t)(seg & 1) * 2 + seq) * 3200;
  }
  __syncthreads();
  {
    const int j = tid & 127;
    const float mu = p.rw_mu[3072 + j];
#pragma unroll
    for (int i = 0; i < 4; i++) {
      int tok = (tid >> 7) + 2 * i;
      int row = r0 + tok;
      float ps = bf2f(((bf16_t*)(p.ws + OW_PJA))[(size_t)row * PJW + 3072 + j]);
      float pv;
      if (tok == 0 && t0 == 0) pv = prev0 ? prev0[3072 + j] : 0.f;
      else pv = bf2f(((bf16_t*)(p.ws + OW_PJA))[(size_t)(row - 1) * PJW + 3072 + j]);
      float xs = ps + mu * (pv - ps);
      lwa[tok * 128 + j] = j < 64 ? tanhf(xs) : xs;
      if (slab == 0 && t0 + tok == len - 1) {
        if (prompt) {
          ((float*)(p.ws + OW_CSH))[((size_t)((seg + 1) & 1) * 2 + seq) * 3200 + 3072 + j] = ps;
          if (seg == NSEG - 1) (p.out + OO_p_shift)[(size_t)seq * 3200 + 3072 + j] = ps;
        } else {
          (p.out + OO_s_shift)[(size_t)(seq - 2) * 3200 + 3072 + j] = ps;
        }
      }
    }
  }
  __syncthreads();
  const int c = slab * 256 + tid;
  float dw[8], da[8];
  {
    const float w0 = p.rw_w0[c], a0 = p.rw_a0[c];
#pragma unroll
    for (int t = 0; t < 8; t++) { dw[t] = w0; da[t] = a0; }
  }
  for (int j = 0; j < 64; j += 4) {
    float w2v[4], a2v[4];
#pragma unroll
    for (int e = 0; e < 4; e++) {
      w2v[e] = p.rw_w2[(size_t)(j + e) * DM + c];
      a2v[e] = p.rw_a2[(size_t)(j + e) * DM + c];
    }
#pragma unroll
    for (int t = 0; t < 8; t++) {
      float4 lw = *(const float4*)(lwa + t * 128 + j);
      float4 la = *(const float4*)(lwa + t * 128 + 64 + j);
      dw[t] += lw.x * w2v[0] + lw.y * w2v[1] + lw.z * w2v[2] + lw.w * w2v[3];
      da[t] += la.x * a2v[0] + la.y * a2v[1] + la.z * a2v[2] + la.w * a2v[3];
    }
  }
  const float mur = p.rw_mu[c], muk = p.rw_mu[1024 + c], muv = p.rw_mu[2048 + c];
  const float kk_w = p.rw_k_k[c], ka_w = p.rw_k_a[c], rk_w = p.rw_r_k[c];
  float pr, pk, pv;
  if (t0 == 0) {
    pr = prev0 ? prev0[c] : 0.f; pk = prev0 ? prev0[1024 + c] : 0.f; pv = prev0 ? prev0[2048 + c] : 0.f;
  } else {
    const bf16_t* q = ((bf16_t*)(p.ws + OW_PJA)) + (size_t)(r0 - 1) * PJW;
    pr = bf2f(q[c]); pk = bf2f(q[1024 + c]); pv = bf2f(q[2048 + c]);
  }
  const int head = c >> 6, e = c & 63;
  const int srow0 = slot_row0(seg);
  char* rws = ((char*)(p.ws + OW_RWS)) + ((size_t)(srow0 + r0) * 16 + head) * 1024;
  float* rwb = ((float*)(p.ws + OW_RWB)) + (size_t)(srow0 + r0) * 16 + head;
#pragma unroll
  for (int t = 0; t < 8; t++) {
    const int row = r0 + t;
    const bf16_t* q = ((bf16_t*)(p.ws + OW_PJA)) + (size_t)row * PJW;
    float cr = bf2f(q[c]), ck = bf2f(q[1024 + c]), cv = bf2f(q[2048 + c]);
    float xr = cr + mur * (pr - cr), xk = ck + muk * (pk - ck), xv = cv + muv * (pv - cv);
    pr = cr; pk = ck; pv = cv;
    float w_log = -softplusf_(-dw[t]) - 0.5f;
    float decay = __expf(-__expf(w_log));
    float a = sigmoidf_(da[t]);
    float kkr = xk * kk_w;
    float ss = wavesum(kkr * kkr);
    float kk = kkr * rsqrtf(ss + 1e-6f);
    float k2 = xk * (1.0f + (a - 1.0f) * ka_w);
    float bon = wavesum(xr * k2 * rk_w);
    char* o = rws + (size_t)t * RWS_ROWB;
    ((f16*)o)[e] = (f16)xr;
    ((f16*)(o + 128))[e] = (f16)k2;
    ((f16*)(o + 256))[e] = (f16)(-kk);
    ((f16*)(o + 384))[e] = (f16)(kk * a);
    ((float*)(o + 512))[e] = decay;
    ((float*)(o + 768))[e] = xv;
    if ((tid & 63) == 0) rwb[(size_t)t * 16] = bon;
    if (t0 + t == len - 1) {
      if (prompt) {
        float* cs = ((float*)(p.ws + OW_CSH)) + ((size_t)((seg + 1) & 1) * 2 + seq) * 3200;
        cs[c] = cr; cs[1024 + c] = ck; cs[2048 + c] = cv;
        if (seg == NSEG - 1) {
          float* ps = (p.out + OO_p_shift) + (size_t)seq * 3200;
          ps[c] = cr; ps[1024 + c] = ck; ps[2048 + c] = cv;
        }
      } else {
        float* ps = (p.out + OO_s_shift) + (size_t)(seq - 2) * 3200;
        ps[c] = cr; ps[1024 + c] = ck; ps[2048 + c] = cv;
      }
    }
  }
}

__device__ __forceinline__ void gd_prepass_item(PP pp, int seg, int grp, int slab) {
  LAUNDER_PP;
  const int tid = tid_l();
  const int r0 = grp * 16;
  int seq, t0, len;
  row_seq(seg, r0, seq, t0, len);
  const bool prompt = seq < 2;
  const int c = slab * 512 + 2 * tid;
  const int kind = slab >> 1;
  const int head = (c & 1023) >> 7, e = c & 127;
  float2 x0, x1, x2;
  if (t0 == 0) {
    const float* cp = nullptr;
    if (seg == 0) cp = prompt ? nullptr : p.st_conv + (size_t)(seq - 2) * 3 * 3072;
    else cp = ((float*)(p.ws + OW_CCV)) + ((size_t)(seg & 1) * 2 + seq) * 3 * 3072;
    if (cp) {
      x0 = *(const float2*)(cp + c); x1 = *(const float2*)(cp + 3072 + c); x2 = *(const float2*)(cp + 6144 + c);
    } else {
      x0 = x1 = x2 = make_float2(0.f, 0.f);
    }
  } else {
    uint32_t u0 = *(const uint32_t*)(((bf16_t*)(p.ws + OW_PJA)) + (size_t)(r0 - 3) * PJW + C_GDC + c);
    uint32_t u1 = *(const uint32_t*)(((bf16_t*)(p.ws + OW_PJA)) + (size_t)(r0 - 2) * PJW + C_GDC + c);
    uint32_t u2 = *(const uint32_t*)(((bf16_t*)(p.ws + OW_PJA)) + (size_t)(r0 - 1) * PJW + C_GDC + c);
    x0 = make_float2(bf2f(u0 & 0xffff), bf2f(u0 >> 16));
    x1 = make_float2(bf2f(u1 & 0xffff), bf2f(u1 >> 16));
    x2 = make_float2(bf2f(u2 & 0xffff), bf2f(u2 >> 16));
  }
  const float2 w0 = *(const float2*)(p.gd_conv_w + c), w1 = *(const float2*)(p.gd_conv_w + 3072 + c),
               w2 = *(const float2*)(p.gd_conv_w + 6144 + c), w3 = *(const float2*)(p.gd_conv_w + 9216 + c);
  const float a_exp = __expf(p.gd_a_log[head]);
  const float dtb = p.gd_dt_bias[head];
  char* gds = ((char*)(p.ws + OW_GDS)) + ((size_t)(slot_row0(seg) + r0) * 8 + head) * GDS_HB;
#pragma unroll 4
  for (int t = 0; t < 16; t++) {
    const int row = r0 + t;
    uint32_t u = *(const uint32_t*)(((bf16_t*)(p.ws + OW_PJA)) + (size_t)row * PJW + C_GDC + c);
    float2 x3 = make_float2(bf2f(u & 0xffff), bf2f(u >> 16));
    float cx = w0.x * x0.x + w1.x * x1.x + w2.x * x2.x + w3.x * x3.x;
    float cy = w0.y * x0.y + w1.y * x1.y + w2.y * x2.y + w3.y * x3.y;
    x0 = x1; x1 = x2; x2 = x3;
    float ax = siluf_(cx), ay = siluf_(cy);
    float sc = 1.0f;
    if (kind < 2) {
      float ss = wavesum(ax * ax + ay * ay);
      sc = rsqrtf(ss + 1e-6f);
      if (kind == 0) sc *= 0.08838834764831845f;
    }
    if (kind >= 1) {
      float beta = sigmoidf_(bf2f(((bf16_t*)(p.ws + OW_PJA))[(size_t)row * PJW + C_BETA + head]));
      sc *= sqrtf(beta);
    }
    ax *= sc; ay *= sc;
    char* o = gds + (size_t)t * GDS_ROWB;
    f16x2 hv = {(f16)ax, (f16)ay};
    *(f16x2*)(o + kind * 256 + e * 2) = hv;
    if (kind == 0 && (tid & 63) == 0) {
      float g = -a_exp * softplusf_(bf2f(((bf16_t*)(p.ws + OW_PJA))[(size_t)row * PJW + C_ALPHA + head]) + dtb);
      *(float*)(o + 768) = __expf(g);
    }
    int jj = t0 + t - (len - 3);
    if (jj >= 0) {
      if (prompt) {
        *(float2*)(((float*)(p.ws + OW_CCV)) + (((size_t)((seg + 1) & 1) * 2 + seq) * 3 + jj) * 3072 + c) = x3;
        if (seg == NSEG - 1) *(float2*)((p.out + OO_p_conv) + ((size_t)seq * 3 + jj) * 3072 + c) = x3;
      } else {
        *(float2*)((p.out + OO_s_conv) + ((size_t)(seq - 2) * 3 + jj) * 3072 + c) = x3;
      }
    }
  }
}


using u32x2 = __attribute__((ext_vector_type(2))) unsigned int;
__device__ __forceinline__ float fmix_lo(unsigned h, float b, float c) {
  float d;
  asm("v_fma_mix_f32 %0, %1, %2, %3 op_sel_hi:[1,0,0]" : "=v"(d) : "v"(h), "v"(b), "v"(c));
  return d;
}
__device__ __forceinline__ float fmix_hi(unsigned h, float b, float c) {
  float d;
  asm("v_fma_mix_f32 %0, %1, %2, %3 op_sel:[1,0,0] op_sel_hi:[1,0,0]" : "=v"(d) : "v"(h), "v"(b), "v"(c));
  return d;
}
__device__ __forceinline__ float vmul1(float a, float b) {
  float d;
  asm("v_mul_f32 %0, %1, %2" : "=v"(d) : "v"(a), "v"(b));
  return d;
}
struct RwOps { f16x4 r, k, a, b; float4 w; float vv; };
__device__ __forceinline__ RwOps rw_ld(const char* Ls, int q, int v) {
  RwOps o;
  o.r = *(const f16x4*)(Ls + q * 8);
  o.k = *(const f16x4*)(Ls + 128 + q * 8);
  o.a = *(const f16x4*)(Ls + 256 + q * 8);
  o.b = *(const f16x4*)(Ls + 384 + q * 8);
  o.w = *(const float4*)(Ls + 512 + q * 16);
  o.vv = *(const float*)(Ls + 768 + v * 4);
  return o;
}
__device__ __forceinline__ float rw_step(const RwOps& o, float4& S) {
  const u32x2 rw = __builtin_bit_cast(u32x2, o.r), kw = __builtin_bit_cast(u32x2, o.k),
              aw = __builtin_bit_cast(u32x2, o.a), bw = __builtin_bit_cast(u32x2, o.b);
  const float z = 0.f;
  float sa0 = fmix_lo(aw[0], S.x, z);
  float sa1 = fmix_lo(aw[1], S.z, z);
  sa0 = fmix_hi(aw[0], S.y, sa0);
  sa1 = fmix_hi(aw[1], S.w, sa1);
  float t0 = vmul1(S.x, o.w.x), t1 = vmul1(S.y, o.w.y), t2 = vmul1(S.z, o.w.z), t3 = vmul1(S.w, o.w.w);
  t0 = fmix_lo(kw[0], o.vv, t0);
  t1 = fmix_hi(kw[0], o.vv, t1);
  t2 = fmix_lo(kw[1], o.vv, t2);
  t3 = fmix_hi(kw[1], o.vv, t3);
  const float sa = rowsum16(sa0 + sa1);
  S.x = fmix_lo(bw[0], sa, t0);
  S.y = fmix_hi(bw[0], sa, t1);
  S.z = fmix_lo(bw[1], sa, t2);
  S.w = fmix_hi(bw[1], sa, t3);
  float y0 = fmix_lo(rw[0], S.x, z);
  float y1 = fmix_lo(rw[1], S.z, z);
  y0 = fmix_hi(rw[0], S.y, y0);
  y1 = fmix_hi(rw[1], S.w, y1);
  return rowsum16(y0 + y1);
}
__device__ __forceinline__ void rw_scan_run(const char* __restrict__ gsrc  , int len, float4& S,
                            float* __restrict__ yo  , int q, int v, char* smem) {
  const int tid = tid_l();
  const int nch = len >> 4;
  const int lstep = tid >> 6, loff = (tid & 63) * 16;
  u32x4 st[4];
#pragma unroll
  for (int i = 0; i < 4; i++) st[i] = *(const u32x4*)(gsrc + (size_t)(lstep + 4 * i) * RWS_ROWB + loff);
  __syncthreads();
#pragma unroll
  for (int i = 0; i < 4; i++) *(u32x4*)(smem + (lstep + 4 * i) * 1024 + loff) = st[i];
  u32x4 st2[4];
#pragma unroll
  for (int i = 0; i < 4; i++) st2[i] = st[i];
  if (nch > 1) {
#pragma unroll
    for (int i = 0; i < 4; i++) st[i] = *(const u32x4*)(gsrc + (size_t)(16 + lstep + 4 * i) * RWS_ROWB + loff);
  }
  if (nch > 2) {
#pragma unroll
    for (int i = 0; i < 4; i++) st2[i] = *(const u32x4*)(gsrc + (size_t)(32 + lstep + 4 * i) * RWS_ROWB + loff);
  }
  __syncthreads();
  for (int c = 0; c < nch; c++) {
    const char* L = smem + (c & 1) * 16384;
    float ykeep = 0.f;
    RwOps oa = rw_ld(L, q, v);
#pragma unroll 1
    for (int t = 0; t < 16; t += 2) {
      const RwOps ob = rw_ld(L + (t + 1) * 1024, q, v);
      asm volatile("" ::: "memory");
      const float ya = rw_step(oa, S);
      ykeep = (q == t) ? ya : ykeep;
      oa = rw_ld(L + ((t + 2) & 15) * 1024, q, v);
      asm volatile("" ::: "memory");
      const float yb = rw_step(ob, S);
      ykeep = (q == t + 1) ? yb : ykeep;
    }
    yo[(size_t)(c * 16 + q) * DM] = ykeep;
    if (c + 1 < nch) {
      char* Ln = smem + ((c + 1) & 1) * 16384;
#pragma unroll
      for (int i = 0; i < 4; i++) *(u32x4*)(Ln + (lstep + 4 * i) * 1024 + loff) = st[i];
#pragma unroll
      for (int i = 0; i < 4; i++) st[i] = st2[i];
      if (c + 3 < nch) {
#pragma unroll
        for (int i = 0; i < 4; i++)
          st2[i] = *(const u32x4*)(gsrc + (size_t)((c + 3) * 16 + lstep + 4 * i) * RWS_ROWB + loff);
      }
    }
    lds_barrier();
  }
}

struct GdOps { f16x8 qv, kv; float vv, eg; };
__device__ __forceinline__ GdOps gd_ld(const char* Ls, int q, int cl) {
  GdOps o;
  o.kv = *(const f16x8*)(Ls + 256 + q * 16);
  o.vv = (float)*(const f16*)(Ls + 512 + cl * 2);
  o.eg = *(const float*)(Ls + 768);
  o.qv = *(const f16x8*)(Ls + q * 16);
  return o;
}
__device__ __forceinline__ float gd_step(const GdOps& o, float (&s)[8]) {
  const u32x4 kw = __builtin_bit_cast(u32x4, o.kv), qw = __builtin_bit_cast(u32x4, o.qv);
  const float z = 0.f;
  float a0 = fmix_lo(kw[0], s[0], z);
  float a1 = fmix_lo(kw[2], s[4], z);
  a0 = fmix_hi(kw[0], s[1], a0);
  a1 = fmix_hi(kw[2], s[5], a1);
  a0 = fmix_lo(kw[1], s[2], a0);
  a1 = fmix_lo(kw[3], s[6], a1);
  a0 = fmix_hi(kw[1], s[3], a0);
  a1 = fmix_hi(kw[3], s[7], a1);
  float es[8];
#pragma unroll
  for (int i = 0; i < 8; i++) es[i] = vmul1(o.eg, s[i]);
  const float ks = rowsum16(a0 + a1);
  const float d = fmaf(-o.eg, ks, o.vv);
  s[0] = fmix_lo(kw[0], d, es[0]); s[1] = fmix_hi(kw[0], d, es[1]);
  s[2] = fmix_lo(kw[1], d, es[2]); s[3] = fmix_hi(kw[1], d, es[3]);
  s[4] = fmix_lo(kw[2], d, es[4]); s[5] = fmix_hi(kw[2], d, es[5]);
  s[6] = fmix_lo(kw[3], d, es[6]); s[7] = fmix_hi(kw[3], d, es[7]);
  float o0 = fmix_lo(qw[0], s[0], z);
  float o1 = fmix_lo(qw[2], s[4], z);
  o0 = fmix_hi(qw[0], s[1], o0);
  o1 = fmix_hi(qw[2], s[5], o1);
  o0 = fmix_lo(qw[1], s[2], o0);
  o1 = fmix_lo(qw[3], s[6], o1);
  o0 = fmix_hi(qw[1], s[3], o0);
  o1 = fmix_hi(qw[3], s[7], o1);
  return rowsum16(o0 + o1);
}
__device__ __forceinline__ void gd_scan_run(const char* __restrict__ gsrc  , int len, float (&s)[8],
                            float* __restrict__ oo  , int q, int cl, char* smem) {
  const int tid = tid_l();
  const int nch = len >> 4;
  u32x4 st[4];
  int lt[4], lo[4];
#pragma unroll
  for (int i = 0; i < 4; i++) {
    int id = tid + 256 * i;
    if (id > 783) id = 783;
    lt[i] = id / 49;
    lo[i] = (id % 49) * 16;
  }
#pragma unroll
  for (int i = 0; i < 4; i++) st[i] = *(const u32x4*)(gsrc + (size_t)lt[i] * GDS_ROWB + lo[i]);
  __syncthreads();
#pragma unroll
  for (int i = 0; i < 4; i++) *(u32x4*)(smem + lt[i] * GDS_HB + lo[i]) = st[i];
  u32x4 st2[4];
#pragma unroll
  for (int i = 0; i < 4; i++) st2[i] = st[i];
  if (nch > 1) {
#pragma unroll
    for (int i = 0; i < 4; i++) st[i] = *(const u32x4*)(gsrc + (size_t)(16 + lt[i]) * GDS_ROWB + lo[i]);
  }
  if (nch > 2) {
#pragma unroll
    for (int i = 0; i < 4; i++) st2[i] = *(const u32x4*)(gsrc + (size_t)(32 + lt[i]) * GDS_ROWB + lo[i]);
  }
  __syncthreads();
  for (int c = 0; c < nch; c++) {
    const char* L = smem + (c & 1) * 16384;
    float okeep = 0.f;
    GdOps oa = gd_ld(L, q, cl);
#pragma unroll 1
    for (int t = 0; t < 16; t += 2) {
      const GdOps ob = gd_ld(L + (t + 1) * GDS_HB, q, cl);
      asm volatile("" ::: "memory");
      const float ya = gd_step(oa, s);
      okeep = (q == t) ? ya : okeep;
      oa = gd_ld(L + ((t + 2) & 15) * GDS_HB, q, cl);
      asm volatile("" ::: "memory");
      const float yb = gd_step(ob, s);
      okeep = (q == t + 1) ? yb : okeep;
    }
    oo[(size_t)(c * 16 + q) * DM] = okeep;
    if (c + 1 < nch) {
      char* Ln = smem + ((c + 1) & 1) * 16384;
#pragma unroll
      for (int i = 0; i < 4; i++) *(u32x4*)(Ln + lt[i] * GDS_HB + lo[i]) = st[i];
#pragma unroll
      for (int i = 0; i < 4; i++) st[i] = st2[i];
      if (c + 3 < nch) {
#pragma unroll
        for (int i = 0; i < 4; i++) st2[i] = *(const u32x4*)(gsrc + (size_t)((c + 3) * 16 + lt[i]) * GDS_ROWB + lo[i]);
      }
    }
    lds_barrier();
  }
}

__device__ __forceinline__ void sample_scan_task(PP pp, int task, char* smem) {
  LAUNDER_PP;
  const int sj = task >> 7, j = task & 127, kind = j >> 6, jj = j & 63;
  const int tid = tid_l(), q = tid & 15;
  const int row0 = 1056 + sj * 16;
  if (kind == 0) {
    const int head = jj >> 2, v = (jj & 3) * 16 + (tid >> 4);
    const float* sin = p.st_wkv + ((size_t)sj * 16 + head) * 4096;
    float* sout = (p.out + OO_s_wkv) + ((size_t)sj * 16 + head) * 4096;
    float4 S = *(const float4*)(sin + v * 64 + 4 * q);
    rw_scan_run(((char*)(p.ws + OW_RWS)) + ((size_t)row0 * 16 + head) * 1024, 16, S, ((float*)(p.ws + OW_YRW)) + (size_t)row0 * DM + head * 64 + v, q, v, smem);
    *(float4*)(sout + v * 64 + 4 * q) = S;
  } else {
    const int head = jj >> 3, cl = (jj & 7) * 16 + (tid >> 4);
    const float* sin = p.st_ssm + ((size_t)sj * 8 + head) * 16384;
    float* sout = (p.out + OO_s_ssm) + ((size_t)sj * 8 + head) * 16384;
    float s[8];
#pragma unroll
    for (int i = 0; i < 8; i++) s[i] = sin[(size_t)(8 * q + i) * 128 + cl];
    gd_scan_run(((char*)(p.ws + OW_GDS)) + ((size_t)row0 * 8 + head) * GDS_HB, 16, s, ((float*)(p.ws + OW_OGD)) + (size_t)row0 * DM + head * 128 + cl, q, cl, smem);
#pragma unroll
    for (int i = 0; i < 8; i++) sout[(size_t)(8 * q + i) * 128 + cl] = s[i];
  }
}

__device__ __forceinline__ void scan_block_rw(PP pp, int j, char* smem) {
  LAUNDER_PP;
  const int seq = j >> 6, jj = j & 63;
  const int tid = tid_l(), q = tid & 15;
  const int head = jj >> 2, v = (jj & 3) * 16 + (tid >> 4);
  float4 S = make_float4(0.f, 0.f, 0.f, 0.f);
  for (int seg = 0; seg < NSEG; seg++) {
    wait_ge(((unsigned int*)(p.ws + OW_sync)) + SW_PRE, seg + 1);
    const int len = seg == 0 ? 528 : TS;
    const int row0 = slot_row0(seg) + (seg == 0 ? seq * 528 : seq * TS);
    rw_scan_run(((char*)(p.ws + OW_RWS)) + ((size_t)row0 * 16 + head) * 1024, len, S,
                ((float*)(p.ws + OW_YRW)) + (size_t)row0 * DM + head * 64 + v, q, v, smem);
    signal_scan_done((unsigned int*)(p.ws + OW_sync), seg);
  }
  {
    const int tid2 = tid_l(), q2 = tid2 & 15, v2 = (jj & 3) * 16 + (tid2 >> 4);
    *(float4*)((p.out + OO_p_wkv) + ((size_t)seq * 16 + head) * 4096 + v2 * 64 + 4 * q2) = S;
  }
}
__device__ __forceinline__ void scan_block_gd(PP pp, int j, char* smem) {
  LAUNDER_PP;
  const int seq = j >> 6, jj = j & 63;
  const int tid = tid_l(), q = tid & 15;
  const int head = jj >> 3, cl = (jj & 7) * 16 + (tid >> 4);
  float s[8];
#pragma unroll
  for (int i = 0; i < 8; i++) s[i] = 0.f;
  for (int seg = 0; seg < NSEG; seg++) {
    wait_ge(((unsigned int*)(p.ws + OW_sync)) + SW_PRE, seg + 1);
    const int len = seg == 0 ? 528 : TS;
    const int row0 = slot_row0(seg) + (seg == 0 ? seq * 528 : seq * TS);
    gd_scan_run(((char*)(p.ws + OW_GDS)) + ((size_t)row0 * 8 + head) * GDS_HB, len, s,
                ((float*)(p.ws + OW_OGD)) + (size_t)row0 * DM + head * 128 + cl, q, cl, smem);
    signal_scan_done((unsigned int*)(p.ws + OW_sync), seg);
  }
  {
    const int tid2 = tid_l(), q2 = tid2 & 15, cl2 = (jj & 7) * 16 + (tid2 >> 4);
    float* sout = (p.out + OO_p_ssm) + ((size_t)seq * 8 + head) * 16384;
#pragma unroll
    for (int i = 0; i < 8; i++) sout[(size_t)(8 * q2 + i) * 128 + cl2] = s[i];
  }
}

__device__ __forceinline__ void post_item(PP pp, int seg, int row) {
  LAUNDER_PP;
  const int tid = tid_l(), c4 = tid * 4;
  const int srow = slot_row0(seg) + row;
  const bf16_t* gt = ((bf16_t*)(p.ws + OW_GT)) + (size_t)(gt_row0(seg) + row) * GTW;
  {
    float4 y = *(const float4*)(((float*)(p.ws + OW_YRW)) + (size_t)srow * DM + c4);
    float mean = rowsum16(y.x + y.y + y.z + y.w) * (1.0f / 64.0f);
    float dx = y.x - mean, dy = y.y - mean, dz = y.z - mean, dw = y.w - mean;
    float var = rowsum16(dx * dx + dy * dy + dz * dz + dw * dw) * (1.0f / 64.0f);
    float rs = rsqrtf(var + 64e-5f);
    float4 lw = *(const float4*)(p.rw_ln_w + c4), lb = *(const float4*)(p.rw_ln_b + c4);
    float bon = ((float*)(p.ws + OW_RWB))[(size_t)srow * 16 + (tid >> 4)];
    float4 v = *(const float4*)(((char*)(p.ws + OW_RWS)) + ((size_t)srow * 16 + (tid >> 4)) * 1024 + 768 + (tid & 15) * 16);
    uint2 g = *(const uint2*)(gt + G_RW + c4);
    float o0 = (dx * rs * lw.x + lb.x + bon * v.x) * siluf_(bf2f(g.x & 0xffff));
    float o1 = (dy * rs * lw.y + lb.y + bon * v.y) * siluf_(bf2f(g.x >> 16));
    float o2 = (dz * rs * lw.z + lb.z + bon * v.z) * siluf_(bf2f(g.y & 0xffff));
    float o3 = (dw * rs * lw.w + lb.w + bon * v.w) * siluf_(bf2f(g.y >> 16));
    *(uint2*)(((bf16_t*)(p.ws + OW_YA)) + (size_t)(seg & 1) * MP0 * DM + blk_off(row, c4)) = make_uint2(pack2(o0, o1), pack2(o2, o3));
  }
  {
    float4 o = *(const float4*)(((float*)(p.ws + OW_OGD)) + (size_t)srow * DM + c4);
    float ss = rowsum16(o.x * o.x + o.y * o.y + o.z * o.z + o.w * o.w);
    ss += __shfl_xor(ss, 16);
    float rs = rsqrtf(ss * (1.0f / 128.0f) + 1e-6f);
    float4 nw = *(const float4*)(p.gd_norm_w + (c4 & 127));
    uint2 g = *(const uint2*)(gt + G_GD + c4);
    float o0 = o.x * rs * nw.x * siluf_(bf2f(g.x & 0xffff));
    float o1 = o.y * rs * nw.y * siluf_(bf2f(g.x >> 16));
    float o2 = o.z * rs * nw.z * siluf_(bf2f(g.y & 0xffff));
    float o3 = o.w * rs * nw.w * siluf_(bf2f(g.y >> 16));
    *(uint2*)(((bf16_t*)(p.ws + OW_YB)) + (size_t)(seg & 1) * MP0 * DM + blk_off(row, c4)) = make_uint2(pack2(o0, o1), pack2(o2, o3));
  }
}

#define SMEM_BYTES (32768 + 32)

__global__ void __launch_bounds__(256, 4) k_mega(Params p_arg) {
  PP pp = (PP)__builtin_amdgcn_kernarg_segment_ptr();
  __shared__ __attribute__((aligned(16))) char smem[SMEM_BYTES];
  cg::grid_group grid = cg::this_grid();
  const int bid = blockIdx.x, nb = gridDim.x;
  unsigned* sync = (unsigned*)(p.ws + OW_sync);
  const unsigned xcc = xcc_id() & 7u;
  if (threadIdx.x == 0) xb_add(&sync[bid >= NSCAN ? SW_XCNT(xcc) : SW_SCNT(xcc)], 1u);
  phase_weights(pp, bid, nb, smem);
  for (int it = bid; it < seg_MP(0) / 4; it += nb) xn_item(pp, 0, it);
  grid.sync();
  if (bid < NSCAN) {
    __builtin_amdgcn_s_setprio(3);
    if (bid < 128) scan_block_rw(pp, bid, smem);
    else scan_block_gd(pp, bid - 128, smem);
    return;
  }
  const int w = bid - NSCAN, NW = nb - NSCAN;
  unsigned* cfg = (unsigned*)(smem + 32768);
  if (threadIdx.x == 0) {
    unsigned mine = 0, nx = 0;
#pragma unroll
    for (unsigned j = 0; j < 8; j++) { unsigned c = xb_ld(&sync[SW_XCNT(j)]); nx += c > 0u ? 1u : 0u; mine = (j == xcc) ? c : mine; }
    cfg[0] = mine > 0u ? mine : 1u;
    cfg[1] = nx > 0u ? nx : 1u;
  }
  __syncthreads();
  for (int i = 0; i < NSEG + 5; i++) {
    const int sm = i - 4, snn = i - 5, sj = i - 3, so = i - 4, sp = i - 2;
    const bool front = i < NSEG;
    const bool mrg = sm >= 0 && sm < NSEG, nrm = snn >= 0 && snn < NSEG, back = sj >= 0 && sj < NSEG, outv = so >= 0 && so < NSEG,
               pst = sp >= 0 && sp < NSEG;
    {
      const int tmF = front ? seg_MP(i) / 128 : 1;
      const int nF = front ? tmF * (VW / 128) : 0;
      const int nM = mrg ? seg_MP(sm) / 4 : 0;
      const int nN = nrm ? seg_M(snn) / 4 : 0;
      if ((NW & 7) == 0) {
        const int x = w & 7, per = NW >> 3;
        const int ncol = front ? ((VW / 128 - x + 7) >> 3) : 0;
        for (int j = w >> 3; j < tmF * ncol; j += per) gemm_tile<0>(pp, i, j % tmF, x + 8 * (j / tmF), smem);
        for (int it = w; it < nM + nN; it += NW) {
          if (it < nM) merge_item(pp, it);
          else norm_item(pp, snn, it - nM);
        }
      } else {
        for (int it = w; it < nF + nM + nN; it += NW) {
          int t = it;
          if (t < nF) { gemm_tile<0>(pp, i, t % tmF, t / tmF, smem); continue; }
          t -= nF;
          if (t < nM) { merge_item(pp, t); continue; }
          t -= nM;
          norm_item(pp, snn, t);
        }
      }
      if (i == 1) {
        for (int it = w; it < 32 * 128; it += NW) sample_scan_task(pp, it, smem);
      }
    }
    if (threadIdx.x == 0)
      ((unsigned*)(smem + 32768))[4] = (pst && xb_ld((unsigned*)(p.ws + OW_sync) + SW_SCAN(sp)) >= (unsigned)NSCAN) ? 1u : 0u;
    worker_barrier((unsigned*)(p.ws + OW_sync), (const unsigned*)(smem + 32768));
    {
      const int nB = back ? (seg_MP(sj) / 128) * 8 : 0;
      const int nO = outv ? (seg_MP(so) / 128) * 8 : 0;
      const int nHeavy = 2 * nB + nO;
      const int nHeavyW = nHeavy < NW / 2 ? nHeavy : NW / 2;
      const int NL = NW - nHeavyW;
      const int ngrp = front ? seg_M(i) / 16 : 0;
      const int nRW = ngrp * 8, nGD = ngrp * 6;
      const int nX = (i + 1 < NSEG) ? seg_MP(i + 1) / 4 : 0;
      const int tot = nRW + nGD + nX;
      if (w >= NL) {
        for (int it = w - NL; it < nHeavy; it += nHeavyW) {
          int t = it;
          if (t < nB) { gemm_tile<1>(pp, sj, t >> 3, t & 7, smem); continue; }
          t -= nB;
          if (t < nB) { gemm_tile<3>(pp, sj, t >> 3, t & 7, smem); continue; }
          t -= nB;
          gemm_tile<2>(pp, so, t >> 3, t & 7, smem);
        }
      } else {
        for (int it = w; it < tot; it += NL) {
          int t = it;
          if (t < nRW) { rw_prepass_item(pp, i, t >> 2, t & 3, smem); continue; }
          t -= nRW;
          if (t < nGD) { gd_prepass_item(pp, i, t / 6, t % 6); continue; }
          t -= nGD;
          xn_item(pp, i + 1, t);
        }
      }
      if (pst) {
        if (!__builtin_amdgcn_readfirstlane((int)((const unsigned*)(smem + 32768))[4]))
          wait_ge((unsigned*)(p.ws + OW_sync) + SW_SCAN(sp), NSCAN);
        const int n = seg_M(sp);
        for (int it = w; it < n; it += NW) post_item(pp, sp, it);
      }
    }
    worker_barrier((unsigned*)(p.ws + OW_sync), (const unsigned*)(smem + 32768));
    if (front && w == 0 && threadIdx.x == 0)
      __hip_atomic_store((unsigned*)(p.ws + OW_sync) + SW_PRE, (unsigned)(i + 1), __ATOMIC_RELAXED, __HIP_MEMORY_SCOPE_AGENT);
  }
}

static inline size_t align_up(size_t x) { return (x + 255) & ~(size_t)255; }

#undef p
extern "C" void kernel_launch(void* const* d_in, const int* in_sizes, int n_in, void* d_out, int out_size, void* d_ws,
                              size_t ws_size, hipStream_t stream) {
  Params p{};
  const float* const* in = (const float* const*)d_in;
  p.x_prompt = in[0]; p.x_sample = in[1]; p.st_shift = in[2]; p.st_wkv = in[3]; p.st_conv = in[4]; p.st_ssm = in[5];
  p.meta = in[6]; p.norm_pre = in[7]; p.w_in = in[8]; p.rw_mu = in[9]; p.rw_w0 = in[10]; p.rw_w2 = in[11];
  p.rw_a0 = in[12]; p.rw_a2 = in[13]; p.rw_k_k = in[14]; p.rw_k_a = in[15]; p.rw_r_k = in[16]; p.rw_ln_w = in[17];
  p.rw_ln_b = in[18]; p.gd_conv_w = in[19]; p.gd_a_log = in[20]; p.gd_dt_bias = in[21]; p.gd_norm_w = in[22];
  p.w_out_a = in[23]; p.w_out_b = in[24]; p.w_out = in[25]; p.norm_post = in[26];
  p.out = (float*)d_out;
  p.ws = (char*)d_ws;
  if (OW_END > ws_size) { fprintf(stderr, "workspace too small: need %zu have %zu\n", (size_t)OW_END, ws_size); return; }

  static int grid_blocks = 0;
  if (!grid_blocks) {
    int dev = 0, cus = 0, per_cu = 0;
    (void)hipGetDevice(&dev);
    (void)hipDeviceGetAttribute(&cus, hipDeviceAttributeMultiprocessorCount, dev);
    (void)hipOccupancyMaxActiveBlocksPerMultiprocessor(&per_cu, k_mega, 256, 0);
    if (per_cu > 4) per_cu = 4;
    grid_blocks = cus * per_cu;
  }
  (void)hipMemsetAsync(p.ws + OW_sync, 0, 16384, stream);
  void* args[] = {&p};
  hipError_t e = hipLaunchCooperativeKernel((void*)k_mega, dim3(grid_blocks), dim3(256), args, 0, stream);
  if (e != hipSuccess) fprintf(stderr, "cooperative launch failed: %s (grid %d)\n", hipGetErrorString(e), grid_blocks);
}
```

```cpp
#include <hip/hip_runtime.h>
#include <hip/hip_cooperative_groups.h>
#include <stdint.h>
#include <stdio.h>
namespace cg = cooperative_groups;

typedef unsigned short bf16_t;
typedef _Float16 f16;
using bf16x8 = __attribute__((ext_vector_type(8))) short;
using f32x4 = __attribute__((ext_vector_type(4))) float;
using u32x4 = __attribute__((ext_vector_type(4))) unsigned int;
using f32x16 = __attribute__((ext_vector_type(16))) float;
using f16x2 = __attribute__((ext_vector_type(2))) _Float16;
using f16x4 = __attribute__((ext_vector_type(4))) _Float16;
using f16x8 = __attribute__((ext_vector_type(8))) _Float16;

#define DM 1024
#define PW 10384
#define VW 10496
#define PJW 6400
#define GTW 4096
#define NSEG 16
#define TS 512
#define M0 1568
#define MP0 1664
#define M1 1024
#define SLOT_ROWS 3712
#define GT_ROWS 4736
#define NSCAN 256
#define C_GDC 3200
#define C_BETA 6272
#define C_ALPHA 6280
#define G_RW 0
#define G_GD 1024
#define G_MA 2048
#define G_MB 3072
#define RWS_ROWB 16384
#define GDS_HB 784
#define GDS_ROWB 6272

struct Params {
  const float *x_prompt, *x_sample, *st_shift, *st_wkv, *st_conv, *st_ssm, *meta, *norm_pre, *w_in, *rw_mu, *rw_w0,
      *rw_w2, *rw_a0, *rw_a2, *rw_k_k, *rw_k_a, *rw_r_k, *rw_ln_w, *rw_ln_b, *gd_conv_w, *gd_a_log, *gd_dt_bias,
      *gd_norm_w, *w_out_a, *w_out_b, *w_out, *norm_post;
  float* out;
  char* ws;
};
#define p (PV(pp))
#define GLOBAL_AS __attribute__((address_space(1)))
#define CONST_AS __attribute__((address_space(4)))
struct ParamsG {
  const GLOBAL_AS float *x_prompt, *x_sample, *st_shift, *st_wkv, *st_conv, *st_ssm, *meta, *norm_pre, *w_in, *rw_mu, *rw_w0,
      *rw_w2, *rw_a0, *rw_a2, *rw_k_k, *rw_k_a, *rw_r_k, *rw_ln_w, *rw_ln_b, *gd_conv_w, *gd_a_log, *gd_dt_bias,
      *gd_norm_w, *w_out_a, *w_out_b, *w_out, *norm_post;
  GLOBAL_AS float* out;
  GLOBAL_AS char* ws;
};
typedef const CONST_AS ParamsG* PP;
__device__ __forceinline__ Params PV(PP pp) {
  Params v;
  v.x_prompt = (const float*)pp->x_prompt;
  v.x_sample = (const float*)pp->x_sample;
  v.st_shift = (const float*)pp->st_shift;
  v.st_wkv = (const float*)pp->st_wkv;
  v.st_conv = (const float*)pp->st_conv;
  v.st_ssm = (const float*)pp->st_ssm;
  v.meta = (const float*)pp->meta;
  v.norm_pre = (const float*)pp->norm_pre;
  v.w_in = (const float*)pp->w_in;
  v.rw_mu = (const float*)pp->rw_mu;
  v.rw_w0 = (const float*)pp->rw_w0;
  v.rw_w2 = (const float*)pp->rw_w2;
  v.rw_a0 = (const float*)pp->rw_a0;
  v.rw_a2 = (const float*)pp->rw_a2;
  v.rw_k_k = (const float*)pp->rw_k_k;
  v.rw_k_a = (const float*)pp->rw_k_a;
  v.rw_r_k = (const float*)pp->rw_r_k;
  v.rw_ln_w = (const float*)pp->rw_ln_w;
  v.rw_ln_b = (const float*)pp->rw_ln_b;
  v.gd_conv_w = (const float*)pp->gd_conv_w;
  v.gd_a_log = (const float*)pp->gd_a_log;
  v.gd_dt_bias = (const float*)pp->gd_dt_bias;
  v.gd_norm_w = (const float*)pp->gd_norm_w;
  v.w_out_a = (const float*)pp->w_out_a;
  v.w_out_b = (const float*)pp->w_out_b;
  v.w_out = (const float*)pp->w_out;
  v.norm_post = (const float*)pp->norm_post;
  v.out = (float*)pp->out;
  v.ws = (char*)pp->ws;
  return v;
}
constexpr size_t al256(size_t x) { return (x + 255) & ~(size_t)255; }
constexpr size_t OO_y_prompt = 0;
constexpr size_t OO_y_sample = OO_y_prompt + (size_t)2 * 8192 * 1024;
constexpr size_t OO_p_shift = OO_y_sample + (size_t)32 * 16 * 1024;
constexpr size_t OO_p_wkv = OO_p_shift + 2 * 3200;
constexpr size_t OO_p_conv = OO_p_wkv + 2 * 16 * 4096;
constexpr size_t OO_p_ssm = OO_p_conv + 2 * 3 * 3072;
constexpr size_t OO_s_shift = OO_p_ssm + 2 * 8 * 16384;
constexpr size_t OO_s_wkv = OO_s_shift + 32 * 3200;
constexpr size_t OO_s_conv = OO_s_wkv + 32 * 16 * 4096;
constexpr size_t OO_s_ssm = OO_s_conv + 32 * 3 * 3072;
constexpr size_t OW_sync = 0;
constexpr size_t OW_WtIn = OW_sync + 16384;
constexpr size_t OW_WtA = OW_WtIn + al256((size_t)VW * DM * 2);
constexpr size_t OW_WtB = OW_WtA + al256((size_t)DM * DM * 2);
constexpr size_t OW_WtO = OW_WtB + al256((size_t)DM * DM * 2);
constexpr size_t OW_XN = OW_WtO + al256((size_t)DM * DM * 2);
constexpr size_t OW_PJA = OW_XN + al256((size_t)MP0 * DM * 2);
constexpr size_t OW_YA = OW_PJA + al256((size_t)MP0 * PJW * 2);
constexpr size_t OW_YB = OW_YA + al256((size_t)2 * MP0 * DM * 2);
constexpr size_t OW_MG = OW_YB + al256((size_t)2 * MP0 * DM * 2);
constexpr size_t OW_OUTB = OW_MG + al256((size_t)MP0 * DM * 2);
constexpr size_t OW_TMP = OW_OUTB + al256((size_t)2 * MP0 * DM * 4);
constexpr size_t OW_GT = OW_TMP + al256((size_t)2 * MP0 * DM * 4);
constexpr size_t OW_RWS = OW_GT + al256((size_t)GT_ROWS * GTW * 2);
constexpr size_t OW_GDS = OW_RWS + al256((size_t)SLOT_ROWS * RWS_ROWB);
constexpr size_t OW_RWB = OW_GDS + al256((size_t)SLOT_ROWS * GDS_ROWB + 256);
constexpr size_t OW_YRW = OW_RWB + al256((size_t)SLOT_ROWS * 16 * 4);
constexpr size_t OW_OGD = OW_YRW + al256((size_t)SLOT_ROWS * DM * 4);
constexpr size_t OW_CSH = OW_OGD + al256((size_t)SLOT_ROWS * DM * 4);
constexpr size_t OW_CCV = OW_CSH + al256((size_t)2 * 2 * 3200 * 4);
constexpr size_t OW_END = OW_CCV + al256((size_t)2 * 2 * 3 * 3072 * 4);


__device__ __forceinline__ bf16_t f2bf(float f) {
  uint32_t u = __float_as_uint(f);
  u += 0x7fffu + ((u >> 16) & 1u);
  return (bf16_t)(u >> 16);
}
__device__ __forceinline__ float bf2f(bf16_t h) { return __uint_as_float(((uint32_t)h) << 16); }
__device__ __forceinline__ uint32_t pack2(float a, float b) { return (uint32_t)f2bf(a) | ((uint32_t)f2bf(b) << 16); }
__device__ __forceinline__ float sigmoidf_(float x) { return 1.0f / (1.0f + __expf(-x)); }
__device__ __forceinline__ float siluf_(float x) { return x / (1.0f + __expf(-x)); }
__device__ __forceinline__ float softplusf_(float x) { return fmaxf(x, 0.0f) + log1pf(__expf(-fabsf(x))); }

__device__ __forceinline__ int tid_l() { int t = threadIdx.x; asm volatile("" : "+v"(t)); return t; }
#define LAUNDER_PP asm volatile("" : "+s"(pp))
template <int CTRL>
__device__ __forceinline__ float dppf(float x) {
  return __builtin_bit_cast(float, __builtin_amdgcn_update_dpp(0, __builtin_bit_cast(int, x), CTRL, 0xf, 0xf, true));
}
__device__ __forceinline__ float rowsum16(float x) {
  x += dppf<0xB1>(x);
  x += dppf<0x4E>(x);
  x += dppf<0x141>(x);
  x += dppf<0x140>(x);
  return x;
}
__device__ __forceinline__ float wavesum(float x) {
  x = rowsum16(x);
  x += __shfl_xor(x, 16);
  x += __shfl_xor(x, 32);
  return x;
}

#define SW_XCNT(j) (64 * (1 + (j)))
#define SW_XSUB(j) (64 * (9 + (j)))
#define SW_XGEN(j) (64 * (17 + (j)))
#define SW_TOP (64 * 25)
#define SW_TOPGEN (64 * 26)
#define SW_PRE (64 * 27)
#define SW_SCAN(s) (64 * (28 + (s)))
#define SW_SCNT(j) (64 * (44 + (j)))
#define SW_SSUB(seg, x) (3328 + ((seg) * 8 + (x)) * 4)
#define SYNC_BYTES 16384
__device__ __forceinline__ unsigned xb_ld(const unsigned* ptr) {
  return __hip_atomic_load(ptr, __ATOMIC_RELAXED, __HIP_MEMORY_SCOPE_AGENT);
}
__device__ __forceinline__ unsigned xb_add(unsigned* ptr, unsigned v) {
  return __hip_atomic_fetch_add(ptr, v, __ATOMIC_RELAXED, __HIP_MEMORY_SCOPE_AGENT);
}
__device__ __forceinline__ unsigned xcc_id() { return (unsigned)__builtin_amdgcn_s_getreg((3 << 11) | 20) & 0xFu; }
__device__ __forceinline__ void wait_ge(const unsigned* ptr, unsigned target) {
  if (threadIdx.x == 0) {
    while (xb_ld(ptr) < target) __builtin_amdgcn_s_sleep(8);
    __builtin_amdgcn_fence(__ATOMIC_ACQUIRE, "agent");
    asm volatile("s_waitcnt vmcnt(0)" ::: "memory");
  }
  __syncthreads();
}
__device__ __forceinline__ void signal_scan_done(unsigned* sync, int seg) {
  asm volatile("s_waitcnt vmcnt(0)" ::: "memory");
  __syncthreads();
  if (threadIdx.x == 0) {
    const unsigned x = xcc_id() & 7u;
    const unsigned nloc = xb_ld(&sync[SW_SCNT(x)]);
    const unsigned old = xb_add(&sync[SW_SSUB(seg, x)], 1u);
    if (old + 1u == nloc) {
      __builtin_amdgcn_fence(__ATOMIC_RELEASE, "agent");
      asm volatile("s_waitcnt vmcnt(0)" ::: "memory");
      xb_add(&sync[SW_SCAN(seg)], nloc);
    }
  }
}
__device__ __forceinline__ void worker_barrier(unsigned* bar, const unsigned* lds_cfg) {
  asm volatile("s_waitcnt vmcnt(0)" ::: "memory");
  __syncthreads();
  if (threadIdx.x == 0) {
    const unsigned x = xcc_id() & 7u, nloc = lds_cfg[0], nx = lds_cfg[1];
    const unsigned old = xb_add(&bar[SW_XSUB(x)], 1u);
    const unsigned gen = old / nloc;
    if (old + 1u == (gen + 1u) * nloc) {
      __builtin_amdgcn_fence(__ATOMIC_RELEASE, "agent");
      asm volatile("s_waitcnt vmcnt(0)" ::: "memory");
      const unsigned og = xb_add(&bar[SW_TOP], 1u);
      const unsigned tg = og / nx;
      if (og + 1u == (tg + 1u) * nx) xb_add(&bar[SW_TOPGEN], 1u);
      else while (xb_ld(&bar[SW_TOPGEN]) == tg) __builtin_amdgcn_s_sleep(1);
      __builtin_amdgcn_fence(__ATOMIC_ACQUIRE, "agent");
      xb_add(&bar[SW_XGEN(x)], 1u);
      asm volatile("s_waitcnt vmcnt(0)" ::: "memory");
    } else {
      while (xb_ld(&bar[SW_XGEN(x)]) == gen) __builtin_amdgcn_s_sleep(1);
      __builtin_amdgcn_fence(__ATOMIC_ACQUIRE, "agent");
      asm volatile("s_waitcnt vmcnt(0)" ::: "memory");
    }
  }
  __syncthreads();
}

__device__ __forceinline__ void lds_barrier() {
  asm volatile("s_waitcnt lgkmcnt(0)" ::: "memory");
  __builtin_amdgcn_s_barrier();
  asm volatile("" ::: "memory");
}

__device__ __forceinline__ int seg_M(int seg) { return seg == 0 ? M0 : M1; }
__device__ __forceinline__ int seg_MP(int seg) { return seg == 0 ? MP0 : M1; }
__device__ __forceinline__ int slot_row0(int seg) { int s = seg % 3; return s == 0 ? 0 : MP0 + (s - 1) * M1; }
__device__ __forceinline__ int gt_row0(int seg) { int s = seg & 3; return s == 0 ? 0 : MP0 + (s - 1) * M1; }
__device__ __forceinline__ const float* row_src(PP pp, int seg, int r) {
  if (seg == 0) {
    if (r < 1056) {
      int b = r >= 528 ? 1 : 0, t = r - b * 528;
      if (t < 16) return p.meta + t * DM;
      return p.x_prompt + ((size_t)b * 8192 + (t - 16)) * DM;
    }
    return p.x_sample + (size_t)(r - 1056) * DM;
  }
  int b = r >> 9, t = r & 511;
  return p.x_prompt + ((size_t)b * 8192 + seg * TS + t) * DM;
}
__device__ __forceinline__ float* row_dst(PP pp, int seg, int r) {
  if (seg == 0) {
    if (r < 1056) {
      int b = r >= 528 ? 1 : 0, t = r - b * 528;
      if (t < 16) return nullptr;
      return (p.out + OO_y_prompt) + ((size_t)b * 8192 + (t - 16)) * DM;
    }
    return (p.out + OO_y_sample) + (size_t)(r - 1056) * DM;
  }
  int b = r >> 9, t = r & 511;
  return (p.out + OO_y_prompt) + ((size_t)b * 8192 + seg * TS + t) * DM;
}
__device__ __forceinline__ void row_seq(int seg, int r, int& seq, int& t, int& len) {
  if (seg == 0) {
    if (r < 528) { seq = 0; t = r; len = 528; }
    else if (r < 1056) { seq = 1; t = r - 528; len = 528; }
    else { seq = 2 + ((r - 1056) >> 4); t = (r - 1056) & 15; len = 16; }
  } else { seq = r >> 9; t = r & 511; len = TS; }
}

__device__ __forceinline__ size_t blk_off(int row, int k) {
  const int kk = (k & 7) | (((((k >> 3) & 3) ^ ((row >> 2) & 3))) << 3);
  return ((size_t)((row >> 7) * 32 + (k >> 5)) * 128 + (row & 127)) * 32 + kk;
}

__device__ __forceinline__ int vcol_src(int n) {
  if (n < 3200) return n;
  if (n < 6288) return n + 1024;
  if (n < 6400) return -1;
  if (n < 7424) return n - 3200;
  return n - 112;
}
__device__ __forceinline__ void transpose_tile(const float* __restrict__ src, int ld, bool remap, bf16_t* __restrict__ dst, int k0, int n0,
                               float* tile  ) {
  int tid = tid_l();
  int i = tid >> 4, j = tid & 15;
  __syncthreads();
  int n = n0 + 4 * j;
  int sc = remap ? vcol_src(n) : n;
#pragma unroll
  for (int pass = 0; pass < 4; pass++) {
    int k = pass * 16 + i;
    float4 v = make_float4(0.f, 0.f, 0.f, 0.f);
    if (sc >= 0) v = *(const float4*)(src + (size_t)(k0 + k) * ld + sc);
    tile[k * 65 + 4 * j + 0] = v.x; tile[k * 65 + 4 * j + 1] = v.y; tile[k * 65 + 4 * j + 2] = v.z; tile[k * 65 + 4 * j + 3] = v.w;
  }
  __syncthreads();
  int nn = tid >> 2, kq = tid & 3;
  uint32_t o[8];
#pragma unroll
  for (int e = 0; e < 8; e++) o[e] = pack2(tile[(kq * 16 + 2 * e) * 65 + nn], tile[(kq * 16 + 2 * e + 1) * 65 + nn]);
  *(u32x4*)(dst + blk_off(n0 + nn, k0 + kq * 16)) = (u32x4){o[0], o[1], o[2], o[3]};
  *(u32x4*)(dst + blk_off(n0 + nn, k0 + kq * 16 + 8)) = (u32x4){o[4], o[5], o[6], o[7]};
}
__device__ __forceinline__ void phase_weights(PP pp, int bid, int nb, char* smem) {
  LAUNDER_PP;
  float* tile = (float*)smem;
  const int nIn = 16 * (VW / 64);
  const int nSq = 16 * 16;
  for (int it = bid; it < nIn + 3 * nSq; it += nb) {
    if (it < nIn) {
      int kt = it & 15, nt = it >> 4;
      transpose_tile(p.w_in, PW, true, ((bf16_t*)(p.ws + OW_WtIn)), kt * 64, nt * 64, tile);
    } else {
      int j = it - nIn, w = j / nSq, r = j % nSq;
      int kt = r & 15, nt = r >> 4;
      const float* src = w == 0 ? p.w_out_a : (w == 1 ? p.w_out_b : p.w_out);
      bf16_t* dst = w == 0 ? ((bf16_t*)(p.ws + OW_WtA)) : (w == 1 ? ((bf16_t*)(p.ws + OW_WtB)) : ((bf16_t*)(p.ws + OW_WtO)));
      transpose_tile(src, DM, false, dst, kt * 64, nt * 64, tile);
    }
  }
}

__device__ __forceinline__ void xn_item(PP pp, int seg, int item) {
  LAUNDER_PP;
  int wave = tid_l() >> 6, lane = tid_l() & 63;
  int M = seg_M(seg);
  int r = item * 4 + wave;
  bf16_t* o = ((bf16_t*)(p.ws + OW_XN));
  if (r >= M) {
#pragma unroll
    for (int i = 0; i < 4; i++) *(uint2*)(o + blk_off(r, (lane + 64 * i) * 4)) = make_uint2(0u, 0u);
    return;
  }
  const float4* src = (const float4*)row_src(pp, seg, r);
  float4 v[4];
  float ss = 0.f;
#pragma unroll
  for (int i = 0; i < 4; i++) {
    v[i] = src[lane + 64 * i];
    ss += v[i].x * v[i].x + v[i].y * v[i].y + v[i].z * v[i].z + v[i].w * v[i].w;
  }
  ss = wavesum(ss);
  float rstd = rsqrtf(ss * (1.0f / DM) + 1e-6f);
#pragma unroll
  for (int i = 0; i < 4; i++) {
    float4 g = ((const float4*)p.norm_pre)[lane + 64 * i];
    *(uint2*)(o + blk_off(r, (lane + 64 * i) * 4)) =
        make_uint2(pack2(v[i].x * rstd * g.x, v[i].y * rstd * g.y), pack2(v[i].z * rstd * g.z, v[i].w * rstd * g.w));
  }
}

__device__ __forceinline__ void norm_item(PP pp, int seg, int item) {
  LAUNDER_PP;
  int wave = tid_l() >> 6, lane = tid_l() & 63;
  int r = item * 4 + wave;
  float* dst = row_dst(pp, seg, r);
  if (!dst) return;
  const float4* h = (const float4*)row_src(pp, seg, r);
  const float4* o = (const float4*)(((float*)(p.ws + OW_OUTB)) + ((size_t)(seg & 1) * MP0 + r) * DM);
  float4 v[4];
  float ss = 0.f;
#pragma unroll
  for (int i = 0; i < 4; i++) {
    v[i] = o[lane + 64 * i];
    ss += v[i].x * v[i].x + v[i].y * v[i].y + v[i].z * v[i].z + v[i].w * v[i].w;
  }
  ss = wavesum(ss);
  float rstd = rsqrtf(ss * (1.0f / DM) + 1e-6f);
#pragma unroll
  for (int i = 0; i < 4; i++) {
    float4 g = ((const float4*)p.norm_post)[lane + 64 * i];
    float4 hh = h[lane + 64 * i];
    ((float4*)dst)[lane + 64 * i] =
        make_float4(hh.x + v[i].x * rstd * g.x, hh.y + v[i].y * rstd * g.y, hh.z + v[i].z * rstd * g.z, hh.w + v[i].w * rstd * g.w);
  }
}

__device__ __forceinline__ void merge_item(PP pp, int item) {
  LAUNDER_PP;
  const int tid = tid_l();
  const int wave = tid >> 6, lane = tid & 63;
  const int r = item * 4 + wave;
  const float4* t1 = (const float4*)((const float*)(p.ws + OW_TMP) + (size_t)r * DM);
  const float4* t2 = (const float4*)((const float*)(p.ws + OW_TMP) + ((size_t)MP0 + r) * DM);
  bf16_t* o = (bf16_t*)(p.ws + OW_MG);
#pragma unroll
  for (int i = 0; i < 4; i++) {
    float4 a = t1[lane + 64 * i], b = t2[lane + 64 * i];
    *(uint2*)(o + blk_off(r, (lane + 64 * i) * 4)) = make_uint2(pack2(a.x + b.x, a.y + b.y), pack2(a.z + b.z, a.w + b.w));
  }
}

#define LDT 32
template <int MODE>
__device__ __forceinline__ void gemm_tile(PP pp, int seg, int tm, int tn, char* smem) {
  LAUNDER_PP;
  const int tid = tid_l(), lane = tid & 63, wid = tid >> 6;
  const int wr = wid >> 1, wc = wid & 1, l31 = lane & 31, lh = lane >> 5;
  const int lrow = tid >> 2, lkc = tid & 3;
  const int m0 = tm * 128, n0 = tn * 128;
  bf16_t* GTs = ((bf16_t*)(p.ws + OW_GT)) + (size_t)gt_row0(seg) * GTW;
  f32x16 acc[2][2];
#pragma unroll
  for (int a = 0; a < 2; a++)
#pragma unroll
    for (int b = 0; b < 2; b++)
#pragma unroll
      for (int e = 0; e < 16; e++) acc[a][b][e] = 0.f;
  {
    const bf16_t* A = (MODE == 0) ? (const bf16_t*)(p.ws + OW_XN)
                    : (MODE == 1) ? (const bf16_t*)(p.ws + OW_YA) + (size_t)(seg & 1) * MP0 * DM
                    : (MODE == 3) ? (const bf16_t*)(p.ws + OW_YB) + (size_t)(seg & 1) * MP0 * DM
                                  : (const bf16_t*)(p.ws + OW_MG);
    const bf16_t* Bt = (const bf16_t*)(p.ws + (MODE == 0 ? OW_WtIn : (MODE == 1 ? OW_WtA : (MODE == 3 ? OW_WtB : OW_WtO))));
    u32x4 ra[2], rb[2];
    const bf16_t* gA = A + ((size_t)(tm * 32) * 128 + lrow) * 32 + lkc * 8;
    const bf16_t* gB = Bt + ((size_t)(tn * 32) * 128 + lrow) * 32 + lkc * 8;
    const int wofs = lrow * 64 + (lkc << 4);
    const int sw = (l31 >> 2) & 3;
    const int rofs0 = l31 * 64 + (((0 + lh) ^ sw) << 4);
    const int rofs1 = l31 * 64 + (((2 + lh) ^ sw) << 4);
    __syncthreads();
#pragma unroll
    for (int i = 0; i < 2; i++) {
      ra[i] = *(const u32x4*)(gA + (size_t)i * 2048);
      rb[i] = *(const u32x4*)(gB + (size_t)i * 2048);
    }
#pragma unroll
    for (int i = 0; i < 2; i++) {
      *(u32x4*)(smem + wofs + i * 4096) = ra[i];
      *(u32x4*)(smem + 8192 + wofs + i * 4096) = rb[i];
    }
#pragma unroll
    for (int i = 0; i < 2; i++) {
      ra[i] = *(const u32x4*)(gA + (size_t)i * 2048 + 4096);
      rb[i] = *(const u32x4*)(gB + (size_t)i * 2048 + 4096);
    }
    lds_barrier();
#pragma unroll 1
    for (int kt = 0; kt < 32; kt++) {
      const char* cA = smem + (kt & 1) * 16384 + wr * 4096;
      const char* cB = smem + (kt & 1) * 16384 + 8192 + wc * 4096;
      const bf16x8 x00 = *(const bf16x8*)(cA + rofs0), x01 = *(const bf16x8*)(cA + 2048 + rofs0);
      const bf16x8 w00 = *(const bf16x8*)(cB + rofs0), w01 = *(const bf16x8*)(cB + 2048 + rofs0);
      const bf16x8 x10 = *(const bf16x8*)(cA + rofs1), x11 = *(const bf16x8*)(cA + 2048 + rofs1);
      const bf16x8 w10 = *(const bf16x8*)(cB + rofs1), w11 = *(const bf16x8*)(cB + 2048 + rofs1);
      asm volatile("" ::: "memory");
      acc[0][0] = __builtin_amdgcn_mfma_f32_32x32x16_bf16(w00, x00, acc[0][0], 0, 0, 0);
      acc[0][1] = __builtin_amdgcn_mfma_f32_32x32x16_bf16(w00, x01, acc[0][1], 0, 0, 0);
      acc[1][0] = __builtin_amdgcn_mfma_f32_32x32x16_bf16(w01, x00, acc[1][0], 0, 0, 0);
      acc[1][1] = __builtin_amdgcn_mfma_f32_32x32x16_bf16(w01, x01, acc[1][1], 0, 0, 0);
      acc[0][0] = __builtin_amdgcn_mfma_f32_32x32x16_bf16(w10, x10, acc[0][0], 0, 0, 0);
      acc[0][1] = __builtin_amdgcn_mfma_f32_32x32x16_bf16(w10, x11, acc[0][1], 0, 0, 0);
      acc[1][0] = __builtin_amdgcn_mfma_f32_32x32x16_bf16(w11, x10, acc[1][0], 0, 0, 0);
      acc[1][1] = __builtin_amdgcn_mfma_f32_32x32x16_bf16(w11, x11, acc[1][1], 0, 0, 0);
      if (kt + 1 < 32) {
        char* nx = smem + ((kt + 1) & 1) * 16384;
#pragma unroll
        for (int i = 0; i < 2; i++) {
          *(u32x4*)(nx + wofs + i * 4096) = ra[i];
          *(u32x4*)(nx + 8192 + wofs + i * 4096) = rb[i];
        }
        if (kt + 2 < 32) {
#pragma unroll
          for (int i = 0; i < 2; i++) {
            ra[i] = *(const u32x4*)(gA + (size_t)i * 2048 + (size_t)(kt + 2) * 4096);
            rb[i] = *(const u32x4*)(gB + (size_t)i * 2048 + (size_t)(kt + 2) * 4096);
          }
        }
      }
      lds_barrier();
    }
  }
  float* OUTBp = (MODE == 2) ? (float*)(p.ws + OW_OUTB) + (size_t)(seg & 1) * MP0 * DM
                             : (float*)(p.ws + OW_TMP) + (size_t)(MODE == 3 ? 1 : 0) * MP0 * DM;
#pragma unroll
  for (int ni = 0; ni < 2; ni++)
#pragma unroll
    for (int mi = 0; mi < 2; mi++)
#pragma unroll
      for (int g = 0; g < 4; g++) {
        const int m = m0 + wr * 64 + mi * 32 + l31;
        const int n = n0 + wc * 64 + ni * 32 + 8 * g + 4 * lh;
        const float c0 = acc[ni][mi][4 * g], c1 = acc[ni][mi][4 * g + 1], c2 = acc[ni][mi][4 * g + 2], c3 = acc[ni][mi][4 * g + 3];
        if (MODE == 0) {
          uint2 o = make_uint2(pack2(c0, c1), pack2(c2, c3));
          if (tn < PJW / 128) *(uint2*)(((bf16_t*)(p.ws + OW_PJA)) + (size_t)m * PJW + n) = o;
          else *(uint2*)(GTs + (size_t)m * GTW + (n - PJW)) = o;
        } else if (MODE == 1 || MODE == 3) {
          uint2 ga = *(const uint2*)(GTs + (size_t)m * GTW + (MODE == 1 ? G_MA : G_MB) + n);
          *(float4*)(OUTBp + (size_t)m * DM + n) =
              make_float4(sigmoidf_(bf2f(ga.x & 0xffff)) * c0, sigmoidf_(bf2f(ga.x >> 16)) * c1,
                          sigmoidf_(bf2f(ga.y & 0xffff)) * c2, sigmoidf_(bf2f(ga.y >> 16)) * c3);
        } else {
          *(float4*)(OUTBp + (size_t)m * DM + n) = make_float4(c0, c1, c2, c3);
        }
      }
}

__device__ __forceinline__ void rw_prepass_item(PP pp, int seg, int grp, int slab, char* smem) {
  LAUNDER_PP;
  float* lwa = (float*)smem;
  const int tid = tid_l();
  const int r0 = grp * 8;
  int seq, t0, len;
  row_seq(seg, r0, seq, t0, len);
  const bool prompt = seq < 2;
  const float* prev0 = nullptr;
  if (t0 == 0) {
    if (seg == 0) prev0 = prompt ? nullptr : p.st_shift + (size_t)(seq - 2) * 3200;
    else prev0 = ((float*)(p.ws + OW_CSH)) + ((size_t)(seg & 1) * 2 + seq) * 3200;
  }
  __syncthreads();
  {
    const int j = tid & 127;
    const float mu = p.rw_mu[3072 + j];
#pragma unroll
    for (int i = 0; i < 4; i++) {
      int tok = (tid >> 7) + 2 * i;
      int row = r0 + tok;
      float ps = bf2f(((bf16_t*)(p.ws + OW_PJA))[(size_t)row * PJW + 3072 + j]);
      float pv;
      if (tok == 0 && t0 == 0) pv = prev0 ? prev0[3072 + j] : 0.f;
      else pv = bf2f(((bf16_t*)(p.ws + OW_PJA))[(size_t)(row - 1) * PJW + 3072 + j]);
      float xs = ps + mu * (pv - ps);
      lwa[tok * 128 + j] = j < 64 ? tanhf(xs) : xs;
      if (slab == 0 && t0 + tok == len - 1) {
        if (prompt) {
          ((float*)(p.ws + OW_CSH))[((size_t)((seg + 1) & 1) * 2 + seq) * 3200 + 3072 + j] = ps;
          if (seg == NSEG - 1) (p.out + OO_p_shift)[(size_t)seq * 3200 + 3072 + j] = ps;
        } else {
          (p.out + OO_s_shift)[(size_t)(seq - 2) * 3200 + 3072 + j] = ps;
        }
      }
    }
  }
  __syncthreads();
  const int c = slab * 256 + tid;
  float dw[8], da[8];
  {
    const float w0 = p.rw_w0[c], a0 = p.rw_a0[c];
#pragma unroll
    for (int t = 0; t < 8; t++) { dw[t] = w0; da[t] = a0; }
  }
  for (int j = 0; j < 64; j += 4) {
    float w2v[4], a2v[4];
#pragma unroll
    for (int e = 0; e < 4; e++) {
      w2v[e] = p.rw_w2[(size_t)(j + e) * DM + c];
      a2v[e] = p.rw_a2[(size_t)(j + e) * DM + c];
    }
#pragma unroll
    for (int t = 0; t < 8; t++) {
      float4 lw = *(const float4*)(lwa + t * 128 + j);
      float4 la = *(const float4*)(lwa + t * 128 + 64 + j);
      dw[t] += lw.x * w2v[0] + lw.y * w2v[1] + lw.z * w2v[2] + lw.w * w2v[3];
      da[t] += la.x * a2v[0] + la.y * a2v[1] + la.z * a2v[2] + la.w * a2v[3];
    }
  }
  const float mur = p.rw_mu[c], muk = p.rw_mu[1024 + c], muv = p.rw_mu[2048 + c];
  const float kk_w = p.rw_k_k[c], ka_w = p.rw_k_a[c], rk_w = p.rw_r_k[c];
  float pr, pk, pv;
  if (t0 == 0) {
    pr = prev0 ? prev0[c] : 0.f; pk = prev0 ? prev0[1024 + c] : 0.f; pv = prev0 ? prev0[2048 + c] : 0.f;
  } else {
    const bf16_t* q = ((bf16_t*)(p.ws + OW_PJA)) + (size_t)(r0 - 1) * PJW;
    pr = bf2f(q[c]); pk = bf2f(q[1024 + c]); pv = bf2f(q[2048 + c]);
  }
  const int head = c >> 6, e = c & 63;
  const int srow0 = slot_row0(seg);
  char* rws = ((char*)(p.ws + OW_RWS)) + ((size_t)(srow0 + r0) * 16 + head) * 1024;
  float* rwb = ((float*)(p.ws + OW_RWB)) + (size_t)(srow0 + r0) * 16 + head;
#pragma unroll
  for (int t = 0; t < 8; t++) {
    const int row = r0 + t;
    const bf16_t* q = ((bf16_t*)(p.ws + OW_PJA)) + (size_t)row * PJW;
    float cr = bf2f(q[c]), ck = bf2f(q[1024 + c]), cv = bf2f(q[2048 + c]);
    float xr = cr + mur * (pr - cr), xk = ck + muk * (pk - ck), xv = cv + muv * (pv - cv);
    pr = cr; pk = ck; pv = cv;
    float w_log = -softplusf_(-dw[t]) - 0.5f;
    float decay = __expf(-__expf(w_log));
    float a = sigmoidf_(da[t]);
    float kkr = xk * kk_w;
    float ss = wavesum(kkr * kkr);
    float kk = kkr * rsqrtf(ss + 1e-6f);
    float k2 = xk * (1.0f + (a - 1.0f) * ka_w);
    float bon = wavesum(xr * k2 * rk_w);
    char* o = rws + (size_t)t * RWS_ROWB;
    ((f16*)o)[e] = (f16)xr;
    ((f16*)(o + 128))[e] = (f16)k2;
    ((f16*)(o + 256))[e] = (f16)(-kk);
    ((f16*)(o + 384))[e] = (f16)(kk * a);
    ((float*)(o + 512))[e] = decay;
    ((float*)(o + 768))[e] = xv;
    if ((tid & 63) == 0) rwb[(size_t)t * 16] = bon;
    if (t0 + t == len - 1) {
      if (prompt) {
        float* cs = ((float*)(p.ws + OW_CSH)) + ((size_t)((seg + 1) & 1) * 2 + seq) * 3200;
        cs[c] = cr; cs[1024 + c] = ck; cs[2048 + c] = cv;
        if (seg == NSEG - 1) {
          float* ps = (p.out + OO_p_shift) + (size_t)seq * 3200;
          ps[c] = cr; ps[1024 + c] = ck; ps[2048 + c] = cv;
        }
      } else {
        float* ps = (p.out + OO_s_shift) + (size_t)(seq - 2) * 3200;
        ps[c] = cr; ps[1024 + c] = ck; ps[2048 + c] = cv;
      }
    }
  }
}

__device__ __forceinline__ void gd_prepass_item(PP pp, int seg, int grp, int slab) {
  LAUNDER_PP;
  const int tid = tid_l();
  const int r0 = grp * 16;
  int seq, t0, len;
  row_seq(seg, r0, seq, t0, len);
  const bool prompt = seq < 2;
  const int c = slab * 512 + 2 * tid;
  const int kind = slab >> 1;
  const int head = (c & 1023) >> 7, e = c & 127;
  float2 x0, x1, x2;
  if (t0 == 0) {
    const float* cp = nullptr;
    if (seg == 0) cp = prompt ? nullptr : p.st_conv + (size_t)(seq - 2) * 3 * 3072;
    else cp = ((float*)(p.ws + OW_CCV)) + ((size_t)(seg & 1) * 2 + seq) * 3 * 3072;
    if (cp) {
      x0 = *(const float2*)(cp + c); x1 = *(const float2*)(cp + 3072 + c); x2 = *(const float2*)(cp + 6144 + c);
    } else {
      x0 = x1 = x2 = make_float2(0.f, 0.f);
    }
  } else {
    uint32_t u0 = *(const uint32_t*)(((bf16_t*)(p.ws + OW_PJA)) + (size_t)(r0 - 3) * PJW + C_GDC + c);
    uint32_t u1 = *(const uint32_t*)(((bf16_t*)(p.ws + OW_PJA)) + (size_t)(r0 - 2) * PJW + C_GDC + c);
    uint32_t u2 = *(const uint32_t*)(((bf16_t*)(p.ws + OW_PJA)) + (size_t)(r0 - 1) * PJW + C_GDC + c);
    x0 = make_float2(bf2f(u0 & 0xffff), bf2f(u0 >> 16));
    x1 = make_float2(bf2f(u1 & 0xffff), bf2f(u1 >> 16));
    x2 = make_float2(bf2f(u2 & 0xffff), bf2f(u2 >> 16));
  }
  const float2 w0 = *(const float2*)(p.gd_conv_w + c), w1 = *(const float2*)(p.gd_conv_w + 3072 + c),
               w2 = *(const float2*)(p.gd_conv_w + 6144 + c), w3 = *(const float2*)(p.gd_conv_w + 9216 + c);
  const float a_exp = __expf(p.gd_a_log[head]);
  const float dtb = p.gd_dt_bias[head];
  char* gds = ((char*)(p.ws + OW_GDS)) + ((size_t)(slot_row0(seg) + r0) * 8 + head) * GDS_HB;
#pragma unroll 4
  for (int t = 0; t < 16; t++) {
    const int row = r0 + t;
    uint32_t u = *(const uint32_t*)(((bf16_t*)(p.ws + OW_PJA)) + (size_t)row * PJW + C_GDC + c);
    float2 x3 = make_float2(bf2f(u & 0xffff), bf2f(u >> 16));
    float cx = w0.x * x0.x + w1.x * x1.x + w2.x * x2.x + w3.x * x3.x;
    float cy = w0.y * x0.y + w1.y * x1.y + w2.y * x2.y + w3.y * x3.y;
    x0 = x1; x1 = x2; x2 = x3;
    float ax = siluf_(cx), ay = siluf_(cy);
    float sc = 1.0f;
    if (kind < 2) {
      float ss = wavesum(ax * ax + ay * ay);
      sc = rsqrtf(ss + 1e-6f);
      if (kind == 0) sc *= 0.08838834764831845f;
    }
    if (kind >= 1) {
      float beta = sigmoidf_(bf2f(((bf16_t*)(p.ws + OW_PJA))[(size_t)row * PJW + C_BETA + head]));
      sc *= sqrtf(beta);
    }
    ax *= sc; ay *= sc;
    char* o = gds + (size_t)t * GDS_ROWB;
    f16x2 hv = {(f16)ax, (f16)ay};
    *(f16x2*)(o + kind * 256 + e * 2) = hv;
    if (kind == 0 && (tid & 63) == 0) {
      float g = -a_exp * softplusf_(bf2f(((bf16_t*)(p.ws + OW_PJA))[(size_t)row * PJW + C_ALPHA + head]) + dtb);
      *(float*)(o + 768) = __expf(g);
    }
    int jj = t0 + t - (len - 3);
    if (jj >= 0) {
      if (prompt) {
        *(float2*)(((float*)(p.ws + OW_CCV)) + (((size_t)((seg + 1) & 1) * 2 + seq) * 3 + jj) * 3072 + c) = x3;
        if (seg == NSEG - 1) *(float2*)((p.out + OO_p_conv) + ((size_t)seq * 3 + jj) * 3072 + c) = x3;
      } else {
        *(float2*)((p.out + OO_s_conv) + ((size_t)(seq - 2) * 3 + jj) * 3072 + c) = x3;
      }
    }
  }
}


using u32x2 = __attribute__((ext_vector_type(2))) unsigned int;
__device__ __forceinline__ float fmix_lo(unsigned h, float b, float c) {
  float d;
  asm("v_fma_mix_f32 %0, %1, %2, %3 op_sel_hi:[1,0,0]" : "=v"(d) : "v"(h), "v"(b), "v"(c));
  return d;
}
__device__ __forceinline__ float fmix_hi(unsigned h, float b, float c) {
  float d;
  asm("v_fma_mix_f32 %0, %1, %2, %3 op_sel:[1,0,0] op_sel_hi:[1,0,0]" : "=v"(d) : "v"(h), "v"(b), "v"(c));
  return d;
}
__device__ __forceinline__ float vmul1(float a, float b) {
  float d;
  asm("v_mul_f32 %0, %1, %2" : "=v"(d) : "v"(a), "v"(b));
  return d;
}
struct RwOps { f16x4 r, k, a, b; float4 w; float vv; };
__device__ __forceinline__ RwOps rw_ld(const char* Ls, int q, int v) {
  RwOps o;
  o.r = *(const f16x4*)(Ls + q * 8);
  o.k = *(const f16x4*)(Ls + 128 + q * 8);
  o.a = *(const f16x4*)(Ls + 256 + q * 8);
  o.b = *(const f16x4*)(Ls + 384 + q * 8);
  o.w = *(const float4*)(Ls + 512 + q * 16);
  o.vv = *(const float*)(Ls + 768 + v * 4);
  return o;
}
__device__ __forceinline__ float rw_step(const RwOps& o, float4& S) {
  const u32x2 rw = __builtin_bit_cast(u32x2, o.r), kw = __builtin_bit_cast(u32x2, o.k),
              aw = __builtin_bit_cast(u32x2, o.a), bw = __builtin_bit_cast(u32x2, o.b);
  const float z = 0.f;
  float sa0 = fmix_lo(aw[0], S.x, z);
  float sa1 = fmix_lo(aw[1], S.z, z);
  sa0 = fmix_hi(aw[0], S.y, sa0);
  sa1 = fmix_hi(aw[1], S.w, sa1);
  float t0 = vmul1(S.x, o.w.x), t1 = vmul1(S.y, o.w.y), t2 = vmul1(S.z, o.w.z), t3 = vmul1(S.w, o.w.w);
  t0 = fmix_lo(kw[0], o.vv, t0);
  t1 = fmix_hi(kw[0], o.vv, t1);
  t2 = fmix_lo(kw[1], o.vv, t2);
  t3 = fmix_hi(kw[1], o.vv, t3);
  const float sa = rowsum16(sa0 + sa1);
  S.x = fmix_lo(bw[0], sa, t0);
  S.y = fmix_hi(bw[0], sa, t1);
  S.z = fmix_lo(bw[1], sa, t2);
  S.w = fmix_hi(bw[1], sa, t3);
  float y0 = fmix_lo(rw[0], S.x, z);
  float y1 = fmix_lo(rw[1], S.z, z);
  y0 = fmix_hi(rw[0], S.y, y0);
  y1 = fmix_hi(rw[1], S.w, y1);
  return rowsum16(y0 + y1);
}
__device__ __forceinline__ void rw_scan_run(const char* __restrict__ gsrc  , int len, float4& S,
                            float* __restrict__ yo  , int q, int v, char* smem) {
  const int tid = tid_l();
  const int nch = len >> 4;
  const int lstep = tid >> 6, loff = (tid & 63) * 16;
  u32x4 st[4];
#pragma unroll
  for (int i = 0; i < 4; i++) st[i] = *(const u32x4*)(gsrc + (size_t)(lstep + 4 * i) * RWS_ROWB + loff);
  __syncthreads();
#pragma unroll
  for (int i = 0; i < 4; i++) *(u32x4*)(smem + (lstep + 4 * i) * 1024 + loff) = st[i];
  u32x4 st2[4];
#pragma unroll
  for (int i = 0; i < 4; i++) st2[i] = st[i];
  if (nch > 1) {
#pragma unroll
    for (int i = 0; i < 4; i++) st[i] = *(const u32x4*)(gsrc + (size_t)(16 + lstep + 4 * i) * RWS_ROWB + loff);
  }
  if (nch > 2) {
#pragma unroll
    for (int i = 0; i < 4; i++) st2[i] = *(const u32x4*)(gsrc + (size_t)(32 + lstep + 4 * i) * RWS_ROWB + loff);
  }
  __syncthreads();
  for (int c = 0; c < nch; c++) {
    const char* L = smem + (c & 1) * 16384;
    float ykeep = 0.f;
    RwOps oa = rw_ld(L, q, v);
#pragma unroll 1
    for (int t = 0; t < 16; t += 2) {
      const RwOps ob = rw_ld(L + (t + 1) * 1024, q, v);
      asm volatile("" ::: "memory");
      const float ya = rw_step(oa, S);
      ykeep = (q == t) ? ya : ykeep;
      oa = rw_ld(L + ((t + 2) & 15) * 1024, q, v);
      asm volatile("" ::: "memory");
      const float yb = rw_step(ob, S);
      ykeep = (q == t + 1) ? yb : ykeep;
    }
    yo[(size_t)(c * 16 + q) * DM] = ykeep;
    if (c + 1 < nch) {
      char* Ln = smem + ((c + 1) & 1) * 16384;
#pragma unroll
      for (int i = 0; i < 4; i++) *(u32x4*)(Ln + (lstep + 4 * i) * 1024 + loff) = st[i];
#pragma unroll
      for (int i = 0; i < 4; i++) st[i] = st2[i];
      if (c + 3 < nch) {
#pragma unroll
        for (int i = 0; i < 4; i++)
          st2[i] = *(const u32x4*)(gsrc + (size_t)((c + 3) * 16 + lstep + 4 * i) * RWS_ROWB + loff);
      }
    }
    lds_barrier();
  }
}

struct GdOps { f16x8 qv, kv; float vv, eg; };
__device__ __forceinline__ GdOps gd_ld(const char* Ls, int q, int cl) {
  GdOps o;
  o.kv = *(const f16x8*)(Ls + 256 + q * 16);
  o.vv = (float)*(const f16*)(Ls + 512 + cl * 2);
  o.eg = *(const float*)(Ls + 768);
  o.qv = *(const f16x8*)(Ls + q * 16);
  return o;
}
__device__ __forceinline__ float gd_step(const GdOps& o, float (&s)[8]) {
  const u32x4 kw = __builtin_bit_cast(u32x4, o.kv), qw = __builtin_bit_cast(u32x4, o.qv);
  const float z = 0.f;
  float a0 = fmix_lo(kw[0], s[0], z);
  float a1 = fmix_lo(kw[2], s[4], z);
  a0 = fmix_hi(kw[0], s[1], a0);
  a1 = fmix_hi(kw[2], s[5], a1);
  a0 = fmix_lo(kw[1], s[2], a0);
  a1 = fmix_lo(kw[3], s[6], a1);
  a0 = fmix_hi(kw[1], s[3], a0);
  a1 = fmix_hi(kw[3], s[7], a1);
  float es[8];
#pragma unroll
  for (int i = 0; i < 8; i++) es[i] = vmul1(o.eg, s[i]);
  const float ks = rowsum16(a0 + a1);
  const float d = fmaf(-o.eg, ks, o.vv);
  s[0] = fmix_lo(kw[0], d, es[0]); s[1] = fmix_hi(kw[0], d, es[1]);
  s[2] = fmix_lo(kw[1], d, es[2]); s[3] = fmix_hi(kw[1], d, es[3]);
  s[4] = fmix_lo(kw[2], d, es[4]); s[5] = fmix_hi(kw[2], d, es[5]);
  s[6] = fmix_lo(kw[3], d, es[6]); s[7] = fmix_hi(kw[3], d, es[7]);
  float o0 = fmix_lo(qw[0], s[0], z);
  float o1 = fmix_lo(qw[2], s[4], z);
  o0 = fmix_hi(qw[0], s[1], o0);
  o1 = fmix_hi(qw[2], s[5], o1);
  o0 = fmix_lo(qw[1], s[2], o0);
  o1 = fmix_lo(qw[3], s[6], o1);
  o0 = fmix_hi(qw[1], s[3], o0);
  o1 = fmix_hi(qw[3], s[7], o1);
  return rowsum16(o0 + o1);
}
__device__ __forceinline__ void gd_scan_run(const char* __restrict__ gsrc  , int len, float (&s)[8],
                            float* __restrict__ oo  , int q, int cl, char* smem) {
  const int tid = tid_l();
  const int nch = len >> 4;
  u32x4 st[4];
  int lt[4], lo[4];
#pragma unroll
  for (int i = 0; i < 4; i++) {
    int id = tid + 256 * i;
    if (id > 783) id = 783;
    lt[i] = id / 49;
    lo[i] = (id % 49) * 16;
  }
#pragma unroll
  for (int i = 0; i < 4; i++) st[i] = *(const u32x4*)(gsrc + (size_t)lt[i] * GDS_ROWB + lo[i]);
  __syncthreads();
#pragma unroll
  for (int i = 0; i < 4; i++) *(u32x4*)(smem + lt[i] * GDS_HB + lo[i]) = st[i];
  u32x4 st2[4];
#pragma unroll
  for (int i = 0; i < 4; i++) st2[i] = st[i];
  if (nch > 1) {
#pragma unroll
    for (int i = 0; i < 4; i++) st[i] = *(const u32x4*)(gsrc + (size_t)(16 + lt[i]) * GDS_ROWB + lo[i]);
  }
  if (nch > 2) {
#pragma unroll
    for (int i = 0; i < 4; i++) st2[i] = *(const u32x4*)(gsrc + (size_t)(32 + lt[i]) * GDS_ROWB + lo[i]);
  }
  __syncthreads();
  for (int c = 0; c < nch; c++) {
    const char* L = smem + (c & 1) * 16384;
    float okeep = 0.f;
    GdOps oa = gd_ld(L, q, cl);
#pragma unroll 1
    for (int t = 0; t < 16; t += 2) {
      const GdOps ob = gd_ld(L + (t + 1) * GDS_HB, q, cl);
      asm volatile("" ::: "memory");
      const float ya = gd_step(oa, s);
      okeep = (q == t) ? ya : okeep;
      oa = gd_ld(L + ((t + 2) & 15) * GDS_HB, q, cl);
      asm volatile("" ::: "memory");
      const float yb = gd_step(ob, s);
      okeep = (q == t + 1) ? yb : okeep;
    }
    oo[(size_t)(c * 16 + q) * DM] = okeep;
    if (c + 1 < nch) {
      char* Ln = smem + ((c + 1) & 1) * 16384;
#pragma unroll
      for (int i = 0; i < 4; i++) *(u32x4*)(Ln + lt[i] * GDS_HB + lo[i]) = st[i];
#pragma unroll
      for (int i = 0; i < 4; i++) st[i] = st2[i];
      if (c + 3 < nch) {
#pragma unroll
        for (int i = 0; i < 4; i++) st2[i] = *(const u32x4*)(gsrc + (size_t)((c + 3) * 16 + lt[i]) * GDS_ROWB + lo[i]);
      }
    }
    lds_barrier();
  }
}

__device__ __forceinline__ void sample_scan_task(PP pp, int task, char* smem) {
  LAUNDER_PP;
  const int sj = task >> 7, j = task & 127, kind = j >> 6, jj = j & 63;
  const int tid = tid_l(), q = tid & 15;
  const int row0 = 1056 + sj * 16;
  if (kind == 0) {
    const int head = jj >> 2, v = (jj & 3) * 16 + (tid >> 4);
    const float* sin = p.st_wkv + ((size_t)sj * 16 + head) * 4096;
    float* sout = (p.out + OO_s_wkv) + ((size_t)sj * 16 + head) * 4096;
    float4 S = *(const float4*)(sin + v * 64 + 4 * q);
    rw_scan_run(((char*)(p.ws + OW_RWS)) + ((size_t)row0 * 16 + head) * 1024, 16, S, ((float*)(p.ws + OW_YRW)) + (size_t)row0 * DM + head * 64 + v, q, v, smem);
    *(float4*)(sout + v * 64 + 4 * q) = S;
  } else {
    const int head = jj >> 3, cl = (jj & 7) * 16 + (tid >> 4);
    const float* sin = p.st_ssm + ((size_t)sj * 8 + head) * 16384;
    float* sout = (p.out + OO_s_ssm) + ((size_t)sj * 8 + head) * 16384;
    float s[8];
#pragma unroll
    for (int i = 0; i < 8; i++) s[i] = sin[(size_t)(8 * q + i) * 128 + cl];
    gd_scan_run(((char*)(p.ws + OW_GDS)) + ((size_t)row0 * 8 + head) * GDS_HB, 16, s, ((float*)(p.ws + OW_OGD)) + (size_t)row0 * DM + head * 128 + cl, q, cl, smem);
#pragma unroll
    for (int i = 0; i < 8; i++) sout[(size_t)(8 * q + i) * 128 + cl] = s[i];
  }
}

__device__ __forceinline__ void scan_block_rw(PP pp, int j, char* smem) {
  LAUNDER_PP;
  const int seq = j >> 6, jj = j & 63;
  const int tid = tid_l(), q = tid & 15;
  const int head = jj >> 2, v = (jj & 3) * 16 + (tid >> 4);
  float4 S = make_float4(0.f, 0.f, 0.f, 0.f);
  for (int seg = 0; seg < NSEG; seg++) {
    wait_ge(((unsigned int*)(p.ws + OW_sync)) + SW_PRE, seg + 1);
    const int len = seg == 0 ? 528 : TS;
    const int row0 = slot_row0(seg) + (seg == 0 ? seq * 528 : seq * TS);
    rw_scan_run(((char*)(p.ws + OW_RWS)) + ((size_t)row0 * 16 + head) * 1024, len, S,
                ((float*)(p.ws + OW_YRW)) + (size_t)row0 * DM + head * 64 + v, q, v, smem);
    signal_scan_done((unsigned int*)(p.ws + OW_sync), seg);
  }
  {
    const int tid2 = tid_l(), q2 = tid2 & 15, v2 = (jj & 3) * 16 + (tid2 >> 4);
    *(float4*)((p.out + OO_p_wkv) + ((size_t)seq * 16 + head) * 4096 + v2 * 64 + 4 * q2) = S;
  }
}
__device__ __forceinline__ void scan_block_gd(PP pp, int j, char* smem) {
  LAUNDER_PP;
  const int seq = j >> 6, jj = j & 63;
  const int tid = tid_l(), q = tid & 15;
  const int head = jj >> 3, cl = (jj & 7) * 16 + (tid >> 4);
  float s[8];
#pragma unroll
  for (int i = 0; i < 8; i++) s[i] = 0.f;
  for (int seg = 0; seg < NSEG; seg++) {
    wait_ge(((unsigned int*)(p.ws + OW_sync)) + SW_PRE, seg + 1);
    const int len = seg == 0 ? 528 : TS;
    const int row0 = slot_row0(seg) + (seg == 0 ? seq * 528 : seq * TS);
    gd_scan_run(((char*)(p.ws + OW_GDS)) + ((size_t)row0 * 8 + head) * GDS_HB, len, s,
                ((float*)(p.ws + OW_OGD)) + (size_t)row0 * DM + head * 128 + cl, q, cl, smem);
    signal_scan_done((unsigned int*)(p.ws + OW_sync), seg);
  }
  {
    const int tid2 = tid_l(), q2 = tid2 & 15, cl2 = (jj & 7) * 16 + (tid2 >> 4);
    float* sout = (p.out + OO_p_ssm) + ((size_t)seq * 8 + head) * 16384;
#pragma unroll
    for (int i = 0; i < 8; i++) sout[(size_t)(8 * q2 + i) * 128 + cl2] = s[i];
  }
}

__device__ __forceinline__ void post_item(PP pp, int seg, int row) {
  LAUNDER_PP;
  const int tid = tid_l(), c4 = tid * 4;
  const int srow = slot_row0(seg) + row;
  const bf16_t* gt = ((bf16_t*)(p.ws + OW_GT)) + (size_t)(gt_row0(seg) + row) * GTW;
  {
    float4 y = *(const float4*)(((float*)(p.ws + OW_YRW)) + (size_t)srow * DM + c4);
    float mean = rowsum16(y.x + y.y + y.z + y.w) * (1.0f / 64.0f);
    float dx = y.x - mean, dy = y.y - mean, dz = y.z - mean, dw = y.w - mean;
    float var = rowsum16(dx * dx + dy * dy + dz * dz + dw * dw) * (1.0f / 64.0f);
    float rs = rsqrtf(var + 64e-5f);
    float4 lw = *(const float4*)(p.rw_ln_w + c4), lb = *(const float4*)(p.rw_ln_b + c4);
    float bon = ((float*)(p.ws + OW_RWB))[(size_t)srow * 16 + (tid >> 4)];
    float4 v = *(const float4*)(((char*)(p.ws + OW_RWS)) + ((size_t)srow * 16 + (tid >> 4)) * 1024 + 768 + (tid & 15) * 16);
    uint2 g = *(const uint2*)(gt + G_RW + c4);
    float o0 = (dx * rs * lw.x + lb.x + bon * v.x) * siluf_(bf2f(g.x & 0xffff));
    float o1 = (dy * rs * lw.y + lb.y + bon * v.y) * siluf_(bf2f(g.x >> 16));
    float o2 = (dz * rs * lw.z + lb.z + bon * v.z) * siluf_(bf2f(g.y & 0xffff));
    float o3 = (dw * rs * lw.w + lb.w + bon * v.w) * siluf_(bf2f(g.y >> 16));
    *(uint2*)(((bf16_t*)(p.ws + OW_YA)) + (size_t)(seg & 1) * MP0 * DM + blk_off(row, c4)) = make_uint2(pack2(o0, o1), pack2(o2, o3));
  }
  {
    float4 o = *(const float4*)(((float*)(p.ws + OW_OGD)) + (size_t)srow * DM + c4);
    float ss = rowsum16(o.x * o.x + o.y * o.y + o.z * o.z + o.w * o.w);
    ss += __shfl_xor(ss, 16);
    float rs = rsqrtf(ss * (1.0f / 128.0f) + 1e-6f);
    float4 nw = *(const float4*)(p.gd_norm_w + (c4 & 127));
    uint2 g = *(const uint2*)(gt + G_GD + c4);
    float o0 = o.x * rs * nw.x * siluf_(bf2f(g.x & 0xffff));
    float o1 = o.y * rs * nw.y * siluf_(bf2f(g.x >> 16));
    float o2 = o.z * rs * nw.z * siluf_(bf2f(g.y & 0xffff));
    float o3 = o.w * rs * nw.w * siluf_(bf2f(g.y >> 16));
    *(uint2*)(((bf16_t*)(p.ws + OW_YB)) + (size_t)(seg & 1) * MP0 * DM + blk_off(row, c4)) = make_uint2(pack2(o0, o1), pack2(o2, o3));
  }
}

#define SMEM_BYTES (32768 + 32)

__global__ void __launch_bounds__(256, 4) k_mega(Params p_arg) {
  PP pp = (PP)__builtin_amdgcn_kernarg_segment_ptr();
  __shared__ __attribute__((aligned(16))) char smem[SMEM_BYTES];
  cg::grid_group grid = cg::this_grid();
  const int bid = blockIdx.x, nb = gridDim.x;
  unsigned* sync = (unsigned*)(p.ws + OW_sync);
  const unsigned xcc = xcc_id() & 7u;
  if (threadIdx.x == 0) xb_add(&sync[bid >= NSCAN ? SW_XCNT(xcc) : SW_SCNT(xcc)], 1u);
  phase_weights(pp, bid, nb, smem);
  for (int it = bid; it < seg_MP(0) / 4; it += nb) xn_item(pp, 0, it);
  grid.sync();
  if (bid < NSCAN) {
    __builtin_amdgcn_s_setprio(3);
    if (bid < 128) scan_block_rw(pp, bid, smem);
    else scan_block_gd(pp, bid - 128, smem);
    return;
  }
  const int w = bid - NSCAN, NW = nb - NSCAN;
  unsigned* cfg = (unsigned*)(smem + 32768);
  if (threadIdx.x == 0) {
    unsigned mine = 0, nx = 0;
#pragma unroll
    for (unsigned j = 0; j < 8; j++) { unsigned c = xb_ld(&sync[SW_XCNT(j)]); nx += c > 0u ? 1u : 0u; mine = (j == xcc) ? c : mine; }
    cfg[0] = mine > 0u ? mine : 1u;
    cfg[1] = nx > 0u ? nx : 1u;
  }
  __syncthreads();
  for (int i = 0; i < NSEG + 5; i++) {
    const int sm = i - 4, snn = i - 5, sj = i - 3, so = i - 4, sp = i - 2;
    const bool front = i < NSEG;
    const bool mrg = sm >= 0 && sm < NSEG, nrm = snn >= 0 && snn < NSEG, back = sj >= 0 && sj < NSEG, outv = so >= 0 && so < NSEG,
               pst = sp >= 0 && sp < NSEG;
    {
      const int tmF = front ? seg_MP(i) / 128 : 1;
      const int nF = front ? tmF * (VW / 128) : 0;
      const int nM = mrg ? seg_MP(sm) / 4 : 0;
      const int nN = nrm ? seg_M(snn) / 4 : 0;
      if ((NW & 7) == 0) {
        const int x = w & 7, per = NW >> 3;
        const int ncol = front ? ((VW / 128 - x + 7) >> 3) : 0;
        for (int j = w >> 3; j < tmF * ncol; j += per) gemm_tile<0>(pp, i, j % tmF, x + 8 * (j / tmF), smem);
        for (int it = w; it < nM + nN; it += NW) {
          if (it < nM) merge_item(pp, it);
          else norm_item(pp, snn, it - nM);
        }
      } else {
        for (int it = w; it < nF + nM + nN; it += NW) {
          int t = it;
          if (t < nF) { gemm_tile<0>(pp, i, t % tmF, t / tmF, smem); continue; }
          t -= nF;
          if (t < nM) { merge_item(pp, t); continue; }
          t -= nM;
          norm_item(pp, snn, t);
        }
      }
      if (i == 1) {
        for (int it = w; it < 32 * 128; it += NW) sample_scan_task(pp, it, smem);
      }
    }
    if (threadIdx.x == 0)
      ((unsigned*)(smem + 32768))[4] = (pst && xb_ld((unsigned*)(p.ws + OW_sync) + SW_SCAN(sp)) >= (unsigned)NSCAN) ? 1u : 0u;
    if (i != NSEG + 4) worker_barrier((unsigned*)(p.ws + OW_sync), (const unsigned*)(smem + 32768));
    {
      const int nB = back ? (seg_MP(sj) / 128) * 8 : 0;
      const int nO = outv ? (seg_MP(so) / 128) * 8 : 0;
      const int nHeavy = 2 * nB + nO;
      const int nHeavyW = nHeavy < NW / 2 ? nHeavy : NW / 2;
      const int NL = NW - nHeavyW;
      const int ngrp = front ? seg_M(i) / 16 : 0;
      const int nRW = ngrp * 8, nGD = ngrp * 6;
      const int nX = (i + 1 < NSEG) ? seg_MP(i + 1) / 4 : 0;
      const int tot = nRW + nGD + nX;
      if (w >= NL) {
        for (int it = w - NL; it < nHeavy; it += nHeavyW) {
          int t = it;
          if (t < nB) { gemm_tile<1>(pp, sj, t >> 3, t & 7, smem); continue; }
          t -= nB;
          if (t < nB) { gemm_tile<3>(pp, sj, t >> 3, t & 7, smem); continue; }
          t -= nB;
          gemm_tile<2>(pp, so, t >> 3, t & 7, smem);
        }
      } else {
        for (int it = w; it < tot; it += NL) {
          int t = it;
          if (t < nRW) { rw_prepass_item(pp, i, t >> 2, t & 3, smem); continue; }
          t -= nRW;
          if (t < nGD) { gd_prepass_item(pp, i, t / 6, t % 6); continue; }
          t -= nGD;
          xn_item(pp, i + 1, t);
        }
      }
      if (pst) {
        if (!__builtin_amdgcn_readfirstlane((int)((const unsigned*)(smem + 32768))[4]))
          wait_ge((unsigned*)(p.ws + OW_sync) + SW_SCAN(sp), NSCAN);
        const int n = seg_M(sp);
        for (int it = w; it < n; it += NW) post_item(pp, sp, it);
      }
    }
    if (i != NSEG + 4) worker_barrier((unsigned*)(p.ws + OW_sync), (const unsigned*)(smem + 32768));
    if (front && w == 0 && threadIdx.x == 0)
      __hip_atomic_store((unsigned*)(p.ws + OW_sync) + SW_PRE, (unsigned)(i + 1), __ATOMIC_RELAXED, __HIP_MEMORY_SCOPE_AGENT);
  }
}

static inline size_t align_up(size_t x) { return (x + 255) & ~(size_t)255; }

#undef p
extern "C" void kernel_launch(void* const* d_in, const int* in_sizes, int n_in, void* d_out, int out_size, void* d_ws,
                              size_t ws_size, hipStream_t stream) {
  Params p{};
  const float* const* in = (const float* const*)d_in;
  p.x_prompt = in[0]; p.x_sample = in[1]; p.st_shift = in[2]; p.st_wkv = in[3]; p.st_conv = in[4]; p.st_ssm = in[5];
  p.meta = in[6]; p.norm_pre = in[7]; p.w_in = in[8]; p.rw_mu = in[9]; p.rw_w0 = in[10]; p.rw_w2 = in[11];
  p.rw_a0 = in[12]; p.rw_a2 = in[13]; p.rw_k_k = in[14]; p.rw_k_a = in[15]; p.rw_r_k = in[16]; p.rw_ln_w = in[17];
  p.rw_ln_b = in[18]; p.gd_conv_w = in[19]; p.gd_a_log = in[20]; p.gd_dt_bias = in[21]; p.gd_norm_w = in[22];
  p.w_out_a = in[23]; p.w_out_b = in[24]; p.w_out = in[25]; p.norm_post = in[26];
  p.out = (float*)d_out;
  p.ws = (char*)d_ws;
  if (OW_END > ws_size) { fprintf(stderr, "workspace too small: need %zu have %zu\n", (size_t)OW_END, ws_size); return; }

  static int grid_blocks = 0;
  if (!grid_blocks) {
    int dev = 0, cus = 0, per_cu = 0;
    (void)hipGetDevice(&dev);
    (void)hipDeviceGetAttribute(&cus, hipDeviceAttributeMultiprocessorCount, dev);
    (void)hipOccupancyMaxActiveBlocksPerMultiprocessor(&per_cu, k_mega, 256, 0);
    if (per_cu > 4) per_cu = 4;
    grid_blocks = cus * per_cu;
  }
  (void)hipMemsetAsync(p.ws + OW_sync, 0, 16384, stream);
  void* args[] = {&p};
  hipError_t e = hipLaunchCooperativeKernel((void*)k_mega, dim3(grid_blocks), dim3(256), args, 0, stream);
  if (e != hipSuccess) fprintf(stderr, "cooperative launch failed: %s (grid %d)\n", hipGetErrorString(e), grid_blocks);
}
```
